# Optimizing an MI355X kernel written in HIP

```python
import jax, jax.numpy as jnp
from jax import lax
import numpy as np

D_MODEL = 2048
BATCH = 1
SEQ = 8192
DEPTH = 4
DEC_BATCH = 8
DEC_SEQ = 64
PAST_LEN = 2048

CHUNK = 64
D_MIX = D_MODEL
D_A = D_MIX // 2
D_B = D_MIX - D_A
HGRN_DK = 128
H_A = D_A // HGRN_DK
HGRN_DV = D_A // H_A
H_B = 4
RET_DK = D_B // H_B
RET_DV = D_B // H_B
D_FF = 4 * D_MODEL
N_PROJ = 4 * D_A + 4 * D_B
N_MOD = 6
EPS = 1e-6
ROPE_BASE = 10000.0

kernel_name = "hymba_hgrn2_retention_stream_step"


def rms_norm(x, g):
    xf = x.astype(jnp.float32)
    y = xf * lax.rsqrt(jnp.mean(xf * xf, axis=-1, keepdims=True) + EPS)
    return y * g.astype(jnp.float32)


def to_chunks(t, c):
    b, l, h, d = t.shape
    return t.reshape(b, l // c, c, h, d).transpose(1, 0, 3, 2, 4)


def from_chunks(t):
    n, b, h, c, d = t.shape
    return t.transpose(1, 0, 3, 2, 4).reshape(b, n * c, h, d)


def rope(x, pos):
    half = x.shape[-1] // 2
    inv_freq = 1.0 / (ROPE_BASE ** jnp.linspace(0.0, 1.0, half, dtype=jnp.float32))
    ang = pos[:, None] * inv_freq[None, :]
    cos = jnp.cos(ang)[None, :, None, :]
    sin = jnp.sin(ang)[None, :, None, :]
    x1, x2 = x[..., :half], x[..., half:]
    return jnp.concatenate([x1 * cos - x2 * sin, x2 * cos + x1 * sin], axis=-1)


def hgrn2_chunkwise(q, k, v, log_f, s0):
    L = q.shape[1]
    c = min(CHUNK, L)
    mask = jnp.tril(jnp.ones((c, c), dtype=bool))
    xs = (to_chunks(q, c), to_chunks(k, c), to_chunks(v, c), to_chunks(log_f, c))

    def step(S, inp):
        qc, kc, vc, gc = inp
        b = jnp.cumsum(gc, axis=2)
        o_inter = jnp.einsum('bhtk,bhkv->bhtv', qc * jnp.exp(b), S)
        diff = b[:, :, :, None, :] - b[:, :, None, :, :]
        decay = jnp.exp(jnp.where(mask[None, None, :, :, None], diff, -jnp.inf))
        A = jnp.einsum('bhtk,bhsk,bhtsk->bhts', qc, kc, decay)
        o = o_inter + jnp.einsum('bhts,bhsv->bhtv', A, vc)
        b_last = b[:, :, -1:, :]
        S_new = jnp.exp(b_last[:, :, 0, :])[..., None] * S + jnp.einsum('bhsk,bhsv->bhkv', kc * jnp.exp(b_last - b), vc)
        return S_new, o

    s_final, o = lax.scan(step, s0.astype(jnp.float32), xs)
    return from_chunks(o), s_final


def retention_chunkwise(q, k, v, log_gamma, s0):
    L = q.shape[1]
    c = min(CHUNK, L)
    idx = jnp.arange(c, dtype=jnp.float32)
    lg = log_gamma[:, None, None]
    dmat = jnp.where(jnp.tril(jnp.ones((c, c), dtype=bool))[None],
                     jnp.exp((idx[:, None] - idx[None, :])[None] * lg), 0.0)
    xi = jnp.exp((idx + 1.0)[None, :] * log_gamma[:, None])[..., None]
    zeta = jnp.exp((c - 1.0 - idx)[None, :] * log_gamma[:, None])[..., None]
    g_c = jnp.exp(c * log_gamma)[:, None, None]
    xs = (to_chunks(q, c), to_chunks(k, c), to_chunks(v, c))

    def step(S, inp):
        qc, kc, vc = inp
        A = jnp.einsum('bhtk,bhsk->bhts', qc, kc) * dmat
        o = jnp.einsum('bhts,bhsv->bhtv', A, vc) + jnp.einsum('bhtk,bhkv->bhtv', qc, S) * xi
        S_new = g_c * S + jnp.einsum('bhsk,bhsv->bhkv', kc * zeta, vc)
        return S_new, o

    s_final, o = lax.scan(step, s0.astype(jnp.float32), xs)
    return from_chunks(o), s_final


def mixer(h, pos, s_a, s_b, lb, w_in, g_hn, g_rn, w_out, log_gamma):
    B, L, _ = h.shape
    proj = (h.astype(w_in.dtype) @ w_in).astype(jnp.float32)
    cuts = [D_A, 2 * D_A, 3 * D_A, 4 * D_A, 4 * D_A + D_B, 4 * D_A + 2 * D_B, 4 * D_A + 3 * D_B]
    qa, fa, ia, ga, qb, kb, vb, gb = jnp.split(proj, cuts, axis=-1)
    q_a = jax.nn.silu(qa.reshape(B, L, H_A, HGRN_DK))
    lb_h = lb.astype(jnp.float32).reshape(H_A, HGRN_DK)
    f = lb_h + (1.0 - lb_h) * jax.nn.sigmoid(fa.reshape(B, L, H_A, HGRN_DK))
    o_a, s_a_new = hgrn2_chunkwise(q_a, 1.0 - f, ia.reshape(B, L, H_A, HGRN_DV), jnp.log(f), s_a)
    o_a = rms_norm(o_a, g_hn.reshape(H_A, HGRN_DV)) * jax.nn.silu(ga.reshape(B, L, H_A, HGRN_DV))
    q_b = rope(qb.reshape(B, L, H_B, RET_DK), pos)
    k_b = rope(kb.reshape(B, L, H_B, RET_DK), pos) * (RET_DK ** -0.5)
    o_b, s_b_new = retention_chunkwise(q_b, k_b, vb.reshape(B, L, H_B, RET_DV), log_gamma, s_b)
    o_b = rms_norm(o_b, g_rn.reshape(H_B, RET_DV)) * jax.nn.silu(gb.reshape(B, L, H_B, RET_DV))
    o = jnp.concatenate([o_a.reshape(B, L, D_A), o_b.reshape(B, L, D_B)], axis=-1)
    return o.astype(w_out.dtype) @ w_out, s_a_new, s_b_new


def trunk(x, c, pos, s_a, s_b, lb_all, log_gamma, w_ada, b_ada, norm1_g, norm2_g, w_in,
          hgrn_norm_g, ret_norm_g, w_out, w_up, w_down, final_g):
    new_a, new_b = [], []
    c_act = jax.nn.silu(c.astype(jnp.float32))
    for l in range(DEPTH):
        mod = c_act @ w_ada[l].astype(jnp.float32) + b_ada[l].astype(jnp.float32)
        sh1, sc1, gt1, sh2, sc2, gt2 = [m[:, None, :] for m in jnp.split(mod, N_MOD, axis=-1)]
        h = rms_norm(x, norm1_g[l]) * (1.0 + sc1) + sh1
        o, sa, sb = mixer(h, pos, s_a[l], s_b[l], lb_all[l], w_in[l], hgrn_norm_g[l], ret_norm_g[l], w_out[l], log_gamma)
        x = (x.astype(jnp.float32) + gt1 * o.astype(jnp.float32)).astype(x.dtype)
        new_a.append(sa)
        new_b.append(sb)
        h = rms_norm(x, norm2_g[l]) * (1.0 + sc2) + sh2
        u = jnp.square(jax.nn.relu(h.astype(w_up.dtype) @ w_up[l]))
        y = u @ w_down[l]
        x = (x.astype(jnp.float32) + gt2 * y.astype(jnp.float32)).astype(x.dtype)
    y_out = rms_norm(x, final_g).astype(x.dtype)
    return y_out, jnp.stack(new_a, axis=0), jnp.stack(new_b, axis=0)


def setup_inputs(seed: int = 0) -> dict:
    key = jax.random.key(seed)
    ks = jax.random.split(key, 20)
    f32 = jnp.float32
    nrm = lambda k, shape, s: jax.random.normal(k, shape, f32) * s
    return {
        "x_prompt": nrm(ks[0], (BATCH, SEQ, D_MODEL), 1.0),
        "x_sample": nrm(ks[1], (DEC_BATCH, DEC_SEQ, D_MODEL), 1.0),
        "state_hgrn": nrm(ks[2], (DEPTH, DEC_BATCH, H_A, HGRN_DK, HGRN_DV), 0.5),
        "state_ret": nrm(ks[3], (DEPTH, DEC_BATCH, H_B, RET_DK, RET_DV), 0.5),
        "c_prompt": nrm(ks[4], (BATCH, D_MODEL), 1.0),
        "c_sample": nrm(ks[5], (DEC_BATCH, D_MODEL), 1.0),
        "lb_logits": nrm(ks[6], (DEPTH, D_A), 0.5),
        "w_ada": nrm(ks[7], (DEPTH, D_MODEL, N_MOD * D_MODEL), 0.5 * D_MODEL ** -0.5),
        "b_ada": nrm(ks[8], (DEPTH, N_MOD * D_MODEL), 0.02),
        "norm1_g": 1.0 + nrm(ks[9], (DEPTH, D_MODEL), 0.02),
        "norm2_g": 1.0 + nrm(ks[10], (DEPTH, D_MODEL), 0.02),
        "w_in": nrm(ks[11], (DEPTH, D_MODEL, N_PROJ), D_MODEL ** -0.5),
        "hgrn_norm_g": 1.0 + nrm(ks[12], (DEPTH, D_A), 0.02),
        "ret_norm_g": 1.0 + nrm(ks[13], (DEPTH, D_B), 0.02),
        "w_out": nrm(ks[14], (DEPTH, D_MIX, D_MODEL), D_MIX ** -0.5),
        "w_up": nrm(ks[15], (DEPTH, D_MODEL, D_FF), D_MODEL ** -0.5),
        "w_down": nrm(ks[16], (DEPTH, D_FF, D_MODEL), D_FF ** -0.5),
        "final_g": 1.0 + nrm(ks[17], (D_MODEL,), 0.02),
    }


def reference(x_prompt, x_sample, state_hgrn, state_ret, c_prompt, c_sample, lb_logits, w_ada, b_ada,
              norm1_g, norm2_g, w_in, hgrn_norm_g, ret_norm_g, w_out, w_up, w_down, final_g):
    p = jax.nn.softmax(lb_logits.astype(jnp.float32), axis=0)
    cs = jnp.cumsum(p, axis=0)
    lb_all = cs - cs[0:1]
    log_gamma = jnp.log1p(-jnp.exp2(-5.0 - jnp.arange(H_B, dtype=jnp.float32)))
    weights = (w_ada, b_ada, norm1_g, norm2_g, w_in, hgrn_norm_g, ret_norm_g, w_out, w_up, w_down, final_g)
    bp, lp = x_prompt.shape[0], x_prompt.shape[1]
    ls = x_sample.shape[1]
    pos_p = jnp.arange(lp, dtype=jnp.float32)
    pos_s = PAST_LEN + jnp.arange(ls, dtype=jnp.float32)
    zeros_a = jnp.zeros((DEPTH, bp, H_A, HGRN_DK, HGRN_DV), jnp.float32)
    zeros_b = jnp.zeros((DEPTH, bp, H_B, RET_DK, RET_DV), jnp.float32)
    y_prompt, sa_p, sb_p = trunk(x_prompt, c_prompt, pos_p, zeros_a, zeros_b, lb_all, log_gamma, *weights)
    y_sample, sa_s, sb_s = trunk(x_sample, c_sample, pos_s, state_hgrn, state_ret, lb_all, log_gamma, *weights)
    return (y_prompt, y_sample, sa_p, sb_p, sa_s, sb_s)
```

```cpp
#include <hip/hip_runtime.h>
#include <cstdio>
#include <cstdint>
__device__ __forceinline__ int row_pos(int row) { return row < 8192 ? row : 2048 + ((row - 8192) & 63); }
__device__ __forceinline__ int row_seq(int row) { return row < 8192 ? 0 : 1 + ((row - 8192) >> 6); }
namespace pg8 {
#define PG8_LAS __attribute__((address_space(3)))
typedef unsigned short bf16_t;
typedef short bf16x8 __attribute__((ext_vector_type(8)));
typedef float f32x4 __attribute__((ext_vector_type(4)));
typedef unsigned u32x4 __attribute__((ext_vector_type(4)));
typedef unsigned u32x2 __attribute__((ext_vector_type(2)));
constexpr int BM = 256, BK = 64, HALF = 128, HTB = HALF * BK * 2  , STAGE_BYTES = 8 * HTB, NXCD = 8, WGM = 8;

__host__ __device__ __forceinline__ int lds_byte(int r, int c) { const int st = (r >> 4) * 2 + (c >> 5), rr = r & 15, cc = c & 31, ob = rr * 64 + cc * 2; return st * 1024 + (ob ^ (((ob >> 9) & 1) << 5)); }
__host__ __device__ __forceinline__ void stage_rc(int b, int& R, int& C) { const int st = b / 1024, sb = b % 1024, swz = sb ^ (((sb >> 9) & 1) << 5); R = (st >> 1) * 16 + swz / 64; C = (st & 1) * 32 + (swz % 64) / 2; }
__host__ __device__ __forceinline__ int perm32(int rho) { const int n = rho >> 4, i = rho & 15; return 8 * (i >> 2) + 4 * n + (i & 3); }

struct Unit { int pm, pn; };
struct Gemm { const bf16_t* A; const bf16_t* Bt; int M, N, K; };

struct StaticOrder {
    int nM, nN, nwg, G, c;
    __host__ __device__ void init(int M, int N, int G_, int c_) { nM = M / BM; nN = N / BM; nwg = nM * nN; G = G_; c = c_; }
    __host__ __device__ bool next(int i, Unit& u) const {
        const long L = (long)i * G + c; if (L >= nwg) return false;
        int wgid = (int)L; { const int q = nwg / NXCD, r = nwg % NXCD, xcd = wgid % NXCD, off = wgid / NXCD; wgid = (xcd < r ? xcd * (q + 1) : r * (q + 1) + (xcd - r) * q) + off; }
        const int nig = WGM * nN, gid = wgid / nig, fm = gid * WGM, gsz = (nM - fm) < WGM ? (nM - fm) : WGM;
        u.pm = fm + ((wgid % nig) % gsz); u.pn = (wgid % nig) / gsz; return true;
    }
    __device__ __forceinline__ void a_ready(const Unit&) const {}
    __device__ __forceinline__ void done(const Unit&) const {}
};

__device__ __forceinline__ unsigned cvt_pk_bf16(float lo, float hi) { unsigned r; asm volatile("v_cvt_pk_bf16_f32 %0, %1, %2" : "=v"(r) : "v"(lo), "v"(hi)); return r; }
__device__ __forceinline__ float fast_rcp(float x) { return __builtin_amdgcn_rcpf(x); }
__device__ __forceinline__ float silu_f(float x) { return x * fast_rcp(1.0f + __expf(-x)); }

struct EpiInProj {
    static constexpr bool PERM = true, AFTER_DRAIN = false;
    bf16_t* P; float* LF; const float* lb; const float* rc; const float* rs;
    __device__ __forceinline__ void operator()(const f32x4 (&acc)[2][2][4][2], const Unit& u, int wr, int wc, int fr, int fq) const {
        const int seg = u.pn >> 2;
        const int row0 = u.pm * BM + wr * 64 + fr;
        const int colg0 = u.pn * BM + wc * 32 + 8 * fq;
        if (seg == 4 || seg == 5) {
            const float ksc = (seg == 5) ? 0.0625f : 1.0f;
            const int j0 = wc * 32 + 8 * fq;
#pragma unroll
            for (int ai = 0; ai < 2; ++ai)
#pragma unroll
                for (int m = 0; m < 4; ++m) {
                    const int row = row0 + ai * HALF + m * 16; const int pos = row_pos(row);
                    const f32x4 c0 = *(const f32x4*)(rc + (size_t)pos * 128 + j0), c1 = *(const f32x4*)(rc + (size_t)pos * 128 + j0 + 4);
                    const f32x4 s0 = *(const f32x4*)(rs + (size_t)pos * 128 + j0), s1 = *(const f32x4*)(rs + (size_t)pos * 128 + j0 + 4);
                    const f32x4 x1a = acc[ai][0][m][0], x1b = acc[ai][0][m][1], x2a = acc[ai][1][m][0], x2b = acc[ai][1][m][1];
                    const f32x4 o1a = (x1a * c0 - x2a * s0) * ksc, o1b = (x1b * c1 - x2b * s1) * ksc;
                    const f32x4 o2a = (x2a * c0 + x1a * s0) * ksc, o2b = (x2b * c1 + x1b * s1) * ksc;
                    bf16_t* rowp = P + (size_t)row * 8192 + colg0;
                    u32x4 w; w.x = cvt_pk_bf16(o1a[0], o1a[1]); w.y = cvt_pk_bf16(o1a[2], o1a[3]); w.z = cvt_pk_bf16(o1b[0], o1b[1]); w.w = cvt_pk_bf16(o1b[2], o1b[3]);
                    *(u32x4*)(rowp) = w;
                    w.x = cvt_pk_bf16(o2a[0], o2a[1]); w.y = cvt_pk_bf16(o2a[2], o2a[3]); w.z = cvt_pk_bf16(o2b[0], o2b[1]); w.w = cvt_pk_bf16(o2b[2], o2b[3]);
                    *(u32x4*)(rowp + HALF) = w;
                }
        } else if (seg == 1) {
#pragma unroll
            for (int bj = 0; bj < 2; ++bj) {
                const int cs = colg0 + bj * HALF - 1024;
                const f32x4 lb0 = *(const f32x4*)(lb + cs), lb1 = *(const f32x4*)(lb + cs + 4);
#pragma unroll
                for (int ai = 0; ai < 2; ++ai)
#pragma unroll
                    for (int m = 0; m < 4; ++m) {
                        const int row = row0 + ai * HALF + m * 16;
                        f32x4 lf0, lf1, k0, k1;
#pragma unroll
                        for (int e = 0; e < 4; ++e) {
                            { const float x = acc[ai][bj][m][0][e], l = lb0[e]; const float sg = fast_rcp(1.0f + __expf(-x)), sn = fast_rcp(1.0f + __expf(x)); lf0[e] = __logf(l + (1.0f - l) * sg); k0[e] = (1.0f - l) * sn; }
                            { const float x = acc[ai][bj][m][1][e], l = lb1[e]; const float sg = fast_rcp(1.0f + __expf(-x)), sn = fast_rcp(1.0f + __expf(x)); lf1[e] = __logf(l + (1.0f - l) * sg); k1[e] = (1.0f - l) * sn; }
                        }
                        float* lfp = LF + (size_t)row * 1024 + cs; *(f32x4*)lfp = lf0; *(f32x4*)(lfp + 4) = lf1;
                        u32x4 w; w.x = cvt_pk_bf16(k0[0], k0[1]); w.y = cvt_pk_bf16(k0[2], k0[3]); w.z = cvt_pk_bf16(k1[0], k1[1]); w.w = cvt_pk_bf16(k1[2], k1[3]);
                        *(u32x4*)(P + (size_t)row * 8192 + colg0 + bj * HALF) = w;
                    }
            }
        } else {
            const bool act = (seg == 0 || seg == 3 || seg == 7);
#pragma unroll
            for (int ai = 0; ai < 2; ++ai)
#pragma unroll
                for (int m = 0; m < 4; ++m) { bf16_t* rowp = P + (size_t)(row0 + ai * HALF + m * 16) * 8192 + colg0;
#pragma unroll
                    for (int bj = 0; bj < 2; ++bj) { f32x4 v0 = acc[ai][bj][m][0], v1 = acc[ai][bj][m][1];
                        if (act) {
#pragma unroll
                            for (int e = 0; e < 4; ++e) { v0[e] = silu_f(v0[e]); v1[e] = silu_f(v1[e]); } }
                        u32x4 w; w.x = cvt_pk_bf16(v0[0], v0[1]); w.y = cvt_pk_bf16(v0[2], v0[3]); w.z = cvt_pk_bf16(v1[0], v1[1]); w.w = cvt_pk_bf16(v1[2], v1[3]);
                        *(u32x4*)(rowp + bj * HALF) = w; } }
        }
    }
};
struct EpiRelu2 {
    static constexpr bool PERM = true, AFTER_DRAIN = false;
    bf16_t* O; int ldc;
    __device__ __forceinline__ void operator()(const f32x4 (&acc)[2][2][4][2], const Unit& u, int wr, int wc, int fr, int fq) const {
        const int row0 = u.pm * BM + wr * 64 + fr, col0 = u.pn * BM + wc * 32 + 8 * fq;
#pragma unroll
        for (int ai = 0; ai < 2; ++ai)
#pragma unroll
            for (int m = 0; m < 4; ++m) { bf16_t* rowp = O + (size_t)(row0 + ai * HALF + m * 16) * ldc + col0;
#pragma unroll
                for (int bj = 0; bj < 2; ++bj) { f32x4 v0 = acc[ai][bj][m][0], v1 = acc[ai][bj][m][1];
#pragma unroll
                    for (int e = 0; e < 4; ++e) { const float a = fmaxf(v0[e], 0.f), b = fmaxf(v1[e], 0.f); v0[e] = a * a; v1[e] = b * b; }
                    u32x4 w; w.x = cvt_pk_bf16(v0[0], v0[1]); w.y = cvt_pk_bf16(v0[2], v0[3]); w.z = cvt_pk_bf16(v1[0], v1[1]); w.w = cvt_pk_bf16(v1[2], v1[3]);
                    *(u32x4*)(rowp + bj * HALF) = w; } }
    }
};
struct EpiResid {
    static constexpr bool PERM = false, AFTER_DRAIN = false;
    float* X; const float* gate; int seq_stride;
    __device__ __forceinline__ void operator()(const f32x4 (&acc)[2][2][4][2], const Unit& u, int wr, int wc, int fr, int fq) const {
        const int row0 = u.pm * BM + wr * 64 + fr, col0 = u.pn * BM + wc * 32 + 4 * fq;
#pragma unroll
        for (int ai = 0; ai < 2; ++ai) {
            const int sq = row_seq(u.pm * BM + wr * 64 + ai * HALF);
            const float* g = gate + (size_t)sq * seq_stride + col0;
            f32x4 gv[2][2];
#pragma unroll
            for (int bj = 0; bj < 2; ++bj)
#pragma unroll
                for (int n = 0; n < 2; ++n) gv[bj][n] = *(const f32x4*)(g + bj * HALF + n * 16);
#pragma unroll
            for (int m = 0; m < 4; ++m) { float* rowp = X + (size_t)(row0 + ai * HALF + m * 16) * 2048 + col0;
#pragma unroll
                for (int bj = 0; bj < 2; ++bj)
#pragma unroll
                    for (int n = 0; n < 2; ++n) { const f32x4 xv = *(const f32x4*)(rowp + bj * HALF + n * 16); *(f32x4*)(rowp + bj * HALF + n * 16) = xv + gv[bj][n] * acc[ai][bj][m][n]; }
                asm volatile("" ::: "memory"); }
        }
    }
};
template <class Epi, class Sched, bool ALIGN_EPI = false, bool SP2 = false>
__device__ __forceinline__ void gemm_phase(PG8_LAS unsigned char* lds, const Gemm g, const Sched& S, const Epi& E) {
    int tid_l = threadIdx.x; asm volatile("" : "+v"(tid_l));
    const int tid = tid_l, wid = __builtin_amdgcn_readfirstlane(tid >> 6), lane = tid & 63, wr = wid >> 2, wc = wid & 3, fr = lane & 15, fq = lane >> 4;
    const int K = g.K, nt = K / BK;
    unsigned voffA[2], voffB[2];
#pragma unroll
    for (int i = 0; i < 2; ++i) { int R, C; stage_rc(tid * 16 + i * 8192, R, C); const int Rb = Epi::PERM ? ((R & ~31) + perm32(R & 31)) : R;
        voffA[i] = (unsigned)(R * K + C) * 2u; voffB[i] = (unsigned)(Rb * K + C) * 2u; }
    const size_t kstep = (size_t)(BK * 2);
    const size_t hstep = (size_t)HALF * K * 2;
    const size_t tstep = 2 * hstep;
    const unsigned ldsw = (unsigned)wid * 1024u;
    const int aoff = lds_byte(wr * 64 + fr, fq * 8), boff = lds_byte(wc * 32 + fr, fq * 8);
#define PG8_SA(b, h) (((b) * 2 + (h)) * HTB)
#define PG8_SB(b, h) ((4 + (b) * 2 + (h)) * HTB)
#define PG8_STAGE(bufoff, gbase, voff) do { _Pragma("unroll") for (int _i = 0; _i < 2; ++_i) \
        __builtin_amdgcn_global_load_lds((const unsigned*)((const char*)(gbase) + (voff)[_i]), (PG8_LAS unsigned*)(lds + (bufoff) + ldsw + _i * 8192), 16, 0, 0); } while (0)
#define PG8_LDA(dst, b, h) do { _Pragma("unroll") for (int m = 0; m < 4; ++m) _Pragma("unroll") for (int k = 0; k < 2; ++k) dst[m][k] = *(const PG8_LAS bf16x8*)(lds + PG8_SA(b, h) + aoff + m * 2048 + k * 1024); } while (0)
#define PG8_LDB(dst, b, h) do { _Pragma("unroll") for (int n = 0; n < 2; ++n) _Pragma("unroll") for (int k = 0; k < 2; ++k) dst[n][k] = *(const PG8_LAS bf16x8*)(lds + PG8_SB(b, h) + boff + n * 2048 + k * 1024); } while (0)
#define PG8_MMA(ai, bj, At, Bt) do { __builtin_amdgcn_s_setprio(1); _Pragma("unroll") for (int m = 0; m < 4; ++m) _Pragma("unroll") for (int n = 0; n < 2; ++n) _Pragma("unroll") for (int k = 0; k < 2; ++k) \
        acc[ai][bj][m][n] = __builtin_amdgcn_mfma_f32_16x16x32_bf16(Bt[n][k], At[m][k], acc[ai][bj][m][n], 0, 0, 0); __builtin_amdgcn_s_setprio(0); } while (0)
#define PG8_WAIT_V(n) asm volatile("s_waitcnt vmcnt(" #n ")" ::: "memory")
#define PG8_WAIT_L(n) asm volatile("s_waitcnt lgkmcnt(" #n ")" ::: "memory")
#define PG8_BAR __builtin_amdgcn_s_barrier()
#define PG8_SCHED __builtin_amdgcn_sched_barrier(0)
    Unit cur, nxt; int ui = 0;
    if (!S.next(0, cur)) return;
    f32x4 acc[2][2][4][2];
#pragma unroll
    for (int a = 0; a < 2; ++a)
#pragma unroll
        for (int b = 0; b < 2; ++b)
#pragma unroll
            for (int m = 0; m < 4; ++m)
#pragma unroll
                for (int n = 0; n < 2; ++n) acc[a][b][m][n] = (f32x4){0.f, 0.f, 0.f, 0.f};
    bf16x8 At[4][2], B0[2][2], B1[2][2];
    const char* cA = (const char*)g.A + (size_t)cur.pm * tstep; const char* cB = (const char*)g.Bt + (size_t)cur.pn * tstep;
    S.a_ready(cur);
    if constexpr (SP2) {
        PG8_STAGE(PG8_SB(0, 0), cB, voffB); PG8_STAGE(PG8_SB(0, 1), cB + hstep, voffB); PG8_STAGE(PG8_SA(0, 0), cA, voffA); PG8_STAGE(PG8_SA(0, 1), cA + hstep, voffA);
        if (wr == 1) PG8_BAR;
        PG8_WAIT_V(2); PG8_BAR;
        PG8_STAGE(PG8_SB(1, 0), cB + kstep, voffB); PG8_STAGE(PG8_SA(1, 0), cA + kstep, voffA); PG8_STAGE(PG8_SB(1, 1), cB + hstep + kstep, voffB);
        PG8_WAIT_V(6); PG8_BAR;
    } else {
        PG8_STAGE(PG8_SB(0, 0), cB, voffB); PG8_STAGE(PG8_SA(0, 0), cA, voffA); PG8_STAGE(PG8_SB(0, 1), cB + hstep, voffB); PG8_STAGE(PG8_SA(0, 1), cA + hstep, voffA);
        if (wr == 1) PG8_BAR;
        PG8_WAIT_V(4); PG8_BAR;
        PG8_STAGE(PG8_SB(1, 0), cB + kstep, voffB); PG8_STAGE(PG8_SA(1, 0), cA + kstep, voffA); PG8_STAGE(PG8_SB(1, 1), cB + hstep + kstep, voffB);
        PG8_WAIT_V(6); PG8_BAR;
    }
    for (;;) {
        const bool has_next = S.next(ui + 1, nxt);
        const char* nA = has_next ? (const char*)g.A + (size_t)nxt.pm * tstep : cA; const char* nB = has_next ? (const char*)g.Bt + (size_t)nxt.pn * tstep : cB;
        for (int t = 0; t < nt; t += 2) {
            const bool last = (t == nt - 2);
            const char* a1 = cA + (size_t)(t + 1) * kstep;
            const char* a2 = last ? nA : cA + (size_t)(t + 2) * kstep; const char* b2 = last ? nB : cB + (size_t)(t + 2) * kstep;
            const char* a3 = a2 + kstep; const char* b3 = b2 + kstep;
            if (last && has_next) S.a_ready(nxt);
            if constexpr (SP2) {
            PG8_LDB(B0, 0, 0); PG8_LDB(B1, 0, 1); PG8_SCHED; PG8_LDA(At, 0, 0); PG8_STAGE(PG8_SA(1, 1), a1 + hstep, voffA);
            PG8_WAIT_V(8); PG8_WAIT_L(0); PG8_BAR; PG8_MMA(0, 0, At, B0); PG8_MMA(0, 1, At, B1); PG8_BAR; PG8_SCHED;
            PG8_LDA(At, 0, 1); PG8_STAGE(PG8_SB(0, 0), b2, voffB); PG8_STAGE(PG8_SB(0, 1), b2 + hstep, voffB); PG8_STAGE(PG8_SA(0, 0), a2, voffA);
            PG8_WAIT_V(8); PG8_WAIT_L(0); PG8_BAR; PG8_MMA(1, 0, At, B0); PG8_MMA(1, 1, At, B1); PG8_BAR; PG8_SCHED;
            PG8_LDB(B0, 1, 0); PG8_LDB(B1, 1, 1); PG8_SCHED; PG8_LDA(At, 1, 0); PG8_STAGE(PG8_SA(0, 1), a2 + hstep, voffA);
            PG8_WAIT_V(8); PG8_WAIT_L(0); PG8_BAR; PG8_MMA(0, 0, At, B0); PG8_MMA(0, 1, At, B1); PG8_BAR; PG8_SCHED;
            PG8_LDA(At, 1, 1); PG8_STAGE(PG8_SB(1, 0), b3, voffB); PG8_STAGE(PG8_SB(1, 1), b3 + hstep, voffB); PG8_STAGE(PG8_SA(1, 0), a3, voffA);
            PG8_WAIT_V(8); PG8_WAIT_L(0); PG8_BAR; PG8_MMA(1, 0, At, B0); PG8_MMA(1, 1, At, B1); PG8_BAR; PG8_SCHED;
            } else {
            PG8_LDB(B0, 0, 0); PG8_SCHED; PG8_LDA(At, 0, 0); PG8_STAGE(PG8_SA(1, 1), a1 + hstep, voffA);
            PG8_WAIT_L(8); PG8_BAR; PG8_WAIT_L(0); PG8_MMA(0, 0, At, B0); PG8_BAR; PG8_SCHED;
            PG8_LDB(B1, 0, 1); PG8_STAGE(PG8_SB(0, 0), b2, voffB);
            PG8_BAR; PG8_WAIT_L(0); PG8_MMA(0, 1, At, B1); PG8_BAR;
            PG8_LDA(At, 0, 1); PG8_STAGE(PG8_SA(0, 0), a2, voffA);
            PG8_BAR; PG8_WAIT_L(0); PG8_MMA(1, 0, At, B0); PG8_BAR; PG8_SCHED;
            PG8_STAGE(PG8_SB(0, 1), b2 + hstep, voffB);
            PG8_WAIT_V(6); PG8_BAR; PG8_MMA(1, 1, At, B1); PG8_BAR;
            PG8_LDB(B0, 1, 0); PG8_SCHED; PG8_LDA(At, 1, 0); PG8_STAGE(PG8_SA(0, 1), a2 + hstep, voffA);
            PG8_WAIT_L(8); PG8_BAR; PG8_WAIT_L(0); PG8_MMA(0, 0, At, B0); PG8_BAR; PG8_SCHED;
            PG8_LDB(B1, 1, 1); PG8_STAGE(PG8_SB(1, 0), b3, voffB);
            PG8_BAR; PG8_WAIT_L(0); PG8_MMA(0, 1, At, B1); PG8_BAR;
            PG8_LDA(At, 1, 1); PG8_STAGE(PG8_SA(1, 0), a3, voffA);
            PG8_BAR; PG8_WAIT_L(0); PG8_MMA(1, 0, At, B0); PG8_BAR; PG8_SCHED;
            PG8_STAGE(PG8_SB(1, 1), b3 + hstep, voffB);
            PG8_WAIT_V(6); PG8_BAR; PG8_MMA(1, 1, At, B1); PG8_BAR;
            }
        }
        if constexpr (ALIGN_EPI) { if (wr == 0) PG8_BAR; }
        if constexpr (!Epi::AFTER_DRAIN) { E(acc, cur, wr, wc, fr, fq); S.done(cur); }
        if (!has_next) break;
#pragma unroll
        for (int a = 0; a < 2; ++a)
#pragma unroll
            for (int b = 0; b < 2; ++b)
#pragma unroll
                for (int m = 0; m < 4; ++m)
#pragma unroll
                    for (int n = 0; n < 2; ++n) acc[a][b][m][n] = (f32x4){0.f, 0.f, 0.f, 0.f};
        cur = nxt; cA = nA; cB = nB; ++ui;
        if constexpr (ALIGN_EPI) { if (wr == 1) PG8_BAR; }
    }
    PG8_WAIT_V(0);
    if constexpr (!ALIGN_EPI) { if (wr == 0) PG8_BAR; }
    PG8_BAR;
    if constexpr (Epi::AFTER_DRAIN) { E.fused(acc, cur, wr, wc, fr, fq, lds, wid, lane); S.done(cur); }
#undef PG8_SA
#undef PG8_SB
#undef PG8_STAGE
#undef PG8_LDA
#undef PG8_LDB
#undef PG8_MMA
#undef PG8_WAIT_V
#undef PG8_WAIT_L
#undef PG8_BAR
#undef PG8_SCHED
}
}
constexpr int NWAVES = 8;
constexpr int DM = 2048, SEQ = 8192, DEPTH = 4, DECB = 8, DECS = 64, M = SEQ + DECB * DECS, NPROJ = 8192, DFF = 8192, NSEQ = 9, NMOD = 6 * DM;
constexpr int HA = 8, HB = 4;
constexpr float EPS = 1e-6f;
constexpr size_t OFF_SA_P = (size_t)M * DM, OFF_SB_P = OFF_SA_P + (size_t)DEPTH * HA * 128 * 128, OFF_SA_S = OFF_SB_P + (size_t)DEPTH * HB * 256 * 256,
                 OFF_SB_S = OFF_SA_S + (size_t)DEPTH * DECB * HA * 128 * 128, OUT_TOTAL = OFF_SB_S + (size_t)DEPTH * DECB * HB * 256 * 256;

constexpr size_t MiB = 1u << 20;
constexpr size_t WS_CTL = 0, CTL_ZERO_BYTES = 1 * MiB;
constexpr size_t WS_WIN = 2 * MiB;
constexpr size_t WS_WOUT = WS_WIN + 128 * MiB;
constexpr size_t WS_WUP = WS_WOUT + 32 * MiB;
constexpr size_t WS_WDN = WS_WUP + 128 * MiB;
constexpr size_t WS_X = WS_WDN + 128 * MiB;
constexpr size_t WS_H = WS_X + 68 * MiB;
constexpr size_t WS_P = WS_H + 34 * MiB;
constexpr size_t WS_LF = WS_P + 136 * MiB;
constexpr size_t WS_O = WS_LF + 34 * MiB;
constexpr size_t WS_U = WS_O + 34 * MiB;
constexpr size_t WS_MOD = WS_U + 136 * MiB;
constexpr size_t WS_LB = WS_MOD + 2 * MiB;
constexpr size_t WS_ROPE = WS_LB + 1 * MiB;
constexpr size_t WS_END = WS_ROPE + 8 * MiB;
constexpr int CW_Q0 = 64;
constexpr int CW_BAR = 4096;

constexpr int RING_OFF = 0, RING_BYTES = 131072;
constexpr int LDS_BYTES = 151552;
constexpr int MISC_OFF = 147456;

#define GAS __attribute__((address_space(1)))
#define LAS __attribute__((address_space(3)))
typedef unsigned short bf16;
typedef unsigned v4u __attribute__((ext_vector_type(4)));
typedef unsigned v2u __attribute__((ext_vector_type(2)));
typedef float f32x4 __attribute__((ext_vector_type(4)));
typedef short bf16x8 __attribute__((ext_vector_type(8)));
#define LDS_WAIT() asm volatile("s_waitcnt lgkmcnt(0)" ::: "memory")
#define VM_WAIT() asm volatile("s_waitcnt vmcnt(0)" ::: "memory")
__device__ __forceinline__ unsigned f2bf(float f) { unsigned u = __builtin_bit_cast(unsigned, f); return (u + 0x7fffu + ((u >> 16) & 1u)) >> 16; }
__device__ __forceinline__ unsigned pk2(float lo, float hi) { return pg8::cvt_pk_bf16(lo, hi); }
__device__ __forceinline__ float bf2f(unsigned short b) { return __builtin_bit_cast(float, ((unsigned)b) << 16); }
__device__ __forceinline__ float bflo(unsigned w) { return __builtin_bit_cast(float, w << 16); }
__device__ __forceinline__ float bfhi(unsigned w) { return __builtin_bit_cast(float, w & 0xffff0000u); }

#define XB_TMO      128
#define XB_XCNT(j)  (256  + 64 * (j))
#define XB_XSUB(j)  (1280 + 64 * (j))
#define XB_XGEN(j)  (2304 + 64 * (j))
#define XB_TOP      3328
#define XB_TOPGEN   3392
#define XCD_BAR_WORDS 3456
#define XB_SPIN_CAP (1u << 20)
__device__ __forceinline__ unsigned xb_ld(unsigned* p)              { return __hip_atomic_load(p, __ATOMIC_RELAXED, __HIP_MEMORY_SCOPE_AGENT); }
__device__ __forceinline__ unsigned xb_add(unsigned* p, unsigned v) { return __hip_atomic_fetch_add(p, v, __ATOMIC_RELAXED, __HIP_MEMORY_SCOPE_AGENT); }
__device__ __forceinline__ unsigned xb_xcc_id() { return (unsigned)__builtin_amdgcn_s_getreg((3 << 11) | 20) & 0xFu; }
#define XB_SPIN(cond, bar) do { unsigned _sp = 0; while (cond) { __builtin_amdgcn_s_sleep(1); \
    if ((++_sp & 255u) == 0u) { if (xb_ld(&(bar)[XB_TMO])) break; if (_sp > XB_SPIN_CAP) { atomicAdd(&(bar)[XB_TMO], 1u); break; } } } } while (0)
struct XcdBarrier { unsigned* bar; unsigned x; volatile LAS unsigned* st; };
__device__ __forceinline__ XcdBarrier xcd_barrier_post(unsigned* bar, volatile LAS unsigned* st) {
    XcdBarrier b; b.bar = bar; b.x = xb_xcc_id(); b.st = st;
    if (threadIdx.x == 0) (void)xb_add(&bar[XB_XCNT(b.x)], 1u);
    return b;
}
__device__ __forceinline__ void xcd_barrier_complete(unsigned* bar, unsigned x, unsigned& nloc, unsigned& nx) {
    const unsigned G = gridDim.x * gridDim.y * gridDim.z;
    unsigned sum, cnt, mine, sp = 0u;
    for (;;) {
        sum = 0u; cnt = 0u; mine = 0u;
#pragma unroll
        for (unsigned j = 0; j < 16; ++j) { const unsigned c = xb_ld(&bar[XB_XCNT(j)]); sum += c; cnt += (c > 0u) ? 1u : 0u; mine = (j == x) ? c : mine; }
        if (sum == G) break;
        __builtin_amdgcn_s_sleep(1);
        if ((++sp & 255u) == 0u) { if (xb_ld(&bar[XB_TMO])) break; if (sp > XB_SPIN_CAP) { atomicAdd(&bar[XB_TMO], 1u); break; } }
    }
    nloc = mine > 0u ? mine : 1u; nx = cnt > 0u ? cnt : 1u;
}
__device__ __forceinline__ void xcd_barrier(const XcdBarrier& b) {
    asm volatile("s_waitcnt vmcnt(0)" ::: "memory");
    __syncthreads();
    if (threadIdx.x == 0) {
        unsigned* bar = b.bar;
        __builtin_amdgcn_s_waitcnt(0);
        unsigned nloc = b.st[0], nx = b.st[1];
        if (nloc == 0u) { xcd_barrier_complete(bar, b.x, nloc, nx); b.st[0] = nloc; b.st[1] = nx; }
        const unsigned old = xb_add(&bar[XB_XSUB(b.x)], 1u);
        const unsigned gen = old / nloc;
        if (old + 1u == (gen + 1u) * nloc) {
            __builtin_amdgcn_fence(__ATOMIC_RELEASE, "agent");
            asm volatile("s_waitcnt vmcnt(0)" ::: "memory");
            const unsigned og = xb_add(&bar[XB_TOP], 1u);
            const unsigned tg = og / nx;
            if (og + 1u == (tg + 1u) * nx) xb_add(&bar[XB_TOPGEN], 1u);
            else XB_SPIN(xb_ld(&bar[XB_TOPGEN]) == tg, bar);
            __builtin_amdgcn_fence(__ATOMIC_ACQUIRE, "agent");
            xb_add(&bar[XB_XGEN(b.x)], 1u);
            asm volatile("s_waitcnt vmcnt(0)" ::: "memory");
        } else {
            XB_SPIN(xb_ld(&bar[XB_XGEN(b.x)]) == gen, bar);
            __builtin_amdgcn_fence(__ATOMIC_ACQUIRE, "agent");
            asm volatile("s_waitcnt vmcnt(0)" ::: "memory");
        }
    }
    __syncthreads();
}

struct Frame {
    LAS unsigned char* lds;
    unsigned* ctl;
    int G, wg;
    const float *x_prompt, *x_sample, *state_hgrn, *state_ret, *c_prompt, *c_sample, *lb_logits, *w_ada, *b_ada, *norm1_g, *norm2_g, *w_in, *hgrn_g, *ret_g, *w_out, *w_up, *w_down, *final_g;
    float* out;
    bf16 *Win_t, *Wout_t, *Wup_t, *Wdn_t, *H, *P, *O, *U;
    float *X, *LF, *MOD, *LB, *RC, *RS;
};

__device__ __forceinline__ int ltid() { int t = threadIdx.x; asm volatile("" : "+v"(t)); return t; }
#define PHASE_IDS() const int tid = ltid(), lane = tid & 63, wave = __builtin_amdgcn_readfirstlane(tid >> 6); (void)lane; (void)wave
__device__ __forceinline__ float wave_sum(float v) {
#pragma unroll
    for (int o = 1; o < 64; o <<= 1) v += __shfl_xor(v, o);
    return v;
}
__device__ __forceinline__ void p0_transpose_item(const float* W, int K, int N, bf16* WT, LAS float* scr, int item, int lane) {
    const int nblk = N / 32, kb = item / nblk, nb = item % nblk, k0 = 64 * kb, n0 = 32 * nb;
#pragma unroll 8
    for (int i = 0; i < 32; ++i) { const int kk = 2 * i + (lane >> 5); scr[kk * 33 + (lane & 31)] = W[(size_t)(k0 + kk) * N + n0 + (lane & 31)]; }
    LDS_WAIT(); asm volatile("" ::: "memory");
    const int c = lane & 7;
#pragma unroll
    for (int j = 0; j < 4; ++j) { const int n = (lane >> 3) + 8 * j; const LAS float* s = scr + (8 * c) * 33 + n;
        v4u o; o.x = pk2(s[0 * 33], s[1 * 33]); o.y = pk2(s[2 * 33], s[3 * 33]); o.z = pk2(s[4 * 33], s[5 * 33]); o.w = pk2(s[6 * 33], s[7 * 33]);
        *(GAS v4u*)(WT + (size_t)(n0 + n) * K + k0 + 8 * c) = o; }
    LDS_WAIT(); asm volatile("" ::: "memory");
}
__device__ __forceinline__ void p0_mod_task(Frame& F, int task) {
    PHASE_IDS();
    const int l = task / 48, cb = task % 48;
    LAS float* cact = (LAS float*)(F.lds);
    LAS float* red = (LAS float*)(F.lds + 73728);
    for (int i = tid; i < NSEQ * DM; i += NWAVES * 64) { const int b = i / DM, k = i % DM; const float c = (b == 0) ? F.c_prompt[k] : F.c_sample[(b - 1) * DM + k]; cact[i] = c / (1.0f + __expf(-c)); }
    __syncthreads();
    const float* W = F.w_ada + (size_t)l * DM * NMOD + cb * 256 + 4 * lane;
    f32x4 acc[NSEQ];
#pragma unroll
    for (int b = 0; b < NSEQ; ++b) acc[b] = (f32x4){0.f, 0.f, 0.f, 0.f};
    const int kbeg = wave * 256;
#pragma unroll 2
    for (int k0 = kbeg; k0 < kbeg + 256; k0 += 4) {
        const f32x4 w0 = *(const f32x4*)(W + (size_t)(k0 + 0) * NMOD), w1 = *(const f32x4*)(W + (size_t)(k0 + 1) * NMOD), w2 = *(const f32x4*)(W + (size_t)(k0 + 2) * NMOD), w3 = *(const f32x4*)(W + (size_t)(k0 + 3) * NMOD);
#pragma unroll
        for (int b = 0; b < NSEQ; ++b) { const f32x4 c = *(const LAS f32x4*)(cact + b * DM + k0); acc[b] += w0 * c.x + w1 * c.y + w2 * c.z + w3 * c.w; }
    }
#pragma unroll
    for (int b = 0; b < NSEQ; ++b) *(LAS f32x4*)(red + (wave * NSEQ + b) * 256 + 4 * lane) = acc[b];
    __syncthreads();
    for (int o = tid; o < NSEQ * 256; o += NWAVES * 64) { const int b = o / 256, c = o % 256; float s = 0.f;
#pragma unroll
        for (int w = 0; w < 8; ++w) s += red[(w * NSEQ + b) * 256 + c];
        F.MOD[(size_t)(b * DEPTH + l) * NMOD + cb * 256 + c] = s + F.b_ada[(size_t)l * NMOD + cb * 256 + c]; }
    __syncthreads();
}
__device__ __forceinline__ void sincos_acc(float angf, float& sn, float& cs) {
    const double a = (double)angf;
    const double q = __builtin_rint(a * 0.63661977236758134308);
    double r = __builtin_fma(-q, 1.57079632679489655800, a); r = __builtin_fma(-q, 6.12323399573676603587e-17, r);
    const double r2 = r * r;
    double sp = 1.0 / 6227020800.0; sp = sp * r2 - 1.0 / 39916800.0; sp = sp * r2 + 1.0 / 362880.0; sp = sp * r2 - 1.0 / 5040.0; sp = sp * r2 + 1.0 / 120.0; sp = sp * r2 - 1.0 / 6.0; sp = sp * r2 * r + r;
    double cp = 1.0 / 479001600.0; cp = cp * r2 - 1.0 / 3628800.0; cp = cp * r2 + 1.0 / 40320.0; cp = cp * r2 - 1.0 / 720.0; cp = cp * r2 + 1.0 / 24.0; cp = cp * r2 - 0.5; cp = cp * r2 + 1.0;
    const int qi = ((int)q) & 3;
    const double s = (qi == 0) ? sp : (qi == 1) ? cp : (qi == 2) ? -sp : -cp;
    const double c = (qi == 0) ? cp : (qi == 1) ? -sp : (qi == 2) ? -cp : sp;
    sn = (float)s; cs = (float)c;
}
__device__ __forceinline__ void p0_prologue(Frame& F) {
    PHASE_IDS();
    const int gt = F.wg * (NWAVES * 64) + tid, NGT = F.G * NWAVES * 64;
    for (int c = gt; c < 1024; c += NGT) {
        const float a0 = F.lb_logits[c], a1 = F.lb_logits[1024 + c], a2 = F.lb_logits[2048 + c], a3 = F.lb_logits[3072 + c];
        const float mx = fmaxf(fmaxf(a0, a1), fmaxf(a2, a3));
        const float e0 = expf(a0 - mx), e1 = expf(a1 - mx), e2 = expf(a2 - mx), e3 = expf(a3 - mx), inv = 1.0f / (e0 + e1 + e2 + e3);
        F.LB[c] = 0.f; F.LB[1024 + c] = e1 * inv; F.LB[2048 + c] = (e1 + e2) * inv; F.LB[3072 + c] = (e1 + e2 + e3) * inv;
    }
    for (int i = gt; i < SEQ * 128; i += NGT) {
        const int pos = i >> 7, j = i & 127;
        const float t = (float)j * (1.0f / 127.0f);
        const float invf = (float)(1.0 / exp((double)t * 9.21034037197618271));
        const float ang = (float)pos * invf;
        float sn, cs; sincos_acc(ang, sn, cs);
        F.RC[i] = cs; F.RS[i] = sn;
    }
    { const f32x4* s0 = (const f32x4*)F.x_prompt; const f32x4* s1 = (const f32x4*)F.x_sample; f32x4* d = (f32x4*)F.X;
      const int n0 = SEQ * DM / 4, n1 = DECB * DECS * DM / 4;
      for (int i = gt; i < n0; i += NGT) d[i] = s0[i];
      for (int i = gt; i < n1; i += NGT) d[n0 + i] = s1[i]; }
    for (int task = F.wg; task < DEPTH * 48; task += F.G) p0_mod_task(F, task);
    LAS float* scr = (LAS float*)(F.lds + wave * 16384);
    constexpr int I_IN = (DM / 64) * (NPROJ / 32), I_OUT = (DM / 64) * (DM / 32), I_UP = (DM / 64) * (DFF / 32), I_DN = (DFF / 64) * (DM / 32);
    constexpr int I_LAYER = I_IN + I_OUT + I_UP + I_DN, NITEMS = DEPTH * I_LAYER;
    for (;;) {
        int base = 0; if (lane == 0) base = (int)atomicAdd(F.ctl + CW_Q0, 8u);
        base = __builtin_amdgcn_readfirstlane(base);
        if (base >= NITEMS) break;
        for (int it = base; it < base + 8 && it < NITEMS; ++it) {
            const int l = it / I_LAYER; int r = it % I_LAYER;
            if (r < I_IN) { p0_transpose_item(F.w_in + (size_t)l * DM * NPROJ, DM, NPROJ, F.Win_t + (size_t)l * NPROJ * DM, scr, r, lane); continue; } r -= I_IN;
            if (r < I_OUT) { p0_transpose_item(F.w_out + (size_t)l * DM * DM, DM, DM, F.Wout_t + (size_t)l * DM * DM, scr, r, lane); continue; } r -= I_OUT;
            if (r < I_UP) { p0_transpose_item(F.w_up + (size_t)l * DM * DFF, DM, DFF, F.Wup_t + (size_t)l * DFF * DM, scr, r, lane); continue; } r -= I_UP;
            p0_transpose_item(F.w_down + (size_t)l * DFF * DM, DFF, DM, F.Wdn_t + (size_t)l * DM * DFF, scr, r, lane);
        }
    }
}
__device__ __forceinline__ void norm_phase(Frame& F, const float* g, int l, int which_sh  ) {
    PHASE_IDS();
    const int gw = F.wg * NWAVES + wave, NGW = F.G * NWAVES;
    for (int m = gw; m < M; m += NGW) {
        const f32x4* xr = (const f32x4*)(F.X + (size_t)m * DM) + lane;
        f32x4 v[8]; float ss = 0.f;
#pragma unroll
        for (int j = 0; j < 8; ++j) { v[j] = xr[64 * j]; ss += (v[j].x * v[j].x + v[j].y * v[j].y) + (v[j].z * v[j].z + v[j].w * v[j].w); }
        const float rstd = 1.0f / sqrtf(wave_sum(ss) * (1.0f / DM) + EPS);
        const float* mod = F.MOD + (size_t)(row_seq(m) * DEPTH + l) * NMOD;
        const f32x4* gp = (const f32x4*)g + lane; const f32x4* shp = (const f32x4*)(mod + which_sh * DM) + lane; const f32x4* scp = (const f32x4*)(mod + (which_sh + 1) * DM) + lane;
        v2u* o8 = (v2u*)(F.H + (size_t)m * DM) + lane;
#pragma unroll
        for (int j = 0; j < 8; ++j) { const f32x4 gg = gp[64 * j], sh = shp[64 * j], sc = scp[64 * j];
            const f32x4 h = v[j] * rstd * gg * (sc + 1.0f) + sh;
            v2u w; w.x = pk2(h.x, h.y); w.y = pk2(h.z, h.w); o8[64 * j] = w; }
    }
}
__device__ __forceinline__ void final_phase(Frame& F) {
    PHASE_IDS();
    const int gw = F.wg * NWAVES + wave, NGW = F.G * NWAVES;
    for (int m = gw; m < M; m += NGW) {
        const f32x4* xr = (const f32x4*)(F.X + (size_t)m * DM) + lane;
        f32x4 v[8]; float ss = 0.f;
#pragma unroll
        for (int j = 0; j < 8; ++j) { v[j] = xr[64 * j]; ss += (v[j].x * v[j].x + v[j].y * v[j].y) + (v[j].z * v[j].z + v[j].w * v[j].w); }
        const float rstd = 1.0f / sqrtf(wave_sum(ss) * (1.0f / DM) + EPS);
        const f32x4* gp = (const f32x4*)F.final_g + lane; f32x4* o = (f32x4*)(F.out + (size_t)m * DM) + lane;
#pragma unroll
        for (int j = 0; j < 8; ++j) o[64 * j] = v[j] * rstd * gp[64 * j];
    }
}
template <int DK, int DV, bool IS_RET>
__device__ __forceinline__ void naive_mix_unit(Frame& F, int l, int seq, int h) {
    constexpr int NS = 512 / DV, KS = DK / NS, TB = 16, NJ = DV / 64;
    PHASE_IDS();
    const int v = tid % DV, ks = tid / DV;
    const int row0 = seq == 0 ? 0 : SEQ + 64 * (seq - 1), ntok = seq == 0 ? SEQ : 64;
    const int cq = IS_RET ? 4096 + h * 256 : h * 128;
    const int ck = IS_RET ? 5120 + h * 256 : 1024 + h * 128;
    const int cv = IS_RET ? 6144 + h * 256 : 2048 + h * 128;
    const int cg = IS_RET ? 7168 + h * 256 : 3072 + h * 128;
    const int co = IS_RET ? 1024 + h * 256 : h * 128;
    LAS float* qs = (LAS float*)F.lds;
    LAS float* kss = qs + TB * DK;
    LAS float* dss = kss + TB * DK;
    LAS float* vss = dss + TB * DK;
    LAS float* part = vss + TB * DV;
    float s[KS];
    if (seq == 0) {
#pragma unroll
        for (int i = 0; i < KS; ++i) s[i] = 0.f;
    } else {
        const float* src = IS_RET ? F.state_ret + ((size_t)((l * DECB + (seq - 1)) * HB + h) * 256) * 256 : F.state_hgrn + ((size_t)((l * DECB + (seq - 1)) * HA + h) * 128) * 128;
#pragma unroll
        for (int i = 0; i < KS; ++i) s[i] = src[(size_t)(ks * KS + i) * DV + v];
    }
    const float gam = 1.0f - exp2f(-5.0f - (float)h);
    const float* gn = (IS_RET ? F.ret_g : F.hgrn_g) + l * 1024 + h * DV;
    for (int t0 = 0; t0 < ntok; t0 += TB) {
        __syncthreads();
        for (int i = tid; i < TB * DK; i += 512) { const int t = i / DK, k = i % DK; const size_t row = row0 + t0 + t;
            qs[i] = bf2f(F.P[row * 8192 + cq + k]); kss[i] = bf2f(F.P[row * 8192 + ck + k]);
            if (!IS_RET) dss[i] = __expf(F.LF[row * 1024 + h * 128 + k]); }
        for (int i = tid; i < TB * DV; i += 512) { const int t = i / DV, vv = i % DV; const size_t row = row0 + t0 + t; vss[i] = bf2f(F.P[row * 8192 + cv + vv]); }
        __syncthreads();
        for (int t = 0; t < TB; ++t) {
            const float vv = vss[t * DV + v]; float po = 0.f;
#pragma unroll
            for (int i = 0; i < KS; ++i) { const int k = ks * KS + i; const float d = IS_RET ? gam : dss[t * DK + k]; s[i] = d * s[i] + kss[t * DK + k] * vv; po += qs[t * DK + k] * s[i]; }
            part[(ks * TB + t) * DV + v] = po;
        }
        __syncthreads();
#pragma unroll
        for (int tt = 0; tt < 2; ++tt) {
            const int t = 2 * wave + tt; const size_t row = row0 + t0 + t;
            float o[NJ]; float ss = 0.f;
#pragma unroll
            for (int j = 0; j < NJ; ++j) { const int vv = lane + 64 * j; float a = 0.f;
#pragma unroll
                for (int q = 0; q < NS; ++q) a += part[(q * TB + t) * DV + vv];
                o[j] = a; ss += a * a; }
            const float rstd = 1.0f / sqrtf(wave_sum(ss) * (1.0f / DV) + EPS);
#pragma unroll
            for (int j = 0; j < NJ; ++j) { const int vv = lane + 64 * j; const float gate = bf2f(F.P[row * 8192 + cg + vv]);
                F.O[row * 2048 + co + vv] = (bf16)f2bf(o[j] * rstd * gn[vv] * gate); }
        }
    }
    float* dst;
    if (IS_RET) dst = F.out + (seq == 0 ? OFF_SB_P + ((size_t)(l * HB + h) * 256) * 256 : OFF_SB_S + ((size_t)((l * DECB + (seq - 1)) * HB + h) * 256) * 256);
    else        dst = F.out + (seq == 0 ? OFF_SA_P + ((size_t)(l * HA + h) * 128) * 128 : OFF_SA_S + ((size_t)((l * DECB + (seq - 1)) * HA + h) * 128) * 128);
#pragma unroll
    for (int i = 0; i < KS; ++i) dst[(size_t)(ks * KS + i) * DV + v] = s[i];
}
__device__ __forceinline__ void naive_mix_phase(Frame& F, int l) {
    for (int u = F.wg; u < NSEQ * 12; u += F.G) {
        const int seq = u / 12, hh = u % 12;
        if (hh < 8) naive_mix_unit<128, 128, false>(F, l, seq, hh);
        else        naive_mix_unit<256, 256, true>(F, l, seq, hh - 8);
        __syncthreads();
    }
}
constexpr int PH_PRO = 0, PH_PER_LAYER = 9, PH_FINAL = 1 + DEPTH * PH_PER_LAYER, N_PHASES = PH_FINAL + 1;
struct Args { const float* in[18]; float* out; unsigned char* ws; int ph_lo, ph_hi; };
__global__ void __launch_bounds__(NWAVES * 64, 2) fwd(Args args) {
    extern __shared__ __attribute__((aligned(16))) unsigned char lds[];
    Frame F;
    F.lds = (LAS unsigned char*)lds;
    F.G = gridDim.x; F.wg = blockIdx.x;
    unsigned char* ws = args.ws;
    F.ctl = (unsigned*)(ws + WS_CTL);
    F.x_prompt = args.in[0]; F.x_sample = args.in[1]; F.state_hgrn = args.in[2]; F.state_ret = args.in[3]; F.c_prompt = args.in[4]; F.c_sample = args.in[5];
    F.lb_logits = args.in[6]; F.w_ada = args.in[7]; F.b_ada = args.in[8]; F.norm1_g = args.in[9]; F.norm2_g = args.in[10]; F.w_in = args.in[11];
    F.hgrn_g = args.in[12]; F.ret_g = args.in[13]; F.w_out = args.in[14]; F.w_up = args.in[15]; F.w_down = args.in[16]; F.final_g = args.in[17];
    F.out = args.out;
    F.Win_t = (bf16*)(ws + WS_WIN); F.Wout_t = (bf16*)(ws + WS_WOUT); F.Wup_t = (bf16*)(ws + WS_WUP); F.Wdn_t = (bf16*)(ws + WS_WDN);
    F.X = (float*)(ws + WS_X); F.H = (bf16*)(ws + WS_H); F.P = (bf16*)(ws + WS_P); F.LF = (float*)(ws + WS_LF); F.O = (bf16*)(ws + WS_O); F.U = (bf16*)(ws + WS_U);
    F.MOD = (float*)(ws + WS_MOD); F.LB = (float*)(ws + WS_LB); F.RC = (float*)(ws + WS_ROPE); F.RS = F.RC + SEQ * 128;
    volatile LAS unsigned* MISC = (volatile LAS unsigned*)(F.lds + MISC_OFF);
    if (threadIdx.x < 64) MISC[threadIdx.x] = 0u;
    __syncthreads();
    const int lo = args.ph_lo, hi = args.ph_hi;
    XcdBarrier bar; bar.bar = F.ctl + CW_BAR; bar.x = 0; bar.st = MISC + 8;
    if (hi - lo > 1) bar = xcd_barrier_post(F.ctl + CW_BAR, MISC + 8);
#define IN(k) (lo <= (k) && (k) < hi)
#define SEAM(k) do { if (IN(k) && IN((k) + 1)) xcd_barrier(bar); } while (0)

    if (IN(PH_PRO)) {
#ifndef SKIP_PRO
 p0_prologue(F);
#endif
 } SEAM(PH_PRO);
    for (int l = 0; l < DEPTH; ++l) {
        const int pb = 1 + l * PH_PER_LAYER;
        if (IN(pb + 0)) {
#ifndef SKIP_NORM
 norm_phase(F, F.norm1_g + l * DM, l, 0);
#endif
 } SEAM(pb + 0);
        if (IN(pb + 1)) {
            pg8::Gemm g{F.H, F.Win_t + (size_t)l * NPROJ * DM, M, NPROJ, DM}; pg8::StaticOrder S; S.init(M, NPROJ, F.G, F.wg);
            pg8::EpiInProj E{F.P, F.LF, F.LB + l * 1024, F.RC, F.RS};
#ifndef SKIP_G1
            pg8::gemm_phase<pg8::EpiInProj, pg8::StaticOrder, true, true>(F.lds + RING_OFF, g, S, E);
#endif
        } SEAM(pb + 1);
        if (IN(pb + 2)) {
#ifndef SKIP_MIX
 naive_mix_phase(F, l);
#endif
 } SEAM(pb + 2);
        SEAM(pb + 3);
        SEAM(pb + 4);
        if (IN(pb + 5)) {
            pg8::Gemm g{F.O, F.Wout_t + (size_t)l * DM * DM, M, DM, DM}; pg8::StaticOrder S; S.init(M, DM, F.G, F.wg);
            pg8::EpiResid E{F.X, F.MOD + (size_t)l * NMOD + 2 * DM, DEPTH * NMOD};
#ifndef SKIP_G2
            pg8::gemm_phase<pg8::EpiResid, pg8::StaticOrder, true, true>(F.lds + RING_OFF, g, S, E);
#endif
        } SEAM(pb + 5);
        if (IN(pb + 6)) {
#ifndef SKIP_NORM
 norm_phase(F, F.norm2_g + l * DM, l, 3);
#endif
 } SEAM(pb + 6);
        if (IN(pb + 7)) {
            pg8::Gemm g{F.H, F.Wup_t + (size_t)l * DFF * DM, M, DFF, DM}; pg8::StaticOrder S; S.init(M, DFF, F.G, F.wg);
            pg8::EpiRelu2 E{F.U, DFF};
#ifndef SKIP_G3
            pg8::gemm_phase<pg8::EpiRelu2, pg8::StaticOrder, true, true>(F.lds + RING_OFF, g, S, E);
#endif
        } SEAM(pb + 7);
        if (IN(pb + 8)) {
            pg8::Gemm g{F.U, F.Wdn_t + (size_t)l * DM * DFF, M, DM, DFF}; pg8::StaticOrder S; S.init(M, DM, F.G, F.wg);
            pg8::EpiResid E{F.X, F.MOD + (size_t)l * NMOD + 5 * DM, DEPTH * NMOD};
#ifndef SKIP_G4
            pg8::gemm_phase<pg8::EpiResid, pg8::StaticOrder, true, true>(F.lds + RING_OFF, g, S, E);
#endif
        } SEAM(pb + 8);
    }
    if (IN(PH_FINAL)) {
#ifndef SKIP_NORM
 final_phase(F);
#endif
 }
#undef IN
#undef SEAM
}

#ifndef MK_ONE_LAUNCH
#define MK_ONE_LAUNCH 0
#endif
extern "C" void kernel_launch(void* const* d_in, const int* in_sizes, int n_in, void* d_out, int out_size, void* d_ws, size_t ws_size, hipStream_t stream) {
    static int grid = 0;
    if (grid == 0) {
        if (n_in != 18 || (size_t)out_size != OUT_TOTAL || ws_size < WS_END) { fprintf(stderr, "kernel_launch: unexpected shapes: n_in %d out %d ws %zu (need %zu)\n", n_in, out_size, ws_size, (size_t)WS_END); grid = -1; return; }
        int dev = 0, cus = 0, per_cu = 0;
        if (hipGetDevice(&dev) != hipSuccess || hipDeviceGetAttribute(&cus, hipDeviceAttributeMultiprocessorCount, dev) != hipSuccess) { grid = -1; return; }
        if (hipFuncSetAttribute((const void*)fwd, hipFuncAttributeMaxDynamicSharedMemorySize, LDS_BYTES) != hipSuccess) { fprintf(stderr, "kernel_launch: hipFuncSetAttribute failed\n"); grid = -1; return; }
        if (hipOccupancyMaxActiveBlocksPerMultiprocessor(&per_cu, (const void*)fwd, NWAVES * 64, LDS_BYTES) != hipSuccess || per_cu < 1)
            fprintf(stderr, "kernel_launch: note: occupancy query reports %d workgroups per CU\n", per_cu);
        (void)hipGetLastError();
        grid = cus;
    }
    if (grid < 0) return;
    if (hipMemsetAsync((char*)d_ws + WS_CTL, 0, CTL_ZERO_BYTES, stream) != hipSuccess) { fprintf(stderr, "kernel_launch: memset failed\n"); return; }
    Args a{};
    for (int i = 0; i < 18; ++i) a.in[i] = (const float*)d_in[i];
    a.out = (float*)d_out; a.ws = (unsigned char*)d_ws;
#if MK_ONE_LAUNCH
    a.ph_lo = 0; a.ph_hi = N_PHASES;
    hipLaunchKernelGGL(fwd, dim3(grid), dim3(NWAVES * 64), LDS_BYTES, stream, a);
#else
    for (int ph = 0; ph < N_PHASES; ++ph) {
        if (ph >= 1 && ph < PH_FINAL) { const int r = (ph - 1) % PH_PER_LAYER; if (r == 3 || r == 4) continue; }
        a.ph_lo = ph; a.ph_hi = ph + 1;
        hipLaunchKernelGGL(fwd, dim3(grid), dim3(NWAVES * 64), LDS_BYTES, stream, a);
    }
#endif
    const hipError_t le = hipPeekAtLastError();
    if (le != hipSuccess) fprintf(stderr, "kernel_launch: launch failed: %s\n", hipGetErrorName(le));
}
```

```cpp
#include <hip/hip_runtime.h>
#include <cstdio>
#include <cstdint>
__device__ __forceinline__ int row_pos(int row) { return row < 8192 ? row : 2048 + ((row - 8192) & 63); }
__device__ __forceinline__ int row_seq(int row) { return row < 8192 ? 0 : 1 + ((row - 8192) >> 6); }
namespace pg8 {
#define PG8_LAS __attribute__((address_space(3)))
typedef unsigned short bf16_t;
typedef short bf16x8 __attribute__((ext_vector_type(8)));
typedef float f32x4 __attribute__((ext_vector_type(4)));
typedef unsigned u32x4 __attribute__((ext_vector_type(4)));
typedef unsigned u32x2 __attribute__((ext_vector_type(2)));
constexpr int BM = 256, BK = 64, HALF = 128, HTB = HALF * BK * 2  , STAGE_BYTES = 8 * HTB, NXCD = 8, WGM = 8;

__host__ __device__ __forceinline__ int lds_byte(int r, int c) { const int st = (r >> 4) * 2 + (c >> 5), rr = r & 15, cc = c & 31, ob = rr * 64 + cc * 2; return st * 1024 + (ob ^ (((ob >> 9) & 1) << 5)); }
__host__ __device__ __forceinline__ void stage_rc(int b, int& R, int& C) { const int st = b / 1024, sb = b % 1024, swz = sb ^ (((sb >> 9) & 1) << 5); R = (st >> 1) * 16 + swz / 64; C = (st & 1) * 32 + (swz % 64) / 2; }
__host__ __device__ __forceinline__ int perm32(int rho) { const int n = rho >> 4, i = rho & 15; return 8 * (i >> 2) + 4 * n + (i & 3); }

struct Unit { int pm, pn; };
struct Gemm { const bf16_t* A; const bf16_t* Bt; int M, N, K; };

struct StaticOrder {
    int nM, nN, nwg, G, c;
    __host__ __device__ void init(int M, int N, int G_, int c_) { nM = M / BM; nN = N / BM; nwg = nM * nN; G = G_; c = c_; }
    __host__ __device__ bool next(int i, Unit& u) const {
        const long L = (long)i * G + c; if (L >= nwg) return false;
        int wgid = (int)L; { const int q = nwg / NXCD, r = nwg % NXCD, xcd = wgid % NXCD, off = wgid / NXCD; wgid = (xcd < r ? xcd * (q + 1) : r * (q + 1) + (xcd - r) * q) + off; }
        const int nig = WGM * nN, gid = wgid / nig, fm = gid * WGM, gsz = (nM - fm) < WGM ? (nM - fm) : WGM;
        u.pm = fm + ((wgid % nig) % gsz); u.pn = (wgid % nig) / gsz; return true;
    }
    __device__ __forceinline__ void a_ready(const Unit&) const {}
    __device__ __forceinline__ void done(const Unit&) const {}
};

__device__ __forceinline__ unsigned cvt_pk_bf16(float lo, float hi) { unsigned r; asm volatile("v_cvt_pk_bf16_f32 %0, %1, %2" : "=v"(r) : "v"(lo), "v"(hi)); return r; }
__device__ __forceinline__ float fast_rcp(float x) { return __builtin_amdgcn_rcpf(x); }
__device__ __forceinline__ float silu_f(float x) { return x * fast_rcp(1.0f + __expf(-x)); }

struct EpiInProj {
    static constexpr bool PERM = true, AFTER_DRAIN = false;
    bf16_t* P; float* LF; const float* lb; const float* rc; const float* rs;
    __device__ __forceinline__ void operator()(const f32x4 (&acc)[2][2][4][2], const Unit& u, int wr, int wc, int fr, int fq) const {
        const int seg = u.pn >> 2;
        const int row0 = u.pm * BM + wr * 64 + fr;
        const int colg0 = u.pn * BM + wc * 32 + 8 * fq;
        if (seg == 4 || seg == 5) {
            const float ksc = (seg == 5) ? 0.0625f : 1.0f;
            const int j0 = wc * 32 + 8 * fq;
#pragma unroll
            for (int ai = 0; ai < 2; ++ai)
#pragma unroll
                for (int m = 0; m < 4; ++m) {
                    const int row = row0 + ai * HALF + m * 16; const int pos = row_pos(row);
                    const f32x4 c0 = *(const f32x4*)(rc + (size_t)pos * 128 + j0), c1 = *(const f32x4*)(rc + (size_t)pos * 128 + j0 + 4);
                    const f32x4 s0 = *(const f32x4*)(rs + (size_t)pos * 128 + j0), s1 = *(const f32x4*)(rs + (size_t)pos * 128 + j0 + 4);
                    const f32x4 x1a = acc[ai][0][m][0], x1b = acc[ai][0][m][1], x2a = acc[ai][1][m][0], x2b = acc[ai][1][m][1];
                    const f32x4 o1a = (x1a * c0 - x2a * s0) * ksc, o1b = (x1b * c1 - x2b * s1) * ksc;
                    const f32x4 o2a = (x2a * c0 + x1a * s0) * ksc, o2b = (x2b * c1 + x1b * s1) * ksc;
                    bf16_t* rowp = P + (size_t)row * 8192 + colg0;
                    u32x4 w; w.x = cvt_pk_bf16(o1a[0], o1a[1]); w.y = cvt_pk_bf16(o1a[2], o1a[3]); w.z = cvt_pk_bf16(o1b[0], o1b[1]); w.w = cvt_pk_bf16(o1b[2], o1b[3]);
                    *(u32x4*)(rowp) = w;
                    w.x = cvt_pk_bf16(o2a[0], o2a[1]); w.y = cvt_pk_bf16(o2a[2], o2a[3]); w.z = cvt_pk_bf16(o2b[0], o2b[1]); w.w = cvt_pk_bf16(o2b[2], o2b[3]);
                    *(u32x4*)(rowp + HALF) = w;
                }
        } else if (seg == 1) {
#pragma unroll
            for (int bj = 0; bj < 2; ++bj) {
                const int cs = colg0 + bj * HALF - 1024;
                const f32x4 lb0 = *(const f32x4*)(lb + cs), lb1 = *(const f32x4*)(lb + cs + 4);
#pragma unroll
                for (int ai = 0; ai < 2; ++ai)
#pragma unroll
                    for (int m = 0; m < 4; ++m) {
                        const int row = row0 + ai * HALF + m * 16;
                        f32x4 lf0, lf1, k0, k1;
#pragma unroll
                        for (int e = 0; e < 4; ++e) {
                            { const float x = acc[ai][bj][m][0][e], l = lb0[e]; const float sg = fast_rcp(1.0f + __expf(-x)), sn = fast_rcp(1.0f + __expf(x)); lf0[e] = __logf(l + (1.0f - l) * sg); k0[e] = (1.0f - l) * sn; }
                            { const float x = acc[ai][bj][m][1][e], l = lb1[e]; const float sg = fast_rcp(1.0f + __expf(-x)), sn = fast_rcp(1.0f + __expf(x)); lf1[e] = __logf(l + (1.0f - l) * sg); k1[e] = (1.0f - l) * sn; }
                        }
                        float* lfp = LF + (size_t)row * 1024 + cs; *(f32x4*)lfp = lf0; *(f32x4*)(lfp + 4) = lf1;
                        u32x4 w; w.x = cvt_pk_bf16(k0[0], k0[1]); w.y = cvt_pk_bf16(k0[2], k0[3]); w.z = cvt_pk_bf16(k1[0], k1[1]); w.w = cvt_pk_bf16(k1[2], k1[3]);
                        *(u32x4*)(P + (size_t)row * 8192 + colg0 + bj * HALF) = w;
                    }
            }
        } else {
            const bool act = (seg == 0 || seg == 3 || seg == 7);
#pragma unroll
            for (int ai = 0; ai < 2; ++ai)
#pragma unroll
                for (int m = 0; m < 4; ++m) { bf16_t* rowp = P + (size_t)(row0 + ai * HALF + m * 16) * 8192 + colg0;
#pragma unroll
                    for (int bj = 0; bj < 2; ++bj) { f32x4 v0 = acc[ai][bj][m][0], v1 = acc[ai][bj][m][1];
                        if (act) {
#pragma unroll
                            for (int e = 0; e < 4; ++e) { v0[e] = silu_f(v0[e]); v1[e] = silu_f(v1[e]); } }
                        u32x4 w; w.x = cvt_pk_bf16(v0[0], v0[1]); w.y = cvt_pk_bf16(v0[2], v0[3]); w.z = cvt_pk_bf16(v1[0], v1[1]); w.w = cvt_pk_bf16(v1[2], v1[3]);
                        *(u32x4*)(rowp + bj * HALF) = w; } }
        }
    }
};
struct EpiRelu2 {
    static constexpr bool PERM = true, AFTER_DRAIN = false;
    bf16_t* O; int ldc;
    __device__ __forceinline__ void operator()(const f32x4 (&acc)[2][2][4][2], const Unit& u, int wr, int wc, int fr, int fq) const {
        const int row0 = u.pm * BM + wr * 64 + fr, col0 = u.pn * BM + wc * 32 + 8 * fq;
#pragma unroll
        for (int ai = 0; ai < 2; ++ai)
#pragma unroll
            for (int m = 0; m < 4; ++m) { bf16_t* rowp = O + (size_t)(row0 + ai * HALF + m * 16) * ldc + col0;
#pragma unroll
                for (int bj = 0; bj < 2; ++bj) { f32x4 v0 = acc[ai][bj][m][0], v1 = acc[ai][bj][m][1];
#pragma unroll
                    for (int e = 0; e < 4; ++e) { const float a = fmaxf(v0[e], 0.f), b = fmaxf(v1[e], 0.f); v0[e] = a * a; v1[e] = b * b; }
                    u32x4 w; w.x = cvt_pk_bf16(v0[0], v0[1]); w.y = cvt_pk_bf16(v0[2], v0[3]); w.z = cvt_pk_bf16(v1[0], v1[1]); w.w = cvt_pk_bf16(v1[2], v1[3]);
                    *(u32x4*)(rowp + bj * HALF) = w; } }
    }
};
struct EpiResid {
    static constexpr bool PERM = false, AFTER_DRAIN = false;
    float* X; const float* gate; int seq_stride;
    __device__ __forceinline__ void operator()(const f32x4 (&acc)[2][2][4][2], const Unit& u, int wr, int wc, int fr, int fq) const {
        const int row0 = u.pm * BM + wr * 64 + fr, col0 = u.pn * BM + wc * 32 + 4 * fq;
#pragma unroll
        for (int ai = 0; ai < 2; ++ai) {
            const int sq = row_seq(u.pm * BM + wr * 64 + ai * HALF);
            const float* g = gate + (size_t)sq * seq_stride + col0;
            f32x4 gv[2][2];
#pragma unroll
            for (int bj = 0; bj < 2; ++bj)
#pragma unroll
                for (int n = 0; n < 2; ++n) gv[bj][n] = *(const f32x4*)(g + bj * HALF + n * 16);
#pragma unroll
            for (int m = 0; m < 4; ++m) { float* rowp = X + (size_t)(row0 + ai * HALF + m * 16) * 2048 + col0;
#pragma unroll
                for (int bj = 0; bj < 2; ++bj)
#pragma unroll
                    for (int n = 0; n < 2; ++n) { const f32x4 xv = *(const f32x4*)(rowp + bj * HALF + n * 16); *(f32x4*)(rowp + bj * HALF + n * 16) = xv + gv[bj][n] * acc[ai][bj][m][n]; }
                asm volatile("" ::: "memory"); }
        }
    }
};
template <class Epi, class Sched, bool ALIGN_EPI = false, bool SP2 = false>
__device__ __forceinline__ void gemm_phase(PG8_LAS unsigned char* lds, const Gemm g, const Sched& S, const Epi& E) {
    int tid_l = threadIdx.x; asm volatile("" : "+v"(tid_l));
    const int tid = tid_l, wid = __builtin_amdgcn_readfirstlane(tid >> 6), lane = tid & 63, wr = wid >> 2, wc = wid & 3, fr = lane & 15, fq = lane >> 4;
    const int K = g.K, nt = K / BK;
    unsigned voffA[2], voffB[2];
#pragma unroll
    for (int i = 0; i < 2; ++i) { int R, C; stage_rc(tid * 16 + i * 8192, R, C); const int Rb = Epi::PERM ? ((R & ~31) + perm32(R & 31)) : R;
        voffA[i] = (unsigned)(R * K + C) * 2u; voffB[i] = (unsigned)(Rb * K + C) * 2u; }
    const size_t kstep = (size_t)(BK * 2);
    const size_t hstep = (size_t)HALF * K * 2;
    const size_t tstep = 2 * hstep;
    const unsigned ldsw = (unsigned)wid * 1024u;
    const int aoff = lds_byte(wr * 64 + fr, fq * 8), boff = lds_byte(wc * 32 + fr, fq * 8);
#define PG8_SA(b, h) (((b) * 2 + (h)) * HTB)
#define PG8_SB(b, h) ((4 + (b) * 2 + (h)) * HTB)
#define PG8_STAGE(bufoff, gbase, voff) do { _Pragma("unroll") for (int _i = 0; _i < 2; ++_i) \
        __builtin_amdgcn_global_load_lds((const unsigned*)((const char*)(gbase) + (voff)[_i]), (PG8_LAS unsigned*)(lds + (bufoff) + ldsw + _i * 8192), 16, 0, 0); } while (0)
#define PG8_LDA(dst, b, h) do { _Pragma("unroll") for (int m = 0; m < 4; ++m) _Pragma("unroll") for (int k = 0; k < 2; ++k) dst[m][k] = *(const PG8_LAS bf16x8*)(lds + PG8_SA(b, h) + aoff + m * 2048 + k * 1024); } while (0)
#define PG8_LDB(dst, b, h) do { _Pragma("unroll") for (int n = 0; n < 2; ++n) _Pragma("unroll") for (int k = 0; k < 2; ++k) dst[n][k] = *(const PG8_LAS bf16x8*)(lds + PG8_SB(b, h) + boff + n * 2048 + k * 1024); } while (0)
#define PG8_MMA(ai, bj, At, Bt) do { __builtin_amdgcn_s_setprio(1); _Pragma("unroll") for (int m = 0; m < 4; ++m) _Pragma("unroll") for (int n = 0; n < 2; ++n) _Pragma("unroll") for (int k = 0; k < 2; ++k) \
        acc[ai][bj][m][n] = __builtin_amdgcn_mfma_f32_16x16x32_bf16(Bt[n][k], At[m][k], acc[ai][bj][m][n], 0, 0, 0); __builtin_amdgcn_s_setprio(0); } while (0)
#define PG8_WAIT_V(n) asm volatile("s_waitcnt vmcnt(" #n ")" ::: "memory")
#define PG8_WAIT_L(n) asm volatile("s_waitcnt lgkmcnt(" #n ")" ::: "memory")
#define PG8_BAR __builtin_amdgcn_s_barrier()
#define PG8_SCHED __builtin_amdgcn_sched_barrier(0)
    Unit cur, nxt; int ui = 0;
    if (!S.next(0, cur)) return;
    f32x4 acc[2][2][4][2];
#pragma unroll
    for (int a = 0; a < 2; ++a)
#pragma unroll
        for (int b = 0; b < 2; ++b)
#pragma unroll
            for (int m = 0; m < 4; ++m)
#pragma unroll
                for (int n = 0; n < 2; ++n) acc[a][b][m][n] = (f32x4){0.f, 0.f, 0.f, 0.f};
    bf16x8 At[4][2], B0[2][2], B1[2][2];
    const char* cA = (const char*)g.A + (size_t)cur.pm * tstep; const char* cB = (const char*)g.Bt + (size_t)cur.pn * tstep;
    S.a_ready(cur);
    if constexpr (SP2) {
        PG8_STAGE(PG8_SB(0, 0), cB, voffB); PG8_STAGE(PG8_SB(0, 1), cB + hstep, voffB); PG8_STAGE(PG8_SA(0, 0), cA, voffA); PG8_STAGE(PG8_SA(0, 1), cA + hstep, voffA);
        if (wr == 1) PG8_BAR;
        PG8_WAIT_V(2); PG8_BAR;
        PG8_STAGE(PG8_SB(1, 0), cB + kstep, voffB); PG8_STAGE(PG8_SA(1, 0), cA + kstep, voffA); PG8_STAGE(PG8_SB(1, 1), cB + hstep + kstep, voffB);
        PG8_WAIT_V(6); PG8_BAR;
    } else {
        PG8_STAGE(PG8_SB(0, 0), cB, voffB); PG8_STAGE(PG8_SA(0, 0), cA, voffA); PG8_STAGE(PG8_SB(0, 1), cB + hstep, voffB); PG8_STAGE(PG8_SA(0, 1), cA + hstep, voffA);
        if (wr == 1) PG8_BAR;
        PG8_WAIT_V(4); PG8_BAR;
        PG8_STAGE(PG8_SB(1, 0), cB + kstep, voffB); PG8_STAGE(PG8_SA(1, 0), cA + kstep, voffA); PG8_STAGE(PG8_SB(1, 1), cB + hstep + kstep, voffB);
        PG8_WAIT_V(6); PG8_BAR;
    }
    for (;;) {
        const bool has_next = S.next(ui + 1, nxt);
        const char* nA = has_next ? (const char*)g.A + (size_t)nxt.pm * tstep : cA; const char* nB = has_next ? (const char*)g.Bt + (size_t)nxt.pn * tstep : cB;
        for (int t = 0; t < nt; t += 2) {
            const bool last = (t == nt - 2);
            const char* a1 = cA + (size_t)(t + 1) * kstep;
            const char* a2 = last ? nA : cA + (size_t)(t + 2) * kstep; const char* b2 = last ? nB : cB + (size_t)(t + 2) * kstep;
            const char* a3 = a2 + kstep; const char* b3 = b2 + kstep;
            if (last && has_next) S.a_ready(nxt);
            if constexpr (SP2) {
            PG8_LDB(B0, 0, 0); PG8_LDB(B1, 0, 1); PG8_SCHED; PG8_LDA(At, 0, 0); PG8_STAGE(PG8_SA(1, 1), a1 + hstep, voffA);
            PG8_WAIT_V(8); PG8_WAIT_L(0); PG8_BAR; PG8_MMA(0, 0, At, B0); PG8_MMA(0, 1, At, B1); PG8_BAR; PG8_SCHED;
            PG8_LDA(At, 0, 1); PG8_STAGE(PG8_SB(0, 0), b2, voffB); PG8_STAGE(PG8_SB(0, 1), b2 + hstep, voffB); PG8_STAGE(PG8_SA(0, 0), a2, voffA);
            PG8_WAIT_V(8); PG8_WAIT_L(0); PG8_BAR; PG8_MMA(1, 0, At, B0); PG8_MMA(1, 1, At, B1); PG8_BAR; PG8_SCHED;
            PG8_LDB(B0, 1, 0); PG8_LDB(B1, 1, 1); PG8_SCHED; PG8_LDA(At, 1, 0); PG8_STAGE(PG8_SA(0, 1), a2 + hstep, voffA);
            PG8_WAIT_V(8); PG8_WAIT_L(0); PG8_BAR; PG8_MMA(0, 0, At, B0); PG8_MMA(0, 1, At, B1); PG8_BAR; PG8_SCHED;
            PG8_LDA(At, 1, 1); PG8_STAGE(PG8_SB(1, 0), b3, voffB); PG8_STAGE(PG8_SB(1, 1), b3 + hstep, voffB); PG8_STAGE(PG8_SA(1, 0), a3, voffA);
            PG8_WAIT_V(8); PG8_WAIT_L(0); PG8_BAR; PG8_MMA(1, 0, At, B0); PG8_MMA(1, 1, At, B1); PG8_BAR; PG8_SCHED;
            } else {
            PG8_LDB(B0, 0, 0); PG8_SCHED; PG8_LDA(At, 0, 0); PG8_STAGE(PG8_SA(1, 1), a1 + hstep, voffA);
            PG8_WAIT_L(8); PG8_BAR; PG8_WAIT_L(0); PG8_MMA(0, 0, At, B0); PG8_BAR; PG8_SCHED;
            PG8_LDB(B1, 0, 1); PG8_STAGE(PG8_SB(0, 0), b2, voffB);
            PG8_BAR; PG8_WAIT_L(0); PG8_MMA(0, 1, At, B1); PG8_BAR;
            PG8_LDA(At, 0, 1); PG8_STAGE(PG8_SA(0, 0), a2, voffA);
            PG8_BAR; PG8_WAIT_L(0); PG8_MMA(1, 0, At, B0); PG8_BAR; PG8_SCHED;
            PG8_STAGE(PG8_SB(0, 1), b2 + hstep, voffB);
            PG8_WAIT_V(6); PG8_BAR; PG8_MMA(1, 1, At, B1); PG8_BAR;
            PG8_LDB(B0, 1, 0); PG8_SCHED; PG8_LDA(At, 1, 0); PG8_STAGE(PG8_SA(0, 1), a2 + hstep, voffA);
            PG8_WAIT_L(8); PG8_BAR; PG8_WAIT_L(0); PG8_MMA(0, 0, At, B0); PG8_BAR; PG8_SCHED;
            PG8_LDB(B1, 1, 1); PG8_STAGE(PG8_SB(1, 0), b3, voffB);
            PG8_BAR; PG8_WAIT_L(0); PG8_MMA(0, 1, At, B1); PG8_BAR;
            PG8_LDA(At, 1, 1); PG8_STAGE(PG8_SA(1, 0), a3, voffA);
            PG8_BAR; PG8_WAIT_L(0); PG8_MMA(1, 0, At, B0); PG8_BAR; PG8_SCHED;
            PG8_STAGE(PG8_SB(1, 1), b3 + hstep, voffB);
            PG8_WAIT_V(6); PG8_BAR; PG8_MMA(1, 1, At, B1); PG8_BAR;
            }
        }
        if constexpr (ALIGN_EPI) { if (wr == 0) PG8_BAR; }
        if constexpr (!Epi::AFTER_DRAIN) { E(acc, cur, wr, wc, fr, fq); S.done(cur); }
        if (!has_next) break;
#pragma unroll
        for (int a = 0; a < 2; ++a)
#pragma unroll
            for (int b = 0; b < 2; ++b)
#pragma unroll
                for (int m = 0; m < 4; ++m)
#pragma unroll
                    for (int n = 0; n < 2; ++n) acc[a][b][m][n] = (f32x4){0.f, 0.f, 0.f, 0.f};
        cur = nxt; cA = nA; cB = nB; ++ui;
        if constexpr (ALIGN_EPI) { if (wr == 1) PG8_BAR; }
    }
    PG8_WAIT_V(0);
    if constexpr (!ALIGN_EPI) { if (wr == 0) PG8_BAR; }
    PG8_BAR;
    if constexpr (Epi::AFTER_DRAIN) { E.fused(acc, cur, wr, wc, fr, fq, lds, wid, lane); S.done(cur); }
#undef PG8_SA
#undef PG8_SB
#undef PG8_STAGE
#undef PG8_LDA
#undef PG8_LDB
#undef PG8_MMA
#undef PG8_WAIT_V
#undef PG8_WAIT_L
#undef PG8_BAR
#undef PG8_SCHED
}
}
constexpr int NWAVES = 8;
constexpr int DM = 2048, SEQ = 8192, DEPTH = 4, DECB = 8, DECS = 64, M = SEQ + DECB * DECS, NPROJ = 8192, DFF = 8192, NSEQ = 9, NMOD = 6 * DM;
constexpr int HA = 8, HB = 4;
constexpr float EPS = 1e-6f;
constexpr size_t OFF_SA_P = (size_t)M * DM, OFF_SB_P = OFF_SA_P + (size_t)DEPTH * HA * 128 * 128, OFF_SA_S = OFF_SB_P + (size_t)DEPTH * HB * 256 * 256,
                 OFF_SB_S = OFF_SA_S + (size_t)DEPTH * DECB * HA * 128 * 128, OUT_TOTAL = OFF_SB_S + (size_t)DEPTH * DECB * HB * 256 * 256;

constexpr size_t MiB = 1u << 20;
constexpr size_t WS_CTL = 0, CTL_ZERO_BYTES = 1 * MiB;
constexpr size_t WS_WIN = 2 * MiB;
constexpr size_t WS_WOUT = WS_WIN + 128 * MiB;
constexpr size_t WS_WUP = WS_WOUT + 32 * MiB;
constexpr size_t WS_WDN = WS_WUP + 128 * MiB;
constexpr size_t WS_X = WS_WDN + 128 * MiB;
constexpr size_t WS_H = WS_X + 68 * MiB;
constexpr size_t WS_P = WS_H + 34 * MiB;
constexpr size_t WS_LF = WS_P + 136 * MiB;
constexpr size_t WS_O = WS_LF + 34 * MiB;
constexpr size_t WS_U = WS_O + 34 * MiB;
constexpr size_t WS_MOD = WS_U + 136 * MiB;
constexpr size_t WS_LB = WS_MOD + 2 * MiB;
constexpr size_t WS_ROPE = WS_LB + 1 * MiB;
constexpr size_t WS_END = WS_ROPE + 8 * MiB;
constexpr int CW_Q0 = 64;
constexpr int CW_BAR = 4096;

constexpr int RING_OFF = 0, RING_BYTES = 131072;
constexpr int LDS_BYTES = 151552;
constexpr int MISC_OFF = 147456;

#define GAS __attribute__((address_space(1)))
#define LAS __attribute__((address_space(3)))
typedef unsigned short bf16;
typedef unsigned v4u __attribute__((ext_vector_type(4)));
typedef unsigned v2u __attribute__((ext_vector_type(2)));
typedef float f32x4 __attribute__((ext_vector_type(4)));
typedef short bf16x8 __attribute__((ext_vector_type(8)));
#define LDS_WAIT() asm volatile("s_waitcnt lgkmcnt(0)" ::: "memory")
#define VM_WAIT() asm volatile("s_waitcnt vmcnt(0)" ::: "memory")
__device__ __forceinline__ unsigned f2bf(float f) { unsigned u = __builtin_bit_cast(unsigned, f); return (u + 0x7fffu + ((u >> 16) & 1u)) >> 16; }
__device__ __forceinline__ unsigned pk2(float lo, float hi) { return pg8::cvt_pk_bf16(lo, hi); }
__device__ __forceinline__ float bf2f(unsigned short b) { return __builtin_bit_cast(float, ((unsigned)b) << 16); }
__device__ __forceinline__ float bflo(unsigned w) { return __builtin_bit_cast(float, w << 16); }
__device__ __forceinline__ float bfhi(unsigned w) { return __builtin_bit_cast(float, w & 0xffff0000u); }

#define XB_TMO      128
#define XB_XCNT(j)  (256  + 64 * (j))
#define XB_XSUB(j)  (1280 + 64 * (j))
#define XB_XGEN(j)  (2304 + 64 * (j))
#define XB_TOP      3328
#define XB_TOPGEN   3392
#define XCD_BAR_WORDS 3456
#define XB_SPIN_CAP (1u << 20)
__device__ __forceinline__ unsigned xb_ld(unsigned* p)              { return __hip_atomic_load(p, __ATOMIC_RELAXED, __HIP_MEMORY_SCOPE_AGENT); }
__device__ __forceinline__ unsigned xb_add(unsigned* p, unsigned v) { return __hip_atomic_fetch_add(p, v, __ATOMIC_RELAXED, __HIP_MEMORY_SCOPE_AGENT); }
__device__ __forceinline__ unsigned xb_xcc_id() { return (unsigned)__builtin_amdgcn_s_getreg((3 << 11) | 20) & 0xFu; }
#define XB_SPIN(cond, bar) do { unsigned _sp = 0; while (cond) { __builtin_amdgcn_s_sleep(1); \
    if ((++_sp & 255u) == 0u) { if (xb_ld(&(bar)[XB_TMO])) break; if (_sp > XB_SPIN_CAP) { atomicAdd(&(bar)[XB_TMO], 1u); break; } } } } while (0)
struct XcdBarrier { unsigned* bar; unsigned x; volatile LAS unsigned* st; };
__device__ __forceinline__ XcdBarrier xcd_barrier_post(unsigned* bar, volatile LAS unsigned* st) {
    XcdBarrier b; b.bar = bar; b.x = xb_xcc_id(); b.st = st;
    if (threadIdx.x == 0) (void)xb_add(&bar[XB_XCNT(b.x)], 1u);
    return b;
}
__device__ __forceinline__ void xcd_barrier_complete(unsigned* bar, unsigned x, unsigned& nloc, unsigned& nx) {
    const unsigned G = gridDim.x * gridDim.y * gridDim.z;
    unsigned sum, cnt, mine, sp = 0u;
    for (;;) {
        sum = 0u; cnt = 0u; mine = 0u;
#pragma unroll
        for (unsigned j = 0; j < 16; ++j) { const unsigned c = xb_ld(&bar[XB_XCNT(j)]); sum += c; cnt += (c > 0u) ? 1u : 0u; mine = (j == x) ? c : mine; }
        if (sum == G) break;
        __builtin_amdgcn_s_sleep(1);
        if ((++sp & 255u) == 0u) { if (xb_ld(&bar[XB_TMO])) break; if (sp > XB_SPIN_CAP) { atomicAdd(&bar[XB_TMO], 1u); break; } }
    }
    nloc = mine > 0u ? mine : 1u; nx = cnt > 0u ? cnt : 1u;
}
__device__ __forceinline__ void xcd_barrier(const XcdBarrier& b) {
    asm volatile("s_waitcnt vmcnt(0)" ::: "memory");
    __syncthreads();
    if (threadIdx.x == 0) {
        unsigned* bar = b.bar;
        __builtin_amdgcn_s_waitcnt(0);
        unsigned nloc = b.st[0], nx = b.st[1];
        if (nloc == 0u) { xcd_barrier_complete(bar, b.x, nloc, nx); b.st[0] = nloc; b.st[1] = nx; }
        const unsigned old = xb_add(&bar[XB_XSUB(b.x)], 1u);
        const unsigned gen = old / nloc;
        if (old + 1u == (gen + 1u) * nloc) {
            __builtin_amdgcn_fence(__ATOMIC_RELEASE, "agent");
            asm volatile("s_waitcnt vmcnt(0)" ::: "memory");
            const unsigned og = xb_add(&bar[XB_TOP], 1u);
            const unsigned tg = og / nx;
            if (og + 1u == (tg + 1u) * nx) xb_add(&bar[XB_TOPGEN], 1u);
            else XB_SPIN(xb_ld(&bar[XB_TOPGEN]) == tg, bar);
            __builtin_amdgcn_fence(__ATOMIC_ACQUIRE, "agent");
            xb_add(&bar[XB_XGEN(b.x)], 1u);
            asm volatile("s_waitcnt vmcnt(0)" ::: "memory");
        } else {
            XB_SPIN(xb_ld(&bar[XB_XGEN(b.x)]) == gen, bar);
            __builtin_amdgcn_fence(__ATOMIC_ACQUIRE, "agent");
            asm volatile("s_waitcnt vmcnt(0)" ::: "memory");
        }
    }
    __syncthreads();
}

struct Frame {
    LAS unsigned char* lds;
    unsigned* ctl;
    int G, wg;
    const float *x_prompt, *x_sample, *state_hgrn, *state_ret, *c_prompt, *c_sample, *lb_logits, *w_ada, *b_ada, *norm1_g, *norm2_g, *w_in, *hgrn_g, *ret_g, *w_out, *w_up, *w_down, *final_g;
    float* out;
    bf16 *Win_t, *Wout_t, *Wup_t, *Wdn_t, *H, *P, *O, *U;
    float *X, *LF, *MOD, *LB, *RC, *RS;
};

__device__ __forceinline__ int ltid() { int t = threadIdx.x; asm volatile("" : "+v"(t)); return t; }
#define PHASE_IDS() const int tid = ltid(), lane = tid & 63, wave = __builtin_amdgcn_readfirstlane(tid >> 6); (void)lane; (void)wave
__device__ __forceinline__ float wave_sum(float v) {
#pragma unroll
    for (int o = 1; o < 64; o <<= 1) v += __shfl_xor(v, o);
    return v;
}
__device__ __forceinline__ void p0_transpose_item(const float* W, int K, int N, bf16* WT, LAS float* scr, int item, int lane) {
    const int nblk = N / 32, kb = item / nblk, nb = item % nblk, k0 = 64 * kb, n0 = 32 * nb;
#pragma unroll 8
    for (int i = 0; i < 32; ++i) { const int kk = 2 * i + (lane >> 5); scr[kk * 33 + (lane & 31)] = W[(size_t)(k0 + kk) * N + n0 + (lane & 31)]; }
    LDS_WAIT(); asm volatile("" ::: "memory");
    const int c = lane & 7;
#pragma unroll
    for (int j = 0; j < 4; ++j) { const int n = (lane >> 3) + 8 * j; const LAS float* s = scr + (8 * c) * 33 + n;
        v4u o; o.x = pk2(s[0 * 33], s[1 * 33]); o.y = pk2(s[2 * 33], s[3 * 33]); o.z = pk2(s[4 * 33], s[5 * 33]); o.w = pk2(s[6 * 33], s[7 * 33]);
        *(GAS v4u*)(WT + (size_t)(n0 + n) * K + k0 + 8 * c) = o; }
    LDS_WAIT(); asm volatile("" ::: "memory");
}
__device__ __forceinline__ void p0_mod_task(Frame& F, int task) {
    PHASE_IDS();
    const int l = task / 48, cb = task % 48;
    LAS float* cact = (LAS float*)(F.lds);
    LAS float* red = (LAS float*)(F.lds + 73728);
    for (int i = tid; i < NSEQ * DM; i += NWAVES * 64) { const int b = i / DM, k = i % DM; const float c = (b == 0) ? F.c_prompt[k] : F.c_sample[(b - 1) * DM + k]; cact[i] = c / (1.0f + __expf(-c)); }
    __syncthreads();
    const float* W = F.w_ada + (size_t)l * DM * NMOD + cb * 256 + 4 * lane;
    f32x4 acc[NSEQ];
#pragma unroll
    for (int b = 0; b < NSEQ; ++b) acc[b] = (f32x4){0.f, 0.f, 0.f, 0.f};
    const int kbeg = wave * 256;
#pragma unroll 2
    for (int k0 = kbeg; k0 < kbeg + 256; k0 += 4) {
        const f32x4 w0 = *(const f32x4*)(W + (size_t)(k0 + 0) * NMOD), w1 = *(const f32x4*)(W + (size_t)(k0 + 1) * NMOD), w2 = *(const f32x4*)(W + (size_t)(k0 + 2) * NMOD), w3 = *(const f32x4*)(W + (size_t)(k0 + 3) * NMOD);
#pragma unroll
        for (int b = 0; b < NSEQ; ++b) { const f32x4 c = *(const LAS f32x4*)(cact + b * DM + k0); acc[b] += w0 * c.x + w1 * c.y + w2 * c.z + w3 * c.w; }
    }
#pragma unroll
    for (int b = 0; b < NSEQ; ++b) *(LAS f32x4*)(red + (wave * NSEQ + b) * 256 + 4 * lane) = acc[b];
    __syncthreads();
    for (int o = tid; o < NSEQ * 256; o += NWAVES * 64) { const int b = o / 256, c = o % 256; float s = 0.f;
#pragma unroll
        for (int w = 0; w < 8; ++w) s += red[(w * NSEQ + b) * 256 + c];
        F.MOD[(size_t)(b * DEPTH + l) * NMOD + cb * 256 + c] = s + F.b_ada[(size_t)l * NMOD + cb * 256 + c]; }
    __syncthreads();
}
__device__ __forceinline__ void sincos_acc(float angf, float& sn, float& cs) {
    const double a = (double)angf;
    const double q = __builtin_rint(a * 0.63661977236758134308);
    double r = __builtin_fma(-q, 1.57079632679489655800, a); r = __builtin_fma(-q, 6.12323399573676603587e-17, r);
    const double r2 = r * r;
    double sp = 1.0 / 6227020800.0; sp = sp * r2 - 1.0 / 39916800.0; sp = sp * r2 + 1.0 / 362880.0; sp = sp * r2 - 1.0 / 5040.0; sp = sp * r2 + 1.0 / 120.0; sp = sp * r2 - 1.0 / 6.0; sp = sp * r2 * r + r;
    double cp = 1.0 / 479001600.0; cp = cp * r2 - 1.0 / 3628800.0; cp = cp * r2 + 1.0 / 40320.0; cp = cp * r2 - 1.0 / 720.0; cp = cp * r2 + 1.0 / 24.0; cp = cp * r2 - 0.5; cp = cp * r2 + 1.0;
    const int qi = ((int)q) & 3;
    const double s = (qi == 0) ? sp : (qi == 1) ? cp : (qi == 2) ? -sp : -cp;
    const double c = (qi == 0) ? cp : (qi == 1) ? -sp : (qi == 2) ? -cp : sp;
    sn = (float)s; cs = (float)c;
}
__device__ __forceinline__ void p0_prologue(Frame& F) {
    PHASE_IDS();
    const int gt = F.wg * (NWAVES * 64) + tid, NGT = F.G * NWAVES * 64;
    for (int c = gt; c < 1024; c += NGT) {
        const float a0 = F.lb_logits[c], a1 = F.lb_logits[1024 + c], a2 = F.lb_logits[2048 + c], a3 = F.lb_logits[3072 + c];
        const float mx = fmaxf(fmaxf(a0, a1), fmaxf(a2, a3));
        const float e0 = expf(a0 - mx), e1 = expf(a1 - mx), e2 = expf(a2 - mx), e3 = expf(a3 - mx), inv = 1.0f / (e0 + e1 + e2 + e3);
        F.LB[c] = 0.f; F.LB[1024 + c] = e1 * inv; F.LB[2048 + c] = (e1 + e2) * inv; F.LB[3072 + c] = (e1 + e2 + e3) * inv;
    }
    for (int i = gt; i < SEQ * 128; i += NGT) {
        const int pos = i >> 7, j = i & 127;
        const float t = (float)j * (1.0f / 127.0f);
        const float invf = (float)(1.0 / exp((double)t * 9.21034037197618271));
        const float ang = (float)pos * invf;
        float sn, cs; sincos_acc(ang, sn, cs);
        F.RC[i] = cs; F.RS[i] = sn;
    }
    { const f32x4* s0 = (const f32x4*)F.x_prompt; const f32x4* s1 = (const f32x4*)F.x_sample; f32x4* d = (f32x4*)F.X;
      const int n0 = SEQ * DM / 4, n1 = DECB * DECS * DM / 4;
      for (int i = gt; i < n0; i += NGT) d[i] = s0[i];
      for (int i = gt; i < n1; i += NGT) d[n0 + i] = s1[i]; }
    for (int task = F.wg; task < DEPTH * 48; task += F.G) p0_mod_task(F, task);
    LAS float* scr = (LAS float*)(F.lds + wave * 16384);
    constexpr int I_IN = (DM / 64) * (NPROJ / 32), I_OUT = (DM / 64) * (DM / 32), I_UP = (DM / 64) * (DFF / 32), I_DN = (DFF / 64) * (DM / 32);
    constexpr int I_LAYER = I_IN + I_OUT + I_UP + I_DN, NITEMS = DEPTH * I_LAYER;
    for (;;) {
        int base = 0; if (lane == 0) base = (int)atomicAdd(F.ctl + CW_Q0, 8u);
        base = __builtin_amdgcn_readfirstlane(base);
        if (base >= NITEMS) break;
        for (int it = base; it < base + 8 && it < NITEMS; ++it) {
            const int l = it / I_LAYER; int r = it % I_LAYER;
            if (r < I_IN) { p0_transpose_item(F.w_in + (size_t)l * DM * NPROJ, DM, NPROJ, F.Win_t + (size_t)l * NPROJ * DM, scr, r, lane); continue; } r -= I_IN;
            if (r < I_OUT) { p0_transpose_item(F.w_out + (size_t)l * DM * DM, DM, DM, F.Wout_t + (size_t)l * DM * DM, scr, r, lane); continue; } r -= I_OUT;
            if (r < I_UP) { p0_transpose_item(F.w_up + (size_t)l * DM * DFF, DM, DFF, F.Wup_t + (size_t)l * DFF * DM, scr, r, lane); continue; } r -= I_UP;
            p0_transpose_item(F.w_down + (size_t)l * DFF * DM, DFF, DM, F.Wdn_t + (size_t)l * DM * DFF, scr, r, lane);
        }
    }
}
__device__ __forceinline__ void norm_phase(Frame& F, const float* g, int l, int which_sh  ) {
    PHASE_IDS();
    const int gw = F.wg * NWAVES + wave, NGW = F.G * NWAVES;
    for (int m = gw; m < M; m += NGW) {
        const f32x4* xr = (const f32x4*)(F.X + (size_t)m * DM) + lane;
        f32x4 v[8]; float ss = 0.f;
#pragma unroll
        for (int j = 0; j < 8; ++j) { v[j] = xr[64 * j]; ss += (v[j].x * v[j].x + v[j].y * v[j].y) + (v[j].z * v[j].z + v[j].w * v[j].w); }
        const float rstd = 1.0f / sqrtf(wave_sum(ss) * (1.0f / DM) + EPS);
        const float* mod = F.MOD + (size_t)(row_seq(m) * DEPTH + l) * NMOD;
        const f32x4* gp = (const f32x4*)g + lane; const f32x4* shp = (const f32x4*)(mod + which_sh * DM) + lane; const f32x4* scp = (const f32x4*)(mod + (which_sh + 1) * DM) + lane;
        v2u* o8 = (v2u*)(F.H + (size_t)m * DM) + lane;
#pragma unroll
        for (int j = 0; j < 8; ++j) { const f32x4 gg = gp[64 * j], sh = shp[64 * j], sc = scp[64 * j];
            const f32x4 h = v[j] * rstd * gg * (sc + 1.0f) + sh;
            v2u w; w.x = pk2(h.x, h.y); w.y = pk2(h.z, h.w); o8[64 * j] = w; }
    }
}
__device__ __forceinline__ void final_phase(Frame& F) {
    PHASE_IDS();
    const int gw = F.wg * NWAVES + wave, NGW = F.G * NWAVES;
    for (int m = gw; m < M; m += NGW) {
        const f32x4* xr = (const f32x4*)(F.X + (size_t)m * DM) + lane;
        f32x4 v[8]; float ss = 0.f;
#pragma unroll
        for (int j = 0; j < 8; ++j) { v[j] = xr[64 * j]; ss += (v[j].x * v[j].x + v[j].y * v[j].y) + (v[j].z * v[j].z + v[j].w * v[j].w); }
        const float rstd = 1.0f / sqrtf(wave_sum(ss) * (1.0f / DM) + EPS);
        const f32x4* gp = (const f32x4*)F.final_g + lane; f32x4* o = (f32x4*)(F.out + (size_t)m * DM) + lane;
#pragma unroll
        for (int j = 0; j < 8; ++j) o[64 * j] = v[j] * rstd * gp[64 * j];
    }
}
template <int DK, int DV, bool IS_RET>
__device__ __forceinline__ void naive_mix_unit(Frame& F, int l, int seq, int h) {
    constexpr int NS = 512 / DV, KS = DK / NS, TB = 16, NJ = DV / 64;
    PHASE_IDS();
    const int v = tid % DV, ks = tid / DV;
    const int row0 = seq == 0 ? 0 : SEQ + 64 * (seq - 1), ntok = seq == 0 ? SEQ : 64;
    const int cq = IS_RET ? 4096 + h * 256 : h * 128;
    const int ck = IS_RET ? 5120 + h * 256 : 1024 + h * 128;
    const int cv = IS_RET ? 6144 + h * 256 : 2048 + h * 128;
    const int cg = IS_RET ? 7168 + h * 256 : 3072 + h * 128;
    const int co = IS_RET ? 1024 + h * 256 : h * 128;
    LAS float* qs = (LAS float*)F.lds;
    LAS float* kss = qs + TB * DK;
    LAS float* dss = kss + TB * DK;
    LAS float* vss = dss + TB * DK;
    LAS float* part = vss + TB * DV;
    float s[KS];
    if (seq == 0) {
#pragma unroll
        for (int i = 0; i < KS; ++i) s[i] = 0.f;
    } else {
        const float* src = IS_RET ? F.state_ret + ((size_t)((l * DECB + (seq - 1)) * HB + h) * 256) * 256 : F.state_hgrn + ((size_t)((l * DECB + (seq - 1)) * HA + h) * 128) * 128;
#pragma unroll
        for (int i = 0; i < KS; ++i) s[i] = src[(size_t)(ks * KS + i) * DV + v];
    }
    const float gam = 1.0f - exp2f(-5.0f - (float)h);
    const float* gn = (IS_RET ? F.ret_g : F.hgrn_g) + l * 1024 + h * DV;
    for (int t0 = 0; t0 < ntok; t0 += TB) {
        __syncthreads();
        for (int i = tid; i < TB * DK; i += 512) { const int t = i / DK, k = i % DK; const size_t row = row0 + t0 + t;
            qs[i] = bf2f(F.P[row * 8192 + cq + k]); kss[i] = bf2f(F.P[row * 8192 + ck + k]);
            if (!IS_RET) dss[i] = __expf(F.LF[row * 1024 + h * 128 + k]); }
        for (int i = tid; i < TB * DV; i += 512) { const int t = i / DV, vv = i % DV; const size_t row = row0 + t0 + t; vss[i] = bf2f(F.P[row * 8192 + cv + vv]); }
        __syncthreads();
        for (int t = 0; t < TB; ++t) {
            const float vv = vss[t * DV + v]; float po = 0.f;
#pragma unroll
            for (int i = 0; i < KS; ++i) { const int k = ks * KS + i; const float d = IS_RET ? gam : dss[t * DK + k]; s[i] = d * s[i] + kss[t * DK + k] * vv; po += qs[t * DK + k] * s[i]; }
            part[(ks * TB + t) * DV + v] = po;
        }
        __syncthreads();
#pragma unroll
        for (int tt = 0; tt < 2; ++tt) {
            const int t = 2 * wave + tt; const size_t row = row0 + t0 + t;
            float o[NJ]; float ss = 0.f;
#pragma unroll
            for (int j = 0; j < NJ; ++j) { const int vv = lane + 64 * j; float a = 0.f;
#pragma unroll
                for (int q = 0; q < NS; ++q) a += part[(q * TB + t) * DV + vv];
                o[j] = a; ss += a * a; }
            const float rstd = 1.0f / sqrtf(wave_sum(ss) * (1.0f / DV) + EPS);
#pragma unroll
            for (int j = 0; j < NJ; ++j) { const int vv = lane + 64 * j; const float gate = bf2f(F.P[row * 8192 + cg + vv]);
                F.O[row * 2048 + co + vv] = (bf16)f2bf(o[j] * rstd * gn[vv] * gate); }
        }
    }
    float* dst;
    if (IS_RET) dst = F.out + (seq == 0 ? OFF_SB_P + ((size_t)(l * HB + h) * 256) * 256 : OFF_SB_S + ((size_t)((l * DECB + (seq - 1)) * HB + h) * 256) * 256);
    else        dst = F.out + (seq == 0 ? OFF_SA_P + ((size_t)(l * HA + h) * 128) * 128 : OFF_SA_S + ((size_t)((l * DECB + (seq - 1)) * HA + h) * 128) * 128);
#pragma unroll
    for (int i = 0; i < KS; ++i) dst[(size_t)(ks * KS + i) * DV + v] = s[i];
}
__device__ __forceinline__ void naive_mix_phase(Frame& F, int l) {
    for (int u = F.wg; u < NSEQ * 12; u += F.G) {
        const int seq = u / 12, hh = u % 12;
        if (hh < 8) naive_mix_unit<128, 128, false>(F, l, seq, hh);
        else        naive_mix_unit<256, 256, true>(F, l, seq, hh - 8);
        __syncthreads();
    }
}
constexpr int PH_PRO = 0, PH_PER_LAYER = 9, PH_FINAL = 1 + DEPTH * PH_PER_LAYER, N_PHASES = PH_FINAL + 1;
struct Args { const float* in[18]; float* out; unsigned char* ws; int ph_lo, ph_hi; };
__global__ void __launch_bounds__(NWAVES * 64, 2) fwd(Args args) {
    extern __shared__ __attribute__((aligned(16))) unsigned char lds[];
    Frame F;
    F.lds = (LAS unsigned char*)lds;
    F.G = gridDim.x; F.wg = blockIdx.x;
    unsigned char* ws = args.ws;
    F.ctl = (unsigned*)(ws + WS_CTL);
    F.x_prompt = args.in[0]; F.x_sample = args.in[1]; F.state_hgrn = args.in[2]; F.state_ret = args.in[3]; F.c_prompt = args.in[4]; F.c_sample = args.in[5];
    F.lb_logits = args.in[6]; F.w_ada = args.in[7]; F.b_ada = args.in[8]; F.norm1_g = args.in[9]; F.norm2_g = args.in[10]; F.w_in = args.in[11];
    F.hgrn_g = args.in[12]; F.ret_g = args.in[13]; F.w_out = args.in[14]; F.w_up = args.in[15]; F.w_down = args.in[16]; F.final_g = args.in[17];
    F.out = args.out;
    F.Win_t = (bf16*)(ws + WS_WIN); F.Wout_t = (bf16*)(ws + WS_WOUT); F.Wup_t = (bf16*)(ws + WS_WUP); F.Wdn_t = (bf16*)(ws + WS_WDN);
    F.X = (float*)(ws + WS_X); F.H = (bf16*)(ws + WS_H); F.P = (bf16*)(ws + WS_P); F.LF = (float*)(ws + WS_LF); F.O = (bf16*)(ws + WS_O); F.U = (bf16*)(ws + WS_U);
    F.MOD = (float*)(ws + WS_MOD); F.LB = (float*)(ws + WS_LB); F.RC = (float*)(ws + WS_ROPE); F.RS = F.RC + SEQ * 128;
    volatile LAS unsigned* MISC = (volatile LAS unsigned*)(F.lds + MISC_OFF);
    if (threadIdx.x < 64) MISC[threadIdx.x] = 0u;
    __syncthreads();
    const int lo = args.ph_lo, hi = args.ph_hi;
    XcdBarrier bar; bar.bar = F.ctl + CW_BAR; bar.x = 0; bar.st = MISC + 8;
    if (hi - lo > 1) bar = xcd_barrier_post(F.ctl + CW_BAR, MISC + 8);
#define IN(k) (lo <= (k) && (k) < hi)
#define SEAM(k) do { if (IN(k) && IN((k) + 1)) xcd_barrier(bar); } while (0)

    if (IN(PH_PRO)) {
#ifndef SKIP_PRO
 p0_prologue(F);
#endif
 } SEAM(PH_PRO);
    for (int l = 0; l < DEPTH; ++l) {
        const int pb = 1 + l * PH_PER_LAYER;
        if (IN(pb + 0)) {
#ifndef SKIP_NORM
 norm_phase(F, F.norm1_g + l * DM, l, 0);
#endif
 } SEAM(pb + 0);
        if (IN(pb + 1)) {
            pg8::Gemm g{F.H, F.Win_t + (size_t)l * NPROJ * DM, M, NPROJ, DM}; pg8::StaticOrder S; S.init(M, NPROJ, F.G, F.wg);
            pg8::EpiInProj E{F.P, F.LF, F.LB + l * 1024, F.RC, F.RS};
#ifndef SKIP_G1
            pg8::gemm_phase<pg8::EpiInProj, pg8::StaticOrder, true, true>(F.lds + RING_OFF, g, S, E);
#endif
        } SEAM(pb + 1);
        if (IN(pb + 2)) {
#ifndef SKIP_MIX
 naive_mix_phase(F, l);
#endif
 } SEAM(pb + 2);
        SEAM(pb + 3);
        SEAM(pb + 4);
        if (IN(pb + 5)) {
            pg8::Gemm g{F.O, F.Wout_t + (size_t)l * DM * DM, M, DM, DM}; pg8::StaticOrder S; S.init(M, DM, F.G, F.wg);
            pg8::EpiResid E{F.X, F.MOD + (size_t)l * NMOD + 2 * DM, DEPTH * NMOD};
#ifndef SKIP_G2
            pg8::gemm_phase<pg8::EpiResid, pg8::StaticOrder, true, true>(F.lds + RING_OFF, g, S, E);
#endif
        } SEAM(pb + 5);
        if (IN(pb + 6)) {
#ifndef SKIP_NORM
 norm_phase(F, F.norm2_g + l * DM, l, 3);
#endif
 } SEAM(pb + 6);
        if (IN(pb + 7)) {
            pg8::Gemm g{F.H, F.Wup_t + (size_t)l * DFF * DM, M, DFF, DM}; pg8::StaticOrder S; S.init(M, DFF, F.G, F.wg);
            pg8::EpiRelu2 E{F.U, DFF};
#ifndef SKIP_G3
            pg8::gemm_phase<pg8::EpiRelu2, pg8::StaticOrder, true, true>(F.lds + RING_OFF, g, S, E);
#endif
        } SEAM(pb + 7);
        if (IN(pb + 8)) {
            pg8::Gemm g{F.U, F.Wdn_t + (size_t)l * DM * DFF, M, DM, DFF}; pg8::StaticOrder S; S.init(M, DM, F.G, F.wg);
            pg8::EpiResid E{F.X, F.MOD + (size_t)l * NMOD + 5 * DM, DEPTH * NMOD};
#ifndef SKIP_G4
            pg8::gemm_phase<pg8::EpiResid, pg8::StaticOrder, true, true>(F.lds + RING_OFF, g, S, E);
#endif
        } SEAM(pb + 8);
    }
    if (IN(PH_FINAL)) {
#ifndef SKIP_NORM
 final_phase(F);
#endif
 }
#undef IN
#undef SEAM
}

#ifndef MK_ONE_LAUNCH
#define MK_ONE_LAUNCH 1
#endif
extern "C" void kernel_launch(void* const* d_in, const int* in_sizes, int n_in, void* d_out, int out_size, void* d_ws, size_t ws_size, hipStream_t stream) {
    static int grid = 0;
    if (grid == 0) {
        if (n_in != 18 || (size_t)out_size != OUT_TOTAL || ws_size < WS_END) { fprintf(stderr, "kernel_launch: unexpected shapes: n_in %d out %d ws %zu (need %zu)\n", n_in, out_size, ws_size, (size_t)WS_END); grid = -1; return; }
        int dev = 0, cus = 0, per_cu = 0;
        if (hipGetDevice(&dev) != hipSuccess || hipDeviceGetAttribute(&cus, hipDeviceAttributeMultiprocessorCount, dev) != hipSuccess) { grid = -1; return; }
        if (hipFuncSetAttribute((const void*)fwd, hipFuncAttributeMaxDynamicSharedMemorySize, LDS_BYTES) != hipSuccess) { fprintf(stderr, "kernel_launch: hipFuncSetAttribute failed\n"); grid = -1; return; }
        if (hipOccupancyMaxActiveBlocksPerMultiprocessor(&per_cu, (const void*)fwd, NWAVES * 64, LDS_BYTES) != hipSuccess || per_cu < 1)
            fprintf(stderr, "kernel_launch: note: occupancy query reports %d workgroups per CU\n", per_cu);
        (void)hipGetLastError();
        grid = cus;
    }
    if (grid < 0) return;
    if (hipMemsetAsync((char*)d_ws + WS_CTL, 0, CTL_ZERO_BYTES, stream) != hipSuccess) { fprintf(stderr, "kernel_launch: memset failed\n"); return; }
    Args a{};
    for (int i = 0; i < 18; ++i) a.in[i] = (const float*)d_in[i];
    a.out = (float*)d_out; a.ws = (unsigned char*)d_ws;
#if MK_ONE_LAUNCH
    a.ph_lo = 0; a.ph_hi = N_PHASES;
    hipLaunchKernelGGL(fwd, dim3(grid), dim3(NWAVES * 64), LDS_BYTES, stream, a);
#else
    for (int ph = 0; ph < N_PHASES; ++ph) {
        if (ph >= 1 && ph < PH_FINAL) { const int r = (ph - 1) % PH_PER_LAYER; if (r == 3 || r == 4) continue; }
        a.ph_lo = ph; a.ph_hi = ph + 1;
        hipLaunchKernelGGL(fwd, dim3(grid), dim3(NWAVES * 64), LDS_BYTES, stream, a);
    }
#endif
    const hipError_t le = hipPeekAtLastError();
    if (le != hipSuccess) fprintf(stderr, "kernel_launch: launch failed: %s\n", hipGetErrorName(le));
}
```

```cpp
#include <hip/hip_runtime.h>
#include <cstdio>
#include <cstdint>
__device__ __forceinline__ int row_pos(int row) { return row < 8192 ? row : 2048 + ((row - 8192) & 63); }
__device__ __forceinline__ int row_seq(int row) { return row < 8192 ? 0 : 1 + ((row - 8192) >> 6); }
namespace pg8 {
#define PG8_LAS __attribute__((address_space(3)))
typedef unsigned short bf16_t;
typedef short bf16x8 __attribute__((ext_vector_type(8)));
typedef float f32x4 __attribute__((ext_vector_type(4)));
typedef unsigned u32x4 __attribute__((ext_vector_type(4)));
typedef unsigned u32x2 __attribute__((ext_vector_type(2)));
constexpr int BM = 256, BK = 64, HALF = 128, HTB = HALF * BK * 2  , STAGE_BYTES = 8 * HTB, NXCD = 8, WGM = 8;

__host__ __device__ __forceinline__ int lds_byte(int r, int c) { const int st = (r >> 4) * 2 + (c >> 5), rr = r & 15, cc = c & 31, ob = rr * 64 + cc * 2; return st * 1024 + (ob ^ (((ob >> 9) & 1) << 5)); }
__host__ __device__ __forceinline__ void stage_rc(int b, int& R, int& C) { const int st = b / 1024, sb = b % 1024, swz = sb ^ (((sb >> 9) & 1) << 5); R = (st >> 1) * 16 + swz / 64; C = (st & 1) * 32 + (swz % 64) / 2; }
__host__ __device__ __forceinline__ int perm32(int rho) { const int n = rho >> 4, i = rho & 15; return 8 * (i >> 2) + 4 * n + (i & 3); }

struct Unit { int pm, pn; };
struct Gemm { const bf16_t* A; const bf16_t* Bt; int M, N, K; };

struct StaticOrder {
    int nM, nN, nwg, G, c;
    __host__ __device__ void init(int M, int N, int G_, int c_) { nM = M / BM; nN = N / BM; nwg = nM * nN; G = G_; c = c_; }
    __host__ __device__ bool next(int i, Unit& u) const {
        const long L = (long)i * G + c; if (L >= nwg) return false;
        int wgid = (int)L; { const int q = nwg / NXCD, r = nwg % NXCD, xcd = wgid % NXCD, off = wgid / NXCD; wgid = (xcd < r ? xcd * (q + 1) : r * (q + 1) + (xcd - r) * q) + off; }
        const int nig = WGM * nN, gid = wgid / nig, fm = gid * WGM, gsz = (nM - fm) < WGM ? (nM - fm) : WGM;
        u.pm = fm + ((wgid % nig) % gsz); u.pn = (wgid % nig) / gsz; return true;
    }
    __device__ __forceinline__ void a_ready(const Unit&) const {}
    __device__ __forceinline__ void done(const Unit&) const {}
};

__device__ __forceinline__ unsigned cvt_pk_bf16(float lo, float hi) { unsigned r; asm volatile("v_cvt_pk_bf16_f32 %0, %1, %2" : "=v"(r) : "v"(lo), "v"(hi)); return r; }
__device__ __forceinline__ float fast_rcp(float x) { return __builtin_amdgcn_rcpf(x); }
__device__ __forceinline__ float silu_f(float x) { return x * fast_rcp(1.0f + __expf(-x)); }

struct EpiInProj {
    static constexpr bool PERM = true, AFTER_DRAIN = false;
    bf16_t* P; float* LF; const float* lb; const float* rc; const float* rs;
    __device__ __forceinline__ void operator()(const f32x4 (&acc)[2][2][4][2], const Unit& u, int wr, int wc, int fr, int fq) const {
        const int seg = u.pn >> 2;
        const int row0 = u.pm * BM + wr * 64 + fr;
        const int colg0 = u.pn * BM + wc * 32 + 8 * fq;
        if (seg == 4 || seg == 5) {
            const float ksc = (seg == 5) ? 0.0625f : 1.0f;
            const int j0 = wc * 32 + 8 * fq;
#pragma unroll
            for (int ai = 0; ai < 2; ++ai)
#pragma unroll
                for (int m = 0; m < 4; ++m) {
                    const int row = row0 + ai * HALF + m * 16; const int pos = row_pos(row);
                    const f32x4 c0 = *(const f32x4*)(rc + (size_t)pos * 128 + j0), c1 = *(const f32x4*)(rc + (size_t)pos * 128 + j0 + 4);
                    const f32x4 s0 = *(const f32x4*)(rs + (size_t)pos * 128 + j0), s1 = *(const f32x4*)(rs + (size_t)pos * 128 + j0 + 4);
                    const f32x4 x1a = acc[ai][0][m][0], x1b = acc[ai][0][m][1], x2a = acc[ai][1][m][0], x2b = acc[ai][1][m][1];
                    const f32x4 o1a = (x1a * c0 - x2a * s0) * ksc, o1b = (x1b * c1 - x2b * s1) * ksc;
                    const f32x4 o2a = (x2a * c0 + x1a * s0) * ksc, o2b = (x2b * c1 + x1b * s1) * ksc;
                    bf16_t* rowp = P + (size_t)row * 8192 + colg0;
                    u32x4 w; w.x = cvt_pk_bf16(o1a[0], o1a[1]); w.y = cvt_pk_bf16(o1a[2], o1a[3]); w.z = cvt_pk_bf16(o1b[0], o1b[1]); w.w = cvt_pk_bf16(o1b[2], o1b[3]);
                    *(u32x4*)(rowp) = w;
                    w.x = cvt_pk_bf16(o2a[0], o2a[1]); w.y = cvt_pk_bf16(o2a[2], o2a[3]); w.z = cvt_pk_bf16(o2b[0], o2b[1]); w.w = cvt_pk_bf16(o2b[2], o2b[3]);
                    *(u32x4*)(rowp + HALF) = w;
                }
        } else if (seg == 1) {
#pragma unroll
            for (int bj = 0; bj < 2; ++bj) {
                const int cs = colg0 + bj * HALF - 1024;
                const f32x4 lb0 = *(const f32x4*)(lb + cs), lb1 = *(const f32x4*)(lb + cs + 4);
#pragma unroll
                for (int ai = 0; ai < 2; ++ai)
#pragma unroll
                    for (int m = 0; m < 4; ++m) {
                        const int row = row0 + ai * HALF + m * 16;
                        f32x4 lf0, lf1, k0, k1;
#pragma unroll
                        for (int e = 0; e < 4; ++e) {
                            { const float x = acc[ai][bj][m][0][e], l = lb0[e]; const float sg = fast_rcp(1.0f + __expf(-x)), sn = fast_rcp(1.0f + __expf(x)); lf0[e] = __logf(l + (1.0f - l) * sg); k0[e] = (1.0f - l) * sn; }
                            { const float x = acc[ai][bj][m][1][e], l = lb1[e]; const float sg = fast_rcp(1.0f + __expf(-x)), sn = fast_rcp(1.0f + __expf(x)); lf1[e] = __logf(l + (1.0f - l) * sg); k1[e] = (1.0f - l) * sn; }
                        }
                        float* lfp = LF + (size_t)row * 1024 + cs; *(f32x4*)lfp = lf0; *(f32x4*)(lfp + 4) = lf1;
                        u32x4 w; w.x = cvt_pk_bf16(k0[0], k0[1]); w.y = cvt_pk_bf16(k0[2], k0[3]); w.z = cvt_pk_bf16(k1[0], k1[1]); w.w = cvt_pk_bf16(k1[2], k1[3]);
                        *(u32x4*)(P + (size_t)row * 8192 + colg0 + bj * HALF) = w;
                    }
            }
        } else {
            const bool act = (seg == 0 || seg == 3 || seg == 7);
#pragma unroll
            for (int ai = 0; ai < 2; ++ai)
#pragma unroll
                for (int m = 0; m < 4; ++m) { bf16_t* rowp = P + (size_t)(row0 + ai * HALF + m * 16) * 8192 + colg0;
#pragma unroll
                    for (int bj = 0; bj < 2; ++bj) { f32x4 v0 = acc[ai][bj][m][0], v1 = acc[ai][bj][m][1];
                        if (act) {
#pragma unroll
                            for (int e = 0; e < 4; ++e) { v0[e] = silu_f(v0[e]); v1[e] = silu_f(v1[e]); } }
                        u32x4 w; w.x = cvt_pk_bf16(v0[0], v0[1]); w.y = cvt_pk_bf16(v0[2], v0[3]); w.z = cvt_pk_bf16(v1[0], v1[1]); w.w = cvt_pk_bf16(v1[2], v1[3]);
                        *(u32x4*)(rowp + bj * HALF) = w; } }
        }
    }
};
struct EpiRelu2 {
    static constexpr bool PERM = true, AFTER_DRAIN = false;
    bf16_t* O; int ldc;
    __device__ __forceinline__ void operator()(const f32x4 (&acc)[2][2][4][2], const Unit& u, int wr, int wc, int fr, int fq) const {
        const int row0 = u.pm * BM + wr * 64 + fr, col0 = u.pn * BM + wc * 32 + 8 * fq;
#pragma unroll
        for (int ai = 0; ai < 2; ++ai)
#pragma unroll
            for (int m = 0; m < 4; ++m) { bf16_t* rowp = O + (size_t)(row0 + ai * HALF + m * 16) * ldc + col0;
#pragma unroll
                for (int bj = 0; bj < 2; ++bj) { f32x4 v0 = acc[ai][bj][m][0], v1 = acc[ai][bj][m][1];
#pragma unroll
                    for (int e = 0; e < 4; ++e) { const float a = fmaxf(v0[e], 0.f), b = fmaxf(v1[e], 0.f); v0[e] = a * a; v1[e] = b * b; }
                    u32x4 w; w.x = cvt_pk_bf16(v0[0], v0[1]); w.y = cvt_pk_bf16(v0[2], v0[3]); w.z = cvt_pk_bf16(v1[0], v1[1]); w.w = cvt_pk_bf16(v1[2], v1[3]);
                    *(u32x4*)(rowp + bj * HALF) = w; } }
    }
};
struct EpiResid {
    static constexpr bool PERM = false, AFTER_DRAIN = false;
    float* X; const float* gate; int seq_stride;
    __device__ __forceinline__ void operator()(const f32x4 (&acc)[2][2][4][2], const Unit& u, int wr, int wc, int fr, int fq) const {
        const int row0 = u.pm * BM + wr * 64 + fr, col0 = u.pn * BM + wc * 32 + 4 * fq;
#pragma unroll
        for (int ai = 0; ai < 2; ++ai) {
            const int sq = row_seq(u.pm * BM + wr * 64 + ai * HALF);
            const float* g = gate + (size_t)sq * seq_stride + col0;
            f32x4 gv[2][2];
#pragma unroll
            for (int bj = 0; bj < 2; ++bj)
#pragma unroll
                for (int n = 0; n < 2; ++n) gv[bj][n] = *(const f32x4*)(g + bj * HALF + n * 16);
#pragma unroll
            for (int m = 0; m < 4; ++m) { float* rowp = X + (size_t)(row0 + ai * HALF + m * 16) * 2048 + col0;
#pragma unroll
                for (int bj = 0; bj < 2; ++bj)
#pragma unroll
                    for (int n = 0; n < 2; ++n) { const f32x4 xv = *(const f32x4*)(rowp + bj * HALF + n * 16); *(f32x4*)(rowp + bj * HALF + n * 16) = xv + gv[bj][n] * acc[ai][bj][m][n]; }
                asm volatile("" ::: "memory"); }
        }
    }
};
template <class Epi, class Sched, bool ALIGN_EPI = false, bool SP2 = false>
__device__ __forceinline__ void gemm_phase(PG8_LAS unsigned char* lds, const Gemm g, const Sched& S, const Epi& E) {
    int tid_l = threadIdx.x; asm volatile("" : "+v"(tid_l));
    const int tid = tid_l, wid = __builtin_amdgcn_readfirstlane(tid >> 6), lane = tid & 63, wr = wid >> 2, wc = wid & 3, fr = lane & 15, fq = lane >> 4;
    const int K = g.K, nt = K / BK;
    unsigned voffA[2], voffB[2];
#pragma unroll
    for (int i = 0; i < 2; ++i) { int R, C; stage_rc(tid * 16 + i * 8192, R, C); const int Rb = Epi::PERM ? ((R & ~31) + perm32(R & 31)) : R;
        voffA[i] = (unsigned)(R * K + C) * 2u; voffB[i] = (unsigned)(Rb * K + C) * 2u; }
    const size_t kstep = (size_t)(BK * 2);
    const size_t hstep = (size_t)HALF * K * 2;
    const size_t tstep = 2 * hstep;
    const unsigned ldsw = (unsigned)wid * 1024u;
    const int aoff = lds_byte(wr * 64 + fr, fq * 8), boff = lds_byte(wc * 32 + fr, fq * 8);
#define PG8_SA(b, h) (((b) * 2 + (h)) * HTB)
#define PG8_SB(b, h) ((4 + (b) * 2 + (h)) * HTB)
#define PG8_STAGE(bufoff, gbase, voff) do { _Pragma("unroll") for (int _i = 0; _i < 2; ++_i) \
        __builtin_amdgcn_global_load_lds((const unsigned*)((const char*)(gbase) + (voff)[_i]), (PG8_LAS unsigned*)(lds + (bufoff) + ldsw + _i * 8192), 16, 0, 0); } while (0)
#define PG8_LDA(dst, b, h) do { _Pragma("unroll") for (int m = 0; m < 4; ++m) _Pragma("unroll") for (int k = 0; k < 2; ++k) dst[m][k] = *(const PG8_LAS bf16x8*)(lds + PG8_SA(b, h) + aoff + m * 2048 + k * 1024); } while (0)
#define PG8_LDB(dst, b, h) do { _Pragma("unroll") for (int n = 0; n < 2; ++n) _Pragma("unroll") for (int k = 0; k < 2; ++k) dst[n][k] = *(const PG8_LAS bf16x8*)(lds + PG8_SB(b, h) + boff + n * 2048 + k * 1024); } while (0)
#define PG8_MMA(ai, bj, At, Bt) do { __builtin_amdgcn_s_setprio(1); _Pragma("unroll") for (int m = 0; m < 4; ++m) _Pragma("unroll") for (int n = 0; n < 2; ++n) _Pragma("unroll") for (int k = 0; k < 2; ++k) \
        acc[ai][bj][m][n] = __builtin_amdgcn_mfma_f32_16x16x32_bf16(Bt[n][k], At[m][k], acc[ai][bj][m][n], 0, 0, 0); __builtin_amdgcn_s_setprio(0); } while (0)
#define PG8_WAIT_V(n) asm volatile("s_waitcnt vmcnt(" #n ")" ::: "memory")
#define PG8_WAIT_L(n) asm volatile("s_waitcnt lgkmcnt(" #n ")" ::: "memory")
#define PG8_BAR __builtin_amdgcn_s_barrier()
#define PG8_SCHED __builtin_amdgcn_sched_barrier(0)
    Unit cur, nxt; int ui = 0;
    if (!S.next(0, cur)) return;
    f32x4 acc[2][2][4][2];
#pragma unroll
    for (int a = 0; a < 2; ++a)
#pragma unroll
        for (int b = 0; b < 2; ++b)
#pragma unroll
            for (int m = 0; m < 4; ++m)
#pragma unroll
                for (int n = 0; n < 2; ++n) acc[a][b][m][n] = (f32x4){0.f, 0.f, 0.f, 0.f};
    bf16x8 At[4][2], B0[2][2], B1[2][2];
    const char* cA = (const char*)g.A + (size_t)cur.pm * tstep; const char* cB = (const char*)g.Bt + (size_t)cur.pn * tstep;
    S.a_ready(cur);
    if constexpr (SP2) {
        PG8_STAGE(PG8_SB(0, 0), cB, voffB); PG8_STAGE(PG8_SB(0, 1), cB + hstep, voffB); PG8_STAGE(PG8_SA(0, 0), cA, voffA); PG8_STAGE(PG8_SA(0, 1), cA + hstep, voffA);
        if (wr == 1) PG8_BAR;
        PG8_WAIT_V(2); PG8_BAR;
        PG8_STAGE(PG8_SB(1, 0), cB + kstep, voffB); PG8_STAGE(PG8_SA(1, 0), cA + kstep, voffA); PG8_STAGE(PG8_SB(1, 1), cB + hstep + kstep, voffB);
        PG8_WAIT_V(6); PG8_BAR;
    } else {
        PG8_STAGE(PG8_SB(0, 0), cB, voffB); PG8_STAGE(PG8_SA(0, 0), cA, voffA); PG8_STAGE(PG8_SB(0, 1), cB + hstep, voffB); PG8_STAGE(PG8_SA(0, 1), cA + hstep, voffA);
        if (wr == 1) PG8_BAR;
        PG8_WAIT_V(4); PG8_BAR;
        PG8_STAGE(PG8_SB(1, 0), cB + kstep, voffB); PG8_STAGE(PG8_SA(1, 0), cA + kstep, voffA); PG8_STAGE(PG8_SB(1, 1), cB + hstep + kstep, voffB);
        PG8_WAIT_V(6); PG8_BAR;
    }
    for (;;) {
        const bool has_next = S.next(ui + 1, nxt);
        const char* nA = has_next ? (const char*)g.A + (size_t)nxt.pm * tstep : cA; const char* nB = has_next ? (const char*)g.Bt + (size_t)nxt.pn * tstep : cB;
        for (int t = 0; t < nt; t += 2) {
            const bool last = (t == nt - 2);
            const char* a1 = cA + (size_t)(t + 1) * kstep;
            const char* a2 = last ? nA : cA + (size_t)(t + 2) * kstep; const char* b2 = last ? nB : cB + (size_t)(t + 2) * kstep;
            const char* a3 = a2 + kstep; const char* b3 = b2 + kstep;
            if (last && has_next) S.a_ready(nxt);
            if constexpr (SP2) {
            PG8_LDB(B0, 0, 0); PG8_LDB(B1, 0, 1); PG8_SCHED; PG8_LDA(At, 0, 0); PG8_STAGE(PG8_SA(1, 1), a1 + hstep, voffA);
            PG8_WAIT_V(8); PG8_WAIT_L(0); PG8_BAR; PG8_MMA(0, 0, At, B0); PG8_MMA(0, 1, At, B1); PG8_BAR; PG8_SCHED;
            PG8_LDA(At, 0, 1); PG8_STAGE(PG8_SB(0, 0), b2, voffB); PG8_STAGE(PG8_SB(0, 1), b2 + hstep, voffB); PG8_STAGE(PG8_SA(0, 0), a2, voffA);
            PG8_WAIT_V(8); PG8_WAIT_L(0); PG8_BAR; PG8_MMA(1, 0, At, B0); PG8_MMA(1, 1, At, B1); PG8_BAR; PG8_SCHED;
            PG8_LDB(B0, 1, 0); PG8_LDB(B1, 1, 1); PG8_SCHED; PG8_LDA(At, 1, 0); PG8_STAGE(PG8_SA(0, 1), a2 + hstep, voffA);
            PG8_WAIT_V(8); PG8_WAIT_L(0); PG8_BAR; PG8_MMA(0, 0, At, B0); PG8_MMA(0, 1, At, B1); PG8_BAR; PG8_SCHED;
            PG8_LDA(At, 1, 1); PG8_STAGE(PG8_SB(1, 0), b3, voffB); PG8_STAGE(PG8_SB(1, 1), b3 + hstep, voffB); PG8_STAGE(PG8_SA(1, 0), a3, voffA);
            PG8_WAIT_V(8); PG8_WAIT_L(0); PG8_BAR; PG8_MMA(1, 0, At, B0); PG8_MMA(1, 1, At, B1); PG8_BAR; PG8_SCHED;
            } else {
            PG8_LDB(B0, 0, 0); PG8_SCHED; PG8_LDA(At, 0, 0); PG8_STAGE(PG8_SA(1, 1), a1 + hstep, voffA);
            PG8_WAIT_L(8); PG8_BAR; PG8_WAIT_L(0); PG8_MMA(0, 0, At, B0); PG8_BAR; PG8_SCHED;
            PG8_LDB(B1, 0, 1); PG8_STAGE(PG8_SB(0, 0), b2, voffB);
            PG8_BAR; PG8_WAIT_L(0); PG8_MMA(0, 1, At, B1); PG8_BAR;
            PG8_LDA(At, 0, 1); PG8_STAGE(PG8_SA(0, 0), a2, voffA);
            PG8_BAR; PG8_WAIT_L(0); PG8_MMA(1, 0, At, B0); PG8_BAR; PG8_SCHED;
            PG8_STAGE(PG8_SB(0, 1), b2 + hstep, voffB);
            PG8_WAIT_V(6); PG8_BAR; PG8_MMA(1, 1, At, B1); PG8_BAR;
            PG8_LDB(B0, 1, 0); PG8_SCHED; PG8_LDA(At, 1, 0); PG8_STAGE(PG8_SA(0, 1), a2 + hstep, voffA);
            PG8_WAIT_L(8); PG8_BAR; PG8_WAIT_L(0); PG8_MMA(0, 0, At, B0); PG8_BAR; PG8_SCHED;
            PG8_LDB(B1, 1, 1); PG8_STAGE(PG8_SB(1, 0), b3, voffB);
            PG8_BAR; PG8_WAIT_L(0); PG8_MMA(0, 1, At, B1); PG8_BAR;
            PG8_LDA(At, 1, 1); PG8_STAGE(PG8_SA(1, 0), a3, voffA);
            PG8_BAR; PG8_WAIT_L(0); PG8_MMA(1, 0, At, B0); PG8_BAR; PG8_SCHED;
            PG8_STAGE(PG8_SB(1, 1), b3 + hstep, voffB);
            PG8_WAIT_V(6); PG8_BAR; PG8_MMA(1, 1, At, B1); PG8_BAR;
            }
        }
        if constexpr (ALIGN_EPI) { if (wr == 0) PG8_BAR; }
        if constexpr (!Epi::AFTER_DRAIN) { E(acc, cur, wr, wc, fr, fq); S.done(cur); }
        if (!has_next) break;
#pragma unroll
        for (int a = 0; a < 2; ++a)
#pragma unroll
            for (int b = 0; b < 2; ++b)
#pragma unroll
                for (int m = 0; m < 4; ++m)
#pragma unroll
                    for (int n = 0; n < 2; ++n) acc[a][b][m][n] = (f32x4){0.f, 0.f, 0.f, 0.f};
        cur = nxt; cA = nA; cB = nB; ++ui;
        if constexpr (ALIGN_EPI) { if (wr == 1) PG8_BAR; }
    }
    PG8_WAIT_V(0);
    if constexpr (!ALIGN_EPI) { if (wr == 0) PG8_BAR; }
    PG8_BAR;
    if constexpr (Epi::AFTER_DRAIN) { E.fused(acc, cur, wr, wc, fr, fq, lds, wid, lane); S.done(cur); }
#undef PG8_SA
#undef PG8_SB
#undef PG8_STAGE
#undef PG8_LDA
#undef PG8_LDB
#undef PG8_MMA
#undef PG8_WAIT_V
#undef PG8_WAIT_L
#undef PG8_BAR
#undef PG8_SCHED
}
}
constexpr int NWAVES = 8;
constexpr int DM = 2048, SEQ = 8192, DEPTH = 4, DECB = 8, DECS = 64, M = SEQ + DECB * DECS, NPROJ = 8192, DFF = 8192, NSEQ = 9, NMOD = 6 * DM;
constexpr int HA = 8, HB = 4;
constexpr float EPS = 1e-6f;
constexpr size_t OFF_SA_P = (size_t)M * DM, OFF_SB_P = OFF_SA_P + (size_t)DEPTH * HA * 128 * 128, OFF_SA_S = OFF_SB_P + (size_t)DEPTH * HB * 256 * 256,
                 OFF_SB_S = OFF_SA_S + (size_t)DEPTH * DECB * HA * 128 * 128, OUT_TOTAL = OFF_SB_S + (size_t)DEPTH * DECB * HB * 256 * 256;

constexpr size_t MiB = 1u << 20;
constexpr size_t WS_CTL = 0, CTL_ZERO_BYTES = 1 * MiB;
constexpr size_t WS_WIN = 2 * MiB;
constexpr size_t WS_WOUT = WS_WIN + 128 * MiB;
constexpr size_t WS_WUP = WS_WOUT + 32 * MiB;
constexpr size_t WS_WDN = WS_WUP + 128 * MiB;
constexpr size_t WS_X = WS_WDN + 128 * MiB;
constexpr size_t WS_H = WS_X + 68 * MiB;
constexpr size_t WS_P = WS_H + 34 * MiB;
constexpr size_t WS_LF = WS_P + 136 * MiB;
constexpr size_t WS_O = WS_LF + 34 * MiB;
constexpr size_t WS_U = WS_O + 34 * MiB;
constexpr size_t WS_MOD = WS_U + 136 * MiB;
constexpr size_t WS_LB = WS_MOD + 2 * MiB;
constexpr size_t WS_ROPE = WS_LB + 1 * MiB;
constexpr size_t WS_END = WS_ROPE + 8 * MiB;
constexpr int CW_Q0 = 64;
constexpr int CW_BAR = 4096;

constexpr int RING_OFF = 0, RING_BYTES = 131072;
constexpr int LDS_BYTES = 151552;
constexpr int MISC_OFF = 147456;

#define GAS __attribute__((address_space(1)))
#define LAS __attribute__((address_space(3)))
typedef unsigned short bf16;
typedef unsigned v4u __attribute__((ext_vector_type(4)));
typedef unsigned v2u __attribute__((ext_vector_type(2)));
typedef float f32x4 __attribute__((ext_vector_type(4)));
typedef short bf16x8 __attribute__((ext_vector_type(8)));
#define LDS_WAIT() asm volatile("s_waitcnt lgkmcnt(0)" ::: "memory")
#define VM_WAIT() asm volatile("s_waitcnt vmcnt(0)" ::: "memory")
__device__ __forceinline__ unsigned f2bf(float f) { unsigned u = __builtin_bit_cast(unsigned, f); return (u + 0x7fffu + ((u >> 16) & 1u)) >> 16; }
__device__ __forceinline__ unsigned pk2(float lo, float hi) { return pg8::cvt_pk_bf16(lo, hi); }
__device__ __forceinline__ float bf2f(unsigned short b) { return __builtin_bit_cast(float, ((unsigned)b) << 16); }
__device__ __forceinline__ float bflo(unsigned w) { return __builtin_bit_cast(float, w << 16); }
__device__ __forceinline__ float bfhi(unsigned w) { return __builtin_bit_cast(float, w & 0xffff0000u); }

#define XB_TMO      128
#define XB_XCNT(j)  (256  + 64 * (j))
#define XB_XSUB(j)  (1280 + 64 * (j))
#define XB_XGEN(j)  (2304 + 64 * (j))
#define XB_TOP      3328
#define XB_TOPGEN   3392
#define XCD_BAR_WORDS 3456
#define XB_SPIN_CAP (1u << 20)
__device__ __forceinline__ unsigned xb_ld(unsigned* p)              { return __hip_atomic_load(p, __ATOMIC_RELAXED, __HIP_MEMORY_SCOPE_AGENT); }
__device__ __forceinline__ unsigned xb_add(unsigned* p, unsigned v) { return __hip_atomic_fetch_add(p, v, __ATOMIC_RELAXED, __HIP_MEMORY_SCOPE_AGENT); }
__device__ __forceinline__ unsigned xb_xcc_id() { return (unsigned)__builtin_amdgcn_s_getreg((3 << 11) | 20) & 0xFu; }
#define XB_SPIN(cond, bar) do { unsigned _sp = 0; while (cond) { __builtin_amdgcn_s_sleep(1); \
    if ((++_sp & 255u) == 0u) { if (xb_ld(&(bar)[XB_TMO])) break; if (_sp > XB_SPIN_CAP) { atomicAdd(&(bar)[XB_TMO], 1u); break; } } } } while (0)
struct XcdBarrier { unsigned* bar; unsigned x; volatile LAS unsigned* st; };
__device__ __forceinline__ XcdBarrier xcd_barrier_post(unsigned* bar, volatile LAS unsigned* st) {
    XcdBarrier b; b.bar = bar; b.x = xb_xcc_id(); b.st = st;
    if (threadIdx.x == 0) (void)xb_add(&bar[XB_XCNT(b.x)], 1u);
    return b;
}
__device__ __forceinline__ void xcd_barrier_complete(unsigned* bar, unsigned x, unsigned& nloc, unsigned& nx) {
    const unsigned G = gridDim.x * gridDim.y * gridDim.z;
    unsigned sum, cnt, mine, sp = 0u;
    for (;;) {
        sum = 0u; cnt = 0u; mine = 0u;
#pragma unroll
        for (unsigned j = 0; j < 16; ++j) { const unsigned c = xb_ld(&bar[XB_XCNT(j)]); sum += c; cnt += (c > 0u) ? 1u : 0u; mine = (j == x) ? c : mine; }
        if (sum == G) break;
        __builtin_amdgcn_s_sleep(1);
        if ((++sp & 255u) == 0u) { if (xb_ld(&bar[XB_TMO])) break; if (sp > XB_SPIN_CAP) { atomicAdd(&bar[XB_TMO], 1u); break; } }
    }
    nloc = mine > 0u ? mine : 1u; nx = cnt > 0u ? cnt : 1u;
}
__device__ __forceinline__ void xcd_barrier(const XcdBarrier& b) {
    asm volatile("s_waitcnt vmcnt(0)" ::: "memory");
    __syncthreads();
    if (threadIdx.x == 0) {
        unsigned* bar = b.bar;
        __builtin_amdgcn_s_waitcnt(0);
        unsigned nloc = b.st[0], nx = b.st[1];
        if (nloc == 0u) { xcd_barrier_complete(bar, b.x, nloc, nx); b.st[0] = nloc; b.st[1] = nx; }
        const unsigned old = xb_add(&bar[XB_XSUB(b.x)], 1u);
        const unsigned gen = old / nloc;
        if (old + 1u == (gen + 1u) * nloc) {
            __builtin_amdgcn_fence(__ATOMIC_RELEASE, "agent");
            asm volatile("s_waitcnt vmcnt(0)" ::: "memory");
            const unsigned og = xb_add(&bar[XB_TOP], 1u);
            const unsigned tg = og / nx;
            if (og + 1u == (tg + 1u) * nx) xb_add(&bar[XB_TOPGEN], 1u);
            else XB_SPIN(xb_ld(&bar[XB_TOPGEN]) == tg, bar);
            __builtin_amdgcn_fence(__ATOMIC_ACQUIRE, "agent");
            xb_add(&bar[XB_XGEN(b.x)], 1u);
            asm volatile("s_waitcnt vmcnt(0)" ::: "memory");
        } else {
            XB_SPIN(xb_ld(&bar[XB_XGEN(b.x)]) == gen, bar);
            __builtin_amdgcn_fence(__ATOMIC_ACQUIRE, "agent");
            asm volatile("s_waitcnt vmcnt(0)" ::: "memory");
        }
    }
    __syncthreads();
}

struct Frame {
    LAS unsigned char* lds;
    unsigned* ctl;
    unsigned char* ws;
    int G, wg;
    const float *x_prompt, *x_sample, *state_hgrn, *state_ret, *c_prompt, *c_sample, *lb_logits, *w_ada, *b_ada, *norm1_g, *norm2_g, *w_in, *hgrn_g, *ret_g, *w_out, *w_up, *w_down, *final_g;
    float* out;
    bf16 *Win_t, *Wout_t, *Wup_t, *Wdn_t, *H, *P, *O, *U;
    float *X, *LF, *MOD, *LB, *RC, *RS;
};

__device__ __forceinline__ int ltid() { int t = threadIdx.x; asm volatile("" : "+v"(t)); return t; }
#define PHASE_IDS() const int tid = ltid(), lane = tid & 63, wave = __builtin_amdgcn_readfirstlane(tid >> 6); (void)lane; (void)wave
__device__ __forceinline__ float wave_sum(float v) {
#pragma unroll
    for (int o = 1; o < 64; o <<= 1) v += __shfl_xor(v, o);
    return v;
}
__device__ __forceinline__ void p0_transpose_item(const float* W, int K, int N, bf16* WT, LAS float* scr, int item, int lane) {
    const int nblk = N / 32, kb = item / nblk, nb = item % nblk, k0 = 64 * kb, n0 = 32 * nb;
#pragma unroll 8
    for (int i = 0; i < 32; ++i) { const int kk = 2 * i + (lane >> 5); scr[kk * 33 + (lane & 31)] = W[(size_t)(k0 + kk) * N + n0 + (lane & 31)]; }
    LDS_WAIT(); asm volatile("" ::: "memory");
    const int c = lane & 7;
#pragma unroll
    for (int j = 0; j < 4; ++j) { const int n = (lane >> 3) + 8 * j; const LAS float* s = scr + (8 * c) * 33 + n;
        v4u o; o.x = pk2(s[0 * 33], s[1 * 33]); o.y = pk2(s[2 * 33], s[3 * 33]); o.z = pk2(s[4 * 33], s[5 * 33]); o.w = pk2(s[6 * 33], s[7 * 33]);
        *(GAS v4u*)(WT + (size_t)(n0 + n) * K + k0 + 8 * c) = o; }
    LDS_WAIT(); asm volatile("" ::: "memory");
}
__device__ __forceinline__ void p0_mod_task(Frame& F, int task) {
    PHASE_IDS();
    const int l = task / 48, cb = task % 48;
    LAS float* cact = (LAS float*)(F.lds);
    LAS float* red = (LAS float*)(F.lds + 73728);
    for (int i = tid; i < NSEQ * DM; i += NWAVES * 64) { const int b = i / DM, k = i % DM; const float c = (b == 0) ? F.c_prompt[k] : F.c_sample[(b - 1) * DM + k]; cact[i] = c / (1.0f + __expf(-c)); }
    __syncthreads();
    const float* W = F.w_ada + (size_t)l * DM * NMOD + cb * 256 + 4 * lane;
    f32x4 acc[NSEQ];
#pragma unroll
    for (int b = 0; b < NSEQ; ++b) acc[b] = (f32x4){0.f, 0.f, 0.f, 0.f};
    const int kbeg = wave * 256;
#pragma unroll 2
    for (int k0 = kbeg; k0 < kbeg + 256; k0 += 4) {
        const f32x4 w0 = *(const f32x4*)(W + (size_t)(k0 + 0) * NMOD), w1 = *(const f32x4*)(W + (size_t)(k0 + 1) * NMOD), w2 = *(const f32x4*)(W + (size_t)(k0 + 2) * NMOD), w3 = *(const f32x4*)(W + (size_t)(k0 + 3) * NMOD);
#pragma unroll
        for (int b = 0; b < NSEQ; ++b) { const f32x4 c = *(const LAS f32x4*)(cact + b * DM + k0); acc[b] += w0 * c.x + w1 * c.y + w2 * c.z + w3 * c.w; }
    }
#pragma unroll
    for (int b = 0; b < NSEQ; ++b) *(LAS f32x4*)(red + (wave * NSEQ + b) * 256 + 4 * lane) = acc[b];
    __syncthreads();
    for (int o = tid; o < NSEQ * 256; o += NWAVES * 64) { const int b = o / 256, c = o % 256; float s = 0.f;
#pragma unroll
        for (int w = 0; w < 8; ++w) s += red[(w * NSEQ + b) * 256 + c];
        F.MOD[(size_t)(b * DEPTH + l) * NMOD + cb * 256 + c] = s + F.b_ada[(size_t)l * NMOD + cb * 256 + c]; }
    __syncthreads();
}
__device__ __forceinline__ void sincos_acc(float angf, float& sn, float& cs) {
    const double a = (double)angf;
    const double q = __builtin_rint(a * 0.63661977236758134308);
    double r = __builtin_fma(-q, 1.57079632679489655800, a); r = __builtin_fma(-q, 6.12323399573676603587e-17, r);
    const double r2 = r * r;
    double sp = 1.0 / 6227020800.0; sp = sp * r2 - 1.0 / 39916800.0; sp = sp * r2 + 1.0 / 362880.0; sp = sp * r2 - 1.0 / 5040.0; sp = sp * r2 + 1.0 / 120.0; sp = sp * r2 - 1.0 / 6.0; sp = sp * r2 * r + r;
    double cp = 1.0 / 479001600.0; cp = cp * r2 - 1.0 / 3628800.0; cp = cp * r2 + 1.0 / 40320.0; cp = cp * r2 - 1.0 / 720.0; cp = cp * r2 + 1.0 / 24.0; cp = cp * r2 - 0.5; cp = cp * r2 + 1.0;
    const int qi = ((int)q) & 3;
    const double s = (qi == 0) ? sp : (qi == 1) ? cp : (qi == 2) ? -sp : -cp;
    const double c = (qi == 0) ? cp : (qi == 1) ? -sp : (qi == 2) ? -cp : sp;
    sn = (float)s; cs = (float)c;
}
__device__ __forceinline__ void p0_prologue(Frame& F) {
    PHASE_IDS();
    const int gt = F.wg * (NWAVES * 64) + tid, NGT = F.G * NWAVES * 64;
    for (int c = gt; c < 1024; c += NGT) {
        const float a0 = F.lb_logits[c], a1 = F.lb_logits[1024 + c], a2 = F.lb_logits[2048 + c], a3 = F.lb_logits[3072 + c];
        const float mx = fmaxf(fmaxf(a0, a1), fmaxf(a2, a3));
        const float e0 = expf(a0 - mx), e1 = expf(a1 - mx), e2 = expf(a2 - mx), e3 = expf(a3 - mx), inv = 1.0f / (e0 + e1 + e2 + e3);
        F.LB[c] = 0.f; F.LB[1024 + c] = e1 * inv; F.LB[2048 + c] = (e1 + e2) * inv; F.LB[3072 + c] = (e1 + e2 + e3) * inv;
    }
    for (int i = gt; i < SEQ * 128; i += NGT) {
        const int pos = i >> 7, j = i & 127;
        const float t = (float)j * (1.0f / 127.0f);
        const float invf = (float)(1.0 / exp((double)t * 9.21034037197618271));
        const float ang = (float)pos * invf;
        float sn, cs; sincos_acc(ang, sn, cs);
        F.RC[i] = cs; F.RS[i] = sn;
    }
    { const f32x4* s0 = (const f32x4*)F.x_prompt; const f32x4* s1 = (const f32x4*)F.x_sample; f32x4* d = (f32x4*)F.X;
      const int n0 = SEQ * DM / 4, n1 = DECB * DECS * DM / 4;
      for (int i = gt; i < n0; i += NGT) d[i] = s0[i];
      for (int i = gt; i < n1; i += NGT) d[n0 + i] = s1[i]; }
    for (int task = F.wg; task < DEPTH * 48; task += F.G) p0_mod_task(F, task);
    LAS float* scr = (LAS float*)(F.lds + wave * 16384);
    constexpr int I_IN = (DM / 64) * (NPROJ / 32), I_OUT = (DM / 64) * (DM / 32), I_UP = (DM / 64) * (DFF / 32), I_DN = (DFF / 64) * (DM / 32);
    constexpr int I_LAYER = I_IN + I_OUT + I_UP + I_DN, NITEMS = DEPTH * I_LAYER;
    for (;;) {
        int base = 0; if (lane == 0) base = (int)atomicAdd(F.ctl + CW_Q0, 8u);
        base = __builtin_amdgcn_readfirstlane(base);
        if (base >= NITEMS) break;
        for (int it = base; it < base + 8 && it < NITEMS; ++it) {
            const int l = it / I_LAYER; int r = it % I_LAYER;
            if (r < I_IN) { p0_transpose_item(F.w_in + (size_t)l * DM * NPROJ, DM, NPROJ, F.Win_t + (size_t)l * NPROJ * DM, scr, r, lane); continue; } r -= I_IN;
            if (r < I_OUT) { p0_transpose_item(F.w_out + (size_t)l * DM * DM, DM, DM, F.Wout_t + (size_t)l * DM * DM, scr, r, lane); continue; } r -= I_OUT;
            if (r < I_UP) { p0_transpose_item(F.w_up + (size_t)l * DM * DFF, DM, DFF, F.Wup_t + (size_t)l * DFF * DM, scr, r, lane); continue; } r -= I_UP;
            p0_transpose_item(F.w_down + (size_t)l * DFF * DM, DFF, DM, F.Wdn_t + (size_t)l * DM * DFF, scr, r, lane);
        }
    }
}
__device__ __forceinline__ void norm_phase(Frame& F, const float* g, int l, int which_sh  ) {
    PHASE_IDS();
    const int gw = F.wg * NWAVES + wave, NGW = F.G * NWAVES;
    for (int m = gw; m < M; m += NGW) {
        const f32x4* xr = (const f32x4*)(F.X + (size_t)m * DM) + lane;
        f32x4 v[8]; float ss = 0.f;
#pragma unroll
        for (int j = 0; j < 8; ++j) { v[j] = xr[64 * j]; ss += (v[j].x * v[j].x + v[j].y * v[j].y) + (v[j].z * v[j].z + v[j].w * v[j].w); }
        const float rstd = 1.0f / sqrtf(wave_sum(ss) * (1.0f / DM) + EPS);
        const float* mod = F.MOD + (size_t)(row_seq(m) * DEPTH + l) * NMOD;
        const f32x4* gp = (const f32x4*)g + lane; const f32x4* shp = (const f32x4*)(mod + which_sh * DM) + lane; const f32x4* scp = (const f32x4*)(mod + (which_sh + 1) * DM) + lane;
        v2u* o8 = (v2u*)(F.H + (size_t)m * DM) + lane;
#pragma unroll
        for (int j = 0; j < 8; ++j) { const f32x4 gg = gp[64 * j], sh = shp[64 * j], sc = scp[64 * j];
            const f32x4 h = v[j] * rstd * gg * (sc + 1.0f) + sh;
            v2u w; w.x = pk2(h.x, h.y); w.y = pk2(h.z, h.w); o8[64 * j] = w; }
    }
}
__device__ __forceinline__ void final_phase(Frame& F) {
    PHASE_IDS();
    const int gw = F.wg * NWAVES + wave, NGW = F.G * NWAVES;
    for (int m = gw; m < M; m += NGW) {
        const f32x4* xr = (const f32x4*)(F.X + (size_t)m * DM) + lane;
        f32x4 v[8]; float ss = 0.f;
#pragma unroll
        for (int j = 0; j < 8; ++j) { v[j] = xr[64 * j]; ss += (v[j].x * v[j].x + v[j].y * v[j].y) + (v[j].z * v[j].z + v[j].w * v[j].w); }
        const float rstd = 1.0f / sqrtf(wave_sum(ss) * (1.0f / DM) + EPS);
        const f32x4* gp = (const f32x4*)F.final_g + lane; f32x4* o = (f32x4*)(F.out + (size_t)m * DM) + lane;
#pragma unroll
        for (int j = 0; j < 8; ++j) o[64 * j] = v[j] * rstd * gp[64 * j];
    }
}
constexpr int NSG = 40;
constexpr size_t WS_UA = WS_END;
constexpr size_t WS_DGA = WS_UA + 20 * MiB;
constexpr size_t WS_SSA = WS_DGA + 1 * MiB;
constexpr size_t WS_UB = WS_SSA + 20 * MiB;
constexpr size_t WS_SSB = WS_UB + 40 * MiB;
constexpr size_t WS_END2 = WS_SSB + 20 * MiB;

constexpr int MX_KHT = 0, MX_VT = 18432, MX_QT = 36864, MX_KT = 54272, MX_QH = 71680, MX_A = 89088, MX_EDEC = 98304, MX_RED = 98816, MX_B = 100864, MX_QTOT = 133632  ;
constexpr int RX_Q = 0, RX_K = 33792, RX_VT = 67584, RX_A = 104448, RX_RED = 113664;
constexpr float LOG2E = 1.4426950408889634f;

__device__ __forceinline__ bf16x8 ldfrag(LAS unsigned char* base, int ld_bytes, int row, int kbyte) { return *(const LAS bf16x8*)(base + row * ld_bytes + kbyte); }
__device__ __forceinline__ int tr_off(int row, int tokpair) { return row * 144 + ((((tokpair >> 2) ^ (row >> 3)) & 7) << 4) + ((tokpair & 3) << 2); }
__device__ __forceinline__ bf16x8 tr_frag(LAS unsigned char* base, int row, int chunk) { return *(const LAS bf16x8*)(base + row * 144 + (((chunk ^ (row >> 3)) & 7) << 4)); }
__device__ __forceinline__ float gamma_log2(int h) { return log2f(1.0f - exp2f(-5.0f - (float)h)); }
__device__ __forceinline__ int sg_row0(int sg) { return sg < 32 ? sg * 256 : SEQ + 64 * (sg - 32); }
__device__ __forceinline__ int sg_nch(int sg) { return sg < 32 ? 4 : 1; }

template <bool IS_RET>
__device__ __forceinline__ void p1_unit(Frame& F, int l, int sg, int h, int quad) {
    PHASE_IDS();
    const int g4 = lane >> 4, l16 = lane & 15;
    const int row0 = sg_row0(sg), nch = sg_nch(sg);
    const int kb = quad >> 1, vb = quad & 1;
    const int ck = IS_RET ? 5120 + h * 256 + 128 * kb : 1024 + h * 128;
    const int cv = IS_RET ? 6144 + h * 256 + 128 * vb : 2048 + h * 128;
    LAS unsigned char* L = F.lds;
    LAS float* Bs = (LAS float*)(L + MX_B); LAS float* Qtot = (LAS float*)(L + MX_QTOT); LAS float* Edec = (LAS float*)(L + MX_EDEC);
    const float lg2 = gamma_log2(h);
    f32x4 S[8];
#pragma unroll
    for (int kt = 0; kt < 8; ++kt) S[kt] = (f32x4){0.f, 0.f, 0.f, 0.f};
    float sumb = 0.f;
    for (int c = 0; c < nch; ++c) {
        const int rowc = row0 + 64 * c;
        if (!IS_RET) {
            const int k = tid & 127, tq = tid >> 7;
            float* lfp = F.LF + (size_t)(rowc + 16 * tq) * 1024 + h * 128 + k;
            float pv[16];
#pragma unroll
            for (int i = 0; i < 16; ++i) pv[i] = lfp[(size_t)i * 1024];
#pragma unroll
            for (int i = 1; i < 16; ++i) pv[i] += pv[i - 1];
            Qtot[tq * 128 + k] = pv[15];
            __syncthreads();
            float off = 0.f;
#pragma unroll
            for (int q = 0; q < 3; ++q) off += (q < tq) ? Qtot[q * 128 + k] : 0.f;
#pragma unroll
            for (int i = 0; i < 16; ++i) { const float b = pv[i] + off; lfp[(size_t)i * 1024] = b; Bs[(16 * tq + i) * 128 + k] = b; }
            __syncthreads();
            if (tid < 128) sumb += Bs[63 * 128 + tid];
        }
        {
            const int tp = tid >> 4, kc = tid & 15, ra = rowc + 2 * tp;
            const v4u ka = *(const v4u*)(F.P + (size_t)ra * 8192 + ck + 8 * kc), kbv = *(const v4u*)(F.P + (size_t)(ra + 1) * 8192 + ck + 8 * kc);
            const v4u va = *(const v4u*)(F.P + (size_t)ra * 8192 + cv + 8 * kc), vbv = *(const v4u*)(F.P + (size_t)(ra + 1) * 8192 + cv + 8 * kc);
            float fa[8], fb[8];
            if (IS_RET) {
                const float za = exp2f(lg2 * (float)(63 - 2 * tp)), zb = exp2f(lg2 * (float)(62 - 2 * tp));
#pragma unroll
                for (int i = 0; i < 8; ++i) { fa[i] = za; fb[i] = zb; }
                if (tid < 128) Edec[tid] = exp2f(lg2 * 64.0f);
            } else {
#pragma unroll
                for (int i = 0; i < 8; ++i) { const float bt = Bs[63 * 128 + 8 * kc + i]; fa[i] = exp2f((bt - Bs[(2 * tp) * 128 + 8 * kc + i]) * LOG2E); fb[i] = exp2f((bt - Bs[(2 * tp + 1) * 128 + 8 * kc + i]) * LOG2E);
                    if (tp == 0) Edec[8 * kc + i] = exp2f(bt * LOG2E); }
            }
#pragma unroll
            for (int i = 0; i < 8; ++i) {
                const unsigned wa = ka[i >> 1], wb = kbv[i >> 1];
                const float xa = (i & 1) ? bfhi(wa) : bflo(wa), xb = (i & 1) ? bfhi(wb) : bflo(wb);
                *(LAS unsigned*)(L + MX_KHT + tr_off(8 * kc + i, tp)) = pk2(xa * fa[i], xb * fb[i]);
                const unsigned ua = va[i >> 1], ub = vbv[i >> 1];
                const unsigned lo = (i & 1) ? (ua >> 16) : (ua & 0xffffu), hi = (i & 1) ? (ub >> 16) : (ub & 0xffffu);
                *(LAS unsigned*)(L + MX_VT + tr_off(8 * kc + i, tp)) = lo | (hi << 16);
            }
        }
        __syncthreads();
        {
            bf16x8 Y[2];
#pragma unroll
            for (int ss = 0; ss < 2; ++ss) Y[ss] = tr_frag(L + MX_VT, 16 * wave + l16, 4 * ss + g4);
#pragma unroll
            for (int kt = 0; kt < 8; ++kt) {
                const f32x4 d = *(const LAS f32x4*)(Edec + 16 * kt + 4 * g4);
                S[kt] = S[kt] * d;
#pragma unroll
                for (int ss = 0; ss < 2; ++ss) { const bf16x8 X = tr_frag(L + MX_KHT, 16 * kt + l16, 4 * ss + g4); S[kt] = __builtin_amdgcn_mfma_f32_16x16x32_bf16(X, Y[ss], S[kt], 0, 0, 0); }
            }
        }
        __syncthreads();
    }
    if (IS_RET) {
        float* U = (float*)(F.ws + WS_UB) + ((size_t)(sg * HB + h) * 256 + 128 * vb + 16 * wave + l16) * 256 + 128 * kb + 4 * g4;
#pragma unroll
        for (int kt = 0; kt < 8; ++kt) *(f32x4*)(U + 16 * kt) = S[kt];
    } else {
        float* U = (float*)(F.ws + WS_UA) + ((size_t)(sg * HA + h) * 128 + 16 * wave + l16) * 128 + 4 * g4;
#pragma unroll
        for (int kt = 0; kt < 8; ++kt) *(f32x4*)(U + 16 * kt) = S[kt];
        if (tid < 128) ((float*)(F.ws + WS_DGA))[(size_t)(sg * HA + h) * 128 + tid] = exp2f(sumb * LOG2E);
    }
    __syncthreads();
}
__device__ __forceinline__ void mix1_phase(Frame& F, int l) {
    for (int u = F.wg; u < 960; u += F.G) {
        bool is_ret; int sg, h, quad = 0;
        if (u < 256) { is_ret = false; sg = u >> 3; h = u & 7; }
        else if (u < 768) { const int r = u - 256; is_ret = true; sg = r >> 4; h = (r >> 2) & 3; quad = r & 3; }
        else if (u < 832) { const int r = u - 768; is_ret = false; sg = 32 + (r >> 3); h = r & 7; }
        else { const int r = u - 832; is_ret = true; sg = 32 + (r >> 4); h = (r >> 2) & 3; quad = r & 3; }
        if (is_ret) p1_unit<true>(F, l, sg, h, quad); else p1_unit<false>(F, l, sg, h, quad);
    }
}

__device__ __forceinline__ void mix2_phase(Frame& F, int l) {
    PHASE_IDS();
    const int gt = F.wg * (NWAVES * 64) + tid, NGT = F.G * NWAVES * 64;
    constexpr int IA = 128 * 32, IB = 256 * 64, PER_SEQ = HA * IA + HB * IB;
    for (int it = gt; it < NSEQ * PER_SEQ; it += NGT) {
        const int seq = it / PER_SEQ; int r = it % PER_SEQ;
        const int ng = seq == 0 ? 32 : 1, sg0 = seq == 0 ? 0 : 31 + seq;
        if (r < HA * IA) {
            const int h = r / IA, v = (r % IA) >> 5, k4 = r & 31;
            f32x4 s = (f32x4){0.f, 0.f, 0.f, 0.f};
            if (seq > 0) { const float* s0 = F.state_hgrn + ((size_t)((l * DECB + (seq - 1)) * HA + h) * 128) * 128;
#pragma unroll
                for (int e = 0; e < 4; ++e) s[e] = s0[(size_t)(4 * k4 + e) * 128 + v]; }
            for (int g = 0; g < ng; ++g) {
                const size_t ub = (size_t)((sg0 + g) * HA + h);
                *(f32x4*)((float*)(F.ws + WS_SSA) + (ub * 128 + v) * 128 + 4 * k4) = s;
                const f32x4 u = *(const f32x4*)((const float*)(F.ws + WS_UA) + (ub * 128 + v) * 128 + 4 * k4);
                const f32x4 d = *(const f32x4*)((const float*)(F.ws + WS_DGA) + ub * 128 + 4 * k4);
                s = d * s + u;
            }
            float* dst = F.out + (seq == 0 ? OFF_SA_P + ((size_t)(l * HA + h) * 128) * 128 : OFF_SA_S + ((size_t)((l * DECB + (seq - 1)) * HA + h) * 128) * 128);
#pragma unroll
            for (int e = 0; e < 4; ++e) dst[(size_t)(4 * k4 + e) * 128 + v] = s[e];
        } else {
            r -= HA * IA;
            const int h = r / IB, v = (r % IB) >> 6, k4 = r & 63;
            const float lg2 = gamma_log2(h); const float gd = exp2f(lg2 * (seq == 0 ? 256.0f : 64.0f));
            f32x4 s = (f32x4){0.f, 0.f, 0.f, 0.f};
            if (seq > 0) { const float* s0 = F.state_ret + ((size_t)((l * DECB + (seq - 1)) * HB + h) * 256) * 256;
#pragma unroll
                for (int e = 0; e < 4; ++e) s[e] = s0[(size_t)(4 * k4 + e) * 256 + v]; }
            for (int g = 0; g < ng; ++g) {
                const size_t ub = (size_t)((sg0 + g) * HB + h);
                v2u w; w.x = pk2(s[0], s[1]); w.y = pk2(s[2], s[3]);
                *(v2u*)((bf16*)(F.ws + WS_SSB) + (ub * 256 + v) * 256 + 4 * k4) = w;
                const f32x4 u = *(const f32x4*)((const float*)(F.ws + WS_UB) + (ub * 256 + v) * 256 + 4 * k4);
                s = s * gd + u;
            }
            float* dst = F.out + (seq == 0 ? OFF_SB_P + ((size_t)(l * HB + h) * 256) * 256 : OFF_SB_S + ((size_t)((l * DECB + (seq - 1)) * HB + h) * 256) * 256);
#pragma unroll
            for (int e = 0; e < 4; ++e) dst[(size_t)(4 * k4 + e) * 256 + v] = s[e];
        }
    }
}
typedef short bf16x4 __attribute__((ext_vector_type(4)));
__device__ __forceinline__ float clampf(float x, float lo, float hi) { return fminf(fmaxf(x, lo), hi); }
__device__ __forceinline__ void p3_hgrn_unit(Frame& F, int l, int sg, int h) {
    PHASE_IDS();
    const int g4 = lane >> 4, l16 = lane & 15;
    const int row0 = sg_row0(sg), nch = sg_nch(sg);
    LAS unsigned char* L = F.lds;
    LAS float* Edec = (LAS float*)(L + MX_EDEC); LAS float* Red = (LAS float*)(L + MX_RED);
    f32x4 S[8];
    { const float* ss = (const float*)(F.ws + WS_SSA) + ((size_t)(sg * HA + h) * 128 + 16 * wave + l16) * 128 + 4 * g4;
#pragma unroll
      for (int kt = 0; kt < 8; ++kt) S[kt] = *(const f32x4*)(ss + 16 * kt); }
    const f32x4 gn4 = *(const f32x4*)(F.hgrn_g + l * 1024 + h * 128 + 16 * wave + 4 * g4);
    for (int c = 0; c < nch; ++c) {
        const int rowc = row0 + 64 * c;
        {
            const int tp = tid >> 4, kc = tid & 15, ra = rowc + 2 * tp;
            const bf16* pa = F.P + (size_t)ra * 8192 + h * 128 + 8 * kc; const bf16* pb = pa + 8192;
            const v4u qa = *(const v4u*)pa, qb = *(const v4u*)pb, ka = *(const v4u*)(pa + 1024), kb = *(const v4u*)(pb + 1024), va = *(const v4u*)(pa + 2048), vb = *(const v4u*)(pb + 2048);
            const float* la = F.LF + (size_t)ra * 1024 + h * 128 + 8 * kc;
            const float* lr = F.LF + (size_t)(rowc + 31) * 1024 + h * 128 + 8 * kc; const float* lt = F.LF + (size_t)(rowc + 63) * 1024 + h * 128 + 8 * kc;
            const f32x4 ba0 = *(const f32x4*)la, ba1 = *(const f32x4*)(la + 4), bb0 = *(const f32x4*)(la + 1024), bb1 = *(const f32x4*)(la + 1028);
            const f32x4 br0 = *(const f32x4*)lr, br1 = *(const f32x4*)(lr + 4), bt0 = *(const f32x4*)lt, bt1 = *(const f32x4*)(lt + 4);
            unsigned qta[4], qtb[4], kta[4], ktb[4], qha[4], qhb[4];
            float pqa = 0.f, pqb = 0.f, pka = 0.f, pkb = 0.f, pha = 0.f, phb = 0.f;
#pragma unroll
            for (int i = 0; i < 8; ++i) {
                const float bref = (i < 4) ? br0[i & 3] : br1[i & 3], btot = (i < 4) ? bt0[i & 3] : bt1[i & 3];
                const float ba = (i < 4) ? ba0[i & 3] : ba1[i & 3], bb = (i < 4) ? bb0[i & 3] : bb1[i & 3];
                const float e1a = exp2f(clampf((ba - bref) * LOG2E, -115.f, 115.f)), e1b = exp2f(clampf((bb - bref) * LOG2E, -115.f, 115.f));
                const float e2a = __builtin_amdgcn_rcpf(e1a), e2b = __builtin_amdgcn_rcpf(e1b);
                const float eref = exp2f(bref * LOG2E), etr = exp2f((btot - bref) * LOG2E);
                const unsigned wqa = qa[i >> 1], wqb = qb[i >> 1], wka = ka[i >> 1], wkb = kb[i >> 1];
                const float xqa = (i & 1) ? bfhi(wqa) : bflo(wqa), xqb = (i & 1) ? bfhi(wqb) : bflo(wqb), xka = (i & 1) ? bfhi(wka) : bflo(wka), xkb = (i & 1) ? bfhi(wkb) : bflo(wkb);
                const float tqa = xqa * e1a, tqb = xqb * e1b, tka = xka * e2a, tkb = xkb * e2b;
                const float hqa = tqa * eref, hqb = tqb * eref;
                *(LAS unsigned*)(L + MX_KHT + tr_off(8 * kc + i, tp)) = pk2(tka * etr, tkb * etr);
                const unsigned ua = va[i >> 1], ub = vb[i >> 1];
                const unsigned lo = (i & 1) ? (ua >> 16) : (ua & 0xffffu), hi = (i & 1) ? (ub >> 16) : (ub & 0xffffu);
                *(LAS unsigned*)(L + MX_VT + tr_off(8 * kc + i, tp)) = lo | (hi << 16);
                if (tp == 0) Edec[8 * kc + i] = exp2f(btot * LOG2E);
                if (i & 1) { qta[i >> 1] = pk2(pqa, tqa); qtb[i >> 1] = pk2(pqb, tqb); kta[i >> 1] = pk2(pka, tka); ktb[i >> 1] = pk2(pkb, tkb); qha[i >> 1] = pk2(pha, hqa); qhb[i >> 1] = pk2(phb, hqb); }
                else { pqa = tqa; pqb = tqb; pka = tka; pkb = tkb; pha = hqa; phb = hqb; }
            }
            const int oa = (2 * tp) * 272 + 16 * kc, ob = oa + 272;
            *(LAS v4u*)(L + MX_QT + oa) = (v4u){qta[0], qta[1], qta[2], qta[3]}; *(LAS v4u*)(L + MX_QT + ob) = (v4u){qtb[0], qtb[1], qtb[2], qtb[3]};
            *(LAS v4u*)(L + MX_KT + oa) = (v4u){kta[0], kta[1], kta[2], kta[3]}; *(LAS v4u*)(L + MX_KT + ob) = (v4u){ktb[0], ktb[1], ktb[2], ktb[3]};
            *(LAS v4u*)(L + MX_QH + oa) = (v4u){qha[0], qha[1], qha[2], qha[3]}; *(LAS v4u*)(L + MX_QH + ob) = (v4u){qhb[0], qhb[1], qhb[2], qhb[3]};
        }
        __syncthreads();
        {
            const int jt = wave >> 1;
#pragma unroll
            for (int ii = 0; ii < 2; ++ii) {
                const int it = 2 * (wave & 1) + ii;
                f32x4 a = (f32x4){0.f, 0.f, 0.f, 0.f};
                if (it <= jt) {
#pragma unroll
                    for (int kk = 0; kk < 4; ++kk) a = __builtin_amdgcn_mfma_f32_16x16x32_bf16(ldfrag(L + MX_KT, 272, 16 * it + l16, 64 * kk + 16 * g4), ldfrag(L + MX_QT, 272, 16 * jt + l16, 64 * kk + 16 * g4), a, 0, 0, 0);
                }
                const int t = 16 * jt + l16, s0 = 16 * it + 4 * g4;
                v2u w; w.x = pk2(s0 <= t ? a[0] : 0.f, s0 + 1 <= t ? a[1] : 0.f); w.y = pk2(s0 + 2 <= t ? a[2] : 0.f, s0 + 3 <= t ? a[3] : 0.f);
                if (it > jt) { w.x = 0u; w.y = 0u; }
                *(LAS v2u*)(L + MX_A + t * 144 + s0 * 2) = w;
            }
        }
        f32x4 o[4];
#pragma unroll
        for (int j = 0; j < 4; ++j) o[j] = (f32x4){0.f, 0.f, 0.f, 0.f};
#pragma unroll
        for (int kk = 0; kk < 4; ++kk) {
            const f32x4 s0 = S[2 * kk], s1 = S[2 * kk + 1];
            const v4u xw = (v4u){pk2(s0[0], s0[1]), pk2(s0[2], s0[3]), pk2(s1[0], s1[1]), pk2(s1[2], s1[3])};
            const bf16x8 X = __builtin_bit_cast(bf16x8, xw);
#pragma unroll
            for (int j = 0; j < 4; ++j) {
                const LAS unsigned char* qp = L + MX_QH + (16 * j + l16) * 272 + 64 * kk + 8 * g4;
                const bf16x4 y0 = *(const LAS bf16x4*)qp, y1 = *(const LAS bf16x4*)(qp + 32);
                const bf16x8 Y = __builtin_shufflevector(y0, y1, 0, 1, 2, 3, 4, 5, 6, 7);
                o[j] = __builtin_amdgcn_mfma_f32_16x16x32_bf16(X, Y, o[j], 0, 0, 0);
            }
        }
        __syncthreads();
        {
            bf16x8 Yv[2];
#pragma unroll
            for (int ss = 0; ss < 2; ++ss) Yv[ss] = tr_frag(L + MX_VT, 16 * wave + l16, 4 * ss + g4);
#pragma unroll
            for (int ss = 0; ss < 2; ++ss)
#pragma unroll
                for (int j = 0; j < 4; ++j) { if (ss == 1 && j < 2) continue;
                    o[j] = __builtin_amdgcn_mfma_f32_16x16x32_bf16(Yv[ss], ldfrag(L + MX_A, 144, 16 * j + l16, 64 * ss + 16 * g4), o[j], 0, 0, 0); }
            if (c + 1 < nch) {
#pragma unroll
                for (int kt = 0; kt < 8; ++kt) {
                    S[kt] = S[kt] * *(const LAS f32x4*)(Edec + 16 * kt + 4 * g4);
#pragma unroll
                    for (int ss = 0; ss < 2; ++ss) S[kt] = __builtin_amdgcn_mfma_f32_16x16x32_bf16(tr_frag(L + MX_KHT, 16 * kt + l16, 4 * ss + g4), Yv[ss], S[kt], 0, 0, 0);
                }
            }
        }
#pragma unroll
        for (int j = 0; j < 4; ++j) { float q = (o[j][0] * o[j][0] + o[j][1] * o[j][1]) + (o[j][2] * o[j][2] + o[j][3] * o[j][3]); q += __shfl_xor(q, 16); q += __shfl_xor(q, 32); if (g4 == 0) Red[wave * 64 + 16 * j + l16] = q; }
        __syncthreads();
#pragma unroll
        for (int j = 0; j < 4; ++j) {
            float tot = 0.f;
#pragma unroll
            for (int w = 0; w < 8; ++w) tot += Red[w * 64 + 16 * j + l16];
            const float rstd = 1.0f / sqrtf(tot * (1.0f / 128.0f) + EPS);
            const size_t row = rowc + 16 * j + l16;
            const v2u gw = *(const v2u*)(F.P + row * 8192 + 3072 + h * 128 + 16 * wave + 4 * g4);
            const f32x4 r = o[j] * rstd * gn4;
            v2u w; w.x = pk2(r[0] * bflo(gw.x), r[1] * bfhi(gw.x)); w.y = pk2(r[2] * bflo(gw.y), r[3] * bfhi(gw.y));
            *(v2u*)(F.O + row * 2048 + h * 128 + 16 * wave + 4 * g4) = w;
        }
        __syncthreads();
    }
}
__device__ __forceinline__ void p3_ret_unit(Frame& F, int l, int sg, int jc, int h) {
    PHASE_IDS();
    const int g4 = lane >> 4, l16 = lane & 15;
    const int rowg = sg_row0(sg), rowq = rowg + 64 * jc;
    LAS unsigned char* L = F.lds;
    LAS float* Red = (LAS float*)(L + RX_RED);
    const float lg2 = gamma_log2(h);
    const int tp = tid >> 4, kc = tid & 15;
    {
        const bf16* pa = F.P + (size_t)(rowq + 2 * tp) * 8192 + 4096 + h * 256 + 8 * kc; const bf16* pb = pa + 8192;
        const v4u a0 = *(const v4u*)pa, a1 = *(const v4u*)(pa + 128), b0 = *(const v4u*)pb, b1 = *(const v4u*)(pb + 128);
        const int oa = (2 * tp) * 528 + 16 * kc;
        *(LAS v4u*)(L + RX_Q + oa) = a0; *(LAS v4u*)(L + RX_Q + oa + 256) = a1; *(LAS v4u*)(L + RX_Q + oa + 528) = b0; *(LAS v4u*)(L + RX_Q + oa + 528 + 256) = b1;
    }
    f32x4 acc[2][4];
#pragma unroll
    for (int vt = 0; vt < 2; ++vt)
#pragma unroll
        for (int j = 0; j < 4; ++j) acc[vt][j] = (f32x4){0.f, 0.f, 0.f, 0.f};
    __syncthreads();
    {
        const bf16* sp = (const bf16*)(F.ws + WS_SSB) + ((size_t)(sg * HB + h) * 256 + 32 * wave + l16) * 256 + 8 * g4;
#pragma unroll
        for (int vt = 0; vt < 2; ++vt) {
            bf16x8 X[8];
#pragma unroll
            for (int kk = 0; kk < 8; ++kk) X[kk] = *(const bf16x8*)(sp + (size_t)vt * 16 * 256 + 32 * kk);
#pragma unroll
            for (int kk = 0; kk < 8; ++kk)
#pragma unroll
                for (int j = 0; j < 4; ++j) acc[vt][j] = __builtin_amdgcn_mfma_f32_16x16x32_bf16(X[kk], ldfrag(L + RX_Q, 528, 16 * j + l16, 64 * kk + 16 * g4), acc[vt][j], 0, 0, 0);
        }
#pragma unroll
        for (int j = 0; j < 4; ++j) { const float xi = exp2f(lg2 * (float)(64 * jc + 16 * j + l16 + 1)); acc[0][j] = acc[0][j] * xi; acc[1][j] = acc[1][j] * xi; }
    }
    for (int jp = 0; jp <= jc; ++jp) {
        __syncthreads();
        {
            const bf16* pa = F.P + (size_t)(rowg + 64 * jp + 2 * tp) * 8192 + 5120 + h * 256 + 8 * kc; const bf16* pb = pa + 8192;
            const v4u a0 = *(const v4u*)pa, a1 = *(const v4u*)(pa + 128), b0 = *(const v4u*)pb, b1 = *(const v4u*)(pb + 128);
            const v4u va0 = *(const v4u*)(pa + 1024), va1 = *(const v4u*)(pa + 1024 + 128), vb0 = *(const v4u*)(pb + 1024), vb1 = *(const v4u*)(pb + 1024 + 128);
            const int oa = (2 * tp) * 528 + 16 * kc;
            *(LAS v4u*)(L + RX_K + oa) = a0; *(LAS v4u*)(L + RX_K + oa + 256) = a1; *(LAS v4u*)(L + RX_K + oa + 528) = b0; *(LAS v4u*)(L + RX_K + oa + 528 + 256) = b1;
#pragma unroll
            for (int i = 0; i < 8; ++i) {
                { const unsigned ua = va0[i >> 1], ub = vb0[i >> 1]; const unsigned lo = (i & 1) ? (ua >> 16) : (ua & 0xffffu), hi = (i & 1) ? (ub >> 16) : (ub & 0xffffu);
                  *(LAS unsigned*)(L + RX_VT + tr_off(8 * kc + i, tp)) = lo | (hi << 16); }
                { const unsigned ua = va1[i >> 1], ub = vb1[i >> 1]; const unsigned lo = (i & 1) ? (ua >> 16) : (ua & 0xffffu), hi = (i & 1) ? (ub >> 16) : (ub & 0xffffu);
                  *(LAS unsigned*)(L + RX_VT + tr_off(128 + 8 * kc + i, tp)) = lo | (hi << 16); }
            }
        }
        __syncthreads();
        {
            const int jt = wave >> 1; const bool diag = (jp == jc);
#pragma unroll
            for (int ii = 0; ii < 2; ++ii) {
                const int it = 2 * (wave & 1) + ii;
                f32x4 a = (f32x4){0.f, 0.f, 0.f, 0.f};
                const bool live = !(diag && it > jt);
                if (live) {
#pragma unroll
                    for (int kk = 0; kk < 8; ++kk) a = __builtin_amdgcn_mfma_f32_16x16x32_bf16(ldfrag(L + RX_K, 528, 16 * it + l16, 64 * kk + 16 * g4), ldfrag(L + RX_Q, 528, 16 * jt + l16, 64 * kk + 16 * g4), a, 0, 0, 0);
                }
                const int t = 16 * jt + l16, s0 = 16 * it + 4 * g4; const int dd = 64 * (jc - jp) + t - s0;
                float e[4];
#pragma unroll
                for (int r = 0; r < 4; ++r) { const float dec = exp2f(lg2 * (float)(dd - r)); e[r] = (!diag || s0 + r <= t) ? a[r] * dec : 0.f; }
                v2u w; w.x = pk2(e[0], e[1]); w.y = pk2(e[2], e[3]);
                if (!live) { w.x = 0u; w.y = 0u; }
                *(LAS v2u*)(L + RX_A + t * 144 + s0 * 2) = w;
            }
        }
        __syncthreads();
#pragma unroll
        for (int ss = 0; ss < 2; ++ss)
#pragma unroll
            for (int vt = 0; vt < 2; ++vt) { const bf16x8 X = tr_frag(L + RX_VT, 32 * wave + 16 * vt + l16, 4 * ss + g4);
#pragma unroll
                for (int j = 0; j < 4; ++j) acc[vt][j] = __builtin_amdgcn_mfma_f32_16x16x32_bf16(X, ldfrag(L + RX_A, 144, 16 * j + l16, 64 * ss + 16 * g4), acc[vt][j], 0, 0, 0); }
    }
#pragma unroll
    for (int j = 0; j < 4; ++j) { float q = 0.f;
#pragma unroll
        for (int vt = 0; vt < 2; ++vt) q += (acc[vt][j][0] * acc[vt][j][0] + acc[vt][j][1] * acc[vt][j][1]) + (acc[vt][j][2] * acc[vt][j][2] + acc[vt][j][3] * acc[vt][j][3]);
        q += __shfl_xor(q, 16); q += __shfl_xor(q, 32); if (g4 == 0) Red[wave * 64 + 16 * j + l16] = q; }
    __syncthreads();
#pragma unroll
    for (int j = 0; j < 4; ++j) {
        float tot = 0.f;
#pragma unroll
        for (int w = 0; w < 8; ++w) tot += Red[w * 64 + 16 * j + l16];
        const float rstd = 1.0f / sqrtf(tot * (1.0f / 256.0f) + EPS);
        const size_t row = rowq + 16 * j + l16;
#pragma unroll
        for (int vt = 0; vt < 2; ++vt) {
            const int vc = h * 256 + 32 * wave + 16 * vt + 4 * g4;
            const v2u gw = *(const v2u*)(F.P + row * 8192 + 7168 + vc);
            const f32x4 r = acc[vt][j] * rstd * *(const f32x4*)(F.ret_g + l * 1024 + vc);
            v2u w; w.x = pk2(r[0] * bflo(gw.x), r[1] * bfhi(gw.x)); w.y = pk2(r[2] * bflo(gw.y), r[3] * bfhi(gw.y));
            *(v2u*)(F.O + row * 2048 + 1024 + vc) = w;
        }
    }
    __syncthreads();
}
__device__ __forceinline__ void mix3_phase(Frame& F, int l) {
    for (int vw = F.wg; vw < 256; vw += F.G) {
        for (int q = 0; q < 2; ++q) {
            if (q == 1 && vw >= 64) break;
            const int sg = q == 0 ? (vw >> 3) : 32 + (vw >> 3);
            p3_hgrn_unit(F, l, sg, vw & 7);
        }
        for (int q = 0; q < 3; ++q) {
            int sg, jc, h;
            if (q < 2) { h = vw & 3; sg = (vw >> 2) & 31; const int half = vw >> 7; jc = q == 0 ? (half ? 2 : 3) : (half ? 1 : 0); }
            else { if (vw < 64 || vw >= 96) break; sg = 32 + ((vw - 64) >> 2); jc = 0; h = (vw - 64) & 3; }
            p3_ret_unit(F, l, sg, jc, h);
        }
    }
}
constexpr int PH_PRO = 0, PH_PER_LAYER = 9, PH_FINAL = 1 + DEPTH * PH_PER_LAYER, N_PHASES = PH_FINAL + 1;
struct Args { const float* in[18]; float* out; unsigned char* ws; int ph_lo, ph_hi; };
__global__ void __launch_bounds__(NWAVES * 64, 2) fwd(Args args) {
    extern __shared__ __attribute__((aligned(16))) unsigned char lds[];
    Frame F;
    F.lds = (LAS unsigned char*)lds;
    F.G = gridDim.x; F.wg = blockIdx.x;
    unsigned char* ws = args.ws;
    F.ctl = (unsigned*)(ws + WS_CTL); F.ws = ws;
    F.x_prompt = args.in[0]; F.x_sample = args.in[1]; F.state_hgrn = args.in[2]; F.state_ret = args.in[3]; F.c_prompt = args.in[4]; F.c_sample = args.in[5];
    F.lb_logits = args.in[6]; F.w_ada = args.in[7]; F.b_ada = args.in[8]; F.norm1_g = args.in[9]; F.norm2_g = args.in[10]; F.w_in = args.in[11];
    F.hgrn_g = args.in[12]; F.ret_g = args.in[13]; F.w_out = args.in[14]; F.w_up = args.in[15]; F.w_down = args.in[16]; F.final_g = args.in[17];
    F.out = args.out;
    F.Win_t = (bf16*)(ws + WS_WIN); F.Wout_t = (bf16*)(ws + WS_WOUT); F.Wup_t = (bf16*)(ws + WS_WUP); F.Wdn_t = (bf16*)(ws + WS_WDN);
    F.X = (float*)(ws + WS_X); F.H = (bf16*)(ws + WS_H); F.P = (bf16*)(ws + WS_P); F.LF = (float*)(ws + WS_LF); F.O = (bf16*)(ws + WS_O); F.U = (bf16*)(ws + WS_U);
    F.MOD = (float*)(ws + WS_MOD); F.LB = (float*)(ws + WS_LB); F.RC = (float*)(ws + WS_ROPE); F.RS = F.RC + SEQ * 128;
    volatile LAS unsigned* MISC = (volatile LAS unsigned*)(F.lds + MISC_OFF);
    if (threadIdx.x < 64) MISC[threadIdx.x] = 0u;
    __syncthreads();
    const int lo = args.ph_lo, hi = args.ph_hi;
    XcdBarrier bar; bar.bar = F.ctl + CW_BAR; bar.x = 0; bar.st = MISC + 8;
    if (hi - lo > 1) bar = xcd_barrier_post(F.ctl + CW_BAR, MISC + 8);
#define IN(k) (lo <= (k) && (k) < hi)
#define SEAM(k) do { if (IN(k) && IN((k) + 1)) xcd_barrier(bar); } while (0)

    if (IN(PH_PRO)) {
#ifndef SKIP_PRO
 p0_prologue(F);
#endif
 } SEAM(PH_PRO);
    for (int l = 0; l < DEPTH; ++l) {
        const int pb = 1 + l * PH_PER_LAYER;
        if (IN(pb + 0)) {
#ifndef SKIP_NORM
 norm_phase(F, F.norm1_g + l * DM, l, 0);
#endif
 } SEAM(pb + 0);
        if (IN(pb + 1)) {
            pg8::Gemm g{F.H, F.Win_t + (size_t)l * NPROJ * DM, M, NPROJ, DM}; pg8::StaticOrder S; S.init(M, NPROJ, F.G, F.wg);
            pg8::EpiInProj E{F.P, F.LF, F.LB + l * 1024, F.RC, F.RS};
#ifndef SKIP_G1
            pg8::gemm_phase<pg8::EpiInProj, pg8::StaticOrder, true, true>(F.lds + RING_OFF, g, S, E);
#endif
        } SEAM(pb + 1);
        if (IN(pb + 2)) { mix1_phase(F, l); } SEAM(pb + 2);
        if (IN(pb + 3)) { mix2_phase(F, l); } SEAM(pb + 3);
        if (IN(pb + 4)) { mix3_phase(F, l); } SEAM(pb + 4);
        if (IN(pb + 5)) {
            pg8::Gemm g{F.O, F.Wout_t + (size_t)l * DM * DM, M, DM, DM}; pg8::StaticOrder S; S.init(M, DM, F.G, F.wg);
            pg8::EpiResid E{F.X, F.MOD + (size_t)l * NMOD + 2 * DM, DEPTH * NMOD};
#ifndef SKIP_G2
            pg8::gemm_phase<pg8::EpiResid, pg8::StaticOrder, true, true>(F.lds + RING_OFF, g, S, E);
#endif
        } SEAM(pb + 5);
        if (IN(pb + 6)) {
#ifndef SKIP_NORM
 norm_phase(F, F.norm2_g + l * DM, l, 3);
#endif
 } SEAM(pb + 6);
        if (IN(pb + 7)) {
            pg8::Gemm g{F.H, F.Wup_t + (size_t)l * DFF * DM, M, DFF, DM}; pg8::StaticOrder S; S.init(M, DFF, F.G, F.wg);
            pg8::EpiRelu2 E{F.U, DFF};
#ifndef SKIP_G3
            pg8::gemm_phase<pg8::EpiRelu2, pg8::StaticOrder, true, true>(F.lds + RING_OFF, g, S, E);
#endif
        } SEAM(pb + 7);
        if (IN(pb + 8)) {
            pg8::Gemm g{F.U, F.Wdn_t + (size_t)l * DM * DFF, M, DM, DFF}; pg8::StaticOrder S; S.init(M, DM, F.G, F.wg);
            pg8::EpiResid E{F.X, F.MOD + (size_t)l * NMOD + 5 * DM, DEPTH * NMOD};
#ifndef SKIP_G4
            pg8::gemm_phase<pg8::EpiResid, pg8::StaticOrder, true, true>(F.lds + RING_OFF, g, S, E);
#endif
        } SEAM(pb + 8);
    }
    if (IN(PH_FINAL)) {
#ifndef SKIP_NORM
 final_phase(F);
#endif
 }
#undef IN
#undef SEAM
}

#ifndef MK_ONE_LAUNCH
#define MK_ONE_LAUNCH 1
#endif
extern "C" void kernel_launch(void* const* d_in, const int* in_sizes, int n_in, void* d_out, int out_size, void* d_ws, size_t ws_size, hipStream_t stream) {
    static int grid = 0;
    if (grid == 0) {
        if (n_in != 18 || (size_t)out_size != OUT_TOTAL || ws_size < WS_END2) { fprintf(stderr, "kernel_launch: unexpected shapes: n_in %d out %d ws %zu (need %zu)\n", n_in, out_size, ws_size, (size_t)WS_END2); grid = -1; return; }
        int dev = 0, cus = 0, per_cu = 0;
        if (hipGetDevice(&dev) != hipSuccess || hipDeviceGetAttribute(&cus, hipDeviceAttributeMultiprocessorCount, dev) != hipSuccess) { grid = -1; return; }
        if (hipFuncSetAttribute((const void*)fwd, hipFuncAttributeMaxDynamicSharedMemorySize, LDS_BYTES) != hipSuccess) { fprintf(stderr, "kernel_launch: hipFuncSetAttribute failed\n"); grid = -1; return; }
        if (hipOccupancyMaxActiveBlocksPerMultiprocessor(&per_cu, (const void*)fwd, NWAVES * 64, LDS_BYTES) != hipSuccess || per_cu < 1)
            fprintf(stderr, "kernel_launch: note: occupancy query reports %d workgroups per CU\n", per_cu);
        (void)hipGetLastError();
        grid = cus;
    }
    if (grid < 0) return;
    if (hipMemsetAsync((char*)d_ws + WS_CTL, 0, CTL_ZERO_BYTES, stream) != hipSuccess) { fprintf(stderr, "kernel_launch: memset failed\n"); return; }
    Args a{};
    for (int i = 0; i < 18; ++i) a.in[i] = (const float*)d_in[i];
    a.out = (float*)d_out; a.ws = (unsigned char*)d_ws;
#if MK_ONE_LAUNCH
    a.ph_lo = 0; a.ph_hi = N_PHASES;
    hipLaunchKernelGGL(fwd, dim3(grid), dim3(NWAVES * 64), LDS_BYTES, stream, a);
#else
    for (int ph = 0; ph < N_PHASES; ++ph) {
        a.ph_lo = ph; a.ph_hi = ph + 1;
        hipLaunchKernelGGL(fwd, dim3(grid), dim3(NWAVES * 64), LDS_BYTES, stream, a);
    }
#endif
    const hipError_t le = hipPeekAtLastError();
    if (le != hipSuccess) fprintf(stderr, "kernel_launch: launch failed: %s\n", hipGetErrorName(le));
}
```

```cpp
#include <hip/hip_runtime.h>
#include <cstdio>
#include <cstdint>
__device__ __forceinline__ int row_pos(int row) { return row < 8192 ? row : 2048 + ((row - 8192) & 63); }
__device__ __forceinline__ int row_seq(int row) { return row < 8192 ? 0 : 1 + ((row - 8192) >> 6); }
namespace pg8 {
#define PG8_LAS __attribute__((address_space(3)))
typedef unsigned short bf16_t;
typedef short bf16x8 __attribute__((ext_vector_type(8)));
typedef float f32x4 __attribute__((ext_vector_type(4)));
typedef unsigned u32x4 __attribute__((ext_vector_type(4)));
typedef unsigned u32x2 __attribute__((ext_vector_type(2)));
constexpr int BM = 256, BK = 64, HALF = 128, HTB = HALF * BK * 2  , STAGE_BYTES = 8 * HTB, NXCD = 8, WGM = 8;

__host__ __device__ __forceinline__ int lds_byte(int r, int c) { const int st = (r >> 4) * 2 + (c >> 5), rr = r & 15, cc = c & 31, ob = rr * 64 + cc * 2; return st * 1024 + (ob ^ (((ob >> 9) & 1) << 5)); }
__host__ __device__ __forceinline__ void stage_rc(int b, int& R, int& C) { const int st = b / 1024, sb = b % 1024, swz = sb ^ (((sb >> 9) & 1) << 5); R = (st >> 1) * 16 + swz / 64; C = (st & 1) * 32 + (swz % 64) / 2; }
__host__ __device__ __forceinline__ int perm32(int rho) { const int n = rho >> 4, i = rho & 15; return 8 * (i >> 2) + 4 * n + (i & 3); }

struct Unit { int pm, pn, kt0, nt, slab; };
struct Gemm { const bf16_t* A; const bf16_t* Bt; int M, N, K; };

struct StaticOrder {
    int nM, nN, nwg, G, c, ntk;
    __host__ __device__ void init(int M, int N, int K, int G_, int c_) { nM = M / BM; nN = N / BM; nwg = nM * nN; G = G_; c = c_; ntk = K / BK; }
    __host__ __device__ bool next(int i, Unit& u) const {
        const long L = (long)i * G + c; if (L >= nwg) return false;
        int wgid = (int)L; { const int q = nwg / NXCD, r = nwg % NXCD, xcd = wgid % NXCD, off = wgid / NXCD; wgid = (xcd < r ? xcd * (q + 1) : r * (q + 1) + (xcd - r) * q) + off; }
        const int nig = WGM * nN, gid = wgid / nig, fm = gid * WGM, gsz = (nM - fm) < WGM ? (nM - fm) : WGM;
        u.pm = fm + ((wgid % nig) % gsz); u.pn = (wgid % nig) / gsz; u.kt0 = 0; u.nt = ntk; u.slab = -1; return true;
    }
    __device__ __forceinline__ void a_ready(const Unit&) const {}
    __device__ __forceinline__ void done(const Unit&) const {}
};

struct ResidOrder {
    StaticOrder so; int G, c, nks, ntk, nsub, nmine;
    __host__ __device__ void init(int K, int nks_, int G_, int c_) { so.init(8192, 2048, K, G_, c_); G = G_; c = c_; nks = nks_; ntk = (K / BK) / nks; nsub = 16 * nks; nmine = c < nsub ? (nsub - c + G - 1) / G : 0; }
    __host__ __device__ bool next(int i, Unit& u) const {
        if (i < nmine) { const int s = c + i * G, su = s / nks, ks = s % nks; u.pm = 32 + (su >> 3); u.pn = su & 7; u.kt0 = ks * ntk; u.nt = ntk; u.slab = ks; return true; }
        return so.next(i - nmine, u);
    }
    __device__ __forceinline__ void a_ready(const Unit&) const {}
    __device__ __forceinline__ void done(const Unit&) const {}
};

__device__ __forceinline__ unsigned cvt_pk_bf16(float lo, float hi) { unsigned r; asm volatile("v_cvt_pk_bf16_f32 %0, %1, %2" : "=v"(r) : "v"(lo), "v"(hi)); return r; }
__device__ __forceinline__ float fast_rcp(float x) { return __builtin_amdgcn_rcpf(x); }
__device__ __forceinline__ float silu_f(float x) { return x * fast_rcp(1.0f + __expf(-x)); }

struct EpiInProj {
    static constexpr bool PERM = true, AFTER_DRAIN = false;
    bf16_t* P; float* LF; const float* lb; const float* rc; const float* rs;
    __device__ __forceinline__ void operator()(const f32x4 (&acc)[2][2][4][2], const Unit& u, int wr, int wc, int fr, int fq) const {
        const int seg = u.pn >> 2;
        const int row0 = u.pm * BM + wr * 64 + fr;
        const int colg0 = u.pn * BM + wc * 32 + 8 * fq;
        if (seg == 4 || seg == 5) {
            const float ksc = (seg == 5) ? 0.0625f : 1.0f;
            const int j0 = wc * 32 + 8 * fq;
#pragma unroll
            for (int ai = 0; ai < 2; ++ai)
#pragma unroll
                for (int m = 0; m < 4; ++m) {
                    const int row = row0 + ai * HALF + m * 16; const int pos = row_pos(row);
                    const f32x4 c0 = *(const f32x4*)(rc + (size_t)pos * 128 + j0), c1 = *(const f32x4*)(rc + (size_t)pos * 128 + j0 + 4);
                    const f32x4 s0 = *(const f32x4*)(rs + (size_t)pos * 128 + j0), s1 = *(const f32x4*)(rs + (size_t)pos * 128 + j0 + 4);
                    const f32x4 x1a = acc[ai][0][m][0], x1b = acc[ai][0][m][1], x2a = acc[ai][1][m][0], x2b = acc[ai][1][m][1];
                    const f32x4 o1a = (x1a * c0 - x2a * s0) * ksc, o1b = (x1b * c1 - x2b * s1) * ksc;
                    const f32x4 o2a = (x2a * c0 + x1a * s0) * ksc, o2b = (x2b * c1 + x1b * s1) * ksc;
                    bf16_t* rowp = P + (size_t)row * 8192 + colg0;
                    u32x4 w; w.x = cvt_pk_bf16(o1a[0], o1a[1]); w.y = cvt_pk_bf16(o1a[2], o1a[3]); w.z = cvt_pk_bf16(o1b[0], o1b[1]); w.w = cvt_pk_bf16(o1b[2], o1b[3]);
                    *(u32x4*)(rowp) = w;
                    w.x = cvt_pk_bf16(o2a[0], o2a[1]); w.y = cvt_pk_bf16(o2a[2], o2a[3]); w.z = cvt_pk_bf16(o2b[0], o2b[1]); w.w = cvt_pk_bf16(o2b[2], o2b[3]);
                    *(u32x4*)(rowp + HALF) = w;
                }
        } else if (seg == 1) {
#pragma unroll
            for (int bj = 0; bj < 2; ++bj) {
                const int cs = colg0 + bj * HALF - 1024;
                const f32x4 lb0 = *(const f32x4*)(lb + cs), lb1 = *(const f32x4*)(lb + cs + 4);
#pragma unroll
                for (int ai = 0; ai < 2; ++ai)
#pragma unroll
                    for (int m = 0; m < 4; ++m) {
                        const int row = row0 + ai * HALF + m * 16;
                        f32x4 lf0, lf1, k0, k1;
#pragma unroll
                        for (int e = 0; e < 4; ++e) {
                            { const float x = acc[ai][bj][m][0][e], l = lb0[e]; const float sg = fast_rcp(1.0f + __expf(-x)), sn = fast_rcp(1.0f + __expf(x)); lf0[e] = __logf(l + (1.0f - l) * sg); k0[e] = (1.0f - l) * sn; }
                            { const float x = acc[ai][bj][m][1][e], l = lb1[e]; const float sg = fast_rcp(1.0f + __expf(-x)), sn = fast_rcp(1.0f + __expf(x)); lf1[e] = __logf(l + (1.0f - l) * sg); k1[e] = (1.0f - l) * sn; }
                        }
                        float* lfp = LF + (size_t)row * 1024 + cs; *(f32x4*)lfp = lf0; *(f32x4*)(lfp + 4) = lf1;
                        u32x4 w; w.x = cvt_pk_bf16(k0[0], k0[1]); w.y = cvt_pk_bf16(k0[2], k0[3]); w.z = cvt_pk_bf16(k1[0], k1[1]); w.w = cvt_pk_bf16(k1[2], k1[3]);
                        *(u32x4*)(P + (size_t)row * 8192 + colg0 + bj * HALF) = w;
                    }
            }
        } else {
            const bool act = (seg == 0 || seg == 3 || seg == 7);
#pragma unroll
            for (int ai = 0; ai < 2; ++ai)
#pragma unroll
                for (int m = 0; m < 4; ++m) { bf16_t* rowp = P + (size_t)(row0 + ai * HALF + m * 16) * 8192 + colg0;
#pragma unroll
                    for (int bj = 0; bj < 2; ++bj) { f32x4 v0 = acc[ai][bj][m][0], v1 = acc[ai][bj][m][1];
                        if (act) {
#pragma unroll
                            for (int e = 0; e < 4; ++e) { v0[e] = silu_f(v0[e]); v1[e] = silu_f(v1[e]); } }
                        u32x4 w; w.x = cvt_pk_bf16(v0[0], v0[1]); w.y = cvt_pk_bf16(v0[2], v0[3]); w.z = cvt_pk_bf16(v1[0], v1[1]); w.w = cvt_pk_bf16(v1[2], v1[3]);
                        *(u32x4*)(rowp + bj * HALF) = w; } }
        }
    }
};
struct EpiRelu2 {
    static constexpr bool PERM = true, AFTER_DRAIN = false;
    bf16_t* O; int ldc;
    __device__ __forceinline__ void operator()(const f32x4 (&acc)[2][2][4][2], const Unit& u, int wr, int wc, int fr, int fq) const {
        const int row0 = u.pm * BM + wr * 64 + fr, col0 = u.pn * BM + wc * 32 + 8 * fq;
#pragma unroll
        for (int ai = 0; ai < 2; ++ai)
#pragma unroll
            for (int m = 0; m < 4; ++m) { bf16_t* rowp = O + (size_t)(row0 + ai * HALF + m * 16) * ldc + col0;
#pragma unroll
                for (int bj = 0; bj < 2; ++bj) { f32x4 v0 = acc[ai][bj][m][0], v1 = acc[ai][bj][m][1];
#pragma unroll
                    for (int e = 0; e < 4; ++e) { const float a = fmaxf(v0[e], 0.f), b = fmaxf(v1[e], 0.f); v0[e] = a * a; v1[e] = b * b; }
                    u32x4 w; w.x = cvt_pk_bf16(v0[0], v0[1]); w.y = cvt_pk_bf16(v0[2], v0[3]); w.z = cvt_pk_bf16(v1[0], v1[1]); w.w = cvt_pk_bf16(v1[2], v1[3]);
                    *(u32x4*)(rowp + bj * HALF) = w; } }
    }
};
struct EpiResid {
    static constexpr bool PERM = false, AFTER_DRAIN = false;
    float* X; const float* gate; float* slab;
    __device__ __forceinline__ void operator()(const f32x4 (&acc)[2][2][4][2], const Unit& u, int wr, int wc, int fr, int fq) const {
        const int row0 = u.pm * BM + wr * 64 + fr, col0 = u.pn * BM + wc * 32 + 4 * fq;
        if (u.slab >= 0) {
            float* sp = slab + ((size_t)u.slab * 512 + (row0 - 8192)) * 2048 + col0;
#pragma unroll
            for (int ai = 0; ai < 2; ++ai)
#pragma unroll
                for (int m = 0; m < 4; ++m) { float* rowp = sp + (size_t)(ai * HALF + m * 16) * 2048;
#pragma unroll
                    for (int bj = 0; bj < 2; ++bj)
#pragma unroll
                        for (int n = 0; n < 2; ++n) *(f32x4*)(rowp + bj * HALF + n * 16) = acc[ai][bj][m][n]; }
            return;
        }
        f32x4 gv[2][2];
#pragma unroll
        for (int bj = 0; bj < 2; ++bj)
#pragma unroll
            for (int n = 0; n < 2; ++n) gv[bj][n] = *(const f32x4*)(gate + col0 + bj * HALF + n * 16);
#pragma unroll
        for (int ai = 0; ai < 2; ++ai)
#pragma unroll
            for (int m = 0; m < 4; ++m) { float* rowp = X + (size_t)(row0 + ai * HALF + m * 16) * 2048 + col0;
#pragma unroll
                for (int bj = 0; bj < 2; ++bj)
#pragma unroll
                    for (int n = 0; n < 2; ++n) { const f32x4 xv = *(const f32x4*)(rowp + bj * HALF + n * 16); *(f32x4*)(rowp + bj * HALF + n * 16) = xv + gv[bj][n] * acc[ai][bj][m][n]; }
                asm volatile("" ::: "memory"); }
    }
};
template <class Epi, class Sched, bool ALIGN_EPI = false, bool SP2 = false>
__device__ __forceinline__ void gemm_phase(PG8_LAS unsigned char* lds, const Gemm g, const Sched& S, const Epi& E) {
    int tid_l = threadIdx.x; asm volatile("" : "+v"(tid_l));
    const int tid = tid_l, wid = __builtin_amdgcn_readfirstlane(tid >> 6), lane = tid & 63, wr = wid >> 2, wc = wid & 3, fr = lane & 15, fq = lane >> 4;
    const int K = g.K;
    unsigned voffA[2], voffB[2];
#pragma unroll
    for (int i = 0; i < 2; ++i) { int R, C; stage_rc(tid * 16 + i * 8192, R, C); const int Rb = Epi::PERM ? ((R & ~31) + perm32(R & 31)) : R;
        voffA[i] = (unsigned)(R * K + C) * 2u; voffB[i] = (unsigned)(Rb * K + C) * 2u; }
    const size_t kstep = (size_t)(BK * 2);
    const size_t hstep = (size_t)HALF * K * 2;
    const size_t tstep = 2 * hstep;
    const unsigned ldsw = (unsigned)wid * 1024u;
    const int aoff = lds_byte(wr * 64 + fr, fq * 8), boff = lds_byte(wc * 32 + fr, fq * 8);
#define PG8_SA(b, h) (((b) * 2 + (h)) * HTB)
#define PG8_SB(b, h) ((4 + (b) * 2 + (h)) * HTB)
#define PG8_STAGE(bufoff, gbase, voff) do { _Pragma("unroll") for (int _i = 0; _i < 2; ++_i) \
        __builtin_amdgcn_global_load_lds((const unsigned*)((const char*)(gbase) + (voff)[_i]), (PG8_LAS unsigned*)(lds + (bufoff) + ldsw + _i * 8192), 16, 0, 0); } while (0)
#define PG8_LDA(dst, b, h) do { _Pragma("unroll") for (int m = 0; m < 4; ++m) _Pragma("unroll") for (int k = 0; k < 2; ++k) dst[m][k] = *(const PG8_LAS bf16x8*)(lds + PG8_SA(b, h) + aoff + m * 2048 + k * 1024); } while (0)
#define PG8_LDB(dst, b, h) do { _Pragma("unroll") for (int n = 0; n < 2; ++n) _Pragma("unroll") for (int k = 0; k < 2; ++k) dst[n][k] = *(const PG8_LAS bf16x8*)(lds + PG8_SB(b, h) + boff + n * 2048 + k * 1024); } while (0)
#define PG8_MMA(ai, bj, At, Bt) do { __builtin_amdgcn_s_setprio(1); _Pragma("unroll") for (int m = 0; m < 4; ++m) _Pragma("unroll") for (int n = 0; n < 2; ++n) _Pragma("unroll") for (int k = 0; k < 2; ++k) \
        acc[ai][bj][m][n] = __builtin_amdgcn_mfma_f32_16x16x32_bf16(Bt[n][k], At[m][k], acc[ai][bj][m][n], 0, 0, 0); __builtin_amdgcn_s_setprio(0); } while (0)
#define PG8_WAIT_V(n) asm volatile("s_waitcnt vmcnt(" #n ")" ::: "memory")
#define PG8_WAIT_L(n) asm volatile("s_waitcnt lgkmcnt(" #n ")" ::: "memory")
#define PG8_BAR __builtin_amdgcn_s_barrier()
#define PG8_SCHED __builtin_amdgcn_sched_barrier(0)
    Unit cur, nxt; int ui = 0;
    if (!S.next(0, cur)) return;
    f32x4 acc[2][2][4][2];
#pragma unroll
    for (int a = 0; a < 2; ++a)
#pragma unroll
        for (int b = 0; b < 2; ++b)
#pragma unroll
            for (int m = 0; m < 4; ++m)
#pragma unroll
                for (int n = 0; n < 2; ++n) acc[a][b][m][n] = (f32x4){0.f, 0.f, 0.f, 0.f};
    bf16x8 At[4][2], B0[2][2], B1[2][2];
    const char* cA = (const char*)g.A + (size_t)cur.pm * tstep + (size_t)cur.kt0 * kstep; const char* cB = (const char*)g.Bt + (size_t)cur.pn * tstep + (size_t)cur.kt0 * kstep;
    S.a_ready(cur);
    if constexpr (SP2) {
        PG8_STAGE(PG8_SB(0, 0), cB, voffB); PG8_STAGE(PG8_SB(0, 1), cB + hstep, voffB); PG8_STAGE(PG8_SA(0, 0), cA, voffA); PG8_STAGE(PG8_SA(0, 1), cA + hstep, voffA);
        if (wr == 1) PG8_BAR;
        PG8_WAIT_V(2); PG8_BAR;
        PG8_STAGE(PG8_SB(1, 0), cB + kstep, voffB); PG8_STAGE(PG8_SA(1, 0), cA + kstep, voffA); PG8_STAGE(PG8_SB(1, 1), cB + hstep + kstep, voffB);
        PG8_WAIT_V(6); PG8_BAR;
    } else {
        PG8_STAGE(PG8_SB(0, 0), cB, voffB); PG8_STAGE(PG8_SA(0, 0), cA, voffA); PG8_STAGE(PG8_SB(0, 1), cB + hstep, voffB); PG8_STAGE(PG8_SA(0, 1), cA + hstep, voffA);
        if (wr == 1) PG8_BAR;
        PG8_WAIT_V(4); PG8_BAR;
        PG8_STAGE(PG8_SB(1, 0), cB + kstep, voffB); PG8_STAGE(PG8_SA(1, 0), cA + kstep, voffA); PG8_STAGE(PG8_SB(1, 1), cB + hstep + kstep, voffB);
        PG8_WAIT_V(6); PG8_BAR;
    }
    for (;;) {
        const bool has_next = S.next(ui + 1, nxt);
        const char* nA = has_next ? (const char*)g.A + (size_t)nxt.pm * tstep + (size_t)nxt.kt0 * kstep : cA; const char* nB = has_next ? (const char*)g.Bt + (size_t)nxt.pn * tstep + (size_t)nxt.kt0 * kstep : cB;
        const int nt = cur.nt;
        for (int t = 0; t < nt; t += 2) {
            const bool last = (t == nt - 2);
            const char* a1 = cA + (size_t)(t + 1) * kstep;
            const char* a2 = last ? nA : cA + (size_t)(t + 2) * kstep; const char* b2 = last ? nB : cB + (size_t)(t + 2) * kstep;
            const char* a3 = a2 + kstep; const char* b3 = b2 + kstep;
            if (last && has_next) S.a_ready(nxt);
            if constexpr (SP2) {
            PG8_LDB(B0, 0, 0); PG8_LDB(B1, 0, 1); PG8_SCHED; PG8_LDA(At, 0, 0); PG8_STAGE(PG8_SA(1, 1), a1 + hstep, voffA);
            PG8_WAIT_V(8); PG8_WAIT_L(0); PG8_BAR; PG8_MMA(0, 0, At, B0); PG8_MMA(0, 1, At, B1); PG8_BAR; PG8_SCHED;
            PG8_LDA(At, 0, 1); PG8_STAGE(PG8_SB(0, 0), b2, voffB); PG8_STAGE(PG8_SB(0, 1), b2 + hstep, voffB); PG8_STAGE(PG8_SA(0, 0), a2, voffA);
            PG8_WAIT_V(8); PG8_WAIT_L(0); PG8_BAR; PG8_MMA(1, 0, At, B0); PG8_MMA(1, 1, At, B1); PG8_BAR; PG8_SCHED;
            PG8_LDB(B0, 1, 0); PG8_LDB(B1, 1, 1); PG8_SCHED; PG8_LDA(At, 1, 0); PG8_STAGE(PG8_SA(0, 1), a2 + hstep, voffA);
            PG8_WAIT_V(8); PG8_WAIT_L(0); PG8_BAR; PG8_MMA(0, 0, At, B0); PG8_MMA(0, 1, At, B1); PG8_BAR; PG8_SCHED;
            PG8_LDA(At, 1, 1); PG8_STAGE(PG8_SB(1, 0), b3, voffB); PG8_STAGE(PG8_SB(1, 1), b3 + hstep, voffB); PG8_STAGE(PG8_SA(1, 0), a3, voffA);
            PG8_WAIT_V(8); PG8_WAIT_L(0); PG8_BAR; PG8_MMA(1, 0, At, B0); PG8_MMA(1, 1, At, B1); PG8_BAR; PG8_SCHED;
            } else {
            PG8_LDB(B0, 0, 0); PG8_SCHED; PG8_LDA(At, 0, 0); PG8_STAGE(PG8_SA(1, 1), a1 + hstep, voffA);
            PG8_WAIT_L(8); PG8_BAR; PG8_WAIT_L(0); PG8_MMA(0, 0, At, B0); PG8_BAR; PG8_SCHED;
            PG8_LDB(B1, 0, 1); PG8_STAGE(PG8_SB(0, 0), b2, voffB);
            PG8_BAR; PG8_WAIT_L(0); PG8_MMA(0, 1, At, B1); PG8_BAR;
            PG8_LDA(At, 0, 1); PG8_STAGE(PG8_SA(0, 0), a2, voffA);
            PG8_BAR; PG8_WAIT_L(0); PG8_MMA(1, 0, At, B0); PG8_BAR; PG8_SCHED;
            PG8_STAGE(PG8_SB(0, 1), b2 + hstep, voffB);
            PG8_WAIT_V(6); PG8_BAR; PG8_MMA(1, 1, At, B1); PG8_BAR;
            PG8_LDB(B0, 1, 0); PG8_SCHED; PG8_LDA(At, 1, 0); PG8_STAGE(PG8_SA(0, 1), a2 + hstep, voffA);
            PG8_WAIT_L(8); PG8_BAR; PG8_WAIT_L(0); PG8_MMA(0, 0, At, B0); PG8_BAR; PG8_SCHED;
            PG8_LDB(B1, 1, 1); PG8_STAGE(PG8_SB(1, 0), b3, voffB);
            PG8_BAR; PG8_WAIT_L(0); PG8_MMA(0, 1, At, B1); PG8_BAR;
            PG8_LDA(At, 1, 1); PG8_STAGE(PG8_SA(1, 0), a3, voffA);
            PG8_BAR; PG8_WAIT_L(0); PG8_MMA(1, 0, At, B0); PG8_BAR; PG8_SCHED;
            PG8_STAGE(PG8_SB(1, 1), b3 + hstep, voffB);
            PG8_WAIT_V(6); PG8_BAR; PG8_MMA(1, 1, At, B1); PG8_BAR;
            }
        }
        if constexpr (ALIGN_EPI) { if (wr == 0) PG8_BAR; }
        if constexpr (!Epi::AFTER_DRAIN) { E(acc, cur, wr, wc, fr, fq); S.done(cur); }
        if (!has_next) break;
#pragma unroll
        for (int a = 0; a < 2; ++a)
#pragma unroll
            for (int b = 0; b < 2; ++b)
#pragma unroll
                for (int m = 0; m < 4; ++m)
#pragma unroll
                    for (int n = 0; n < 2; ++n) acc[a][b][m][n] = (f32x4){0.f, 0.f, 0.f, 0.f};
        cur = nxt; cA = nA; cB = nB; ++ui;
        if constexpr (ALIGN_EPI) { if (wr == 1) PG8_BAR; }
    }
    PG8_WAIT_V(0);
    if constexpr (!ALIGN_EPI) { if (wr == 0) PG8_BAR; }
    PG8_BAR;
    if constexpr (Epi::AFTER_DRAIN) { E.fused(acc, cur, wr, wc, fr, fq, lds, wid, lane); S.done(cur); }
#undef PG8_SA
#undef PG8_SB
#undef PG8_STAGE
#undef PG8_LDA
#undef PG8_LDB
#undef PG8_MMA
#undef PG8_WAIT_V
#undef PG8_WAIT_L
#undef PG8_BAR
#undef PG8_SCHED
}
}
constexpr int NWAVES = 8;
constexpr int DM = 2048, SEQ = 8192, DEPTH = 4, DECB = 8, DECS = 64, M = SEQ + DECB * DECS, NPROJ = 8192, DFF = 8192, NSEQ = 9, NMOD = 6 * DM;
constexpr int HA = 8, HB = 4;
constexpr float EPS = 1e-6f;
constexpr size_t OFF_SA_P = (size_t)M * DM, OFF_SB_P = OFF_SA_P + (size_t)DEPTH * HA * 128 * 128, OFF_SA_S = OFF_SB_P + (size_t)DEPTH * HB * 256 * 256,
                 OFF_SB_S = OFF_SA_S + (size_t)DEPTH * DECB * HA * 128 * 128, OUT_TOTAL = OFF_SB_S + (size_t)DEPTH * DECB * HB * 256 * 256;

constexpr size_t MiB = 1u << 20;
constexpr size_t WS_CTL = 0, CTL_ZERO_BYTES = 1 * MiB;
constexpr size_t WS_WIN = 2 * MiB;
constexpr size_t WS_WOUT = WS_WIN + 128 * MiB;
constexpr size_t WS_WUP = WS_WOUT + 32 * MiB;
constexpr size_t WS_WDN = WS_WUP + 128 * MiB;
constexpr size_t WS_X = WS_WDN + 128 * MiB;
constexpr size_t WS_H = WS_X + 68 * MiB;
constexpr size_t WS_P = WS_H + 34 * MiB;
constexpr size_t WS_LF = WS_P + 136 * MiB;
constexpr size_t WS_O = WS_LF + 34 * MiB;
constexpr size_t WS_U = WS_O + 34 * MiB;
constexpr size_t WS_MOD = WS_U + 136 * MiB;
constexpr size_t WS_LB = WS_MOD + 2 * MiB;
constexpr size_t WS_ROPE = WS_LB + 1 * MiB;
constexpr size_t WS_SLAB = WS_ROPE + 8 * MiB;
constexpr size_t WS_END = WS_SLAB + 64 * MiB;
constexpr int CW_Q0 = 64;
constexpr int CW_BAR = 4096;

constexpr int RING_OFF = 0, RING_BYTES = 131072;
constexpr int LDS_BYTES = 151552;
constexpr int MISC_OFF = 147456;

#define GAS __attribute__((address_space(1)))
#define LAS __attribute__((address_space(3)))
typedef unsigned short bf16;
typedef unsigned v4u __attribute__((ext_vector_type(4)));
typedef unsigned v2u __attribute__((ext_vector_type(2)));
typedef float f32x4 __attribute__((ext_vector_type(4)));
typedef short bf16x8 __attribute__((ext_vector_type(8)));
#define LDS_WAIT() asm volatile("s_waitcnt lgkmcnt(0)" ::: "memory")
#define VM_WAIT() asm volatile("s_waitcnt vmcnt(0)" ::: "memory")
__device__ __forceinline__ unsigned f2bf(float f) { unsigned u = __builtin_bit_cast(unsigned, f); return (u + 0x7fffu + ((u >> 16) & 1u)) >> 16; }
__device__ __forceinline__ unsigned pk2(float lo, float hi) { return pg8::cvt_pk_bf16(lo, hi); }
__device__ __forceinline__ float bf2f(unsigned short b) { return __builtin_bit_cast(float, ((unsigned)b) << 16); }
__device__ __forceinline__ float bflo(unsigned w) { return __builtin_bit_cast(float, w << 16); }
__device__ __forceinline__ float bfhi(unsigned w) { return __builtin_bit_cast(float, w & 0xffff0000u); }

#define XB_TMO      128
#define XB_XCNT(j)  (256  + 64 * (j))
#define XB_XSUB(j)  (1280 + 64 * (j))
#define XB_XGEN(j)  (2304 + 64 * (j))
#define XB_TOP      3328
#define XB_TOPGEN   3392
#define XCD_BAR_WORDS 3456
#define XB_SPIN_CAP (1u << 20)
__device__ __forceinline__ unsigned xb_ld(unsigned* p)              { return __hip_atomic_load(p, __ATOMIC_RELAXED, __HIP_MEMORY_SCOPE_AGENT); }
__device__ __forceinline__ unsigned xb_add(unsigned* p, unsigned v) { return __hip_atomic_fetch_add(p, v, __ATOMIC_RELAXED, __HIP_MEMORY_SCOPE_AGENT); }
__device__ __forceinline__ unsigned xb_xcc_id() { return (unsigned)__builtin_amdgcn_s_getreg((3 << 11) | 20) & 0xFu; }
#define XB_SPIN(cond, bar) do { unsigned _sp = 0; while (cond) { __builtin_amdgcn_s_sleep(1); \
    if ((++_sp & 255u) == 0u) { if (xb_ld(&(bar)[XB_TMO])) break; if (_sp > XB_SPIN_CAP) { atomicAdd(&(bar)[XB_TMO], 1u); break; } } } } while (0)
struct XcdBarrier { unsigned* bar; unsigned x; volatile LAS unsigned* st; };
__device__ __forceinline__ XcdBarrier xcd_barrier_post(unsigned* bar, volatile LAS unsigned* st) {
    XcdBarrier b; b.bar = bar; b.x = xb_xcc_id(); b.st = st;
    if (threadIdx.x == 0) (void)xb_add(&bar[XB_XCNT(b.x)], 1u);
    return b;
}
__device__ __forceinline__ void xcd_barrier_complete(unsigned* bar, unsigned x, unsigned& nloc, unsigned& nx) {
    const unsigned G = gridDim.x * gridDim.y * gridDim.z;
    unsigned sum, cnt, mine, sp = 0u;
    for (;;) {
        sum = 0u; cnt = 0u; mine = 0u;
#pragma unroll
        for (unsigned j = 0; j < 16; ++j) { const unsigned c = xb_ld(&bar[XB_XCNT(j)]); sum += c; cnt += (c > 0u) ? 1u : 0u; mine = (j == x) ? c : mine; }
        if (sum == G) break;
        __builtin_amdgcn_s_sleep(1);
        if ((++sp & 255u) == 0u) { if (xb_ld(&bar[XB_TMO])) break; if (sp > XB_SPIN_CAP) { atomicAdd(&bar[XB_TMO], 1u); break; } }
    }
    nloc = mine > 0u ? mine : 1u; nx = cnt > 0u ? cnt : 1u;
}
__device__ __forceinline__ void xcd_barrier(const XcdBarrier& b) {
    asm volatile("s_waitcnt vmcnt(0)" ::: "memory");
    __syncthreads();
    if (threadIdx.x == 0) {
        unsigned* bar = b.bar;
        __builtin_amdgcn_s_waitcnt(0);
        unsigned nloc = b.st[0], nx = b.st[1];
        if (nloc == 0u) { xcd_barrier_complete(bar, b.x, nloc, nx); b.st[0] = nloc; b.st[1] = nx; }
        const unsigned old = xb_add(&bar[XB_XSUB(b.x)], 1u);
        const unsigned gen = old / nloc;
        if (old + 1u == (gen + 1u) * nloc) {
            __builtin_amdgcn_fence(__ATOMIC_RELEASE, "agent");
            asm volatile("s_waitcnt vmcnt(0)" ::: "memory");
            const unsigned og = xb_add(&bar[XB_TOP], 1u);
            const unsigned tg = og / nx;
            if (og + 1u == (tg + 1u) * nx) xb_add(&bar[XB_TOPGEN], 1u);
            else XB_SPIN(xb_ld(&bar[XB_TOPGEN]) == tg, bar);
            __builtin_amdgcn_fence(__ATOMIC_ACQUIRE, "agent");
            xb_add(&bar[XB_XGEN(b.x)], 1u);
            asm volatile("s_waitcnt vmcnt(0)" ::: "memory");
        } else {
            XB_SPIN(xb_ld(&bar[XB_XGEN(b.x)]) == gen, bar);
            __builtin_amdgcn_fence(__ATOMIC_ACQUIRE, "agent");
            asm volatile("s_waitcnt vmcnt(0)" ::: "memory");
        }
    }
    __syncthreads();
}

struct Frame {
    LAS unsigned char* lds;
    unsigned* ctl;
    unsigned char* ws;
    int G, wg;
    const float *x_prompt, *x_sample, *state_hgrn, *state_ret, *c_prompt, *c_sample, *lb_logits, *w_ada, *b_ada, *norm1_g, *norm2_g, *w_in, *hgrn_g, *ret_g, *w_out, *w_up, *w_down, *final_g;
    float* out;
    bf16 *Win_t, *Wout_t, *Wup_t, *Wdn_t, *H, *P, *O, *U;
    float *X, *LF, *MOD, *LB, *RC, *RS;
};

__device__ __forceinline__ int ltid() { int t = threadIdx.x; asm volatile("" : "+v"(t)); return t; }
#define PHASE_IDS() const int tid = ltid(), lane = tid & 63, wave = __builtin_amdgcn_readfirstlane(tid >> 6); (void)lane; (void)wave
__device__ __forceinline__ float wave_sum(float v) {
#pragma unroll
    for (int o = 1; o < 64; o <<= 1) v += __shfl_xor(v, o);
    return v;
}
__device__ __forceinline__ void p0_transpose_item(const float* W, int K, int N, bf16* WT, LAS float* scr, int item, int lane) {
    const int nblk = N / 32, kb = item / nblk, nb = item % nblk, k0 = 64 * kb, n0 = 32 * nb;
#pragma unroll 8
    for (int i = 0; i < 32; ++i) { const int kk = 2 * i + (lane >> 5); scr[kk * 33 + (lane & 31)] = W[(size_t)(k0 + kk) * N + n0 + (lane & 31)]; }
    LDS_WAIT(); asm volatile("" ::: "memory");
    const int c = lane & 7;
#pragma unroll
    for (int j = 0; j < 4; ++j) { const int n = (lane >> 3) + 8 * j; const LAS float* s = scr + (8 * c) * 33 + n;
        v4u o; o.x = pk2(s[0 * 33], s[1 * 33]); o.y = pk2(s[2 * 33], s[3 * 33]); o.z = pk2(s[4 * 33], s[5 * 33]); o.w = pk2(s[6 * 33], s[7 * 33]);
        *(GAS v4u*)(WT + (size_t)(n0 + n) * K + k0 + 8 * c) = o; }
    LDS_WAIT(); asm volatile("" ::: "memory");
}
__device__ __forceinline__ void p0_mod_task(Frame& F, int task) {
    PHASE_IDS();
    const int l = task / 48, cb = task % 48;
    LAS float* cact = (LAS float*)(F.lds);
    LAS float* red = (LAS float*)(F.lds + 73728);
    for (int i = tid; i < NSEQ * DM; i += NWAVES * 64) { const int b = i / DM, k = i % DM; const float c = (b == 0) ? F.c_prompt[k] : F.c_sample[(b - 1) * DM + k]; cact[i] = c / (1.0f + __expf(-c)); }
    __syncthreads();
    const float* W = F.w_ada + (size_t)l * DM * NMOD + cb * 256 + 4 * lane;
    f32x4 acc[NSEQ];
#pragma unroll
    for (int b = 0; b < NSEQ; ++b) acc[b] = (f32x4){0.f, 0.f, 0.f, 0.f};
    const int kbeg = wave * 256;
#pragma unroll 2
    for (int k0 = kbeg; k0 < kbeg + 256; k0 += 4) {
        const f32x4 w0 = *(const f32x4*)(W + (size_t)(k0 + 0) * NMOD), w1 = *(const f32x4*)(W + (size_t)(k0 + 1) * NMOD), w2 = *(const f32x4*)(W + (size_t)(k0 + 2) * NMOD), w3 = *(const f32x4*)(W + (size_t)(k0 + 3) * NMOD);
#pragma unroll
        for (int b = 0; b < NSEQ; ++b) { const f32x4 c = *(const LAS f32x4*)(cact + b * DM + k0); acc[b] += w0 * c.x + w1 * c.y + w2 * c.z + w3 * c.w; }
    }
#pragma unroll
    for (int b = 0; b < NSEQ; ++b) *(LAS f32x4*)(red + (wave * NSEQ + b) * 256 + 4 * lane) = acc[b];
    __syncthreads();
    for (int o = tid; o < NSEQ * 256; o += NWAVES * 64) { const int b = o / 256, c = o % 256; float s = 0.f;
#pragma unroll
        for (int w = 0; w < 8; ++w) s += red[(w * NSEQ + b) * 256 + c];
        F.MOD[(size_t)(b * DEPTH + l) * NMOD + cb * 256 + c] = s + F.b_ada[(size_t)l * NMOD + cb * 256 + c]; }
    __syncthreads();
}
__device__ __forceinline__ void sincos_acc(float angf, float& sn, float& cs) {
    const double a = (double)angf;
    const double q = __builtin_rint(a * 0.63661977236758134308);
    double r = __builtin_fma(-q, 1.57079632679489655800, a); r = __builtin_fma(-q, 6.12323399573676603587e-17, r);
    const double r2 = r * r;
    double sp = 1.0 / 6227020800.0; sp = sp * r2 - 1.0 / 39916800.0; sp = sp * r2 + 1.0 / 362880.0; sp = sp * r2 - 1.0 / 5040.0; sp = sp * r2 + 1.0 / 120.0; sp = sp * r2 - 1.0 / 6.0; sp = sp * r2 * r + r;
    double cp = 1.0 / 479001600.0; cp = cp * r2 - 1.0 / 3628800.0; cp = cp * r2 + 1.0 / 40320.0; cp = cp * r2 - 1.0 / 720.0; cp = cp * r2 + 1.0 / 24.0; cp = cp * r2 - 0.5; cp = cp * r2 + 1.0;
    const int qi = ((int)q) & 3;
    const double s = (qi == 0) ? sp : (qi == 1) ? cp : (qi == 2) ? -sp : -cp;
    const double c = (qi == 0) ? cp : (qi == 1) ? -sp : (qi == 2) ? -cp : sp;
    sn = (float)s; cs = (float)c;
}
__device__ __forceinline__ void p0_prologue(Frame& F) {
    PHASE_IDS();
    const int gt = F.wg * (NWAVES * 64) + tid, NGT = F.G * NWAVES * 64;
    for (int c = gt; c < 1024; c += NGT) {
        const float a0 = F.lb_logits[c], a1 = F.lb_logits[1024 + c], a2 = F.lb_logits[2048 + c], a3 = F.lb_logits[3072 + c];
        const float mx = fmaxf(fmaxf(a0, a1), fmaxf(a2, a3));
        const float e0 = expf(a0 - mx), e1 = expf(a1 - mx), e2 = expf(a2 - mx), e3 = expf(a3 - mx), inv = 1.0f / (e0 + e1 + e2 + e3);
        F.LB[c] = 0.f; F.LB[1024 + c] = e1 * inv; F.LB[2048 + c] = (e1 + e2) * inv; F.LB[3072 + c] = (e1 + e2 + e3) * inv;
    }
    for (int i = gt; i < SEQ * 128; i += NGT) {
        const int pos = i >> 7, j = i & 127;
        const float t = (float)j * (1.0f / 127.0f);
        const float invf = (float)(1.0 / exp((double)t * 9.21034037197618271));
        const float ang = (float)pos * invf;
        float sn, cs; sincos_acc(ang, sn, cs);
        F.RC[i] = cs; F.RS[i] = sn;
    }
    { const f32x4* s0 = (const f32x4*)F.x_prompt; const f32x4* s1 = (const f32x4*)F.x_sample; f32x4* d = (f32x4*)F.X;
      const int n0 = SEQ * DM / 4, n1 = DECB * DECS * DM / 4;
      for (int i = gt; i < n0; i += NGT) d[i] = s0[i];
      for (int i = gt; i < n1; i += NGT) d[n0 + i] = s1[i]; }
    for (int task = F.wg; task < DEPTH * 48; task += F.G) p0_mod_task(F, task);
    LAS float* scr = (LAS float*)(F.lds + wave * 16384);
    constexpr int I_IN = (DM / 64) * (NPROJ / 32), I_OUT = (DM / 64) * (DM / 32), I_UP = (DM / 64) * (DFF / 32), I_DN = (DFF / 64) * (DM / 32);
    constexpr int I_LAYER = I_IN + I_OUT + I_UP + I_DN, NITEMS = DEPTH * I_LAYER;
    for (;;) {
        int base = 0; if (lane == 0) base = (int)atomicAdd(F.ctl + CW_Q0, 8u);
        base = __builtin_amdgcn_readfirstlane(base);
        if (base >= NITEMS) break;
        for (int it = base; it < base + 8 && it < NITEMS; ++it) {
            const int l = it / I_LAYER; int r = it % I_LAYER;
            if (r < I_IN) { p0_transpose_item(F.w_in + (size_t)l * DM * NPROJ, DM, NPROJ, F.Win_t + (size_t)l * NPROJ * DM, scr, r, lane); continue; } r -= I_IN;
            if (r < I_OUT) { p0_transpose_item(F.w_out + (size_t)l * DM * DM, DM, DM, F.Wout_t + (size_t)l * DM * DM, scr, r, lane); continue; } r -= I_OUT;
            if (r < I_UP) { p0_transpose_item(F.w_up + (size_t)l * DM * DFF, DM, DFF, F.Wup_t + (size_t)l * DFF * DM, scr, r, lane); continue; } r -= I_UP;
            p0_transpose_item(F.w_down + (size_t)l * DFF * DM, DFF, DM, F.Wdn_t + (size_t)l * DM * DFF, scr, r, lane);
        }
    }
}
template <bool FINAL>
__device__ __forceinline__ void norm_rows(Frame& F, const float* g, int l, int which_sh  , int nslab, int slab_l, int slab_which) {
    PHASE_IDS();
    const int gw = F.wg * NWAVES + wave, NGW = F.G * NWAVES;
    for (int m = gw; m < SEQ; m += NGW) {
        const f32x4* xr = (const f32x4*)(F.X + (size_t)m * DM) + lane;
        f32x4 v[8]; float ss = 0.f;
#pragma unroll
        for (int j = 0; j < 8; ++j) { v[j] = xr[64 * j]; ss += (v[j].x * v[j].x + v[j].y * v[j].y) + (v[j].z * v[j].z + v[j].w * v[j].w); }
        const float rstd = 1.0f / sqrtf(wave_sum(ss) * (1.0f / DM) + EPS);
        const f32x4* gp = (const f32x4*)g + lane;
        if (FINAL) { f32x4* o = (f32x4*)(F.out + (size_t)m * DM) + lane;
#pragma unroll
            for (int j = 0; j < 8; ++j) o[64 * j] = v[j] * rstd * gp[64 * j];
        } else {
            const float* mod = F.MOD + (size_t)l * NMOD;
            const f32x4* shp = (const f32x4*)(mod + which_sh * DM) + lane; const f32x4* scp = (const f32x4*)(mod + (which_sh + 1) * DM) + lane;
            v2u* o8 = (v2u*)(F.H + (size_t)m * DM) + lane;
#pragma unroll
            for (int j = 0; j < 8; ++j) { const f32x4 gg = gp[64 * j], sh = shp[64 * j], sc = scp[64 * j];
                const f32x4 h = v[j] * rstd * gg * (sc + 1.0f) + sh;
                v2u w; w.x = pk2(h.x, h.y); w.y = pk2(h.z, h.w); o8[64 * j] = w; }
        }
    }
    LAS float* red = (LAS float*)F.lds;
    for (int r = F.wg; r < DECB * DECS; r += F.G) {
        const int m = SEQ + r, idx = 64 * wave + lane, sq = 1 + (r >> 6);
        f32x4 v = *((const f32x4*)(F.X + (size_t)m * DM) + idx);
        if (nslab > 0) {
            const f32x4* sp = (const f32x4*)((const float*)(F.ws + WS_SLAB) + (size_t)r * DM) + idx;
            f32x4 a = (f32x4){0.f, 0.f, 0.f, 0.f};
            if (nslab == 16) {
#pragma unroll
                for (int s = 0; s < 16; ++s) a += sp[(size_t)s * (512 * DM / 4)];
            } else {
#pragma unroll
                for (int s = 0; s < 8; ++s) a += sp[(size_t)s * (512 * DM / 4)];
            }
            const f32x4 gv = *((const f32x4*)(F.MOD + (size_t)(sq * DEPTH + slab_l) * NMOD + slab_which * DM) + idx);
            v += gv * a;
            *((f32x4*)(F.X + (size_t)m * DM) + idx) = v;
        }
        const float ss = wave_sum((v.x * v.x + v.y * v.y) + (v.z * v.z + v.w * v.w));
        __syncthreads();
        if (lane == 0) red[wave] = ss;
        __syncthreads();
        float tot = 0.f;
#pragma unroll
        for (int w = 0; w < 8; ++w) tot += red[w];
        const float rstd = 1.0f / sqrtf(tot * (1.0f / DM) + EPS);
        const f32x4 gg = *((const f32x4*)g + idx);
        if (FINAL) { *((f32x4*)(F.out + (size_t)m * DM) + idx) = v * rstd * gg; }
        else {
            const float* mod = F.MOD + (size_t)(sq * DEPTH + l) * NMOD;
            const f32x4 sh = *((const f32x4*)(mod + which_sh * DM) + idx), sc = *((const f32x4*)(mod + (which_sh + 1) * DM) + idx);
            const f32x4 h = v * rstd * gg * (sc + 1.0f) + sh;
            v2u w; w.x = pk2(h.x, h.y); w.y = pk2(h.z, h.w); *((v2u*)(F.H + (size_t)m * DM) + idx) = w;
        }
    }
    __syncthreads();
}
constexpr int NSG = 40;
constexpr size_t WS_UA = WS_END;
constexpr size_t WS_DGA = WS_UA + 20 * MiB;
constexpr size_t WS_SSA = WS_DGA + 1 * MiB;
constexpr size_t WS_UB = WS_SSA + 20 * MiB;
constexpr size_t WS_SSB = WS_UB + 40 * MiB;
constexpr size_t WS_END2 = WS_SSB + 20 * MiB;

constexpr int MX_KHT = 0, MX_VT = 18432, MX_QT = 36864, MX_KT = 54272, MX_QH = 71680, MX_A = 89088, MX_EDEC = 98304, MX_RED = 98816, MX_B = 100864, MX_QTOT = 133632  ;
constexpr int RX_Q = 0, RX_K = 33792, RX_VT = 67584, RX_A = 104448, RX_RED = 113664;
constexpr float LOG2E = 1.4426950408889634f;

__device__ __forceinline__ bf16x8 ldfrag(LAS unsigned char* base, int ld_bytes, int row, int kbyte) { return *(const LAS bf16x8*)(base + row * ld_bytes + kbyte); }
__device__ __forceinline__ int tr_off(int row, int tokpair) { return row * 144 + ((((tokpair >> 2) ^ (row >> 3)) & 7) << 4) + ((tokpair & 3) << 2); }
__device__ __forceinline__ bf16x8 tr_frag(LAS unsigned char* base, int row, int chunk) { return *(const LAS bf16x8*)(base + row * 144 + (((chunk ^ (row >> 3)) & 7) << 4)); }
__device__ __forceinline__ float gamma_log2(int h) { return log2f(1.0f - exp2f(-5.0f - (float)h)); }
__device__ __forceinline__ int sg_row0(int sg) { return sg < 32 ? sg * 256 : SEQ + 64 * (sg - 32); }
__device__ __forceinline__ int sg_nch(int sg) { return sg < 32 ? 4 : 1; }

template <bool IS_RET>
__device__ __forceinline__ void p1_unit(Frame& F, int l, int sg, int h, int quad) {
    PHASE_IDS();
    const int g4 = lane >> 4, l16 = lane & 15;
    const int row0 = sg_row0(sg), nch = sg_nch(sg);
    const int kb = quad >> 1, vb = quad & 1;
    const int ck = IS_RET ? 5120 + h * 256 + 128 * kb : 1024 + h * 128;
    const int cv = IS_RET ? 6144 + h * 256 + 128 * vb : 2048 + h * 128;
    LAS unsigned char* L = F.lds;
    LAS float* Bs = (LAS float*)(L + MX_B); LAS float* Qtot = (LAS float*)(L + MX_QTOT); LAS float* Edec = (LAS float*)(L + MX_EDEC);
    const float lg2 = gamma_log2(h);
    f32x4 S[8];
#pragma unroll
    for (int kt = 0; kt < 8; ++kt) S[kt] = (f32x4){0.f, 0.f, 0.f, 0.f};
    float sumb = 0.f;
    for (int c = 0; c < nch; ++c) {
        const int rowc = row0 + 64 * c;
        if (!IS_RET) {
            const int k = tid & 127, tq = tid >> 7;
            float* lfp = F.LF + (size_t)(rowc + 16 * tq) * 1024 + h * 128 + k;
            float pv[16];
#pragma unroll
            for (int i = 0; i < 16; ++i) pv[i] = lfp[(size_t)i * 1024];
#pragma unroll
            for (int i = 1; i < 16; ++i) pv[i] += pv[i - 1];
            Qtot[tq * 128 + k] = pv[15];
            __syncthreads();
            float off = 0.f;
#pragma unroll
            for (int q = 0; q < 3; ++q) off += (q < tq) ? Qtot[q * 128 + k] : 0.f;
#pragma unroll
            for (int i = 0; i < 16; ++i) { const float b = pv[i] + off; lfp[(size_t)i * 1024] = b; Bs[(16 * tq + i) * 128 + k] = b; }
            __syncthreads();
            if (tid < 128) sumb += Bs[63 * 128 + tid];
        }
        {
            const int tp = tid >> 4, kc = tid & 15, ra = rowc + 2 * tp;
            const v4u ka = *(const v4u*)(F.P + (size_t)ra * 8192 + ck + 8 * kc), kbv = *(const v4u*)(F.P + (size_t)(ra + 1) * 8192 + ck + 8 * kc);
            const v4u va = *(const v4u*)(F.P + (size_t)ra * 8192 + cv + 8 * kc), vbv = *(const v4u*)(F.P + (size_t)(ra + 1) * 8192 + cv + 8 * kc);
            float fa[8], fb[8];
            if (IS_RET) {
                const float za = exp2f(lg2 * (float)(63 - 2 * tp)), zb = exp2f(lg2 * (float)(62 - 2 * tp));
#pragma unroll
                for (int i = 0; i < 8; ++i) { fa[i] = za; fb[i] = zb; }
                if (tid < 128) Edec[tid] = exp2f(lg2 * 64.0f);
            } else {
#pragma unroll
                for (int i = 0; i < 8; ++i) { const float bt = Bs[63 * 128 + 8 * kc + i]; fa[i] = exp2f((bt - Bs[(2 * tp) * 128 + 8 * kc + i]) * LOG2E); fb[i] = exp2f((bt - Bs[(2 * tp + 1) * 128 + 8 * kc + i]) * LOG2E);
                    if (tp == 0) Edec[8 * kc + i] = exp2f(bt * LOG2E); }
            }
#pragma unroll
            for (int i = 0; i < 8; ++i) {
                const unsigned wa = ka[i >> 1], wb = kbv[i >> 1];
                const float xa = (i & 1) ? bfhi(wa) : bflo(wa), xb = (i & 1) ? bfhi(wb) : bflo(wb);
                *(LAS unsigned*)(L + MX_KHT + tr_off(8 * kc + i, tp)) = pk2(xa * fa[i], xb * fb[i]);
                const unsigned ua = va[i >> 1], ub = vbv[i >> 1];
                const unsigned lo = (i & 1) ? (ua >> 16) : (ua & 0xffffu), hi = (i & 1) ? (ub >> 16) : (ub & 0xffffu);
                *(LAS unsigned*)(L + MX_VT + tr_off(8 * kc + i, tp)) = lo | (hi << 16);
            }
        }
        __syncthreads();
        {
            bf16x8 Y[2];
#pragma unroll
            for (int ss = 0; ss < 2; ++ss) Y[ss] = tr_frag(L + MX_VT, 16 * wave + l16, 4 * ss + g4);
#pragma unroll
            for (int kt = 0; kt < 8; ++kt) {
                const f32x4 d = *(const LAS f32x4*)(Edec + 16 * kt + 4 * g4);
                S[kt] = S[kt] * d;
#pragma unroll
                for (int ss = 0; ss < 2; ++ss) { const bf16x8 X = tr_frag(L + MX_KHT, 16 * kt + l16, 4 * ss + g4); S[kt] = __builtin_amdgcn_mfma_f32_16x16x32_bf16(X, Y[ss], S[kt], 0, 0, 0); }
            }
        }
        __syncthreads();
    }
    if (IS_RET) {
        float* U = (float*)(F.ws + WS_UB) + ((size_t)(sg * HB + h) * 256 + 128 * vb + 16 * wave + l16) * 256 + 128 * kb + 4 * g4;
#pragma unroll
        for (int kt = 0; kt < 8; ++kt) *(f32x4*)(U + 16 * kt) = S[kt];
    } else {
        float* U = (float*)(F.ws + WS_UA) + ((size_t)(sg * HA + h) * 128 + 16 * wave + l16) * 128 + 4 * g4;
#pragma unroll
        for (int kt = 0; kt < 8; ++kt) *(f32x4*)(U + 16 * kt) = S[kt];
        if (tid < 128) ((float*)(F.ws + WS_DGA))[(size_t)(sg * HA + h) * 128 + tid] = exp2f(sumb * LOG2E);
    }
    __syncthreads();
}
__device__ __forceinline__ void mix1_phase(Frame& F, int l) {
    for (int u = F.wg; u < 960; u += F.G) {
        bool is_ret; int sg, h, quad = 0;
        if (u < 256) { is_ret = false; sg = u >> 3; h = u & 7; }
        else if (u < 768) { const int r = u - 256; is_ret = true; sg = r >> 4; h = (r >> 2) & 3; quad = r & 3; }
        else if (u < 832) { const int r = u - 768; is_ret = false; sg = 32 + (r >> 3); h = r & 7; }
        else { const int r = u - 832; is_ret = true; sg = 32 + (r >> 4); h = (r >> 2) & 3; quad = r & 3; }
        if (is_ret) p1_unit<true>(F, l, sg, h, quad); else p1_unit<false>(F, l, sg, h, quad);
    }
}

__device__ __forceinline__ void mix2_phase(Frame& F, int l) {
    PHASE_IDS();
    const int gt = F.wg * (NWAVES * 64) + tid, NGT = F.G * NWAVES * 64;
    constexpr int IA = 128 * 32, IB = 256 * 64, PER_SEQ = HA * IA + HB * IB;
    for (int it = gt; it < NSEQ * PER_SEQ; it += NGT) {
        const int seq = it / PER_SEQ; int r = it % PER_SEQ;
        const int ng = seq == 0 ? 32 : 1, sg0 = seq == 0 ? 0 : 31 + seq;
        if (r < HA * IA) {
            const int h = r / IA, v = (r % IA) >> 5, k4 = r & 31;
            f32x4 s = (f32x4){0.f, 0.f, 0.f, 0.f};
            if (seq > 0) { const float* s0 = F.state_hgrn + ((size_t)((l * DECB + (seq - 1)) * HA + h) * 128) * 128;
#pragma unroll
                for (int e = 0; e < 4; ++e) s[e] = s0[(size_t)(4 * k4 + e) * 128 + v]; }
            for (int g = 0; g < ng; ++g) {
                const size_t ub = (size_t)((sg0 + g) * HA + h);
                *(f32x4*)((float*)(F.ws + WS_SSA) + (ub * 128 + v) * 128 + 4 * k4) = s;
                const f32x4 u = *(const f32x4*)((const float*)(F.ws + WS_UA) + (ub * 128 + v) * 128 + 4 * k4);
                const f32x4 d = *(const f32x4*)((const float*)(F.ws + WS_DGA) + ub * 128 + 4 * k4);
                s = d * s + u;
            }
            float* dst = F.out + (seq == 0 ? OFF_SA_P + ((size_t)(l * HA + h) * 128) * 128 : OFF_SA_S + ((size_t)((l * DECB + (seq - 1)) * HA + h) * 128) * 128);
#pragma unroll
            for (int e = 0; e < 4; ++e) dst[(size_t)(4 * k4 + e) * 128 + v] = s[e];
        } else {
            r -= HA * IA;
            const int h = r / IB, v = (r % IB) >> 6, k4 = r & 63;
            const float lg2 = gamma_log2(h); const float gd = exp2f(lg2 * (seq == 0 ? 256.0f : 64.0f));
            f32x4 s = (f32x4){0.f, 0.f, 0.f, 0.f};
            if (seq > 0) { const float* s0 = F.state_ret + ((size_t)((l * DECB + (seq - 1)) * HB + h) * 256) * 256;
#pragma unroll
                for (int e = 0; e < 4; ++e) s[e] = s0[(size_t)(4 * k4 + e) * 256 + v]; }
            for (int g = 0; g < ng; ++g) {
                const size_t ub = (size_t)((sg0 + g) * HB + h);
                v2u w; w.x = pk2(s[0], s[1]); w.y = pk2(s[2], s[3]);
                *(v2u*)((bf16*)(F.ws + WS_SSB) + (ub * 256 + v) * 256 + 4 * k4) = w;
                const f32x4 u = *(const f32x4*)((const float*)(F.ws + WS_UB) + (ub * 256 + v) * 256 + 4 * k4);
                s = s * gd + u;
            }
            float* dst = F.out + (seq == 0 ? OFF_SB_P + ((size_t)(l * HB + h) * 256) * 256 : OFF_SB_S + ((size_t)((l * DECB + (seq - 1)) * HB + h) * 256) * 256);
#pragma unroll
            for (int e = 0; e < 4; ++e) dst[(size_t)(4 * k4 + e) * 256 + v] = s[e];
        }
    }
}
typedef short bf16x4 __attribute__((ext_vector_type(4)));
__device__ __forceinline__ float clampf(float x, float lo, float hi) { return fminf(fmaxf(x, lo), hi); }
__device__ __forceinline__ void p3_hgrn_unit(Frame& F, int l, int sg, int h) {
    PHASE_IDS();
    const int g4 = lane >> 4, l16 = lane & 15;
    const int row0 = sg_row0(sg), nch = sg_nch(sg);
    LAS unsigned char* L = F.lds;
    LAS float* Edec = (LAS float*)(L + MX_EDEC); LAS float* Red = (LAS float*)(L + MX_RED);
    f32x4 S[8];
    { const float* ss = (const float*)(F.ws + WS_SSA) + ((size_t)(sg * HA + h) * 128 + 16 * wave + l16) * 128 + 4 * g4;
#pragma unroll
      for (int kt = 0; kt < 8; ++kt) S[kt] = *(const f32x4*)(ss + 16 * kt); }
    const f32x4 gn4 = *(const f32x4*)(F.hgrn_g + l * 1024 + h * 128 + 16 * wave + 4 * g4);
    for (int c = 0; c < nch; ++c) {
        const int rowc = row0 + 64 * c;
        {
            const int tp = tid >> 4, kc = tid & 15, ra = rowc + 2 * tp;
            const bf16* pa = F.P + (size_t)ra * 8192 + h * 128 + 8 * kc; const bf16* pb = pa + 8192;
            const v4u qa = *(const v4u*)pa, qb = *(const v4u*)pb, ka = *(const v4u*)(pa + 1024), kb = *(const v4u*)(pb + 1024), va = *(const v4u*)(pa + 2048), vb = *(const v4u*)(pb + 2048);
            const float* la = F.LF + (size_t)ra * 1024 + h * 128 + 8 * kc;
            const float* lr = F.LF + (size_t)(rowc + 31) * 1024 + h * 128 + 8 * kc; const float* lt = F.LF + (size_t)(rowc + 63) * 1024 + h * 128 + 8 * kc;
            const f32x4 ba0 = *(const f32x4*)la, ba1 = *(const f32x4*)(la + 4), bb0 = *(const f32x4*)(la + 1024), bb1 = *(const f32x4*)(la + 1028);
            const f32x4 br0 = *(const f32x4*)lr, br1 = *(const f32x4*)(lr + 4), bt0 = *(const f32x4*)lt, bt1 = *(const f32x4*)(lt + 4);
            unsigned qta[4], qtb[4], kta[4], ktb[4], qha[4], qhb[4];
            float pqa = 0.f, pqb = 0.f, pka = 0.f, pkb = 0.f, pha = 0.f, phb = 0.f;
#pragma unroll
            for (int i = 0; i < 8; ++i) {
                const float bref = (i < 4) ? br0[i & 3] : br1[i & 3], btot = (i < 4) ? bt0[i & 3] : bt1[i & 3];
                const float ba = (i < 4) ? ba0[i & 3] : ba1[i & 3], bb = (i < 4) ? bb0[i & 3] : bb1[i & 3];
                const float e1a = exp2f(clampf((ba - bref) * LOG2E, -115.f, 115.f)), e1b = exp2f(clampf((bb - bref) * LOG2E, -115.f, 115.f));
                const float e2a = __builtin_amdgcn_rcpf(e1a), e2b = __builtin_amdgcn_rcpf(e1b);
                const float eref = exp2f(bref * LOG2E), etr = exp2f((btot - bref) * LOG2E);
                const unsigned wqa = qa[i >> 1], wqb = qb[i >> 1], wka = ka[i >> 1], wkb = kb[i >> 1];
                const float xqa = (i & 1) ? bfhi(wqa) : bflo(wqa), xqb = (i & 1) ? bfhi(wqb) : bflo(wqb), xka = (i & 1) ? bfhi(wka) : bflo(wka), xkb = (i & 1) ? bfhi(wkb) : bflo(wkb);
                const float tqa = xqa * e1a, tqb = xqb * e1b, tka = xka * e2a, tkb = xkb * e2b;
                const float hqa = tqa * eref, hqb = tqb * eref;
                *(LAS unsigned*)(L + MX_KHT + tr_off(8 * kc + i, tp)) = pk2(tka * etr, tkb * etr);
                const unsigned ua = va[i >> 1], ub = vb[i >> 1];
                const unsigned lo = (i & 1) ? (ua >> 16) : (ua & 0xffffu), hi = (i & 1) ? (ub >> 16) : (ub & 0xffffu);
                *(LAS unsigned*)(L + MX_VT + tr_off(8 * kc + i, tp)) = lo | (hi << 16);
                if (tp == 0) Edec[8 * kc + i] = exp2f(btot * LOG2E);
                if (i & 1) { qta[i >> 1] = pk2(pqa, tqa); qtb[i >> 1] = pk2(pqb, tqb); kta[i >> 1] = pk2(pka, tka); ktb[i >> 1] = pk2(pkb, tkb); qha[i >> 1] = pk2(pha, hqa); qhb[i >> 1] = pk2(phb, hqb); }
                else { pqa = tqa; pqb = tqb; pka = tka; pkb = tkb; pha = hqa; phb = hqb; }
            }
            const int oa = (2 * tp) * 272 + 16 * kc, ob = oa + 272;
            *(LAS v4u*)(L + MX_QT + oa) = (v4u){qta[0], qta[1], qta[2], qta[3]}; *(LAS v4u*)(L + MX_QT + ob) = (v4u){qtb[0], qtb[1], qtb[2], qtb[3]};
            *(LAS v4u*)(L + MX_KT + oa) = (v4u){kta[0], kta[1], kta[2], kta[3]}; *(LAS v4u*)(L + MX_KT + ob) = (v4u){ktb[0], ktb[1], ktb[2], ktb[3]};
            *(LAS v4u*)(L + MX_QH + oa) = (v4u){qha[0], qha[1], qha[2], qha[3]}; *(LAS v4u*)(L + MX_QH + ob) = (v4u){qhb[0], qhb[1], qhb[2], qhb[3]};
        }
        __syncthreads();
        {
            const int jt = wave >> 1;
#pragma unroll
            for (int ii = 0; ii < 2; ++ii) {
                const int it = 2 * (wave & 1) + ii;
                f32x4 a = (f32x4){0.f, 0.f, 0.f, 0.f};
                if (it <= jt) {
#pragma unroll
                    for (int kk = 0; kk < 4; ++kk) a = __builtin_amdgcn_mfma_f32_16x16x32_bf16(ldfrag(L + MX_KT, 272, 16 * it + l16, 64 * kk + 16 * g4), ldfrag(L + MX_QT, 272, 16 * jt + l16, 64 * kk + 16 * g4), a, 0, 0, 0);
                }
                const int t = 16 * jt + l16, s0 = 16 * it + 4 * g4;
                v2u w; w.x = pk2(s0 <= t ? a[0] : 0.f, s0 + 1 <= t ? a[1] : 0.f); w.y = pk2(s0 + 2 <= t ? a[2] : 0.f, s0 + 3 <= t ? a[3] : 0.f);
                if (it > jt) { w.x = 0u; w.y = 0u; }
                *(LAS v2u*)(L + MX_A + t * 144 + s0 * 2) = w;
            }
        }
        f32x4 o[4];
#pragma unroll
        for (int j = 0; j < 4; ++j) o[j] = (f32x4){0.f, 0.f, 0.f, 0.f};
#pragma unroll
        for (int kk = 0; kk < 4; ++kk) {
            const f32x4 s0 = S[2 * kk], s1 = S[2 * kk + 1];
            const v4u xw = (v4u){pk2(s0[0], s0[1]), pk2(s0[2], s0[3]), pk2(s1[0], s1[1]), pk2(s1[2], s1[3])};
            const bf16x8 X = __builtin_bit_cast(bf16x8, xw);
#pragma unroll
            for (int j = 0; j < 4; ++j) {
                const LAS unsigned char* qp = L + MX_QH + (16 * j + l16) * 272 + 64 * kk + 8 * g4;
                const bf16x4 y0 = *(const LAS bf16x4*)qp, y1 = *(const LAS bf16x4*)(qp + 32);
                const bf16x8 Y = __builtin_shufflevector(y0, y1, 0, 1, 2, 3, 4, 5, 6, 7);
                o[j] = __builtin_amdgcn_mfma_f32_16x16x32_bf16(X, Y, o[j], 0, 0, 0);
            }
        }
        __syncthreads();
        {
            bf16x8 Yv[2];
#pragma unroll
            for (int ss = 0; ss < 2; ++ss) Yv[ss] = tr_frag(L + MX_VT, 16 * wave + l16, 4 * ss + g4);
#pragma unroll
            for (int ss = 0; ss < 2; ++ss)
#pragma unroll
                for (int j = 0; j < 4; ++j) { if (ss == 1 && j < 2) continue;
                    o[j] = __builtin_amdgcn_mfma_f32_16x16x32_bf16(Yv[ss], ldfrag(L + MX_A, 144, 16 * j + l16, 64 * ss + 16 * g4), o[j], 0, 0, 0); }
            if (c + 1 < nch) {
#pragma unroll
                for (int kt = 0; kt < 8; ++kt) {
                    S[kt] = S[kt] * *(const LAS f32x4*)(Edec + 16 * kt + 4 * g4);
#pragma unroll
                    for (int ss = 0; ss < 2; ++ss) S[kt] = __builtin_amdgcn_mfma_f32_16x16x32_bf16(tr_frag(L + MX_KHT, 16 * kt + l16, 4 * ss + g4), Yv[ss], S[kt], 0, 0, 0);
                }
            }
        }
#pragma unroll
        for (int j = 0; j < 4; ++j) { float q = (o[j][0] * o[j][0] + o[j][1] * o[j][1]) + (o[j][2] * o[j][2] + o[j][3] * o[j][3]); q += __shfl_xor(q, 16); q += __shfl_xor(q, 32); if (g4 == 0) Red[wave * 64 + 16 * j + l16] = q; }
        __syncthreads();
#pragma unroll
        for (int j = 0; j < 4; ++j) {
            float tot = 0.f;
#pragma unroll
            for (int w = 0; w < 8; ++w) tot += Red[w * 64 + 16 * j + l16];
            const float rstd = 1.0f / sqrtf(tot * (1.0f / 128.0f) + EPS);
            const size_t row = rowc + 16 * j + l16;
            const v2u gw = *(const v2u*)(F.P + row * 8192 + 3072 + h * 128 + 16 * wave + 4 * g4);
            const f32x4 r = o[j] * rstd * gn4;
            v2u w; w.x = pk2(r[0] * bflo(gw.x), r[1] * bfhi(gw.x)); w.y = pk2(r[2] * bflo(gw.y), r[3] * bfhi(gw.y));
            *(v2u*)(F.O + row * 2048 + h * 128 + 16 * wave + 4 * g4) = w;
        }
        __syncthreads();
    }
}
__device__ __forceinline__ void p3_ret_unit(Frame& F, int l, int sg, int jc, int h) {
    PHASE_IDS();
    const int g4 = lane >> 4, l16 = lane & 15;
    const int rowg = sg_row0(sg), rowq = rowg + 64 * jc;
    LAS unsigned char* L = F.lds;
    LAS float* Red = (LAS float*)(L + RX_RED);
    const float lg2 = gamma_log2(h);
    const int tp = tid >> 4, kc = tid & 15;
    {
        const bf16* pa = F.P + (size_t)(rowq + 2 * tp) * 8192 + 4096 + h * 256 + 8 * kc; const bf16* pb = pa + 8192;
        const v4u a0 = *(const v4u*)pa, a1 = *(const v4u*)(pa + 128), b0 = *(const v4u*)pb, b1 = *(const v4u*)(pb + 128);
        const int oa = (2 * tp) * 528 + 16 * kc;
        *(LAS v4u*)(L + RX_Q + oa) = a0; *(LAS v4u*)(L + RX_Q + oa + 256) = a1; *(LAS v4u*)(L + RX_Q + oa + 528) = b0; *(LAS v4u*)(L + RX_Q + oa + 528 + 256) = b1;
    }
    f32x4 acc[2][4];
#pragma unroll
    for (int vt = 0; vt < 2; ++vt)
#pragma unroll
        for (int j = 0; j < 4; ++j) acc[vt][j] = (f32x4){0.f, 0.f, 0.f, 0.f};
    __syncthreads();
    {
        const bf16* sp = (const bf16*)(F.ws + WS_SSB) + ((size_t)(sg * HB + h) * 256 + 32 * wave + l16) * 256 + 8 * g4;
#pragma unroll
        for (int vt = 0; vt < 2; ++vt) {
            bf16x8 X[8];
#pragma unroll
            for (int kk = 0; kk < 8; ++kk) X[kk] = *(const bf16x8*)(sp + (size_t)vt * 16 * 256 + 32 * kk);
#pragma unroll
            for (int kk = 0; kk < 8; ++kk)
#pragma unroll
                for (int j = 0; j < 4; ++j) acc[vt][j] = __builtin_amdgcn_mfma_f32_16x16x32_bf16(X[kk], ldfrag(L + RX_Q, 528, 16 * j + l16, 64 * kk + 16 * g4), acc[vt][j], 0, 0, 0);
        }
#pragma unroll
        for (int j = 0; j < 4; ++j) { const float xi = exp2f(lg2 * (float)(64 * jc + 16 * j + l16 + 1)); acc[0][j] = acc[0][j] * xi; acc[1][j] = acc[1][j] * xi; }
    }
    for (int jp = 0; jp <= jc; ++jp) {
        __syncthreads();
        {
            const bf16* pa = F.P + (size_t)(rowg + 64 * jp + 2 * tp) * 8192 + 5120 + h * 256 + 8 * kc; const bf16* pb = pa + 8192;
            const v4u a0 = *(const v4u*)pa, a1 = *(const v4u*)(pa + 128), b0 = *(const v4u*)pb, b1 = *(const v4u*)(pb + 128);
            const v4u va0 = *(const v4u*)(pa + 1024), va1 = *(const v4u*)(pa + 1024 + 128), vb0 = *(const v4u*)(pb + 1024), vb1 = *(const v4u*)(pb + 1024 + 128);
            const int oa = (2 * tp) * 528 + 16 * kc;
            *(LAS v4u*)(L + RX_K + oa) = a0; *(LAS v4u*)(L + RX_K + oa + 256) = a1; *(LAS v4u*)(L + RX_K + oa + 528) = b0; *(LAS v4u*)(L + RX_K + oa + 528 + 256) = b1;
#pragma unroll
            for (int i = 0; i < 8; ++i) {
                { const unsigned ua = va0[i >> 1], ub = vb0[i >> 1]; const unsigned lo = (i & 1) ? (ua >> 16) : (ua & 0xffffu), hi = (i & 1) ? (ub >> 16) : (ub & 0xffffu);
                  *(LAS unsigned*)(L + RX_VT + tr_off(8 * kc + i, tp)) = lo | (hi << 16); }
                { const unsigned ua = va1[i >> 1], ub = vb1[i >> 1]; const unsigned lo = (i & 1) ? (ua >> 16) : (ua & 0xffffu), hi = (i & 1) ? (ub >> 16) : (ub & 0xffffu);
                  *(LAS unsigned*)(L + RX_VT + tr_off(128 + 8 * kc + i, tp)) = lo | (hi << 16); }
            }
        }
        __syncthreads();
        {
            const int jt = wave >> 1; const bool diag = (jp == jc);
#pragma unroll
            for (int ii = 0; ii < 2; ++ii) {
                const int it = 2 * (wave & 1) + ii;
                f32x4 a = (f32x4){0.f, 0.f, 0.f, 0.f};
                const bool live = !(diag && it > jt);
                if (live) {
#pragma unroll
                    for (int kk = 0; kk < 8; ++kk) a = __builtin_amdgcn_mfma_f32_16x16x32_bf16(ldfrag(L + RX_K, 528, 16 * it + l16, 64 * kk + 16 * g4), ldfrag(L + RX_Q, 528, 16 * jt + l16, 64 * kk + 16 * g4), a, 0, 0, 0);
                }
                const int t = 16 * jt + l16, s0 = 16 * it + 4 * g4; const int dd = 64 * (jc - jp) + t - s0;
                float e[4];
#pragma unroll
                for (int r = 0; r < 4; ++r) { const float dec = exp2f(lg2 * (float)(dd - r)); e[r] = (!diag || s0 + r <= t) ? a[r] * dec : 0.f; }
                v2u w; w.x = pk2(e[0], e[1]); w.y = pk2(e[2], e[3]);
                if (!live) { w.x = 0u; w.y = 0u; }
                *(LAS v2u*)(L + RX_A + t * 144 + s0 * 2) = w;
            }
        }
        __syncthreads();
#pragma unroll
        for (int ss = 0; ss < 2; ++ss)
#pragma unroll
            for (int vt = 0; vt < 2; ++vt) { const bf16x8 X = tr_frag(L + RX_VT, 32 * wave + 16 * vt + l16, 4 * ss + g4);
#pragma unroll
                for (int j = 0; j < 4; ++j) acc[vt][j] = __builtin_amdgcn_mfma_f32_16x16x32_bf16(X, ldfrag(L + RX_A, 144, 16 * j + l16, 64 * ss + 16 * g4), acc[vt][j], 0, 0, 0); }
    }
#pragma unroll
    for (int j = 0; j < 4; ++j) { float q = 0.f;
#pragma unroll
        for (int vt = 0; vt < 2; ++vt) q += (acc[vt][j][0] * acc[vt][j][0] + acc[vt][j][1] * acc[vt][j][1]) + (acc[vt][j][2] * acc[vt][j][2] + acc[vt][j][3] * acc[vt][j][3]);
        q += __shfl_xor(q, 16); q += __shfl_xor(q, 32); if (g4 == 0) Red[wave * 64 + 16 * j + l16] = q; }
    __syncthreads();
#pragma unroll
    for (int j = 0; j < 4; ++j) {
        float tot = 0.f;
#pragma unroll
        for (int w = 0; w < 8; ++w) tot += Red[w * 64 + 16 * j + l16];
        const float rstd = 1.0f / sqrtf(tot * (1.0f / 256.0f) + EPS);
        const size_t row = rowq + 16 * j + l16;
#pragma unroll
        for (int vt = 0; vt < 2; ++vt) {
            const int vc = h * 256 + 32 * wave + 16 * vt + 4 * g4;
            const v2u gw = *(const v2u*)(F.P + row * 8192 + 7168 + vc);
            const f32x4 r = acc[vt][j] * rstd * *(const f32x4*)(F.ret_g + l * 1024 + vc);
            v2u w; w.x = pk2(r[0] * bflo(gw.x), r[1] * bfhi(gw.x)); w.y = pk2(r[2] * bflo(gw.y), r[3] * bfhi(gw.y));
            *(v2u*)(F.O + row * 2048 + 1024 + vc) = w;
        }
    }
    __syncthreads();
}
__device__ __forceinline__ void mix3_phase(Frame& F, int l) {
    for (int vw = F.wg; vw < 256; vw += F.G) {
        for (int q = 0; q < 2; ++q) {
            if (q == 1 && vw >= 64) break;
            const int sg = q == 0 ? (vw >> 3) : 32 + (vw >> 3);
            p3_hgrn_unit(F, l, sg, vw & 7);
        }
        for (int q = 0; q < 3; ++q) {
            int sg, jc, h;
            if (q < 2) { h = vw & 3; sg = (vw >> 2) & 31; const int half = vw >> 7; jc = q == 0 ? (half ? 2 : 3) : (half ? 1 : 0); }
            else { if (vw < 64 || vw >= 96) break; sg = 32 + ((vw - 64) >> 2); jc = 0; h = (vw - 64) & 3; }
            p3_ret_unit(F, l, sg, jc, h);
        }
    }
}
constexpr int PH_PRO = 0, PH_PER_LAYER = 9, PH_FINAL = 1 + DEPTH * PH_PER_LAYER, N_PHASES = PH_FINAL + 1;
struct Args { const float* in[18]; float* out; unsigned char* ws; int ph_lo, ph_hi; };
__global__ void __launch_bounds__(NWAVES * 64, 2) fwd(Args args) {
    extern __shared__ __attribute__((aligned(16))) unsigned char lds[];
    Frame F;
    F.lds = (LAS unsigned char*)lds;
    F.G = gridDim.x; F.wg = blockIdx.x;
    unsigned char* ws = args.ws;
    F.ctl = (unsigned*)(ws + WS_CTL); F.ws = ws;
    F.x_prompt = args.in[0]; F.x_sample = args.in[1]; F.state_hgrn = args.in[2]; F.state_ret = args.in[3]; F.c_prompt = args.in[4]; F.c_sample = args.in[5];
    F.lb_logits = args.in[6]; F.w_ada = args.in[7]; F.b_ada = args.in[8]; F.norm1_g = args.in[9]; F.norm2_g = args.in[10]; F.w_in = args.in[11];
    F.hgrn_g = args.in[12]; F.ret_g = args.in[13]; F.w_out = args.in[14]; F.w_up = args.in[15]; F.w_down = args.in[16]; F.final_g = args.in[17];
    F.out = args.out;
    F.Win_t = (bf16*)(ws + WS_WIN); F.Wout_t = (bf16*)(ws + WS_WOUT); F.Wup_t = (bf16*)(ws + WS_WUP); F.Wdn_t = (bf16*)(ws + WS_WDN);
    F.X = (float*)(ws + WS_X); F.H = (bf16*)(ws + WS_H); F.P = (bf16*)(ws + WS_P); F.LF = (float*)(ws + WS_LF); F.O = (bf16*)(ws + WS_O); F.U = (bf16*)(ws + WS_U);
    F.MOD = (float*)(ws + WS_MOD); F.LB = (float*)(ws + WS_LB); F.RC = (float*)(ws + WS_ROPE); F.RS = F.RC + SEQ * 128;
    volatile LAS unsigned* MISC = (volatile LAS unsigned*)(F.lds + MISC_OFF);
    if (threadIdx.x < 64) MISC[threadIdx.x] = 0u;
    __syncthreads();
    const int lo = args.ph_lo, hi = args.ph_hi;
    XcdBarrier bar; bar.bar = F.ctl + CW_BAR; bar.x = 0; bar.st = MISC + 8;
    if (hi - lo > 1) bar = xcd_barrier_post(F.ctl + CW_BAR, MISC + 8);
#define IN(k) (lo <= (k) && (k) < hi)
#define SEAM(k) do { if (IN(k) && IN((k) + 1)) xcd_barrier(bar); } while (0)

    if (IN(PH_PRO)) {
#ifndef SKIP_PRO
 p0_prologue(F);
#endif
 } SEAM(PH_PRO);
    for (int l = 0; l < DEPTH; ++l) {
        const int pb = 1 + l * PH_PER_LAYER;
        if (IN(pb + 0)) {
#ifndef SKIP_NORM
 norm_rows<false>(F, F.norm1_g + l * DM, l, 0, l > 0 ? 16 : 0, l - 1, 5);
#endif
 } SEAM(pb + 0);
        if (IN(pb + 1)) {
            pg8::Gemm g{F.H, F.Win_t + (size_t)l * NPROJ * DM, M, NPROJ, DM}; pg8::StaticOrder S; S.init(M, NPROJ, DM, F.G, F.wg);
            pg8::EpiInProj E{F.P, F.LF, F.LB + l * 1024, F.RC, F.RS};
#ifndef SKIP_G1
            pg8::gemm_phase<pg8::EpiInProj, pg8::StaticOrder, true, true>(F.lds + RING_OFF, g, S, E);
#endif
#ifdef PROBE_DUP_INPROJ
            for (int rep = 0; rep < PROBE_DUP_INPROJ; ++rep) pg8::gemm_phase<pg8::EpiInProj, pg8::StaticOrder, true, true>(F.lds + RING_OFF, g, S, E);
#endif
        } SEAM(pb + 1);
        if (IN(pb + 2)) { mix1_phase(F, l); } SEAM(pb + 2);
        if (IN(pb + 3)) { mix2_phase(F, l); } SEAM(pb + 3);
        if (IN(pb + 4)) { mix3_phase(F, l); } SEAM(pb + 4);
        if (IN(pb + 5)) {
            pg8::Gemm g{F.O, F.Wout_t + (size_t)l * DM * DM, M, DM, DM}; pg8::ResidOrder S; S.init(DM, 8, F.G, F.wg);
            pg8::EpiResid E{F.X, F.MOD + (size_t)l * NMOD + 2 * DM, (float*)(F.ws + WS_SLAB)};
#ifndef SKIP_G2
            pg8::gemm_phase<pg8::EpiResid, pg8::ResidOrder, true, true>(F.lds + RING_OFF, g, S, E);
#endif
        } SEAM(pb + 5);
        if (IN(pb + 6)) {
#ifndef SKIP_NORM
 norm_rows<false>(F, F.norm2_g + l * DM, l, 3, 8, l, 2);
#endif
 } SEAM(pb + 6);
        if (IN(pb + 7)) {
            pg8::Gemm g{F.H, F.Wup_t + (size_t)l * DFF * DM, M, DFF, DM}; pg8::StaticOrder S; S.init(M, DFF, DM, F.G, F.wg);
            pg8::EpiRelu2 E{F.U, DFF};
#ifndef SKIP_G3
            pg8::gemm_phase<pg8::EpiRelu2, pg8::StaticOrder, true, true>(F.lds + RING_OFF, g, S, E);
#endif
        } SEAM(pb + 7);
        if (IN(pb + 8)) {
            pg8::Gemm g{F.U, F.Wdn_t + (size_t)l * DM * DFF, M, DM, DFF}; pg8::ResidOrder S; S.init(DFF, 16, F.G, F.wg);
            pg8::EpiResid E{F.X, F.MOD + (size_t)l * NMOD + 5 * DM, (float*)(F.ws + WS_SLAB)};
#ifndef SKIP_G4
            pg8::gemm_phase<pg8::EpiResid, pg8::ResidOrder, true, true>(F.lds + RING_OFF, g, S, E);
#endif
        } SEAM(pb + 8);
    }
    if (IN(PH_FINAL)) {
#ifndef SKIP_NORM
 norm_rows<true>(F, F.final_g, DEPTH - 1, 0, 16, DEPTH - 1, 5);
#endif
 }
#undef IN
#undef SEAM
}

#ifndef MK_ONE_LAUNCH
#define MK_ONE_LAUNCH 1
#endif
extern "C" void kernel_launch(void* const* d_in, const int* in_sizes, int n_in, void* d_out, int out_size, void* d_ws, size_t ws_size, hipStream_t stream) {
    static int grid = 0;
    if (grid == 0) {
        if (n_in != 18 || (size_t)out_size != OUT_TOTAL || ws_size < WS_END2) { fprintf(stderr, "kernel_launch: unexpected shapes: n_in %d out %d ws %zu (need %zu)\n", n_in, out_size, ws_size, (size_t)WS_END2); grid = -1; return; }
        int dev = 0, cus = 0, per_cu = 0;
        if (hipGetDevice(&dev) != hipSuccess || hipDeviceGetAttribute(&cus, hipDeviceAttributeMultiprocessorCount, dev) != hipSuccess) { grid = -1; return; }
        if (hipFuncSetAttribute((const void*)fwd, hipFuncAttributeMaxDynamicSharedMemorySize, LDS_BYTES) != hipSuccess) { fprintf(stderr, "kernel_launch: hipFuncSetAttribute failed\n"); grid = -1; return; }
        if (hipOccupancyMaxActiveBlocksPerMultiprocessor(&per_cu, (const void*)fwd, NWAVES * 64, LDS_BYTES) != hipSuccess || per_cu < 1)
            fprintf(stderr, "kernel_launch: note: occupancy query reports %d workgroups per CU\n", per_cu);
        (void)hipGetLastError();
        grid = cus;
    }
    if (grid < 0) return;
    if (hipMemsetAsync((char*)d_ws + WS_CTL, 0, CTL_ZERO_BYTES, stream) != hipSuccess) { fprintf(stderr, "kernel_launch: memset failed\n"); return; }
    Args a{};
    for (int i = 0; i < 18; ++i) a.in[i] = (const float*)d_in[i];
    a.out = (float*)d_out; a.ws = (unsigned char*)d_ws;
#if MK_ONE_LAUNCH
    a.ph_lo = 0; a.ph_hi = N_PHASES;
    hipLaunchKernelGGL(fwd, dim3(grid), dim3(NWAVES * 64), LDS_BYTES, stream, a);
#else
    for (int ph = 0; ph < N_PHASES; ++ph) {
        a.ph_lo = ph; a.ph_hi = ph + 1;
        hipLaunchKernelGGL(fwd, dim3(grid), dim3(NWAVES * 64), LDS_BYTES, stream, a);
    }
#endif
    const hipError_t le = hipPeekAtLastError();
    if (le != hipSuccess) fprintf(stderr, "kernel_launch: launch failed: %s\n", hipGetErrorName(le));
}
```

```cpp
#include <hip/hip_runtime.h>
#include <cstdio>
#include <cstdint>
__device__ __forceinline__ int row_pos(int row) { return row < 8192 ? row : 2048 + ((row - 8192) & 63); }
__device__ __forceinline__ int row_seq(int row) { return row < 8192 ? 0 : 1 + ((row - 8192) >> 6); }
namespace pg8 {
#define PG8_LAS __attribute__((address_space(3)))
typedef unsigned short bf16_t;
typedef short bf16x8 __attribute__((ext_vector_type(8)));
typedef float f32x4 __attribute__((ext_vector_type(4)));
typedef unsigned u32x4 __attribute__((ext_vector_type(4)));
typedef unsigned u32x2 __attribute__((ext_vector_type(2)));
constexpr int BM = 256, BK = 64, HALF = 128, HTB = HALF * BK * 2  , STAGE_BYTES = 8 * HTB, NXCD = 8, WGM = 8;

__host__ __device__ __forceinline__ int lds_byte(int r, int c) { const int st = (r >> 4) * 2 + (c >> 5), rr = r & 15, cc = c & 31, ob = rr * 64 + cc * 2; return st * 1024 + (ob ^ (((ob >> 9) & 1) << 5)); }
__host__ __device__ __forceinline__ void stage_rc(int b, int& R, int& C) { const int st = b / 1024, sb = b % 1024, swz = sb ^ (((sb >> 9) & 1) << 5); R = (st >> 1) * 16 + swz / 64; C = (st & 1) * 32 + (swz % 64) / 2; }
__host__ __device__ __forceinline__ int perm32(int rho) { const int n = rho >> 4, i = rho & 15; return 8 * (i >> 2) + 4 * n + (i & 3); }

struct Unit { int pm, pn, kt0, nt, slab, qa, qh; };
struct Gemm { const bf16_t* A; const bf16_t* Bt; int M, N, K; };

struct StaticOrder {
    int nM, nN, nwg, G, c, ntk;
    __host__ __device__ void init(int M, int N, int K, int G_, int c_) { nM = M / BM; nN = N / BM; nwg = nM * nN; G = G_; c = c_; ntk = K / BK; }
    __host__ __device__ bool next(int i, Unit& u) const {
        const long L = (long)i * G + c; if (L >= nwg) return false;
        int wgid = (int)L; { const int q = nwg / NXCD, r = nwg % NXCD, xcd = wgid % NXCD, off = wgid / NXCD; wgid = (xcd < r ? xcd * (q + 1) : r * (q + 1) + (xcd - r) * q) + off; }
        const int nig = WGM * nN, gid = wgid / nig, fm = gid * WGM, gsz = (nM - fm) < WGM ? (nM - fm) : WGM;
        u.pm = fm + ((wgid % nig) % gsz); u.pn = (wgid % nig) / gsz; u.kt0 = 0; u.nt = ntk; u.slab = -1; u.qa = -1; u.qh = 0; return true;
    }
    __device__ __forceinline__ void a_ready(const Unit&) const {}
    __device__ __forceinline__ void done(const Unit&) const {}
};

struct ResidOrder {
    StaticOrder so; int G, c, nks, ntk, nsub, nmine;
    __host__ __device__ void init(int K, int nks_, int G_, int c_) { so.init(8192, 2048, K, G_, c_); G = G_; c = c_; nks = nks_; ntk = (K / BK) / nks; nsub = 16 * nks; nmine = c < nsub ? (nsub - c + G - 1) / G : 0; }
    __host__ __device__ bool next(int i, Unit& u) const {
        if (i < nmine) { const int s = c + i * G, su = s / nks, ks = s % nks; u.pm = 32 + (su >> 3); u.pn = su & 7; u.kt0 = ks * ntk; u.nt = ntk; u.slab = ks; u.qa = -1; u.qh = 0; return true; }
        return so.next(i - nmine, u);
    }
    __device__ __forceinline__ void a_ready(const Unit&) const {}
    __device__ __forceinline__ void done(const Unit&) const {}
};

struct QuarterOrder {
    int nN, G, c, ntk, nsub;
    __host__ __device__ void init(int N, int K, int G_, int c_) { nN = N / BM; G = G_; c = c_; ntk = K / BK; nsub = 2 * nN * 4; }
    __host__ __device__ bool next(int i, Unit& u) const {
        const int s = c + i * G; if (s >= nsub) return false;
        const int q = s / (2 * nN), t = s % (2 * nN);
        u.pm = 32 + t / nN; u.pn = t % nN; u.kt0 = 0; u.nt = ntk; u.slab = -1; u.qa = q >> 1; u.qh = q & 1; return true;
    }
    __device__ __forceinline__ void a_ready(const Unit&) const {}
    __device__ __forceinline__ void done(const Unit&) const {}
};

__device__ __forceinline__ unsigned cvt_pk_bf16(float lo, float hi) { unsigned r; asm volatile("v_cvt_pk_bf16_f32 %0, %1, %2" : "=v"(r) : "v"(lo), "v"(hi)); return r; }
__device__ __forceinline__ float fast_rcp(float x) { return __builtin_amdgcn_rcpf(x); }
__device__ __forceinline__ float silu_f(float x) { return x * fast_rcp(1.0f + __expf(-x)); }

struct EpiInProj {
    static constexpr bool PERM = true, AFTER_DRAIN = false;
    bf16_t* P; float* LF; const float* lb; const float* rc; const float* rs;
    __device__ __forceinline__ void operator()(const f32x4 (&acc)[2][2][4][2], const Unit& u, int wr, int wc, int fr, int fq) const {
        const int seg = u.pn >> 2;
        const int row0 = u.pm * BM + wr * 64 + fr;
        const int colg0 = u.pn * BM + wc * 32 + 8 * fq;
        if (seg == 4 || seg == 5) {
            const float ksc = (seg == 5) ? 0.0625f : 1.0f;
            const int j0 = wc * 32 + 8 * fq;
#pragma unroll
            for (int ai = 0; ai < 2; ++ai)
#pragma unroll
                for (int m = 0; m < 4; ++m) {
                    if (u.qa >= 0 && (ai != u.qa || (m >> 1) != u.qh)) continue;
                    const int row = row0 + ai * HALF + m * 16; const int pos = row_pos(row);
                    const f32x4 c0 = *(const f32x4*)(rc + (size_t)pos * 128 + j0), c1 = *(const f32x4*)(rc + (size_t)pos * 128 + j0 + 4);
                    const f32x4 s0 = *(const f32x4*)(rs + (size_t)pos * 128 + j0), s1 = *(const f32x4*)(rs + (size_t)pos * 128 + j0 + 4);
                    const f32x4 x1a = acc[ai][0][m][0], x1b = acc[ai][0][m][1], x2a = acc[ai][1][m][0], x2b = acc[ai][1][m][1];
                    const f32x4 o1a = (x1a * c0 - x2a * s0) * ksc, o1b = (x1b * c1 - x2b * s1) * ksc;
                    const f32x4 o2a = (x2a * c0 + x1a * s0) * ksc, o2b = (x2b * c1 + x1b * s1) * ksc;
                    bf16_t* rowp = P + (size_t)row * 8192 + colg0;
                    u32x4 w; w.x = cvt_pk_bf16(o1a[0], o1a[1]); w.y = cvt_pk_bf16(o1a[2], o1a[3]); w.z = cvt_pk_bf16(o1b[0], o1b[1]); w.w = cvt_pk_bf16(o1b[2], o1b[3]);
                    *(u32x4*)(rowp) = w;
                    w.x = cvt_pk_bf16(o2a[0], o2a[1]); w.y = cvt_pk_bf16(o2a[2], o2a[3]); w.z = cvt_pk_bf16(o2b[0], o2b[1]); w.w = cvt_pk_bf16(o2b[2], o2b[3]);
                    *(u32x4*)(rowp + HALF) = w;
                }
        } else if (seg == 1) {
#pragma unroll
            for (int bj = 0; bj < 2; ++bj) {
                const int cs = colg0 + bj * HALF - 1024;
                const f32x4 lb0 = *(const f32x4*)(lb + cs), lb1 = *(const f32x4*)(lb + cs + 4);
#pragma unroll
                for (int ai = 0; ai < 2; ++ai)
#pragma unroll
                    for (int m = 0; m < 4; ++m) {
                        if (u.qa >= 0 && (ai != u.qa || (m >> 1) != u.qh)) continue;
                        const int row = row0 + ai * HALF + m * 16;
                        f32x4 lf0, lf1, k0, k1;
#pragma unroll
                        for (int e = 0; e < 4; ++e) {
                            { const float x = acc[ai][bj][m][0][e], l = lb0[e]; const float sg = fast_rcp(1.0f + __expf(-x)), sn = fast_rcp(1.0f + __expf(x)); lf0[e] = __logf(l + (1.0f - l) * sg); k0[e] = (1.0f - l) * sn; }
                            { const float x = acc[ai][bj][m][1][e], l = lb1[e]; const float sg = fast_rcp(1.0f + __expf(-x)), sn = fast_rcp(1.0f + __expf(x)); lf1[e] = __logf(l + (1.0f - l) * sg); k1[e] = (1.0f - l) * sn; }
                        }
                        float* lfp = LF + (size_t)row * 1024 + cs; *(f32x4*)lfp = lf0; *(f32x4*)(lfp + 4) = lf1;
                        u32x4 w; w.x = cvt_pk_bf16(k0[0], k0[1]); w.y = cvt_pk_bf16(k0[2], k0[3]); w.z = cvt_pk_bf16(k1[0], k1[1]); w.w = cvt_pk_bf16(k1[2], k1[3]);
                        *(u32x4*)(P + (size_t)row * 8192 + colg0 + bj * HALF) = w;
                    }
            }
        } else {
            const bool act = (seg == 0 || seg == 3 || seg == 7);
#pragma unroll
            for (int ai = 0; ai < 2; ++ai)
#pragma unroll
                for (int m = 0; m < 4; ++m) { if (u.qa >= 0 && (ai != u.qa || (m >> 1) != u.qh)) continue;
                    bf16_t* rowp = P + (size_t)(row0 + ai * HALF + m * 16) * 8192 + colg0;
#pragma unroll
                    for (int bj = 0; bj < 2; ++bj) { f32x4 v0 = acc[ai][bj][m][0], v1 = acc[ai][bj][m][1];
                        if (act) {
#pragma unroll
                            for (int e = 0; e < 4; ++e) { v0[e] = silu_f(v0[e]); v1[e] = silu_f(v1[e]); } }
                        u32x4 w; w.x = cvt_pk_bf16(v0[0], v0[1]); w.y = cvt_pk_bf16(v0[2], v0[3]); w.z = cvt_pk_bf16(v1[0], v1[1]); w.w = cvt_pk_bf16(v1[2], v1[3]);
                        *(u32x4*)(rowp + bj * HALF) = w; } }
        }
    }
};
struct EpiRelu2 {
    static constexpr bool PERM = true, AFTER_DRAIN = false;
    bf16_t* O; int ldc;
    __device__ __forceinline__ void operator()(const f32x4 (&acc)[2][2][4][2], const Unit& u, int wr, int wc, int fr, int fq) const {
        const int row0 = u.pm * BM + wr * 64 + fr, col0 = u.pn * BM + wc * 32 + 8 * fq;
#pragma unroll
        for (int ai = 0; ai < 2; ++ai)
#pragma unroll
            for (int m = 0; m < 4; ++m) { if (u.qa >= 0 && (ai != u.qa || (m >> 1) != u.qh)) continue;
                bf16_t* rowp = O + (size_t)(row0 + ai * HALF + m * 16) * ldc + col0;
#pragma unroll
                for (int bj = 0; bj < 2; ++bj) { f32x4 v0 = acc[ai][bj][m][0], v1 = acc[ai][bj][m][1];
#pragma unroll
                    for (int e = 0; e < 4; ++e) { const float a = fmaxf(v0[e], 0.f), b = fmaxf(v1[e], 0.f); v0[e] = a * a; v1[e] = b * b; }
                    u32x4 w; w.x = cvt_pk_bf16(v0[0], v0[1]); w.y = cvt_pk_bf16(v0[2], v0[3]); w.z = cvt_pk_bf16(v1[0], v1[1]); w.w = cvt_pk_bf16(v1[2], v1[3]);
                    *(u32x4*)(rowp + bj * HALF) = w; } }
    }
};
struct EpiResid {
    static constexpr bool PERM = false, AFTER_DRAIN = false;
    float* X; const float* gate; float* slab;
    __device__ __forceinline__ void operator()(const f32x4 (&acc)[2][2][4][2], const Unit& u, int wr, int wc, int fr, int fq) const {
        const int row0 = u.pm * BM + wr * 64 + fr, col0 = u.pn * BM + wc * 32 + 4 * fq;
        if (u.slab >= 0) {
            float* sp = slab + ((size_t)u.slab * 512 + (row0 - 8192)) * 2048 + col0;
#pragma unroll
            for (int ai = 0; ai < 2; ++ai)
#pragma unroll
                for (int m = 0; m < 4; ++m) { float* rowp = sp + (size_t)(ai * HALF + m * 16) * 2048;
#pragma unroll
                    for (int bj = 0; bj < 2; ++bj)
#pragma unroll
                        for (int n = 0; n < 2; ++n) *(f32x4*)(rowp + bj * HALF + n * 16) = acc[ai][bj][m][n]; }
            return;
        }
        f32x4 gv[2][2];
#pragma unroll
        for (int bj = 0; bj < 2; ++bj)
#pragma unroll
            for (int n = 0; n < 2; ++n) gv[bj][n] = *(const f32x4*)(gate + col0 + bj * HALF + n * 16);
#pragma unroll
        for (int ai = 0; ai < 2; ++ai)
#pragma unroll
            for (int m = 0; m < 4; ++m) { float* rowp = X + (size_t)(row0 + ai * HALF + m * 16) * 2048 + col0;
#pragma unroll
                for (int bj = 0; bj < 2; ++bj)
#pragma unroll
                    for (int n = 0; n < 2; ++n) { const f32x4 xv = *(const f32x4*)(rowp + bj * HALF + n * 16); *(f32x4*)(rowp + bj * HALF + n * 16) = xv + gv[bj][n] * acc[ai][bj][m][n]; }
                asm volatile("" ::: "memory"); }
    }
};
template <class Epi, class Sched, bool ALIGN_EPI = false, bool SP2 = false, int QM = 0>
__device__ __forceinline__ void gemm_phase(PG8_LAS unsigned char* lds, const Gemm g, const Sched& S, const Epi& E) {
    int tid_l = threadIdx.x; asm volatile("" : "+v"(tid_l));
    const int tid = tid_l, wid = __builtin_amdgcn_readfirstlane(tid >> 6), lane = tid & 63, wr = wid >> 2, wc = wid & 3, fr = lane & 15, fq = lane >> 4;
    const int K = g.K;
    unsigned voffA[2], voffB[2];
#pragma unroll
    for (int i = 0; i < 2; ++i) { int R, C; stage_rc(tid * 16 + i * 8192, R, C); const int Rb = Epi::PERM ? ((R & ~31) + perm32(R & 31)) : R;
        voffA[i] = (unsigned)(R * K + C) * 2u; voffB[i] = (unsigned)(Rb * K + C) * 2u; }
    const size_t kstep = (size_t)(BK * 2);
    const size_t hstep = (size_t)HALF * K * 2;
    const size_t tstep = 2 * hstep;
    const unsigned ldsw = (unsigned)wid * 1024u;
    const int aoff = lds_byte(wr * 64 + fr, fq * 8), boff = lds_byte(wc * 32 + fr, fq * 8);
#define PG8_SA(b, h) (((b) * 2 + (h)) * HTB)
#define PG8_SB(b, h) ((4 + (b) * 2 + (h)) * HTB)
#define PG8_STAGE(bufoff, gbase, voff) do { _Pragma("unroll") for (int _i = 0; _i < 2; ++_i) \
        __builtin_amdgcn_global_load_lds((const unsigned*)((const char*)(gbase) + (voff)[_i]), (PG8_LAS unsigned*)(lds + (bufoff) + ldsw + _i * 8192), 16, 0, 0); } while (0)
#define PG8_LDA(dst, b, h) do { if (!QM || (h) == q_a) { _Pragma("unroll") for (int m = 0; m < 4; ++m) _Pragma("unroll") for (int k = 0; k < 2; ++k) dst[m][k] = *(const PG8_LAS bf16x8*)(lds + PG8_SA(b, h) + aoff + m * 2048 + k * 1024); } } while (0)
#define PG8_LDB(dst, b, h) do { _Pragma("unroll") for (int n = 0; n < 2; ++n) _Pragma("unroll") for (int k = 0; k < 2; ++k) dst[n][k] = *(const PG8_LAS bf16x8*)(lds + PG8_SB(b, h) + boff + n * 2048 + k * 1024); } while (0)
#define PG8_MMA(ai, bj, At, Bt) do { if (!QM || (ai) == q_a) { __builtin_amdgcn_s_setprio(1); _Pragma("unroll") for (int m = 0; m < 4; ++m) { if (!QM || (m >> 1) == q_h) { _Pragma("unroll") for (int n = 0; n < 2; ++n) _Pragma("unroll") for (int k = 0; k < 2; ++k) \
        acc[ai][bj][m][n] = __builtin_amdgcn_mfma_f32_16x16x32_bf16(Bt[n][k], At[m][k], acc[ai][bj][m][n], 0, 0, 0); } } __builtin_amdgcn_s_setprio(0); } } while (0)
#define PG8_WAIT_V(n) asm volatile("s_waitcnt vmcnt(" #n ")" ::: "memory")
#define PG8_WAIT_L(n) asm volatile("s_waitcnt lgkmcnt(" #n ")" ::: "memory")
#define PG8_BAR __builtin_amdgcn_s_barrier()
#define PG8_SCHED __builtin_amdgcn_sched_barrier(0)
    Unit cur, nxt; int ui = 0;
    if (!S.next(0, cur)) return;
    int q_a = cur.qa, q_h = cur.qh; (void)q_a; (void)q_h;
    f32x4 acc[2][2][4][2];
#pragma unroll
    for (int a = 0; a < 2; ++a)
#pragma unroll
        for (int b = 0; b < 2; ++b)
#pragma unroll
            for (int m = 0; m < 4; ++m)
#pragma unroll
                for (int n = 0; n < 2; ++n) acc[a][b][m][n] = (f32x4){0.f, 0.f, 0.f, 0.f};
    bf16x8 At[4][2], B0[2][2], B1[2][2];
    const char* cA = (const char*)g.A + (size_t)cur.pm * tstep + (size_t)cur.kt0 * kstep; const char* cB = (const char*)g.Bt + (size_t)cur.pn * tstep + (size_t)cur.kt0 * kstep;
    S.a_ready(cur);
    if constexpr (SP2) {
        PG8_STAGE(PG8_SB(0, 0), cB, voffB); PG8_STAGE(PG8_SB(0, 1), cB + hstep, voffB); PG8_STAGE(PG8_SA(0, 0), cA, voffA); PG8_STAGE(PG8_SA(0, 1), cA + hstep, voffA);
        if (wr == 1) PG8_BAR;
        PG8_WAIT_V(2); PG8_BAR;
        PG8_STAGE(PG8_SB(1, 0), cB + kstep, voffB); PG8_STAGE(PG8_SA(1, 0), cA + kstep, voffA); PG8_STAGE(PG8_SB(1, 1), cB + hstep + kstep, voffB);
        PG8_WAIT_V(6); PG8_BAR;
    } else {
        PG8_STAGE(PG8_SB(0, 0), cB, voffB); PG8_STAGE(PG8_SA(0, 0), cA, voffA); PG8_STAGE(PG8_SB(0, 1), cB + hstep, voffB); PG8_STAGE(PG8_SA(0, 1), cA + hstep, voffA);
        if (wr == 1) PG8_BAR;
        PG8_WAIT_V(4); PG8_BAR;
        PG8_STAGE(PG8_SB(1, 0), cB + kstep, voffB); PG8_STAGE(PG8_SA(1, 0), cA + kstep, voffA); PG8_STAGE(PG8_SB(1, 1), cB + hstep + kstep, voffB);
        PG8_WAIT_V(6); PG8_BAR;
    }
    for (;;) {
        const bool has_next = S.next(ui + 1, nxt);
        const char* nA = has_next ? (const char*)g.A + (size_t)nxt.pm * tstep + (size_t)nxt.kt0 * kstep : cA; const char* nB = has_next ? (const char*)g.Bt + (size_t)nxt.pn * tstep + (size_t)nxt.kt0 * kstep : cB;
        const int nt = cur.nt;
        for (int t = 0; t < nt; t += 2) {
            const bool last = (t == nt - 2);
            const char* a1 = cA + (size_t)(t + 1) * kstep;
            const char* a2 = last ? nA : cA + (size_t)(t + 2) * kstep; const char* b2 = last ? nB : cB + (size_t)(t + 2) * kstep;
            const char* a3 = a2 + kstep; const char* b3 = b2 + kstep;
            if (last && has_next) S.a_ready(nxt);
            if constexpr (SP2) {
            PG8_LDB(B0, 0, 0); PG8_LDB(B1, 0, 1); PG8_SCHED; PG8_LDA(At, 0, 0); PG8_STAGE(PG8_SA(1, 1), a1 + hstep, voffA);
            PG8_WAIT_V(8); PG8_WAIT_L(0); PG8_BAR; PG8_MMA(0, 0, At, B0); PG8_MMA(0, 1, At, B1); PG8_BAR; PG8_SCHED;
            PG8_LDA(At, 0, 1); PG8_STAGE(PG8_SB(0, 0), b2, voffB); PG8_STAGE(PG8_SB(0, 1), b2 + hstep, voffB); PG8_STAGE(PG8_SA(0, 0), a2, voffA);
            PG8_WAIT_V(8); PG8_WAIT_L(0); PG8_BAR; PG8_MMA(1, 0, At, B0); PG8_MMA(1, 1, At, B1); PG8_BAR; PG8_SCHED;
            PG8_LDB(B0, 1, 0); PG8_LDB(B1, 1, 1); PG8_SCHED; PG8_LDA(At, 1, 0); PG8_STAGE(PG8_SA(0, 1), a2 + hstep, voffA);
            PG8_WAIT_V(8); PG8_WAIT_L(0); PG8_BAR; PG8_MMA(0, 0, At, B0); PG8_MMA(0, 1, At, B1); PG8_BAR; PG8_SCHED;
            PG8_LDA(At, 1, 1); PG8_STAGE(PG8_SB(1, 0), b3, voffB); PG8_STAGE(PG8_SB(1, 1), b3 + hstep, voffB); PG8_STAGE(PG8_SA(1, 0), a3, voffA);
            PG8_WAIT_V(8); PG8_WAIT_L(0); PG8_BAR; PG8_MMA(1, 0, At, B0); PG8_MMA(1, 1, At, B1); PG8_BAR; PG8_SCHED;
            } else {
            PG8_LDB(B0, 0, 0); PG8_SCHED; PG8_LDA(At, 0, 0); PG8_STAGE(PG8_SA(1, 1), a1 + hstep, voffA);
            PG8_WAIT_L(8); PG8_BAR; PG8_WAIT_L(0); PG8_MMA(0, 0, At, B0); PG8_BAR; PG8_SCHED;
            PG8_LDB(B1, 0, 1); PG8_STAGE(PG8_SB(0, 0), b2, voffB);
            PG8_BAR; PG8_WAIT_L(0); PG8_MMA(0, 1, At, B1); PG8_BAR;
            PG8_LDA(At, 0, 1); PG8_STAGE(PG8_SA(0, 0), a2, voffA);
            PG8_BAR; PG8_WAIT_L(0); PG8_MMA(1, 0, At, B0); PG8_BAR; PG8_SCHED;
            PG8_STAGE(PG8_SB(0, 1), b2 + hstep, voffB);
            PG8_WAIT_V(6); PG8_BAR; PG8_MMA(1, 1, At, B1); PG8_BAR;
            PG8_LDB(B0, 1, 0); PG8_SCHED; PG8_LDA(At, 1, 0); PG8_STAGE(PG8_SA(0, 1), a2 + hstep, voffA);
            PG8_WAIT_L(8); PG8_BAR; PG8_WAIT_L(0); PG8_MMA(0, 0, At, B0); PG8_BAR; PG8_SCHED;
            PG8_LDB(B1, 1, 1); PG8_STAGE(PG8_SB(1, 0), b3, voffB);
            PG8_BAR; PG8_WAIT_L(0); PG8_MMA(0, 1, At, B1); PG8_BAR;
            PG8_LDA(At, 1, 1); PG8_STAGE(PG8_SA(1, 0), a3, voffA);
            PG8_BAR; PG8_WAIT_L(0); PG8_MMA(1, 0, At, B0); PG8_BAR; PG8_SCHED;
            PG8_STAGE(PG8_SB(1, 1), b3 + hstep, voffB);
            PG8_WAIT_V(6); PG8_BAR; PG8_MMA(1, 1, At, B1); PG8_BAR;
            }
        }
        if constexpr (ALIGN_EPI) { if (wr == 0) PG8_BAR; }
        if constexpr (!Epi::AFTER_DRAIN) { E(acc, cur, wr, wc, fr, fq); S.done(cur); }
        if (!has_next) break;
#pragma unroll
        for (int a = 0; a < 2; ++a)
#pragma unroll
            for (int b = 0; b < 2; ++b)
#pragma unroll
                for (int m = 0; m < 4; ++m)
#pragma unroll
                    for (int n = 0; n < 2; ++n) acc[a][b][m][n] = (f32x4){0.f, 0.f, 0.f, 0.f};
        cur = nxt; cA = nA; cB = nB; ++ui; q_a = cur.qa; q_h = cur.qh;
        if constexpr (ALIGN_EPI) { if (wr == 1) PG8_BAR; }
    }
    PG8_WAIT_V(0);
    if constexpr (!ALIGN_EPI) { if (wr == 0) PG8_BAR; }
    PG8_BAR;
    if constexpr (Epi::AFTER_DRAIN) { E.fused(acc, cur, wr, wc, fr, fq, lds, wid, lane); S.done(cur); }
#undef PG8_SA
#undef PG8_SB
#undef PG8_STAGE
#undef PG8_LDA
#undef PG8_LDB
#undef PG8_MMA
#undef PG8_WAIT_V
#undef PG8_WAIT_L
#undef PG8_BAR
#undef PG8_SCHED
}
}
constexpr int NWAVES = 8;
constexpr int DM = 2048, SEQ = 8192, DEPTH = 4, DECB = 8, DECS = 64, M = SEQ + DECB * DECS, NPROJ = 8192, DFF = 8192, NSEQ = 9, NMOD = 6 * DM;
constexpr int HA = 8, HB = 4;
constexpr float EPS = 1e-6f;
constexpr size_t OFF_SA_P = (size_t)M * DM, OFF_SB_P = OFF_SA_P + (size_t)DEPTH * HA * 128 * 128, OFF_SA_S = OFF_SB_P + (size_t)DEPTH * HB * 256 * 256,
                 OFF_SB_S = OFF_SA_S + (size_t)DEPTH * DECB * HA * 128 * 128, OUT_TOTAL = OFF_SB_S + (size_t)DEPTH * DECB * HB * 256 * 256;

constexpr size_t MiB = 1u << 20;
constexpr size_t WS_CTL = 0, CTL_ZERO_BYTES = 1 * MiB;
constexpr size_t WS_WIN = 2 * MiB;
constexpr size_t WS_WOUT = WS_WIN + 128 * MiB;
constexpr size_t WS_WUP = WS_WOUT + 32 * MiB;
constexpr size_t WS_WDN = WS_WUP + 128 * MiB;
constexpr size_t WS_X = WS_WDN + 128 * MiB;
constexpr size_t WS_H = WS_X + 68 * MiB;
constexpr size_t WS_P = WS_H + 34 * MiB;
constexpr size_t WS_LF = WS_P + 136 * MiB;
constexpr size_t WS_O = WS_LF + 34 * MiB;
constexpr size_t WS_U = WS_O + 34 * MiB;
constexpr size_t WS_MOD = WS_U + 136 * MiB;
constexpr size_t WS_LB = WS_MOD + 2 * MiB;
constexpr size_t WS_ROPE = WS_LB + 1 * MiB;
constexpr size_t WS_SLAB = WS_ROPE + 8 * MiB;
constexpr size_t WS_END = WS_SLAB + 64 * MiB;
constexpr int CW_Q0 = 64;
constexpr int CW_BAR = 4096;

constexpr int RING_OFF = 0, RING_BYTES = 131072;
constexpr int LDS_BYTES = 151552;
constexpr int MISC_OFF = 147456;

#define GAS __attribute__((address_space(1)))
#define LAS __attribute__((address_space(3)))
typedef unsigned short bf16;
typedef unsigned v4u __attribute__((ext_vector_type(4)));
typedef unsigned v2u __attribute__((ext_vector_type(2)));
typedef float f32x4 __attribute__((ext_vector_type(4)));
typedef short bf16x8 __attribute__((ext_vector_type(8)));
#define LDS_WAIT() asm volatile("s_waitcnt lgkmcnt(0)" ::: "memory")
#define VM_WAIT() asm volatile("s_waitcnt vmcnt(0)" ::: "memory")
__device__ __forceinline__ unsigned f2bf(float f) { unsigned u = __builtin_bit_cast(unsigned, f); return (u + 0x7fffu + ((u >> 16) & 1u)) >> 16; }
__device__ __forceinline__ unsigned pk2(float lo, float hi) { return pg8::cvt_pk_bf16(lo, hi); }
__device__ __forceinline__ float bf2f(unsigned short b) { return __builtin_bit_cast(float, ((unsigned)b) << 16); }
__device__ __forceinline__ float bflo(unsigned w) { return __builtin_bit_cast(float, w << 16); }
__device__ __forceinline__ float bfhi(unsigned w) { return __builtin_bit_cast(float, w & 0xffff0000u); }

#define XB_TMO      128
#define XB_XCNT(j)  (256  + 64 * (j))
#define XB_XSUB(j)  (1280 + 64 * (j))
#define XB_XGEN(j)  (2304 + 64 * (j))
#define XB_TOP      3328
#define XB_TOPGEN   3392
#define XCD_BAR_WORDS 3456
#define XB_SPIN_CAP (1u << 20)
__device__ __forceinline__ unsigned xb_ld(unsigned* p)              { return __hip_atomic_load(p, __ATOMIC_RELAXED, __HIP_MEMORY_SCOPE_AGENT); }
__device__ __forceinline__ unsigned xb_add(unsigned* p, unsigned v) { return __hip_atomic_fetch_add(p, v, __ATOMIC_RELAXED, __HIP_MEMORY_SCOPE_AGENT); }
__device__ __forceinline__ unsigned xb_xcc_id() { return (unsigned)__builtin_amdgcn_s_getreg((3 << 11) | 20) & 0xFu; }
#define XB_SPIN(cond, bar) do { unsigned _sp = 0; while (cond) { __builtin_amdgcn_s_sleep(1); \
    if ((++_sp & 255u) == 0u) { if (xb_ld(&(bar)[XB_TMO])) break; if (_sp > XB_SPIN_CAP) { atomicAdd(&(bar)[XB_TMO], 1u); break; } } } } while (0)
struct XcdBarrier { unsigned* bar; unsigned x; volatile LAS unsigned* st; };
__device__ __forceinline__ XcdBarrier xcd_barrier_post(unsigned* bar, volatile LAS unsigned* st) {
    XcdBarrier b; b.bar = bar; b.x = xb_xcc_id(); b.st = st;
    if (threadIdx.x == 0) (void)xb_add(&bar[XB_XCNT(b.x)], 1u);
    return b;
}
__device__ __forceinline__ void xcd_barrier_complete(unsigned* bar, unsigned x, unsigned& nloc, unsigned& nx) {
    const unsigned G = gridDim.x * gridDim.y * gridDim.z;
    unsigned sum, cnt, mine, sp = 0u;
    for (;;) {
        sum = 0u; cnt = 0u; mine = 0u;
#pragma unroll
        for (unsigned j = 0; j < 16; ++j) { const unsigned c = xb_ld(&bar[XB_XCNT(j)]); sum += c; cnt += (c > 0u) ? 1u : 0u; mine = (j == x) ? c : mine; }
        if (sum == G) break;
        __builtin_amdgcn_s_sleep(1);
        if ((++sp & 255u) == 0u) { if (xb_ld(&bar[XB_TMO])) break; if (sp > XB_SPIN_CAP) { atomicAdd(&bar[XB_TMO], 1u); break; } }
    }
    nloc = mine > 0u ? mine : 1u; nx = cnt > 0u ? cnt : 1u;
}
__device__ __forceinline__ void xcd_barrier(const XcdBarrier& b) {
    asm volatile("s_waitcnt vmcnt(0)" ::: "memory");
    __syncthreads();
    if (threadIdx.x == 0) {
        unsigned* bar = b.bar;
        __builtin_amdgcn_s_waitcnt(0);
        unsigned nloc = b.st[0], nx = b.st[1];
        if (nloc == 0u) { xcd_barrier_complete(bar, b.x, nloc, nx); b.st[0] = nloc; b.st[1] = nx; }
        const unsigned old = xb_add(&bar[XB_XSUB(b.x)], 1u);
        const unsigned gen = old / nloc;
        if (old + 1u == (gen + 1u) * nloc) {
            __builtin_amdgcn_fence(__ATOMIC_RELEASE, "agent");
            asm volatile("s_waitcnt vmcnt(0)" ::: "memory");
            const unsigned og = xb_add(&bar[XB_TOP], 1u);
            const unsigned tg = og / nx;
            if (og + 1u == (tg + 1u) * nx) xb_add(&bar[XB_TOPGEN], 1u);
            else XB_SPIN(xb_ld(&bar[XB_TOPGEN]) == tg, bar);
            __builtin_amdgcn_fence(__ATOMIC_ACQUIRE, "agent");
            xb_add(&bar[XB_XGEN(b.x)], 1u);
            asm volatile("s_waitcnt vmcnt(0)" ::: "memory");
        } else {
            XB_SPIN(xb_ld(&bar[XB_XGEN(b.x)]) == gen, bar);
            __builtin_amdgcn_fence(__ATOMIC_ACQUIRE, "agent");
            asm volatile("s_waitcnt vmcnt(0)" ::: "memory");
        }
    }
    __syncthreads();
}

struct Frame {
    LAS unsigned char* lds;
    unsigned* ctl;
    unsigned char* ws;
    int G, wg;
    const float *x_prompt, *x_sample, *state_hgrn, *state_ret, *c_prompt, *c_sample, *lb_logits, *w_ada, *b_ada, *norm1_g, *norm2_g, *w_in, *hgrn_g, *ret_g, *w_out, *w_up, *w_down, *final_g;
    float* out;
    bf16 *Win_t, *Wout_t, *Wup_t, *Wdn_t, *H, *P, *O, *U;
    float *X, *LF, *MOD, *LB, *RC, *RS;
};

__device__ __forceinline__ int ltid() { int t = threadIdx.x; asm volatile("" : "+v"(t)); return t; }
#define PHASE_IDS() const int tid = ltid(), lane = tid & 63, wave = __builtin_amdgcn_readfirstlane(tid >> 6); (void)lane; (void)wave
__device__ __forceinline__ float wave_sum(float v) {
#pragma unroll
    for (int o = 1; o < 64; o <<= 1) v += __shfl_xor(v, o);
    return v;
}
__device__ __forceinline__ void p0_transpose_item(const float* W, int K, int N, bf16* WT, LAS float* scr, int item, int lane) {
    const int nblk = N / 32, kb = item / nblk, nb = item % nblk, k0 = 64 * kb, n0 = 32 * nb;
#pragma unroll 8
    for (int i = 0; i < 32; ++i) { const int kk = 2 * i + (lane >> 5); scr[kk * 33 + (lane & 31)] = W[(size_t)(k0 + kk) * N + n0 + (lane & 31)]; }
    LDS_WAIT(); asm volatile("" ::: "memory");
    const int c = lane & 7;
#pragma unroll
    for (int j = 0; j < 4; ++j) { const int n = (lane >> 3) + 8 * j; const LAS float* s = scr + (8 * c) * 33 + n;
        v4u o; o.x = pk2(s[0 * 33], s[1 * 33]); o.y = pk2(s[2 * 33], s[3 * 33]); o.z = pk2(s[4 * 33], s[5 * 33]); o.w = pk2(s[6 * 33], s[7 * 33]);
        *(GAS v4u*)(WT + (size_t)(n0 + n) * K + k0 + 8 * c) = o; }
    LDS_WAIT(); asm volatile("" ::: "memory");
}
__device__ __forceinline__ void p0_mod_task(Frame& F, int task) {
    PHASE_IDS();
    const int l = task / 48, cb = task % 48;
    LAS float* cact = (LAS float*)(F.lds);
    LAS float* red = (LAS float*)(F.lds + 73728);
    for (int i = tid; i < NSEQ * DM; i += NWAVES * 64) { const int b = i / DM, k = i % DM; const float c = (b == 0) ? F.c_prompt[k] : F.c_sample[(b - 1) * DM + k]; cact[i] = c / (1.0f + __expf(-c)); }
    __syncthreads();
    const float* W = F.w_ada + (size_t)l * DM * NMOD + cb * 256 + 4 * lane;
    f32x4 acc[NSEQ];
#pragma unroll
    for (int b = 0; b < NSEQ; ++b) acc[b] = (f32x4){0.f, 0.f, 0.f, 0.f};
    const int kbeg = wave * 256;
#pragma unroll 2
    for (int k0 = kbeg; k0 < kbeg + 256; k0 += 4) {
        const f32x4 w0 = *(const f32x4*)(W + (size_t)(k0 + 0) * NMOD), w1 = *(const f32x4*)(W + (size_t)(k0 + 1) * NMOD), w2 = *(const f32x4*)(W + (size_t)(k0 + 2) * NMOD), w3 = *(const f32x4*)(W + (size_t)(k0 + 3) * NMOD);
#pragma unroll
        for (int b = 0; b < NSEQ; ++b) { const f32x4 c = *(const LAS f32x4*)(cact + b * DM + k0); acc[b] += w0 * c.x + w1 * c.y + w2 * c.z + w3 * c.w; }
    }
#pragma unroll
    for (int b = 0; b < NSEQ; ++b) *(LAS f32x4*)(red + (wave * NSEQ + b) * 256 + 4 * lane) = acc[b];
    __syncthreads();
    for (int o = tid; o < NSEQ * 256; o += NWAVES * 64) { const int b = o / 256, c = o % 256; float s = 0.f;
#pragma unroll
        for (int w = 0; w < 8; ++w) s += red[(w * NSEQ + b) * 256 + c];
        F.MOD[(size_t)(b * DEPTH + l) * NMOD + cb * 256 + c] = s + F.b_ada[(size_t)l * NMOD + cb * 256 + c]; }
    __syncthreads();
}
__device__ __forceinline__ void sincos_acc(float angf, float& sn, float& cs) {
    const double a = (double)angf;
    const double q = __builtin_rint(a * 0.63661977236758134308);
    double r = __builtin_fma(-q, 1.57079632679489655800, a); r = __builtin_fma(-q, 6.12323399573676603587e-17, r);
    const double r2 = r * r;
    double sp = 1.0 / 6227020800.0; sp = sp * r2 - 1.0 / 39916800.0; sp = sp * r2 + 1.0 / 362880.0; sp = sp * r2 - 1.0 / 5040.0; sp = sp * r2 + 1.0 / 120.0; sp = sp * r2 - 1.0 / 6.0; sp = sp * r2 * r + r;
    double cp = 1.0 / 479001600.0; cp = cp * r2 - 1.0 / 3628800.0; cp = cp * r2 + 1.0 / 40320.0; cp = cp * r2 - 1.0 / 720.0; cp = cp * r2 + 1.0 / 24.0; cp = cp * r2 - 0.5; cp = cp * r2 + 1.0;
    const int qi = ((int)q) & 3;
    const double s = (qi == 0) ? sp : (qi == 1) ? cp : (qi == 2) ? -sp : -cp;
    const double c = (qi == 0) ? cp : (qi == 1) ? -sp : (qi == 2) ? -cp : sp;
    sn = (float)s; cs = (float)c;
}
__device__ __forceinline__ void p0_prologue(Frame& F, int qslot) {
    PHASE_IDS();
    const int gt = F.wg * (NWAVES * 64) + tid, NGT = F.G * NWAVES * 64;
    for (int c = gt; c < 1024; c += NGT) {
        const float a0 = F.lb_logits[c], a1 = F.lb_logits[1024 + c], a2 = F.lb_logits[2048 + c], a3 = F.lb_logits[3072 + c];
        const float mx = fmaxf(fmaxf(a0, a1), fmaxf(a2, a3));
        const float e0 = expf(a0 - mx), e1 = expf(a1 - mx), e2 = expf(a2 - mx), e3 = expf(a3 - mx), inv = 1.0f / (e0 + e1 + e2 + e3);
        F.LB[c] = 0.f; F.LB[1024 + c] = e1 * inv; F.LB[2048 + c] = (e1 + e2) * inv; F.LB[3072 + c] = (e1 + e2 + e3) * inv;
    }
    for (int i = gt; i < SEQ * 128; i += NGT) {
        const int pos = i >> 7, j = i & 127;
        const float t = (float)j * (1.0f / 127.0f);
        const float invf = (float)(1.0 / exp((double)t * 9.21034037197618271));
        const float ang = (float)pos * invf;
        float sn, cs; sincos_acc(ang, sn, cs);
        F.RC[i] = cs; F.RS[i] = sn;
    }
    { const f32x4* s0 = (const f32x4*)F.x_prompt; const f32x4* s1 = (const f32x4*)F.x_sample; f32x4* d = (f32x4*)F.X;
      const int n0 = SEQ * DM / 4, n1 = DECB * DECS * DM / 4;
      for (int i = gt; i < n0; i += NGT) d[i] = s0[i];
      for (int i = gt; i < n1; i += NGT) d[n0 + i] = s1[i]; }
    for (int task = F.wg; task < DEPTH * 48; task += F.G) p0_mod_task(F, task);
    LAS float* scr = (LAS float*)(F.lds + wave * 16384);
    constexpr int I_IN = (DM / 64) * (NPROJ / 32), I_OUT = (DM / 64) * (DM / 32), I_UP = (DM / 64) * (DFF / 32), I_DN = (DFF / 64) * (DM / 32);
    constexpr int I_LAYER = I_IN + I_OUT + I_UP + I_DN, NITEMS = DEPTH * I_LAYER;
    for (;;) {
        int base = 0; if (lane == 0) base = (int)atomicAdd(F.ctl + CW_Q0 + 64 * qslot, 8u);
        base = __builtin_amdgcn_readfirstlane(base);
        if (base >= NITEMS) break;
        for (int it = base; it < base + 8 && it < NITEMS; ++it) {
            const int l = it / I_LAYER; int r = it % I_LAYER;
            if (r < I_IN) { p0_transpose_item(F.w_in + (size_t)l * DM * NPROJ, DM, NPROJ, F.Win_t + (size_t)l * NPROJ * DM, scr, r, lane); continue; } r -= I_IN;
            if (r < I_OUT) { p0_transpose_item(F.w_out + (size_t)l * DM * DM, DM, DM, F.Wout_t + (size_t)l * DM * DM, scr, r, lane); continue; } r -= I_OUT;
            if (r < I_UP) { p0_transpose_item(F.w_up + (size_t)l * DM * DFF, DM, DFF, F.Wup_t + (size_t)l * DFF * DM, scr, r, lane); continue; } r -= I_UP;
            p0_transpose_item(F.w_down + (size_t)l * DFF * DM, DFF, DM, F.Wdn_t + (size_t)l * DM * DFF, scr, r, lane);
        }
    }
}
template <bool FINAL>
__device__ __forceinline__ void norm_rows(Frame& F, const float* g, int l, int which_sh  , int nslab, int slab_l, int slab_which) {
    PHASE_IDS();
    const int gw = F.wg * NWAVES + wave, NGW = F.G * NWAVES;
    for (int m = gw; m < SEQ; m += NGW) {
        const f32x4* xr = (const f32x4*)(F.X + (size_t)m * DM) + lane;
        f32x4 v[8]; float ss = 0.f;
#pragma unroll
        for (int j = 0; j < 8; ++j) { v[j] = xr[64 * j]; ss += (v[j].x * v[j].x + v[j].y * v[j].y) + (v[j].z * v[j].z + v[j].w * v[j].w); }
        const float rstd = 1.0f / sqrtf(wave_sum(ss) * (1.0f / DM) + EPS);
        const f32x4* gp = (const f32x4*)g + lane;
        if (FINAL) { f32x4* o = (f32x4*)(F.out + (size_t)m * DM) + lane;
#pragma unroll
            for (int j = 0; j < 8; ++j) o[64 * j] = v[j] * rstd * gp[64 * j];
        } else {
            const float* mod = F.MOD + (size_t)l * NMOD;
            const f32x4* shp = (const f32x4*)(mod + which_sh * DM) + lane; const f32x4* scp = (const f32x4*)(mod + (which_sh + 1) * DM) + lane;
            v2u* o8 = (v2u*)(F.H + (size_t)m * DM) + lane;
#pragma unroll
            for (int j = 0; j < 8; ++j) { const f32x4 gg = gp[64 * j], sh = shp[64 * j], sc = scp[64 * j];
                const f32x4 h = v[j] * rstd * gg * (sc + 1.0f) + sh;
                v2u w; w.x = pk2(h.x, h.y); w.y = pk2(h.z, h.w); o8[64 * j] = w; }
        }
    }
    LAS float* red = (LAS float*)F.lds;
    for (int r = F.wg; r < DECB * DECS; r += F.G) {
        const int m = SEQ + r, idx = 64 * wave + lane, sq = 1 + (r >> 6);
        f32x4 v = *((const f32x4*)(F.X + (size_t)m * DM) + idx);
        if (nslab > 0) {
            const f32x4* sp = (const f32x4*)((const float*)(F.ws + WS_SLAB) + (size_t)r * DM) + idx;
            f32x4 a = (f32x4){0.f, 0.f, 0.f, 0.f};
            if (nslab == 16) {
#pragma unroll
                for (int s = 0; s < 16; ++s) a += sp[(size_t)s * (512 * DM / 4)];
            } else {
#pragma unroll
                for (int s = 0; s < 8; ++s) a += sp[(size_t)s * (512 * DM / 4)];
            }
            const f32x4 gv = *((const f32x4*)(F.MOD + (size_t)(sq * DEPTH + slab_l) * NMOD + slab_which * DM) + idx);
            v += gv * a;
            *((f32x4*)(F.X + (size_t)m * DM) + idx) = v;
        }
        const float ss = wave_sum((v.x * v.x + v.y * v.y) + (v.z * v.z + v.w * v.w));
        __syncthreads();
        if (lane == 0) red[wave] = ss;
        __syncthreads();
        float tot = 0.f;
#pragma unroll
        for (int w = 0; w < 8; ++w) tot += red[w];
        const float rstd = 1.0f / sqrtf(tot * (1.0f / DM) + EPS);
        const f32x4 gg = *((const f32x4*)g + idx);
        if (FINAL) { *((f32x4*)(F.out + (size_t)m * DM) + idx) = v * rstd * gg; }
        else {
            const float* mod = F.MOD + (size_t)(sq * DEPTH + l) * NMOD;
            const f32x4 sh = *((const f32x4*)(mod + which_sh * DM) + idx), sc = *((const f32x4*)(mod + (which_sh + 1) * DM) + idx);
            const f32x4 h = v * rstd * gg * (sc + 1.0f) + sh;
            v2u w; w.x = pk2(h.x, h.y); w.y = pk2(h.z, h.w); *((v2u*)(F.H + (size_t)m * DM) + idx) = w;
        }
    }
    __syncthreads();
}
constexpr int NSG = 40;
constexpr size_t WS_UA = WS_END;
constexpr size_t WS_DGA = WS_UA + 20 * MiB;
constexpr size_t WS_SSA = WS_DGA + 1 * MiB;
constexpr size_t WS_UB = WS_SSA + 20 * MiB;
constexpr size_t WS_SSB = WS_UB + 40 * MiB;
constexpr size_t WS_END2 = WS_SSB + 20 * MiB;

constexpr int MX_KHT = 0, MX_VT = 18432, MX_QT = 36864, MX_KT = 54272, MX_QH = 71680, MX_A = 89088, MX_EDEC = 98304, MX_RED = 98816, MX_B = 100864, MX_QTOT = 133632  ;
constexpr int RX_Q = 0, RX_K = 33792, RX_VT = 67584, RX_A = 104448, RX_RED = 113664;
constexpr float LOG2E = 1.4426950408889634f;

__device__ __forceinline__ bf16x8 ldfrag(LAS unsigned char* base, int ld_bytes, int row, int kbyte) { return *(const LAS bf16x8*)(base + row * ld_bytes + kbyte); }
__device__ __forceinline__ int tr_off(int row, int tokpair) { return row * 144 + ((((tokpair >> 2) ^ (row >> 3)) & 7) << 4) + ((tokpair & 3) << 2); }
__device__ __forceinline__ bf16x8 tr_frag(LAS unsigned char* base, int row, int chunk) { return *(const LAS bf16x8*)(base + row * 144 + (((chunk ^ (row >> 3)) & 7) << 4)); }
__device__ __forceinline__ float gamma_log2(int h) { return log2f(1.0f - exp2f(-5.0f - (float)h)); }
__device__ __forceinline__ int sg_row0(int sg) { return sg < 32 ? sg * 256 : SEQ + 64 * (sg - 32); }
__device__ __forceinline__ int sg_nch(int sg) { return sg < 32 ? 4 : 1; }

template <bool IS_RET>
__device__ __forceinline__ void p1_unit(Frame& F, int l, int sg, int h, int quad) {
    PHASE_IDS();
    const int g4 = lane >> 4, l16 = lane & 15;
    const int row0 = sg_row0(sg), nch = sg_nch(sg);
    const int kb = quad >> 1, vb = quad & 1;
    const int ck = IS_RET ? 5120 + h * 256 + 128 * kb : 1024 + h * 128;
    const int cv = IS_RET ? 6144 + h * 256 + 128 * vb : 2048 + h * 128;
    LAS unsigned char* L = F.lds;
    LAS float* Bs = (LAS float*)(L + MX_B); LAS float* Qtot = (LAS float*)(L + MX_QTOT); LAS float* Edec = (LAS float*)(L + MX_EDEC);
    const float lg2 = gamma_log2(h);
    f32x4 S[8];
#pragma unroll
    for (int kt = 0; kt < 8; ++kt) S[kt] = (f32x4){0.f, 0.f, 0.f, 0.f};
    float sumb = 0.f;
    for (int c = 0; c < nch; ++c) {
        const int rowc = row0 + 64 * c;
        if (!IS_RET) {
            const int k = tid & 127, tq = tid >> 7;
            float* lfp = F.LF + (size_t)(rowc + 16 * tq) * 1024 + h * 128 + k;
            float pv[16];
#pragma unroll
            for (int i = 0; i < 16; ++i) pv[i] = lfp[(size_t)i * 1024];
#pragma unroll
            for (int i = 1; i < 16; ++i) pv[i] += pv[i - 1];
            Qtot[tq * 128 + k] = pv[15];
            __syncthreads();
            float off = 0.f;
#pragma unroll
            for (int q = 0; q < 3; ++q) off += (q < tq) ? Qtot[q * 128 + k] : 0.f;
#pragma unroll
            for (int i = 0; i < 16; ++i) { const float b = pv[i] + off; lfp[(size_t)i * 1024] = b; Bs[(16 * tq + i) * 128 + k] = b; }
            __syncthreads();
            if (tid < 128) sumb += Bs[63 * 128 + tid];
        }
        {
            const int tp = tid >> 4, kc = tid & 15, ra = rowc + 2 * tp;
            const v4u ka = *(const v4u*)(F.P + (size_t)ra * 8192 + ck + 8 * kc), kbv = *(const v4u*)(F.P + (size_t)(ra + 1) * 8192 + ck + 8 * kc);
            const v4u va = *(const v4u*)(F.P + (size_t)ra * 8192 + cv + 8 * kc), vbv = *(const v4u*)(F.P + (size_t)(ra + 1) * 8192 + cv + 8 * kc);
            float fa[8], fb[8];
            if (IS_RET) {
                const float za = exp2f(lg2 * (float)(63 - 2 * tp)), zb = exp2f(lg2 * (float)(62 - 2 * tp));
#pragma unroll
                for (int i = 0; i < 8; ++i) { fa[i] = za; fb[i] = zb; }
                if (tid < 128) Edec[tid] = exp2f(lg2 * 64.0f);
            } else {
#pragma unroll
                for (int i = 0; i < 8; ++i) { const float bt = Bs[63 * 128 + 8 * kc + i]; fa[i] = exp2f((bt - Bs[(2 * tp) * 128 + 8 * kc + i]) * LOG2E); fb[i] = exp2f((bt - Bs[(2 * tp + 1) * 128 + 8 * kc + i]) * LOG2E);
                    if (tp == 0) Edec[8 * kc + i] = exp2f(bt * LOG2E); }
            }
#pragma unroll
            for (int i = 0; i < 8; ++i) {
                const unsigned wa = ka[i >> 1], wb = kbv[i >> 1];
                const float xa = (i & 1) ? bfhi(wa) : bflo(wa), xb = (i & 1) ? bfhi(wb) : bflo(wb);
                *(LAS unsigned*)(L + MX_KHT + tr_off(8 * kc + i, tp)) = pk2(xa * fa[i], xb * fb[i]);
                const unsigned ua = va[i >> 1], ub = vbv[i >> 1];
                const unsigned lo = (i & 1) ? (ua >> 16) : (ua & 0xffffu), hi = (i & 1) ? (ub >> 16) : (ub & 0xffffu);
                *(LAS unsigned*)(L + MX_VT + tr_off(8 * kc + i, tp)) = lo | (hi << 16);
            }
        }
        __syncthreads();
        {
            bf16x8 Y[2];
#pragma unroll
            for (int ss = 0; ss < 2; ++ss) Y[ss] = tr_frag(L + MX_VT, 16 * wave + l16, 4 * ss + g4);
#pragma unroll
            for (int kt = 0; kt < 8; ++kt) {
                const f32x4 d = *(const LAS f32x4*)(Edec + 16 * kt + 4 * g4);
                S[kt] = S[kt] * d;
#pragma unroll
                for (int ss = 0; ss < 2; ++ss) { const bf16x8 X = tr_frag(L + MX_KHT, 16 * kt + l16, 4 * ss + g4); S[kt] = __builtin_amdgcn_mfma_f32_16x16x32_bf16(X, Y[ss], S[kt], 0, 0, 0); }
            }
        }
        __syncthreads();
    }
    if (IS_RET) {
        float* U = (float*)(F.ws + WS_UB) + ((size_t)(sg * HB + h) * 256 + 128 * vb + 16 * wave + l16) * 256 + 128 * kb + 4 * g4;
#pragma unroll
        for (int kt = 0; kt < 8; ++kt) *(f32x4*)(U + 16 * kt) = S[kt];
    } else {
        float* U = (float*)(F.ws + WS_UA) + ((size_t)(sg * HA + h) * 128 + 16 * wave + l16) * 128 + 4 * g4;
#pragma unroll
        for (int kt = 0; kt < 8; ++kt) *(f32x4*)(U + 16 * kt) = S[kt];
        if (tid < 128) ((float*)(F.ws + WS_DGA))[(size_t)(sg * HA + h) * 128 + tid] = exp2f(sumb * LOG2E);
    }
    __syncthreads();
}
__device__ __forceinline__ void mix1_phase(Frame& F, int l) {
    for (int u = F.wg; u < 960; u += F.G) {
        bool is_ret; int sg, h, quad = 0;
        if (u < 256) { is_ret = false; sg = u >> 3; h = u & 7; }
        else if (u < 768) { const int r = u - 256; is_ret = true; sg = r >> 4; h = (r >> 2) & 3; quad = r & 3; }
        else if (u < 832) { const int r = u - 768; is_ret = false; sg = 32 + (r >> 3); h = r & 7; }
        else { const int r = u - 832; is_ret = true; sg = 32 + (r >> 4); h = (r >> 2) & 3; quad = r & 3; }
        if (is_ret) p1_unit<true>(F, l, sg, h, quad); else p1_unit<false>(F, l, sg, h, quad);
    }
}

__device__ __forceinline__ void mix2_phase(Frame& F, int l) {
    PHASE_IDS();
    const int gt = F.wg * (NWAVES * 64) + tid, NGT = F.G * NWAVES * 64;
    constexpr int IA = 128 * 32, IB = 256 * 64, PER_SEQ = HA * IA + HB * IB;
    for (int it = gt; it < NSEQ * PER_SEQ; it += NGT) {
        const int seq = it / PER_SEQ; int r = it % PER_SEQ;
        const int ng = seq == 0 ? 32 : 1, sg0 = seq == 0 ? 0 : 31 + seq;
        if (r < HA * IA) {
            const int h = r / IA, v = (r % IA) >> 5, k4 = r & 31;
            f32x4 s = (f32x4){0.f, 0.f, 0.f, 0.f};
            if (seq > 0) { const float* s0 = F.state_hgrn + ((size_t)((l * DECB + (seq - 1)) * HA + h) * 128) * 128;
#pragma unroll
                for (int e = 0; e < 4; ++e) s[e] = s0[(size_t)(4 * k4 + e) * 128 + v]; }
            for (int g = 0; g < ng; ++g) {
                const size_t ub = (size_t)((sg0 + g) * HA + h);
                *(f32x4*)((float*)(F.ws + WS_SSA) + (ub * 128 + v) * 128 + 4 * k4) = s;
                const f32x4 u = *(const f32x4*)((const float*)(F.ws + WS_UA) + (ub * 128 + v) * 128 + 4 * k4);
                const f32x4 d = *(const f32x4*)((const float*)(F.ws + WS_DGA) + ub * 128 + 4 * k4);
                s = d * s + u;
            }
            float* dst = F.out + (seq == 0 ? OFF_SA_P + ((size_t)(l * HA + h) * 128) * 128 : OFF_SA_S + ((size_t)((l * DECB + (seq - 1)) * HA + h) * 128) * 128);
#pragma unroll
            for (int e = 0; e < 4; ++e) dst[(size_t)(4 * k4 + e) * 128 + v] = s[e];
        } else {
            r -= HA * IA;
            const int h = r / IB, v = (r % IB) >> 6, k4 = r & 63;
            const float lg2 = gamma_log2(h); const float gd = exp2f(lg2 * (seq == 0 ? 256.0f : 64.0f));
            f32x4 s = (f32x4){0.f, 0.f, 0.f, 0.f};
            if (seq > 0) { const float* s0 = F.state_ret + ((size_t)((l * DECB + (seq - 1)) * HB + h) * 256) * 256;
#pragma unroll
                for (int e = 0; e < 4; ++e) s[e] = s0[(size_t)(4 * k4 + e) * 256 + v]; }
            for (int g = 0; g < ng; ++g) {
                const size_t ub = (size_t)((sg0 + g) * HB + h);
                v2u w; w.x = pk2(s[0], s[1]); w.y = pk2(s[2], s[3]);
                *(v2u*)((bf16*)(F.ws + WS_SSB) + (ub * 256 + v) * 256 + 4 * k4) = w;
                const f32x4 u = *(const f32x4*)((const float*)(F.ws + WS_UB) + (ub * 256 + v) * 256 + 4 * k4);
                s = s * gd + u;
            }
            float* dst = F.out + (seq == 0 ? OFF_SB_P + ((size_t)(l * HB + h) * 256) * 256 : OFF_SB_S + ((size_t)((l * DECB + (seq - 1)) * HB + h) * 256) * 256);
#pragma unroll
            for (int e = 0; e < 4; ++e) dst[(size_t)(4 * k4 + e) * 256 + v] = s[e];
        }
    }
}
typedef short bf16x4 __attribute__((ext_vector_type(4)));
__device__ __forceinline__ float clampf(float x, float lo, float hi) { return fminf(fmaxf(x, lo), hi); }
__device__ __forceinline__ void p3_hgrn_unit(Frame& F, int l, int sg, int h) {
    PHASE_IDS();
    const int g4 = lane >> 4, l16 = lane & 15;
    const int row0 = sg_row0(sg), nch = sg_nch(sg);
    LAS unsigned char* L = F.lds;
    LAS float* Edec = (LAS float*)(L + MX_EDEC); LAS float* Red = (LAS float*)(L + MX_RED);
    f32x4 S[8];
    { const float* ss = (const float*)(F.ws + WS_SSA) + ((size_t)(sg * HA + h) * 128 + 16 * wave + l16) * 128 + 4 * g4;
#pragma unroll
      for (int kt = 0; kt < 8; ++kt) S[kt] = *(const f32x4*)(ss + 16 * kt); }
    const f32x4 gn4 = *(const f32x4*)(F.hgrn_g + l * 1024 + h * 128 + 16 * wave + 4 * g4);
    for (int c = 0; c < nch; ++c) {
        const int rowc = row0 + 64 * c;
        {
            const int tp = tid >> 4, kc = tid & 15, ra = rowc + 2 * tp;
            const bf16* pa = F.P + (size_t)ra * 8192 + h * 128 + 8 * kc; const bf16* pb = pa + 8192;
            const v4u qa = *(const v4u*)pa, qb = *(const v4u*)pb, ka = *(const v4u*)(pa + 1024), kb = *(const v4u*)(pb + 1024), va = *(const v4u*)(pa + 2048), vb = *(const v4u*)(pb + 2048);
            const float* la = F.LF + (size_t)ra * 1024 + h * 128 + 8 * kc;
            const float* lr = F.LF + (size_t)(rowc + 31) * 1024 + h * 128 + 8 * kc; const float* lt = F.LF + (size_t)(rowc + 63) * 1024 + h * 128 + 8 * kc;
            const f32x4 ba0 = *(const f32x4*)la, ba1 = *(const f32x4*)(la + 4), bb0 = *(const f32x4*)(la + 1024), bb1 = *(const f32x4*)(la + 1028);
            const f32x4 br0 = *(const f32x4*)lr, br1 = *(const f32x4*)(lr + 4), bt0 = *(const f32x4*)lt, bt1 = *(const f32x4*)(lt + 4);
            unsigned qta[4], qtb[4], kta[4], ktb[4], qha[4], qhb[4];
            float pqa = 0.f, pqb = 0.f, pka = 0.f, pkb = 0.f, pha = 0.f, phb = 0.f;
#pragma unroll
            for (int i = 0; i < 8; ++i) {
                const float bref = (i < 4) ? br0[i & 3] : br1[i & 3], btot = (i < 4) ? bt0[i & 3] : bt1[i & 3];
                const float ba = (i < 4) ? ba0[i & 3] : ba1[i & 3], bb = (i < 4) ? bb0[i & 3] : bb1[i & 3];
                const float e1a = exp2f(clampf((ba - bref) * LOG2E, -115.f, 115.f)), e1b = exp2f(clampf((bb - bref) * LOG2E, -115.f, 115.f));
                const float e2a = __builtin_amdgcn_rcpf(e1a), e2b = __builtin_amdgcn_rcpf(e1b);
                const float eref = exp2f(bref * LOG2E), etr = exp2f((btot - bref) * LOG2E);
                const unsigned wqa = qa[i >> 1], wqb = qb[i >> 1], wka = ka[i >> 1], wkb = kb[i >> 1];
                const float xqa = (i & 1) ? bfhi(wqa) : bflo(wqa), xqb = (i & 1) ? bfhi(wqb) : bflo(wqb), xka = (i & 1) ? bfhi(wka) : bflo(wka), xkb = (i & 1) ? bfhi(wkb) : bflo(wkb);
                const float tqa = xqa * e1a, tqb = xqb * e1b, tka = xka * e2a, tkb = xkb * e2b;
                const float hqa = tqa * eref, hqb = tqb * eref;
                *(LAS unsigned*)(L + MX_KHT + tr_off(8 * kc + i, tp)) = pk2(tka * etr, tkb * etr);
                const unsigned ua = va[i >> 1], ub = vb[i >> 1];
                const unsigned lo = (i & 1) ? (ua >> 16) : (ua & 0xffffu), hi = (i & 1) ? (ub >> 16) : (ub & 0xffffu);
                *(LAS unsigned*)(L + MX_VT + tr_off(8 * kc + i, tp)) = lo | (hi << 16);
                if (tp == 0) Edec[8 * kc + i] = exp2f(btot * LOG2E);
                if (i & 1) { qta[i >> 1] = pk2(pqa, tqa); qtb[i >> 1] = pk2(pqb, tqb); kta[i >> 1] = pk2(pka, tka); ktb[i >> 1] = pk2(pkb, tkb); qha[i >> 1] = pk2(pha, hqa); qhb[i >> 1] = pk2(phb, hqb); }
                else { pqa = tqa; pqb = tqb; pka = tka; pkb = tkb; pha = hqa; phb = hqb; }
            }
            const int oa = (2 * tp) * 272 + 16 * kc, ob = oa + 272;
            *(LAS v4u*)(L + MX_QT + oa) = (v4u){qta[0], qta[1], qta[2], qta[3]}; *(LAS v4u*)(L + MX_QT + ob) = (v4u){qtb[0], qtb[1], qtb[2], qtb[3]};
            *(LAS v4u*)(L + MX_KT + oa) = (v4u){kta[0], kta[1], kta[2], kta[3]}; *(LAS v4u*)(L + MX_KT + ob) = (v4u){ktb[0], ktb[1], ktb[2], ktb[3]};
            *(LAS v4u*)(L + MX_QH + oa) = (v4u){qha[0], qha[1], qha[2], qha[3]}; *(LAS v4u*)(L + MX_QH + ob) = (v4u){qhb[0], qhb[1], qhb[2], qhb[3]};
        }
        __syncthreads();
        {
            const int jt = wave >> 1;
#pragma unroll
            for (int ii = 0; ii < 2; ++ii) {
                const int it = 2 * (wave & 1) + ii;
                f32x4 a = (f32x4){0.f, 0.f, 0.f, 0.f};
                if (it <= jt) {
#pragma unroll
                    for (int kk = 0; kk < 4; ++kk) a = __builtin_amdgcn_mfma_f32_16x16x32_bf16(ldfrag(L + MX_KT, 272, 16 * it + l16, 64 * kk + 16 * g4), ldfrag(L + MX_QT, 272, 16 * jt + l16, 64 * kk + 16 * g4), a, 0, 0, 0);
                }
                const int t = 16 * jt + l16, s0 = 16 * it + 4 * g4;
                v2u w; w.x = pk2(s0 <= t ? a[0] : 0.f, s0 + 1 <= t ? a[1] : 0.f); w.y = pk2(s0 + 2 <= t ? a[2] : 0.f, s0 + 3 <= t ? a[3] : 0.f);
                if (it > jt) { w.x = 0u; w.y = 0u; }
                *(LAS v2u*)(L + MX_A + t * 144 + s0 * 2) = w;
            }
        }
        f32x4 o[4];
#pragma unroll
        for (int j = 0; j < 4; ++j) o[j] = (f32x4){0.f, 0.f, 0.f, 0.f};
#pragma unroll
        for (int kk = 0; kk < 4; ++kk) {
            const f32x4 s0 = S[2 * kk], s1 = S[2 * kk + 1];
            const v4u xw = (v4u){pk2(s0[0], s0[1]), pk2(s0[2], s0[3]), pk2(s1[0], s1[1]), pk2(s1[2], s1[3])};
            const bf16x8 X = __builtin_bit_cast(bf16x8, xw);
#pragma unroll
            for (int j = 0; j < 4; ++j) {
                const LAS unsigned char* qp = L + MX_QH + (16 * j + l16) * 272 + 64 * kk + 8 * g4;
                const bf16x4 y0 = *(const LAS bf16x4*)qp, y1 = *(const LAS bf16x4*)(qp + 32);
                const bf16x8 Y = __builtin_shufflevector(y0, y1, 0, 1, 2, 3, 4, 5, 6, 7);
                o[j] = __builtin_amdgcn_mfma_f32_16x16x32_bf16(X, Y, o[j], 0, 0, 0);
            }
        }
        __syncthreads();
        {
            bf16x8 Yv[2];
#pragma unroll
            for (int ss = 0; ss < 2; ++ss) Yv[ss] = tr_frag(L + MX_VT, 16 * wave + l16, 4 * ss + g4);
#pragma unroll
            for (int ss = 0; ss < 2; ++ss)
#pragma unroll
                for (int j = 0; j < 4; ++j) { if (ss == 1 && j < 2) continue;
                    o[j] = __builtin_amdgcn_mfma_f32_16x16x32_bf16(Yv[ss], ldfrag(L + MX_A, 144, 16 * j + l16, 64 * ss + 16 * g4), o[j], 0, 0, 0); }
            if (c + 1 < nch) {
#pragma unroll
                for (int kt = 0; kt < 8; ++kt) {
                    S[kt] = S[kt] * *(const LAS f32x4*)(Edec + 16 * kt + 4 * g4);
#pragma unroll
                    for (int ss = 0; ss < 2; ++ss) S[kt] = __builtin_amdgcn_mfma_f32_16x16x32_bf16(tr_frag(L + MX_KHT, 16 * kt + l16, 4 * ss + g4), Yv[ss], S[kt], 0, 0, 0);
                }
            }
        }
#pragma unroll
        for (int j = 0; j < 4; ++j) { float q = (o[j][0] * o[j][0] + o[j][1] * o[j][1]) + (o[j][2] * o[j][2] + o[j][3] * o[j][3]); q += __shfl_xor(q, 16); q += __shfl_xor(q, 32); if (g4 == 0) Red[wave * 64 + 16 * j + l16] = q; }
        __syncthreads();
#pragma unroll
        for (int j = 0; j < 4; ++j) {
            float tot = 0.f;
#pragma unroll
            for (int w = 0; w < 8; ++w) tot += Red[w * 64 + 16 * j + l16];
            const float rstd = 1.0f / sqrtf(tot * (1.0f / 128.0f) + EPS);
            const size_t row = rowc + 16 * j + l16;
            const v2u gw = *(const v2u*)(F.P + row * 8192 + 3072 + h * 128 + 16 * wave + 4 * g4);
            const f32x4 r = o[j] * rstd * gn4;
            v2u w; w.x = pk2(r[0] * bflo(gw.x), r[1] * bfhi(gw.x)); w.y = pk2(r[2] * bflo(gw.y), r[3] * bfhi(gw.y));
            *(v2u*)(F.O + row * 2048 + h * 128 + 16 * wave + 4 * g4) = w;
        }
        __syncthreads();
    }
}
__device__ __forceinline__ void p3_ret_unit(Frame& F, int l, int sg, int jc, int h) {
    PHASE_IDS();
    const int g4 = lane >> 4, l16 = lane & 15;
    const int rowg = sg_row0(sg), rowq = rowg + 64 * jc;
    LAS unsigned char* L = F.lds;
    LAS float* Red = (LAS float*)(L + RX_RED);
    const float lg2 = gamma_log2(h);
    const int tp = tid >> 4, kc = tid & 15;
    {
        const bf16* pa = F.P + (size_t)(rowq + 2 * tp) * 8192 + 4096 + h * 256 + 8 * kc; const bf16* pb = pa + 8192;
        const v4u a0 = *(const v4u*)pa, a1 = *(const v4u*)(pa + 128), b0 = *(const v4u*)pb, b1 = *(const v4u*)(pb + 128);
        const int oa = (2 * tp) * 528 + 16 * kc;
        *(LAS v4u*)(L + RX_Q + oa) = a0; *(LAS v4u*)(L + RX_Q + oa + 256) = a1; *(LAS v4u*)(L + RX_Q + oa + 528) = b0; *(LAS v4u*)(L + RX_Q + oa + 528 + 256) = b1;
    }
    f32x4 acc[2][4];
#pragma unroll
    for (int vt = 0; vt < 2; ++vt)
#pragma unroll
        for (int j = 0; j < 4; ++j) acc[vt][j] = (f32x4){0.f, 0.f, 0.f, 0.f};
    __syncthreads();
    {
        const bf16* sp = (const bf16*)(F.ws + WS_SSB) + ((size_t)(sg * HB + h) * 256 + 32 * wave + l16) * 256 + 8 * g4;
#pragma unroll
        for (int vt = 0; vt < 2; ++vt) {
            bf16x8 X[8];
#pragma unroll
            for (int kk = 0; kk < 8; ++kk) X[kk] = *(const bf16x8*)(sp + (size_t)vt * 16 * 256 + 32 * kk);
#pragma unroll
            for (int kk = 0; kk < 8; ++kk)
#pragma unroll
                for (int j = 0; j < 4; ++j) acc[vt][j] = __builtin_amdgcn_mfma_f32_16x16x32_bf16(X[kk], ldfrag(L + RX_Q, 528, 16 * j + l16, 64 * kk + 16 * g4), acc[vt][j], 0, 0, 0);
        }
#pragma unroll
        for (int j = 0; j < 4; ++j) { const float xi = exp2f(lg2 * (float)(64 * jc + 16 * j + l16 + 1)); acc[0][j] = acc[0][j] * xi; acc[1][j] = acc[1][j] * xi; }
    }
    for (int jp = 0; jp <= jc; ++jp) {
        __syncthreads();
        {
            const bf16* pa = F.P + (size_t)(rowg + 64 * jp + 2 * tp) * 8192 + 5120 + h * 256 + 8 * kc; const bf16* pb = pa + 8192;
            const v4u a0 = *(const v4u*)pa, a1 = *(const v4u*)(pa + 128), b0 = *(const v4u*)pb, b1 = *(const v4u*)(pb + 128);
            const v4u va0 = *(const v4u*)(pa + 1024), va1 = *(const v4u*)(pa + 1024 + 128), vb0 = *(const v4u*)(pb + 1024), vb1 = *(const v4u*)(pb + 1024 + 128);
            const int oa = (2 * tp) * 528 + 16 * kc;
            *(LAS v4u*)(L + RX_K + oa) = a0; *(LAS v4u*)(L + RX_K + oa + 256) = a1; *(LAS v4u*)(L + RX_K + oa + 528) = b0; *(LAS v4u*)(L + RX_K + oa + 528 + 256) = b1;
#pragma unroll
            for (int i = 0; i < 8; ++i) {
                { const unsigned ua = va0[i >> 1], ub = vb0[i >> 1]; const unsigned lo = (i & 1) ? (ua >> 16) : (ua & 0xffffu), hi = (i & 1) ? (ub >> 16) : (ub & 0xffffu);
                  *(LAS unsigned*)(L + RX_VT + tr_off(8 * kc + i, tp)) = lo | (hi << 16); }
                { const unsigned ua = va1[i >> 1], ub = vb1[i >> 1]; const unsigned lo = (i & 1) ? (ua >> 16) : (ua & 0xffffu), hi = (i & 1) ? (ub >> 16) : (ub & 0xffffu);
                  *(LAS unsigned*)(L + RX_VT + tr_off(128 + 8 * kc + i, tp)) = lo | (hi << 16); }
            }
        }
        __syncthreads();
        {
            const int jt = wave >> 1; const bool diag = (jp == jc);
#pragma unroll
            for (int ii = 0; ii < 2; ++ii) {
                const int it = 2 * (wave & 1) + ii;
                f32x4 a = (f32x4){0.f, 0.f, 0.f, 0.f};
                const bool live = !(diag && it > jt);
                if (live) {
#pragma unroll
                    for (int kk = 0; kk < 8; ++kk) a = __builtin_amdgcn_mfma_f32_16x16x32_bf16(ldfrag(L + RX_K, 528, 16 * it + l16, 64 * kk + 16 * g4), ldfrag(L + RX_Q, 528, 16 * jt + l16, 64 * kk + 16 * g4), a, 0, 0, 0);
                }
                const int t = 16 * jt + l16, s0 = 16 * it + 4 * g4; const int dd = 64 * (jc - jp) + t - s0;
                float e[4];
#pragma unroll
                for (int r = 0; r < 4; ++r) { const float dec = exp2f(lg2 * (float)(dd - r)); e[r] = (!diag || s0 + r <= t) ? a[r] * dec : 0.f; }
                v2u w; w.x = pk2(e[0], e[1]); w.y = pk2(e[2], e[3]);
                if (!live) { w.x = 0u; w.y = 0u; }
                *(LAS v2u*)(L + RX_A + t * 144 + s0 * 2) = w;
            }
        }
        __syncthreads();
#pragma unroll
        for (int ss = 0; ss < 2; ++ss)
#pragma unroll
            for (int vt = 0; vt < 2; ++vt) { const bf16x8 X = tr_frag(L + RX_VT, 32 * wave + 16 * vt + l16, 4 * ss + g4);
#pragma unroll
                for (int j = 0; j < 4; ++j) acc[vt][j] = __builtin_amdgcn_mfma_f32_16x16x32_bf16(X, ldfrag(L + RX_A, 144, 16 * j + l16, 64 * ss + 16 * g4), acc[vt][j], 0, 0, 0); }
    }
#pragma unroll
    for (int j = 0; j < 4; ++j) { float q = 0.f;
#pragma unroll
        for (int vt = 0; vt < 2; ++vt) q += (acc[vt][j][0] * acc[vt][j][0] + acc[vt][j][1] * acc[vt][j][1]) + (acc[vt][j][2] * acc[vt][j][2] + acc[vt][j][3] * acc[vt][j][3]);
        q += __shfl_xor(q, 16); q += __shfl_xor(q, 32); if (g4 == 0) Red[wave * 64 + 16 * j + l16] = q; }
    __syncthreads();
#pragma unroll
    for (int j = 0; j < 4; ++j) {
        float tot = 0.f;
#pragma unroll
        for (int w = 0; w < 8; ++w) tot += Red[w * 64 + 16 * j + l16];
        const float rstd = 1.0f / sqrtf(tot * (1.0f / 256.0f) + EPS);
        const size_t row = rowq + 16 * j + l16;
#pragma unroll
        for (int vt = 0; vt < 2; ++vt) {
            const int vc = h * 256 + 32 * wave + 16 * vt + 4 * g4;
            const v2u gw = *(const v2u*)(F.P + row * 8192 + 7168 + vc);
            const f32x4 r = acc[vt][j] * rstd * *(const f32x4*)(F.ret_g + l * 1024 + vc);
            v2u w; w.x = pk2(r[0] * bflo(gw.x), r[1] * bfhi(gw.x)); w.y = pk2(r[2] * bflo(gw.y), r[3] * bfhi(gw.y));
            *(v2u*)(F.O + row * 2048 + 1024 + vc) = w;
        }
    }
    __syncthreads();
}
__device__ __forceinline__ void mix3_phase(Frame& F, int l) {
    for (int vw = F.wg; vw < 256; vw += F.G) {
        for (int q = 0; q < 2; ++q) {
            if (q == 1 && vw >= 64) break;
            const int sg = q == 0 ? (vw >> 3) : 32 + (vw >> 3);
            p3_hgrn_unit(F, l, sg, vw & 7);
        }
        for (int q = 0; q < 3; ++q) {
            int sg, jc, h;
            if (q < 2) { h = vw & 3; sg = (vw >> 2) & 31; const int half = vw >> 7; jc = q == 0 ? (half ? 2 : 3) : (half ? 1 : 0); }
            else { if (vw < 64 || vw >= 96) break; sg = 32 + ((vw - 64) >> 2); jc = 0; h = (vw - 64) & 3; }
            p3_ret_unit(F, l, sg, jc, h);
        }
    }
}
constexpr int PH_PRO = 0, PH_PER_LAYER = 9, PH_FINAL = 1 + DEPTH * PH_PER_LAYER, N_PHASES = PH_FINAL + 1;
struct Args { const float* in[18]; float* out; unsigned char* ws; int ph_lo, ph_hi; };
__global__ void __launch_bounds__(NWAVES * 64, 2) fwd(Args args) {
    extern __shared__ __attribute__((aligned(16))) unsigned char lds[];
    Frame F;
    F.lds = (LAS unsigned char*)lds;
    F.G = gridDim.x; F.wg = blockIdx.x;
    unsigned char* ws = args.ws;
    F.ctl = (unsigned*)(ws + WS_CTL); F.ws = ws;
    F.x_prompt = args.in[0]; F.x_sample = args.in[1]; F.state_hgrn = args.in[2]; F.state_ret = args.in[3]; F.c_prompt = args.in[4]; F.c_sample = args.in[5];
    F.lb_logits = args.in[6]; F.w_ada = args.in[7]; F.b_ada = args.in[8]; F.norm1_g = args.in[9]; F.norm2_g = args.in[10]; F.w_in = args.in[11];
    F.hgrn_g = args.in[12]; F.ret_g = args.in[13]; F.w_out = args.in[14]; F.w_up = args.in[15]; F.w_down = args.in[16]; F.final_g = args.in[17];
    F.out = args.out;
    F.Win_t = (bf16*)(ws + WS_WIN); F.Wout_t = (bf16*)(ws + WS_WOUT); F.Wup_t = (bf16*)(ws + WS_WUP); F.Wdn_t = (bf16*)(ws + WS_WDN);
    F.X = (float*)(ws + WS_X); F.H = (bf16*)(ws + WS_H); F.P = (bf16*)(ws + WS_P); F.LF = (float*)(ws + WS_LF); F.O = (bf16*)(ws + WS_O); F.U = (bf16*)(ws + WS_U);
    F.MOD = (float*)(ws + WS_MOD); F.LB = (float*)(ws + WS_LB); F.RC = (float*)(ws + WS_ROPE); F.RS = F.RC + SEQ * 128;
    volatile LAS unsigned* MISC = (volatile LAS unsigned*)(F.lds + MISC_OFF);
    if (threadIdx.x < 64) MISC[threadIdx.x] = 0u;
    __syncthreads();
    const int lo = args.ph_lo, hi = args.ph_hi;
    XcdBarrier bar; bar.bar = F.ctl + CW_BAR; bar.x = 0; bar.st = MISC + 8;
    if (hi - lo > 1) bar = xcd_barrier_post(F.ctl + CW_BAR, MISC + 8);
#define IN(k) (lo <= (k) && (k) < hi)
#define SEAM(k) do { if (IN(k) && IN((k) + 1)) xcd_barrier(bar); } while (0)

    if (IN(PH_PRO)) {
#ifndef SKIP_PRO
 p0_prologue(F, 0);
#endif
#ifdef PROBE_PRO
 __syncthreads(); p0_prologue(F, 1);
#endif
 } SEAM(PH_PRO);
    for (int l = 0; l < DEPTH; ++l) {
        const int pb = 1 + l * PH_PER_LAYER;
        if (IN(pb + 0)) {
#ifndef SKIP_NORM
 norm_rows<false>(F, F.norm1_g + l * DM, l, 0, l > 0 ? 16 : 0, l - 1, 5);
#endif
 } SEAM(pb + 0);
        if (IN(pb + 1)) {
            pg8::Gemm g{F.H, F.Win_t + (size_t)l * NPROJ * DM, M, NPROJ, DM};
            pg8::EpiInProj E{F.P, F.LF, F.LB + l * 1024, F.RC, F.RS};
            { pg8::StaticOrder S; S.init(SEQ, NPROJ, DM, F.G, F.wg); pg8::gemm_phase<pg8::EpiInProj, pg8::StaticOrder, true, true, 0>(F.lds + RING_OFF, g, S, E); }
            { pg8::QuarterOrder S; S.init(NPROJ, DM, F.G, F.wg); pg8::gemm_phase<pg8::EpiInProj, pg8::QuarterOrder, true, true, 1>(F.lds + RING_OFF, g, S, E); }
        } SEAM(pb + 1);
        if (IN(pb + 2)) { mix1_phase(F, l); } SEAM(pb + 2);
        if (IN(pb + 3)) { mix2_phase(F, l); } SEAM(pb + 3);
#ifdef PROBE_MIX2
        mix2_phase(F, l); xcd_barrier(bar);
#endif
        if (IN(pb + 4)) { mix3_phase(F, l); } SEAM(pb + 4);
#ifdef PROBE_MIX3
        mix3_phase(F, l); xcd_barrier(bar);
#endif
        if (IN(pb + 5)) {
            pg8::Gemm g{F.O, F.Wout_t + (size_t)l * DM * DM, M, DM, DM}; pg8::ResidOrder S; S.init(DM, 8, F.G, F.wg);
            pg8::EpiResid E{F.X, F.MOD + (size_t)l * NMOD + 2 * DM, (float*)(F.ws + WS_SLAB)};
#ifndef SKIP_G2
            pg8::gemm_phase<pg8::EpiResid, pg8::ResidOrder, true, true>(F.lds + RING_OFF, g, S, E);
#endif
        } SEAM(pb + 5);
        if (IN(pb + 6)) {
#ifndef SKIP_NORM
 norm_rows<false>(F, F.norm2_g + l * DM, l, 3, 8, l, 2);
#endif
 } SEAM(pb + 6);
        if (IN(pb + 7)) {
            pg8::Gemm g{F.H, F.Wup_t + (size_t)l * DFF * DM, M, DFF, DM};
            pg8::EpiRelu2 E{F.U, DFF};
            { pg8::StaticOrder S; S.init(SEQ, DFF, DM, F.G, F.wg); pg8::gemm_phase<pg8::EpiRelu2, pg8::StaticOrder, true, true, 0>(F.lds + RING_OFF, g, S, E); }
            { pg8::QuarterOrder S; S.init(DFF, DM, F.G, F.wg); pg8::gemm_phase<pg8::EpiRelu2, pg8::QuarterOrder, true, true, 1>(F.lds + RING_OFF, g, S, E); }
        } SEAM(pb + 7);
        if (IN(pb + 8)) {
            pg8::Gemm g{F.U, F.Wdn_t + (size_t)l * DM * DFF, M, DM, DFF}; pg8::ResidOrder S; S.init(DFF, 16, F.G, F.wg);
            pg8::EpiResid E{F.X, F.MOD + (size_t)l * NMOD + 5 * DM, (float*)(F.ws + WS_SLAB)};
#ifndef SKIP_G4
            pg8::gemm_phase<pg8::EpiResid, pg8::ResidOrder, true, true>(F.lds + RING_OFF, g, S, E);
#endif
#ifdef PROBE_DOWN
            { xcd_barrier(bar); pg8::EpiResid E2{(float*)(F.ws + WS_P), F.MOD + (size_t)l * NMOD + 5 * DM, (float*)(F.ws + WS_SLAB)}; pg8::gemm_phase<pg8::EpiResid, pg8::ResidOrder, true, true>(F.lds + RING_OFF, g, S, E2); }
#endif
        } SEAM(pb + 8);
    }
    if (IN(PH_FINAL)) {
#ifndef SKIP_NORM
 norm_rows<true>(F, F.final_g, DEPTH - 1, 0, 16, DEPTH - 1, 5);
#endif
 }
#undef IN
#undef SEAM
}

#ifndef MK_ONE_LAUNCH
#define MK_ONE_LAUNCH 1
#endif
extern "C" void kernel_launch(void* const* d_in, const int* in_sizes, int n_in, void* d_out, int out_size, void* d_ws, size_t ws_size, hipStream_t stream) {
    static int grid = 0;
    if (grid == 0) {
        if (n_in != 18 || (size_t)out_size != OUT_TOTAL || ws_size < WS_END2) { fprintf(stderr, "kernel_launch: unexpected shapes: n_in %d out %d ws %zu (need %zu)\n", n_in, out_size, ws_size, (size_t)WS_END2); grid = -1; return; }
        int dev = 0, cus = 0, per_cu = 0;
        if (hipGetDevice(&dev) != hipSuccess || hipDeviceGetAttribute(&cus, hipDeviceAttributeMultiprocessorCount, dev) != hipSuccess) { grid = -1; return; }
        if (hipFuncSetAttribute((const void*)fwd, hipFuncAttributeMaxDynamicSharedMemorySize, LDS_BYTES) != hipSuccess) { fprintf(stderr, "kernel_launch: hipFuncSetAttribute failed\n"); grid = -1; return; }
        if (hipOccupancyMaxActiveBlocksPerMultiprocessor(&per_cu, (const void*)fwd, NWAVES * 64, LDS_BYTES) != hipSuccess || per_cu < 1)
            fprintf(stderr, "kernel_launch: note: occupancy query reports %d workgroups per CU\n", per_cu);
        (void)hipGetLastError();
        grid = cus;
    }
    if (grid < 0) return;
    if (hipMemsetAsync((char*)d_ws + WS_CTL, 0, CTL_ZERO_BYTES, stream) != hipSuccess) { fprintf(stderr, "kernel_launch: memset failed\n"); return; }
    Args a{};
    for (int i = 0; i < 18; ++i) a.in[i] = (const float*)d_in[i];
    a.out = (float*)d_out; a.ws = (unsigned char*)d_ws;
#if MK_ONE_LAUNCH
    a.ph_lo = 0; a.ph_hi = N_PHASES;
    hipLaunchKernelGGL(fwd, dim3(grid), dim3(NWAVES * 64), LDS_BYTES, stream, a);
#else
    for (int ph = 0; ph < N_PHASES; ++ph) {
        a.ph_lo = ph; a.ph_hi = ph + 1;
        hipLaunchKernelGGL(fwd, dim3(grid), dim3(NWAVES * 64), LDS_BYTES, stream, a);
    }
#endif
    const hipError_t le = hipPeekAtLastError();
    if (le != hipSuccess) fprintf(stderr, "kernel_launch: launch failed: %s\n", hipGetErrorName(le));
}
```

```cpp
#include <hip/hip_runtime.h>
#include <cstdio>
#include <cstdint>
__device__ __forceinline__ int row_pos(int row) { return row < 8192 ? row : 2048 + ((row - 8192) & 63); }
__device__ __forceinline__ int row_seq(int row) { return row < 8192 ? 0 : 1 + ((row - 8192) >> 6); }
namespace pg8 {
#define PG8_LAS __attribute__((address_space(3)))
typedef unsigned short bf16_t;
typedef short bf16x8 __attribute__((ext_vector_type(8)));
typedef float f32x4 __attribute__((ext_vector_type(4)));
typedef unsigned u32x4 __attribute__((ext_vector_type(4)));
typedef unsigned u32x2 __attribute__((ext_vector_type(2)));
constexpr int BM = 256, BK = 64, HALF = 128, HTB = HALF * BK * 2  , STAGE_BYTES = 8 * HTB, NXCD = 8, WGM = 8;

__host__ __device__ __forceinline__ int lds_byte(int r, int c) { const int st = (r >> 4) * 2 + (c >> 5), rr = r & 15, cc = c & 31, ob = rr * 64 + cc * 2; return st * 1024 + (ob ^ (((ob >> 9) & 1) << 5)); }
__host__ __device__ __forceinline__ void stage_rc(int b, int& R, int& C) { const int st = b / 1024, sb = b % 1024, swz = sb ^ (((sb >> 9) & 1) << 5); R = (st >> 1) * 16 + swz / 64; C = (st & 1) * 32 + (swz % 64) / 2; }
__host__ __device__ __forceinline__ int perm32(int rho) { const int n = rho >> 4, i = rho & 15; return 8 * (i >> 2) + 4 * n + (i & 3); }

struct Unit { int pm, pn, kt0, nt, slab, qa, qh; };
struct Gemm { const bf16_t* A; const bf16_t* Bt; int M, N, K; };

struct StaticOrder {
    int nM, nN, nwg, G, c, ntk;
    __host__ __device__ void init(int M, int N, int K, int G_, int c_) { nM = M / BM; nN = N / BM; nwg = nM * nN; G = G_; c = c_; ntk = K / BK; }
    __host__ __device__ bool next(int i, Unit& u) const {
        const long L = (long)i * G + c; if (L >= nwg) return false;
        int wgid = (int)L; { const int q = nwg / NXCD, r = nwg % NXCD, xcd = wgid % NXCD, off = wgid / NXCD; wgid = (xcd < r ? xcd * (q + 1) : r * (q + 1) + (xcd - r) * q) + off; }
        const int nig = WGM * nN, gid = wgid / nig, fm = gid * WGM, gsz = (nM - fm) < WGM ? (nM - fm) : WGM;
        u.pm = fm + ((wgid % nig) % gsz); u.pn = (wgid % nig) / gsz; u.kt0 = 0; u.nt = ntk; u.slab = -1; u.qa = -1; u.qh = 0; return true;
    }
    __device__ __forceinline__ void a_ready(const Unit&) const {}
    __device__ __forceinline__ void done(const Unit&) const {}
};

struct ResidOrder {
    StaticOrder so; int G, c, nks, ntk, nsub, nmine;
    __host__ __device__ void init(int K, int nks_, int G_, int c_) { so.init(8192, 2048, K, G_, c_); G = G_; c = c_; nks = nks_; ntk = (K / BK) / nks; nsub = 16 * nks; nmine = c < nsub ? (nsub - c + G - 1) / G : 0; }
    __host__ __device__ bool next(int i, Unit& u) const {
        if (i < nmine) { const int s = c + i * G, su = s / nks, ks = s % nks; u.pm = 32 + (su >> 3); u.pn = su & 7; u.kt0 = ks * ntk; u.nt = ntk; u.slab = ks; u.qa = -1; u.qh = 0; return true; }
        return so.next(i - nmine, u);
    }
    __device__ __forceinline__ void a_ready(const Unit&) const {}
    __device__ __forceinline__ void done(const Unit&) const {}
};

struct SameTileOrder : StaticOrder {
    __host__ __device__ bool next(int i, Unit& u) const { const bool ok = StaticOrder::next(i, u); u.slab = u.pm * 64 + u.pn; u.pm = 0; u.pn = 0; return ok; }
};
struct QuarterOrder {
    int nN, G, c, ntk, nsub;
    __host__ __device__ void init(int N, int K, int G_, int c_) { nN = N / BM; G = G_; c = c_; ntk = K / BK; nsub = 2 * nN * 4; }
    __host__ __device__ bool next(int i, Unit& u) const {
        const int s = c + i * G; if (s >= nsub) return false;
        const int q = s / (2 * nN), t = s % (2 * nN);
        u.pm = 32 + t / nN; u.pn = t % nN; u.kt0 = 0; u.nt = ntk; u.slab = -1; u.qa = q >> 1; u.qh = q & 1; return true;
    }
    __device__ __forceinline__ void a_ready(const Unit&) const {}
    __device__ __forceinline__ void done(const Unit&) const {}
};

__device__ __forceinline__ unsigned cvt_pk_bf16(float lo, float hi) { unsigned r; asm volatile("v_cvt_pk_bf16_f32 %0, %1, %2" : "=v"(r) : "v"(lo), "v"(hi)); return r; }
__device__ __forceinline__ float fast_rcp(float x) { return __builtin_amdgcn_rcpf(x); }
__device__ __forceinline__ float silu_f(float x) { return x * fast_rcp(1.0f + __expf(-x)); }

struct EpiInProj {
    static constexpr bool PERM = true, AFTER_DRAIN = false;
    bf16_t* P; float* LF; const float* lb; const float* rc; const float* rs;
    __device__ __forceinline__ void operator()(const f32x4 (&acc)[2][2][4][2], const Unit& u, int wr, int wc, int fr, int fq) const {
        const int seg = u.pn >> 2;
        const int row0 = u.pm * BM + wr * 64 + fr;
        const int colg0 = u.pn * BM + wc * 32 + 8 * fq;
        if (seg == 4 || seg == 5) {
            const float ksc = (seg == 5) ? 0.0625f : 1.0f;
            const int j0 = wc * 32 + 8 * fq;
#pragma unroll
            for (int ai = 0; ai < 2; ++ai)
#pragma unroll
                for (int m = 0; m < 4; ++m) {
                    if (u.qa >= 0 && (ai != u.qa || (m >> 1) != u.qh)) continue;
                    const int row = row0 + ai * HALF + m * 16; const int pos = row_pos(row);
                    const f32x4 c0 = *(const f32x4*)(rc + (size_t)pos * 128 + j0), c1 = *(const f32x4*)(rc + (size_t)pos * 128 + j0 + 4);
                    const f32x4 s0 = *(const f32x4*)(rs + (size_t)pos * 128 + j0), s1 = *(const f32x4*)(rs + (size_t)pos * 128 + j0 + 4);
                    const f32x4 x1a = acc[ai][0][m][0], x1b = acc[ai][0][m][1], x2a = acc[ai][1][m][0], x2b = acc[ai][1][m][1];
                    const f32x4 o1a = (x1a * c0 - x2a * s0) * ksc, o1b = (x1b * c1 - x2b * s1) * ksc;
                    const f32x4 o2a = (x2a * c0 + x1a * s0) * ksc, o2b = (x2b * c1 + x1b * s1) * ksc;
                    bf16_t* rowp = P + (size_t)row * 8192 + colg0;
                    u32x4 w; w.x = cvt_pk_bf16(o1a[0], o1a[1]); w.y = cvt_pk_bf16(o1a[2], o1a[3]); w.z = cvt_pk_bf16(o1b[0], o1b[1]); w.w = cvt_pk_bf16(o1b[2], o1b[3]);
                    *(u32x4*)(rowp) = w;
                    w.x = cvt_pk_bf16(o2a[0], o2a[1]); w.y = cvt_pk_bf16(o2a[2], o2a[3]); w.z = cvt_pk_bf16(o2b[0], o2b[1]); w.w = cvt_pk_bf16(o2b[2], o2b[3]);
                    *(u32x4*)(rowp + HALF) = w;
                }
        } else if (seg == 1) {
#pragma unroll
            for (int bj = 0; bj < 2; ++bj)
#pragma unroll
                for (int n = 0; n < 2; ++n) {
                    const int cs = colg0 + bj * HALF - 1024 + 4 * n;
                    const f32x4 lbv = *(const f32x4*)(lb + cs);
#pragma unroll
                    for (int ai = 0; ai < 2; ++ai) {
                        f32x4 carry = (f32x4){0.f, 0.f, 0.f, 0.f};
#pragma unroll
                        for (int m = 0; m < 4; ++m) {
                            const int row = row0 + ai * HALF + m * 16;
                            f32x4 v, kk;
#pragma unroll
                            for (int e = 0; e < 4; ++e) { const float x = acc[ai][bj][m][n][e], l = lbv[e]; const float sg = fast_rcp(1.0f + __expf(-x)), sn = fast_rcp(1.0f + __expf(x)); v[e] = __logf(l + (1.0f - l) * sg); kk[e] = (1.0f - l) * sn; }
                            u32x2 w; w.x = cvt_pk_bf16(kk[0], kk[1]); w.y = cvt_pk_bf16(kk[2], kk[3]);
                            *(u32x2*)(P + (size_t)row * 8192 + colg0 + bj * HALF + 4 * n) = w;
#pragma unroll
                            for (int d = 1; d < 16; d <<= 1) {
#pragma unroll
                                for (int e = 0; e < 4; ++e) { const float t = __shfl_up(v[e], d, 16); v[e] += (fr >= d) ? t : 0.f; }
                            }
                            v += carry;
#pragma unroll
                            for (int e = 0; e < 4; ++e) carry[e] = __shfl(v[e], 15, 16);
                            *(f32x4*)(LF + (size_t)row * 1024 + cs) = v;
                        }
                    }
                }
        } else {
            const bool act = (seg == 0 || seg == 3 || seg == 7);
#pragma unroll
            for (int ai = 0; ai < 2; ++ai)
#pragma unroll
                for (int m = 0; m < 4; ++m) { if (u.qa >= 0 && (ai != u.qa || (m >> 1) != u.qh)) continue;
                    bf16_t* rowp = P + (size_t)(row0 + ai * HALF + m * 16) * 8192 + colg0;
#pragma unroll
                    for (int bj = 0; bj < 2; ++bj) { f32x4 v0 = acc[ai][bj][m][0], v1 = acc[ai][bj][m][1];
                        if (act) {
#pragma unroll
                            for (int e = 0; e < 4; ++e) { v0[e] = silu_f(v0[e]); v1[e] = silu_f(v1[e]); } }
                        u32x4 w; w.x = cvt_pk_bf16(v0[0], v0[1]); w.y = cvt_pk_bf16(v0[2], v0[3]); w.z = cvt_pk_bf16(v1[0], v1[1]); w.w = cvt_pk_bf16(v1[2], v1[3]);
                        *(u32x4*)(rowp + bj * HALF) = w; } }
        }
    }
};
struct EpiRelu2 {
    static constexpr bool PERM = true, AFTER_DRAIN = false;
    bf16_t* O; int ldc;
    __device__ __forceinline__ void operator()(const f32x4 (&acc)[2][2][4][2], const Unit& u, int wr, int wc, int fr, int fq) const {
        const int row0 = u.pm * BM + wr * 64 + fr, col0 = u.pn * BM + wc * 32 + 8 * fq;
#pragma unroll
        for (int ai = 0; ai < 2; ++ai)
#pragma unroll
            for (int m = 0; m < 4; ++m) { if (u.qa >= 0 && (ai != u.qa || (m >> 1) != u.qh)) continue;
                bf16_t* rowp = O + (size_t)(row0 + ai * HALF + m * 16) * ldc + col0;
#pragma unroll
                for (int bj = 0; bj < 2; ++bj) { f32x4 v0 = acc[ai][bj][m][0], v1 = acc[ai][bj][m][1];
#pragma unroll
                    for (int e = 0; e < 4; ++e) { const float a = fmaxf(v0[e], 0.f), b = fmaxf(v1[e], 0.f); v0[e] = a * a; v1[e] = b * b; }
                    u32x4 w; w.x = cvt_pk_bf16(v0[0], v0[1]); w.y = cvt_pk_bf16(v0[2], v0[3]); w.z = cvt_pk_bf16(v1[0], v1[1]); w.w = cvt_pk_bf16(v1[2], v1[3]);
                    *(u32x4*)(rowp + bj * HALF) = w; } }
    }
};
struct EpiResid {
    static constexpr bool PERM = false, AFTER_DRAIN = false;
    float* X; const float* gate; float* slab;
    __device__ __forceinline__ void operator()(const f32x4 (&acc)[2][2][4][2], const Unit& u, int wr, int wc, int fr, int fq) const {
        const int row0 = u.pm * BM + wr * 64 + fr, col0 = u.pn * BM + wc * 32 + 4 * fq;
        if (u.slab >= 0) {
            float* sp = slab + ((size_t)u.slab * 512 + (row0 - 8192)) * 2048 + col0;
#pragma unroll
            for (int ai = 0; ai < 2; ++ai)
#pragma unroll
                for (int m = 0; m < 4; ++m) { float* rowp = sp + (size_t)(ai * HALF + m * 16) * 2048;
#pragma unroll
                    for (int bj = 0; bj < 2; ++bj)
#pragma unroll
                        for (int n = 0; n < 2; ++n) *(f32x4*)(rowp + bj * HALF + n * 16) = acc[ai][bj][m][n]; }
            return;
        }
        f32x4 gv[2][2];
#pragma unroll
        for (int bj = 0; bj < 2; ++bj)
#pragma unroll
            for (int n = 0; n < 2; ++n) gv[bj][n] = *(const f32x4*)(gate + col0 + bj * HALF + n * 16);
#pragma unroll
        for (int ai = 0; ai < 2; ++ai)
#pragma unroll
            for (int m = 0; m < 4; ++m) { float* rowp = X + (size_t)(row0 + ai * HALF + m * 16) * 2048 + col0;
#pragma unroll
                for (int bj = 0; bj < 2; ++bj)
#pragma unroll
                    for (int n = 0; n < 2; ++n) { const f32x4 xv = *(const f32x4*)(rowp + bj * HALF + n * 16); *(f32x4*)(rowp + bj * HALF + n * 16) = xv + gv[bj][n] * acc[ai][bj][m][n]; }
                asm volatile("" ::: "memory"); }
    }
};

struct EpiProbe {
    static constexpr bool PERM = true, AFTER_DRAIN = false;
    bf16_t* O; int ldc;
    __device__ __forceinline__ void operator()(const f32x4 (&acc)[2][2][4][2], const Unit& u, int wr, int wc, int fr, int fq) const {
        Unit t = u; t.pm = u.slab >> 6; t.pn = u.slab & 63; t.qa = -1;
        EpiRelu2 e{O, ldc}; e(acc, t, wr, wc, fr, fq);
    }
};
template <class Epi, class Sched, bool ALIGN_EPI = false, bool SP2 = false, int QM = 0>
__device__ __forceinline__ void gemm_phase(PG8_LAS unsigned char* lds, const Gemm g, const Sched& S, const Epi& E) {
    int tid_l = threadIdx.x; asm volatile("" : "+v"(tid_l));
    const int tid = tid_l, wid = __builtin_amdgcn_readfirstlane(tid >> 6), lane = tid & 63, wr = wid >> 2, wc = wid & 3, fr = lane & 15, fq = lane >> 4;
    const int K = g.K;
    unsigned voffA[2], voffB[2];
#pragma unroll
    for (int i = 0; i < 2; ++i) { int R, C; stage_rc(tid * 16 + i * 8192, R, C); const int Rb = Epi::PERM ? ((R & ~31) + perm32(R & 31)) : R;
        voffA[i] = (unsigned)(R * K + C) * 2u; voffB[i] = (unsigned)(Rb * K + C) * 2u; }
    const size_t kstep = (size_t)(BK * 2);
    const size_t hstep = (size_t)HALF * K * 2;
    const size_t tstep = 2 * hstep;
    const unsigned ldsw = (unsigned)wid * 1024u;
    const int aoff = lds_byte(wr * 64 + fr, fq * 8), boff = lds_byte(wc * 32 + fr, fq * 8);
#define PG8_SA(b, h) (((b) * 2 + (h)) * HTB)
#define PG8_SB(b, h) ((4 + (b) * 2 + (h)) * HTB)
#define PG8_STAGE(bufoff, gbase, voff) do { _Pragma("unroll") for (int _i = 0; _i < 2; ++_i) \
        __builtin_amdgcn_global_load_lds((const unsigned*)((const char*)(gbase) + (voff)[_i]), (PG8_LAS unsigned*)(lds + (bufoff) + ldsw + _i * 8192), 16, 0, 0); } while (0)
#define PG8_LDA(dst, b, h) do { if (!QM || (h) == q_a) { _Pragma("unroll") for (int m = 0; m < 4; ++m) _Pragma("unroll") for (int k = 0; k < 2; ++k) dst[m][k] = *(const PG8_LAS bf16x8*)(lds + PG8_SA(b, h) + aoff + m * 2048 + k * 1024); } } while (0)
#define PG8_LDB(dst, b, h) do { _Pragma("unroll") for (int n = 0; n < 2; ++n) _Pragma("unroll") for (int k = 0; k < 2; ++k) dst[n][k] = *(const PG8_LAS bf16x8*)(lds + PG8_SB(b, h) + boff + n * 2048 + k * 1024); } while (0)
#define PG8_MMA(ai, bj, At, Bt) do { if (!QM || (ai) == q_a) { __builtin_amdgcn_s_setprio(1); _Pragma("unroll") for (int m = 0; m < 4; ++m) { if (!QM || (m >> 1) == q_h) { _Pragma("unroll") for (int n = 0; n < 2; ++n) _Pragma("unroll") for (int k = 0; k < 2; ++k) \
        acc[ai][bj][m][n] = __builtin_amdgcn_mfma_f32_16x16x32_bf16(Bt[n][k], At[m][k], acc[ai][bj][m][n], 0, 0, 0); } } __builtin_amdgcn_s_setprio(0); } } while (0)
#define PG8_WAIT_V(n) asm volatile("s_waitcnt vmcnt(" #n ")" ::: "memory")
#define PG8_WAIT_L(n) asm volatile("s_waitcnt lgkmcnt(" #n ")" ::: "memory")
#define PG8_BAR __builtin_amdgcn_s_barrier()
#define PG8_SCHED __builtin_amdgcn_sched_barrier(0)
    Unit cur, nxt; int ui = 0;
    if (!S.next(0, cur)) return;
    int q_a = cur.qa, q_h = cur.qh; (void)q_a; (void)q_h;
    f32x4 acc[2][2][4][2];
#pragma unroll
    for (int a = 0; a < 2; ++a)
#pragma unroll
        for (int b = 0; b < 2; ++b)
#pragma unroll
            for (int m = 0; m < 4; ++m)
#pragma unroll
                for (int n = 0; n < 2; ++n) acc[a][b][m][n] = (f32x4){0.f, 0.f, 0.f, 0.f};
    bf16x8 At[4][2], B0[2][2], B1[2][2];
    const char* cA = (const char*)g.A + (size_t)cur.pm * tstep + (size_t)cur.kt0 * kstep; const char* cB = (const char*)g.Bt + (size_t)cur.pn * tstep + (size_t)cur.kt0 * kstep;
    S.a_ready(cur);
    if constexpr (SP2) {
        PG8_STAGE(PG8_SB(0, 0), cB, voffB); PG8_STAGE(PG8_SB(0, 1), cB + hstep, voffB); PG8_STAGE(PG8_SA(0, 0), cA, voffA); PG8_STAGE(PG8_SA(0, 1), cA + hstep, voffA);
        if (wr == 1) PG8_BAR;
        PG8_WAIT_V(2); PG8_BAR;
        PG8_STAGE(PG8_SB(1, 0), cB + kstep, voffB); PG8_STAGE(PG8_SA(1, 0), cA + kstep, voffA); PG8_STAGE(PG8_SB(1, 1), cB + hstep + kstep, voffB);
        PG8_WAIT_V(6); PG8_BAR;
    } else {
        PG8_STAGE(PG8_SB(0, 0), cB, voffB); PG8_STAGE(PG8_SA(0, 0), cA, voffA); PG8_STAGE(PG8_SB(0, 1), cB + hstep, voffB); PG8_STAGE(PG8_SA(0, 1), cA + hstep, voffA);
        if (wr == 1) PG8_BAR;
        PG8_WAIT_V(4); PG8_BAR;
        PG8_STAGE(PG8_SB(1, 0), cB + kstep, voffB); PG8_STAGE(PG8_SA(1, 0), cA + kstep, voffA); PG8_STAGE(PG8_SB(1, 1), cB + hstep + kstep, voffB);
        PG8_WAIT_V(6); PG8_BAR;
    }
    for (;;) {
        const bool has_next = S.next(ui + 1, nxt);
        const char* nA = has_next ? (const char*)g.A + (size_t)nxt.pm * tstep + (size_t)nxt.kt0 * kstep : cA; const char* nB = has_next ? (const char*)g.Bt + (size_t)nxt.pn * tstep + (size_t)nxt.kt0 * kstep : cB;
        const int nt = cur.nt;
        for (int t = 0; t < nt; t += 2) {
            const bool last = (t == nt - 2);
            const char* a1 = cA + (size_t)(t + 1) * kstep;
            const char* a2 = last ? nA : cA + (size_t)(t + 2) * kstep; const char* b2 = last ? nB : cB + (size_t)(t + 2) * kstep;
            const char* a3 = a2 + kstep; const char* b3 = b2 + kstep;
            if (last && has_next) S.a_ready(nxt);
            if constexpr (SP2) {
            PG8_LDB(B0, 0, 0); PG8_LDB(B1, 0, 1); PG8_SCHED; PG8_LDA(At, 0, 0); PG8_STAGE(PG8_SA(1, 1), a1 + hstep, voffA);
            PG8_WAIT_V(8); PG8_WAIT_L(0); PG8_BAR; PG8_MMA(0, 0, At, B0); PG8_MMA(0, 1, At, B1); PG8_BAR; PG8_SCHED;
            PG8_LDA(At, 0, 1); PG8_STAGE(PG8_SB(0, 0), b2, voffB); PG8_STAGE(PG8_SB(0, 1), b2 + hstep, voffB); PG8_STAGE(PG8_SA(0, 0), a2, voffA);
            PG8_WAIT_V(8); PG8_WAIT_L(0); PG8_BAR; PG8_MMA(1, 0, At, B0); PG8_MMA(1, 1, At, B1); PG8_BAR; PG8_SCHED;
            PG8_LDB(B0, 1, 0); PG8_LDB(B1, 1, 1); PG8_SCHED; PG8_LDA(At, 1, 0); PG8_STAGE(PG8_SA(0, 1), a2 + hstep, voffA);
            PG8_WAIT_V(8); PG8_WAIT_L(0); PG8_BAR; PG8_MMA(0, 0, At, B0); PG8_MMA(0, 1, At, B1); PG8_BAR; PG8_SCHED;
            PG8_LDA(At, 1, 1); PG8_STAGE(PG8_SB(1, 0), b3, voffB); PG8_STAGE(PG8_SB(1, 1), b3 + hstep, voffB); PG8_STAGE(PG8_SA(1, 0), a3, voffA);
            PG8_WAIT_V(8); PG8_WAIT_L(0); PG8_BAR; PG8_MMA(1, 0, At, B0); PG8_MMA(1, 1, At, B1); PG8_BAR; PG8_SCHED;
            } else {
            PG8_LDB(B0, 0, 0); PG8_SCHED; PG8_LDA(At, 0, 0); PG8_STAGE(PG8_SA(1, 1), a1 + hstep, voffA);
            PG8_WAIT_L(8); PG8_BAR; PG8_WAIT_L(0); PG8_MMA(0, 0, At, B0); PG8_BAR; PG8_SCHED;
            PG8_LDB(B1, 0, 1); PG8_STAGE(PG8_SB(0, 0), b2, voffB);
            PG8_BAR; PG8_WAIT_L(0); PG8_MMA(0, 1, At, B1); PG8_BAR;
            PG8_LDA(At, 0, 1); PG8_STAGE(PG8_SA(0, 0), a2, voffA);
            PG8_BAR; PG8_WAIT_L(0); PG8_MMA(1, 0, At, B0); PG8_BAR; PG8_SCHED;
            PG8_STAGE(PG8_SB(0, 1), b2 + hstep, voffB);
            PG8_WAIT_V(6); PG8_BAR; PG8_MMA(1, 1, At, B1); PG8_BAR;
            PG8_LDB(B0, 1, 0); PG8_SCHED; PG8_LDA(At, 1, 0); PG8_STAGE(PG8_SA(0, 1), a2 + hstep, voffA);
            PG8_WAIT_L(8); PG8_BAR; PG8_WAIT_L(0); PG8_MMA(0, 0, At, B0); PG8_BAR; PG8_SCHED;
            PG8_LDB(B1, 1, 1); PG8_STAGE(PG8_SB(1, 0), b3, voffB);
            PG8_BAR; PG8_WAIT_L(0); PG8_MMA(0, 1, At, B1); PG8_BAR;
            PG8_LDA(At, 1, 1); PG8_STAGE(PG8_SA(1, 0), a3, voffA);
            PG8_BAR; PG8_WAIT_L(0); PG8_MMA(1, 0, At, B0); PG8_BAR; PG8_SCHED;
            PG8_STAGE(PG8_SB(1, 1), b3 + hstep, voffB);
            PG8_WAIT_V(6); PG8_BAR; PG8_MMA(1, 1, At, B1); PG8_BAR;
            }
        }
        if constexpr (ALIGN_EPI) { if (wr == 0) PG8_BAR; }
        if constexpr (!Epi::AFTER_DRAIN) { E(acc, cur, wr, wc, fr, fq); S.done(cur); }
        if (!has_next) break;
#pragma unroll
        for (int a = 0; a < 2; ++a)
#pragma unroll
            for (int b = 0; b < 2; ++b)
#pragma unroll
                for (int m = 0; m < 4; ++m)
#pragma unroll
                    for (int n = 0; n < 2; ++n) acc[a][b][m][n] = (f32x4){0.f, 0.f, 0.f, 0.f};
        cur = nxt; cA = nA; cB = nB; ++ui; q_a = cur.qa; q_h = cur.qh;
        if constexpr (ALIGN_EPI) { if (wr == 1) PG8_BAR; }
    }
    PG8_WAIT_V(0);
    if constexpr (!ALIGN_EPI) { if (wr == 0) PG8_BAR; }
    PG8_BAR;
    if constexpr (Epi::AFTER_DRAIN) { E.fused(acc, cur, wr, wc, fr, fq, lds, wid, lane); S.done(cur); }
#undef PG8_SA
#undef PG8_SB
#undef PG8_STAGE
#undef PG8_LDA
#undef PG8_LDB
#undef PG8_MMA
#undef PG8_WAIT_V
#undef PG8_WAIT_L
#undef PG8_BAR
#undef PG8_SCHED
}
}
constexpr int NWAVES = 8;
constexpr int DM = 2048, SEQ = 8192, DEPTH = 4, DECB = 8, DECS = 64, M = SEQ + DECB * DECS, NPROJ = 8192, DFF = 8192, NSEQ = 9, NMOD = 6 * DM;
constexpr int HA = 8, HB = 4;
constexpr float EPS = 1e-6f;
constexpr size_t OFF_SA_P = (size_t)M * DM, OFF_SB_P = OFF_SA_P + (size_t)DEPTH * HA * 128 * 128, OFF_SA_S = OFF_SB_P + (size_t)DEPTH * HB * 256 * 256,
                 OFF_SB_S = OFF_SA_S + (size_t)DEPTH * DECB * HA * 128 * 128, OUT_TOTAL = OFF_SB_S + (size_t)DEPTH * DECB * HB * 256 * 256;

constexpr size_t MiB = 1u << 20;
constexpr size_t WS_CTL = 0, CTL_ZERO_BYTES = 1 * MiB;
constexpr size_t WS_WIN = 2 * MiB;
constexpr size_t WS_WOUT = WS_WIN + 128 * MiB;
constexpr size_t WS_WUP = WS_WOUT + 32 * MiB;
constexpr size_t WS_WDN = WS_WUP + 128 * MiB;
constexpr size_t WS_X = WS_WDN + 128 * MiB;
constexpr size_t WS_H = WS_X + 68 * MiB;
constexpr size_t WS_P = WS_H + 34 * MiB;
constexpr size_t WS_LF = WS_P + 136 * MiB;
constexpr size_t WS_O = WS_LF + 34 * MiB;
constexpr size_t WS_U = WS_O + 34 * MiB;
constexpr size_t WS_MOD = WS_U + 136 * MiB;
constexpr size_t WS_LB = WS_MOD + 2 * MiB;
constexpr size_t WS_ROPE = WS_LB + 1 * MiB;
constexpr size_t WS_SLAB = WS_ROPE + 8 * MiB;
constexpr size_t WS_END = WS_SLAB + 64 * MiB;
constexpr int CW_Q0 = 64;
constexpr int CW_BAR = 4096;

constexpr int RING_OFF = 0, RING_BYTES = 131072;
constexpr int LDS_BYTES = 151552;
constexpr int MISC_OFF = 147456;

#define GAS __attribute__((address_space(1)))
#define LAS __attribute__((address_space(3)))
typedef unsigned short bf16;
typedef unsigned v4u __attribute__((ext_vector_type(4)));
typedef unsigned v2u __attribute__((ext_vector_type(2)));
typedef float f32x4 __attribute__((ext_vector_type(4)));
typedef short bf16x8 __attribute__((ext_vector_type(8)));
#define LDS_WAIT() asm volatile("s_waitcnt lgkmcnt(0)" ::: "memory")
#define VM_WAIT() asm volatile("s_waitcnt vmcnt(0)" ::: "memory")
__device__ __forceinline__ unsigned f2bf(float f) { unsigned u = __builtin_bit_cast(unsigned, f); return (u + 0x7fffu + ((u >> 16) & 1u)) >> 16; }
__device__ __forceinline__ unsigned pk2(float lo, float hi) { return pg8::cvt_pk_bf16(lo, hi); }
__device__ __forceinline__ float bf2f(unsigned short b) { return __builtin_bit_cast(float, ((unsigned)b) << 16); }
__device__ __forceinline__ float bflo(unsigned w) { return __builtin_bit_cast(float, w << 16); }
__device__ __forceinline__ float bfhi(unsigned w) { return __builtin_bit_cast(float, w & 0xffff0000u); }

#define XB_TMO      128
#define XB_XCNT(j)  (256  + 64 * (j))
#define XB_XSUB(j)  (1280 + 64 * (j))
#define XB_XGEN(j)  (2304 + 64 * (j))
#define XB_TOP      3328
#define XB_TOPGEN   3392
#define XCD_BAR_WORDS 3456
#define XB_SPIN_CAP (1u << 20)
__device__ __forceinline__ unsigned xb_ld(unsigned* p)              { return __hip_atomic_load(p, __ATOMIC_RELAXED, __HIP_MEMORY_SCOPE_AGENT); }
__device__ __forceinline__ unsigned xb_add(unsigned* p, unsigned v) { return __hip_atomic_fetch_add(p, v, __ATOMIC_RELAXED, __HIP_MEMORY_SCOPE_AGENT); }
__device__ __forceinline__ unsigned xb_xcc_id() { return (unsigned)__builtin_amdgcn_s_getreg((3 << 11) | 20) & 0xFu; }
#define XB_SPIN(cond, bar) do { unsigned _sp = 0; while (cond) { __builtin_amdgcn_s_sleep(1); \
    if ((++_sp & 255u) == 0u) { if (xb_ld(&(bar)[XB_TMO])) break; if (_sp > XB_SPIN_CAP) { atomicAdd(&(bar)[XB_TMO], 1u); break; } } } } while (0)
struct XcdBarrier { unsigned* bar; unsigned x; volatile LAS unsigned* st; };
__device__ __forceinline__ XcdBarrier xcd_barrier_post(unsigned* bar, volatile LAS unsigned* st) {
    XcdBarrier b; b.bar = bar; b.x = xb_xcc_id(); b.st = st;
    if (threadIdx.x == 0) (void)xb_add(&bar[XB_XCNT(b.x)], 1u);
    return b;
}
__device__ __forceinline__ void xcd_barrier_complete(unsigned* bar, unsigned x, unsigned& nloc, unsigned& nx) {
    const unsigned G = gridDim.x * gridDim.y * gridDim.z;
    unsigned sum, cnt, mine, sp = 0u;
    for (;;) {
        sum = 0u; cnt = 0u; mine = 0u;
#pragma unroll
        for (unsigned j = 0; j < 16; ++j) { const unsigned c = xb_ld(&bar[XB_XCNT(j)]); sum += c; cnt += (c > 0u) ? 1u : 0u; mine = (j == x) ? c : mine; }
        if (sum == G) break;
        __builtin_amdgcn_s_sleep(1);
        if ((++sp & 255u) == 0u) { if (xb_ld(&bar[XB_TMO])) break; if (sp > XB_SPIN_CAP) { atomicAdd(&bar[XB_TMO], 1u); break; } }
    }
    nloc = mine > 0u ? mine : 1u; nx = cnt > 0u ? cnt : 1u;
}
__device__ __forceinline__ void xcd_barrier(const XcdBarrier& b) {
    asm volatile("s_waitcnt vmcnt(0)" ::: "memory");
    __syncthreads();
    if (threadIdx.x == 0) {
        unsigned* bar = b.bar;
        __builtin_amdgcn_s_waitcnt(0);
        unsigned nloc = b.st[0], nx = b.st[1];
        if (nloc == 0u) { xcd_barrier_complete(bar, b.x, nloc, nx); b.st[0] = nloc; b.st[1] = nx; }
        const unsigned old = xb_add(&bar[XB_XSUB(b.x)], 1u);
        const unsigned gen = old / nloc;
        if (old + 1u == (gen + 1u) * nloc) {
            __builtin_amdgcn_fence(__ATOMIC_RELEASE, "agent");
            asm volatile("s_waitcnt vmcnt(0)" ::: "memory");
            const unsigned og = xb_add(&bar[XB_TOP], 1u);
            const unsigned tg = og / nx;
            if (og + 1u == (tg + 1u) * nx) xb_add(&bar[XB_TOPGEN], 1u);
            else XB_SPIN(xb_ld(&bar[XB_TOPGEN]) == tg, bar);
            __builtin_amdgcn_fence(__ATOMIC_ACQUIRE, "agent");
            xb_add(&bar[XB_XGEN(b.x)], 1u);
            asm volatile("s_waitcnt vmcnt(0)" ::: "memory");
        } else {
            XB_SPIN(xb_ld(&bar[XB_XGEN(b.x)]) == gen, bar);
            __builtin_amdgcn_fence(__ATOMIC_ACQUIRE, "agent");
            asm volatile("s_waitcnt vmcnt(0)" ::: "memory");
        }
    }
    __syncthreads();
}

struct Frame {
    LAS unsigned char* lds;
    unsigned* ctl;
    unsigned char* ws;
    int G, wg;
    const float *x_prompt, *x_sample, *state_hgrn, *state_ret, *c_prompt, *c_sample, *lb_logits, *w_ada, *b_ada, *norm1_g, *norm2_g, *w_in, *hgrn_g, *ret_g, *w_out, *w_up, *w_down, *final_g;
    float* out;
    bf16 *Win_t, *Wout_t, *Wup_t, *Wdn_t, *H, *P, *O, *U;
    float *X, *LF, *MOD, *LB, *RC, *RS;
};

__device__ __forceinline__ int ltid() { int t = threadIdx.x; asm volatile("" : "+v"(t)); return t; }
#define PHASE_IDS() const int tid = ltid(), lane = tid & 63, wave = __builtin_amdgcn_readfirstlane(tid >> 6); (void)lane; (void)wave
__device__ __forceinline__ float wave_sum(float v) {
#pragma unroll
    for (int o = 1; o < 64; o <<= 1) v += __shfl_xor(v, o);
    return v;
}
__device__ __forceinline__ void p0_transpose_item(const float* W, int K, int N, bf16* WT, LAS float* scr, int item, int lane) {
    const int nblk = N / 32, kb = item / nblk, nb = item % nblk, k0 = 64 * kb, n0 = 32 * nb;
#pragma unroll 8
    for (int i = 0; i < 32; ++i) { const int kk = 2 * i + (lane >> 5); scr[kk * 33 + (lane & 31)] = W[(size_t)(k0 + kk) * N + n0 + (lane & 31)]; }
    LDS_WAIT(); asm volatile("" ::: "memory");
    const int c = lane & 7;
#pragma unroll
    for (int j = 0; j < 4; ++j) { const int n = (lane >> 3) + 8 * j; const LAS float* s = scr + (8 * c) * 33 + n;
        v4u o; o.x = pk2(s[0 * 33], s[1 * 33]); o.y = pk2(s[2 * 33], s[3 * 33]); o.z = pk2(s[4 * 33], s[5 * 33]); o.w = pk2(s[6 * 33], s[7 * 33]);
        *(GAS v4u*)(WT + (size_t)(n0 + n) * K + k0 + 8 * c) = o; }
    LDS_WAIT(); asm volatile("" ::: "memory");
}
__device__ __forceinline__ void p0_mod_task(Frame& F, int task) {
    PHASE_IDS();
    const int l = task / 48, cb = task % 48;
    LAS float* cact = (LAS float*)(F.lds);
    LAS float* red = (LAS float*)(F.lds + 73728);
    for (int i = tid; i < NSEQ * DM; i += NWAVES * 64) { const int b = i / DM, k = i % DM; const float c = (b == 0) ? F.c_prompt[k] : F.c_sample[(b - 1) * DM + k]; cact[i] = c / (1.0f + __expf(-c)); }
    __syncthreads();
    const float* W = F.w_ada + (size_t)l * DM * NMOD + cb * 256 + 4 * lane;
    f32x4 acc[NSEQ];
#pragma unroll
    for (int b = 0; b < NSEQ; ++b) acc[b] = (f32x4){0.f, 0.f, 0.f, 0.f};
    const int kbeg = wave * 256;
#pragma unroll 2
    for (int k0 = kbeg; k0 < kbeg + 256; k0 += 4) {
        const f32x4 w0 = *(const f32x4*)(W + (size_t)(k0 + 0) * NMOD), w1 = *(const f32x4*)(W + (size_t)(k0 + 1) * NMOD), w2 = *(const f32x4*)(W + (size_t)(k0 + 2) * NMOD), w3 = *(const f32x4*)(W + (size_t)(k0 + 3) * NMOD);
#pragma unroll
        for (int b = 0; b < NSEQ; ++b) { const f32x4 c = *(const LAS f32x4*)(cact + b * DM + k0); acc[b] += w0 * c.x + w1 * c.y + w2 * c.z + w3 * c.w; }
    }
#pragma unroll
    for (int b = 0; b < NSEQ; ++b) *(LAS f32x4*)(red + (wave * NSEQ + b) * 256 + 4 * lane) = acc[b];
    __syncthreads();
    for (int o = tid; o < NSEQ * 256; o += NWAVES * 64) { const int b = o / 256, c = o % 256; float s = 0.f;
#pragma unroll
        for (int w = 0; w < 8; ++w) s += red[(w * NSEQ + b) * 256 + c];
        F.MOD[(size_t)(b * DEPTH + l) * NMOD + cb * 256 + c] = s + F.b_ada[(size_t)l * NMOD + cb * 256 + c]; }
    __syncthreads();
}
__device__ __forceinline__ void sincos_acc(float angf, float& sn, float& cs) {
    const double a = (double)angf;
    const double q = __builtin_rint(a * 0.63661977236758134308);
    double r = __builtin_fma(-q, 1.57079632679489655800, a); r = __builtin_fma(-q, 6.12323399573676603587e-17, r);
    const double r2 = r * r;
    double sp = 1.0 / 6227020800.0; sp = sp * r2 - 1.0 / 39916800.0; sp = sp * r2 + 1.0 / 362880.0; sp = sp * r2 - 1.0 / 5040.0; sp = sp * r2 + 1.0 / 120.0; sp = sp * r2 - 1.0 / 6.0; sp = sp * r2 * r + r;
    double cp = 1.0 / 479001600.0; cp = cp * r2 - 1.0 / 3628800.0; cp = cp * r2 + 1.0 / 40320.0; cp = cp * r2 - 1.0 / 720.0; cp = cp * r2 + 1.0 / 24.0; cp = cp * r2 - 0.5; cp = cp * r2 + 1.0;
    const int qi = ((int)q) & 3;
    const double s = (qi == 0) ? sp : (qi == 1) ? cp : (qi == 2) ? -sp : -cp;
    const double c = (qi == 0) ? cp : (qi == 1) ? -sp : (qi == 2) ? -cp : sp;
    sn = (float)s; cs = (float)c;
}
__device__ __forceinline__ void p0_prologue(Frame& F, int qslot) {
    PHASE_IDS();
    const int gt = F.wg * (NWAVES * 64) + tid, NGT = F.G * NWAVES * 64;
    for (int c = gt; c < 1024; c += NGT) {
        const float a0 = F.lb_logits[c], a1 = F.lb_logits[1024 + c], a2 = F.lb_logits[2048 + c], a3 = F.lb_logits[3072 + c];
        const float mx = fmaxf(fmaxf(a0, a1), fmaxf(a2, a3));
        const float e0 = expf(a0 - mx), e1 = expf(a1 - mx), e2 = expf(a2 - mx), e3 = expf(a3 - mx), inv = 1.0f / (e0 + e1 + e2 + e3);
        F.LB[c] = 0.f; F.LB[1024 + c] = e1 * inv; F.LB[2048 + c] = (e1 + e2) * inv; F.LB[3072 + c] = (e1 + e2 + e3) * inv;
    }
    for (int i = gt; i < SEQ * 128; i += NGT) {
        const int pos = i >> 7, j = i & 127;
        const float t = (float)j * (1.0f / 127.0f);
        const float invf = (float)(1.0 / exp((double)t * 9.21034037197618271));
        const float ang = (float)pos * invf;
        float sn, cs; sincos_acc(ang, sn, cs);
        F.RC[i] = cs; F.RS[i] = sn;
    }
    { const f32x4* s0 = (const f32x4*)F.x_prompt; const f32x4* s1 = (const f32x4*)F.x_sample; f32x4* d = (f32x4*)F.X;
      const int n0 = SEQ * DM / 4, n1 = DECB * DECS * DM / 4;
      for (int i = gt; i < n0; i += NGT) d[i] = s0[i];
      for (int i = gt; i < n1; i += NGT) d[n0 + i] = s1[i]; }
    for (int task = F.wg; task < DEPTH * 48; task += F.G) p0_mod_task(F, task);
    LAS float* scr = (LAS float*)(F.lds + wave * 16384);
    constexpr int I_IN = (DM / 64) * (NPROJ / 32), I_OUT = (DM / 64) * (DM / 32), I_UP = (DM / 64) * (DFF / 32), I_DN = (DFF / 64) * (DM / 32);
    constexpr int I_LAYER = I_IN + I_OUT + I_UP + I_DN, NITEMS = DEPTH * I_LAYER;
    for (;;) {
        int base = 0; if (lane == 0) base = (int)atomicAdd(F.ctl + CW_Q0 + 64 * qslot, 8u);
        base = __builtin_amdgcn_readfirstlane(base);
        if (base >= NITEMS) break;
        for (int it = base; it < base + 8 && it < NITEMS; ++it) {
            const int l = it / I_LAYER; int r = it % I_LAYER;
            if (r < I_IN) { p0_transpose_item(F.w_in + (size_t)l * DM * NPROJ, DM, NPROJ, F.Win_t + (size_t)l * NPROJ * DM, scr, r, lane); continue; } r -= I_IN;
            if (r < I_OUT) { p0_transpose_item(F.w_out + (size_t)l * DM * DM, DM, DM, F.Wout_t + (size_t)l * DM * DM, scr, r, lane); continue; } r -= I_OUT;
            if (r < I_UP) { p0_transpose_item(F.w_up + (size_t)l * DM * DFF, DM, DFF, F.Wup_t + (size_t)l * DFF * DM, scr, r, lane); continue; } r -= I_UP;
            p0_transpose_item(F.w_down + (size_t)l * DFF * DM, DFF, DM, F.Wdn_t + (size_t)l * DM * DFF, scr, r, lane);
        }
    }
}
template <bool FINAL>
__device__ __forceinline__ void norm_rows(Frame& F, const float* g, int l, int which_sh  , int nslab, int slab_l, int slab_which) {
    PHASE_IDS();
    const int gw = F.wg * NWAVES + wave, NGW = F.G * NWAVES;
    for (int m = gw; m < SEQ; m += NGW) {
        const f32x4* xr = (const f32x4*)(F.X + (size_t)m * DM) + lane;
        f32x4 v[8]; float ss = 0.f;
#pragma unroll
        for (int j = 0; j < 8; ++j) { v[j] = xr[64 * j]; ss += (v[j].x * v[j].x + v[j].y * v[j].y) + (v[j].z * v[j].z + v[j].w * v[j].w); }
        const float rstd = 1.0f / sqrtf(wave_sum(ss) * (1.0f / DM) + EPS);
        const f32x4* gp = (const f32x4*)g + lane;
        if (FINAL) { f32x4* o = (f32x4*)(F.out + (size_t)m * DM) + lane;
#pragma unroll
            for (int j = 0; j < 8; ++j) o[64 * j] = v[j] * rstd * gp[64 * j];
        } else {
            const float* mod = F.MOD + (size_t)l * NMOD;
            const f32x4* shp = (const f32x4*)(mod + which_sh * DM) + lane; const f32x4* scp = (const f32x4*)(mod + (which_sh + 1) * DM) + lane;
            v2u* o8 = (v2u*)(F.H + (size_t)m * DM) + lane;
#pragma unroll
            for (int j = 0; j < 8; ++j) { const f32x4 gg = gp[64 * j], sh = shp[64 * j], sc = scp[64 * j];
                const f32x4 h = v[j] * rstd * gg * (sc + 1.0f) + sh;
                v2u w; w.x = pk2(h.x, h.y); w.y = pk2(h.z, h.w); o8[64 * j] = w; }
        }
    }
    LAS float* red = (LAS float*)F.lds;
    for (int r = F.wg; r < DECB * DECS; r += F.G) {
        const int m = SEQ + r, idx = 64 * wave + lane, sq = 1 + (r >> 6);
        f32x4 v = *((const f32x4*)(F.X + (size_t)m * DM) + idx);
        if (nslab > 0) {
            const f32x4* sp = (const f32x4*)((const float*)(F.ws + WS_SLAB) + (size_t)r * DM) + idx;
            f32x4 a = (f32x4){0.f, 0.f, 0.f, 0.f};
            if (nslab == 16) {
#pragma unroll
                for (int s = 0; s < 16; ++s) a += sp[(size_t)s * (512 * DM / 4)];
            } else {
#pragma unroll
                for (int s = 0; s < 8; ++s) a += sp[(size_t)s * (512 * DM / 4)];
            }
            const f32x4 gv = *((const f32x4*)(F.MOD + (size_t)(sq * DEPTH + slab_l) * NMOD + slab_which * DM) + idx);
            v += gv * a;
            *((f32x4*)(F.X + (size_t)m * DM) + idx) = v;
        }
        const float ss = wave_sum((v.x * v.x + v.y * v.y) + (v.z * v.z + v.w * v.w));
        __syncthreads();
        if (lane == 0) red[wave] = ss;
        __syncthreads();
        float tot = 0.f;
#pragma unroll
        for (int w = 0; w < 8; ++w) tot += red[w];
        const float rstd = 1.0f / sqrtf(tot * (1.0f / DM) + EPS);
        const f32x4 gg = *((const f32x4*)g + idx);
        if (FINAL) { *((f32x4*)(F.out + (size_t)m * DM) + idx) = v * rstd * gg; }
        else {
            const float* mod = F.MOD + (size_t)(sq * DEPTH + l) * NMOD;
            const f32x4 sh = *((const f32x4*)(mod + which_sh * DM) + idx), sc = *((const f32x4*)(mod + (which_sh + 1) * DM) + idx);
            const f32x4 h = v * rstd * gg * (sc + 1.0f) + sh;
            v2u w; w.x = pk2(h.x, h.y); w.y = pk2(h.z, h.w); *((v2u*)(F.H + (size_t)m * DM) + idx) = w;
        }
    }
    __syncthreads();
}
constexpr int NSG = 40;
constexpr size_t WS_UA = WS_END;
constexpr size_t WS_DGA = WS_UA + 20 * MiB;
constexpr size_t WS_SSA = WS_DGA + 1 * MiB;
constexpr size_t WS_UB = WS_SSA + 20 * MiB;
constexpr size_t WS_SSB = WS_UB + 40 * MiB;
constexpr size_t WS_END2 = WS_SSB + 20 * MiB;

constexpr int MX_KHT = 0, MX_VT = 18432, MX_QT = 36864, MX_KT = 54272, MX_QH = 71680, MX_A = 89088, MX_EDEC = 98304, MX_RED = 98816, MX_B = 100864, MX_QTOT = 133632  ;
constexpr int RX_Q = 0, RX_K = 33792, RX_VT = 67584, RX_A = 104448, RX_RED = 113664;
constexpr float LOG2E = 1.4426950408889634f;

__device__ __forceinline__ bf16x8 ldfrag(LAS unsigned char* base, int ld_bytes, int row, int kbyte) { return *(const LAS bf16x8*)(base + row * ld_bytes + kbyte); }
__device__ __forceinline__ int tr_off(int row, int tokpair) { return row * 144 + ((((tokpair >> 2) ^ (row >> 3)) & 7) << 4) + ((tokpair & 3) << 2); }
__device__ __forceinline__ bf16x8 tr_frag(LAS unsigned char* base, int row, int chunk) { return *(const LAS bf16x8*)(base + row * 144 + (((chunk ^ (row >> 3)) & 7) << 4)); }
__device__ __forceinline__ float gamma_log2(int h) { return log2f(1.0f - exp2f(-5.0f - (float)h)); }
__device__ __forceinline__ int sg_row0(int sg) { return sg < 32 ? sg * 256 : SEQ + 64 * (sg - 32); }
__device__ __forceinline__ int sg_nch(int sg) { return sg < 32 ? 4 : 1; }

template <bool IS_RET>
__device__ __forceinline__ void p1_unit(Frame& F, int l, int sg, int h, int quad) {
    PHASE_IDS();
    const int g4 = lane >> 4, l16 = lane & 15;
    const int row0 = sg_row0(sg), nch = sg_nch(sg);
    const int kb = quad >> 1, vb = quad & 1;
    const int ck = IS_RET ? 5120 + h * 256 + 128 * kb : 1024 + h * 128;
    const int cv = IS_RET ? 6144 + h * 256 + 128 * vb : 2048 + h * 128;
    LAS unsigned char* L = F.lds;
    LAS float* Edec = (LAS float*)(L + MX_EDEC);
    const float lg2 = gamma_log2(h);
    f32x4 S[8];
#pragma unroll
    for (int kt = 0; kt < 8; ++kt) S[kt] = (f32x4){0.f, 0.f, 0.f, 0.f};
    float sumb = 0.f;
    const int tp = tid >> 4, kc = tid & 15;
    v4u ka, kbv, va, vbv; f32x4 ba0, ba1, bb0, bb1, bt0, bt1; float btk = 0.f;
#define P1_LOAD(rowc_) do { const int ra_ = (rowc_) + 2 * tp; \
        ka = *(const v4u*)(F.P + (size_t)ra_ * 8192 + ck + 8 * kc); kbv = *(const v4u*)(F.P + (size_t)(ra_ + 1) * 8192 + ck + 8 * kc); \
        va = *(const v4u*)(F.P + (size_t)ra_ * 8192 + cv + 8 * kc); vbv = *(const v4u*)(F.P + (size_t)(ra_ + 1) * 8192 + cv + 8 * kc); \
        if (!IS_RET) { const float* la_ = F.LF + (size_t)ra_ * 1024 + h * 128 + 8 * kc; const float* lt_ = F.LF + (size_t)((rowc_) + 63) * 1024 + h * 128; \
            ba0 = *(const f32x4*)la_; ba1 = *(const f32x4*)(la_ + 4); bb0 = *(const f32x4*)(la_ + 1024); bb1 = *(const f32x4*)(la_ + 1028); bt0 = *(const f32x4*)(lt_ + 8 * kc); bt1 = *(const f32x4*)(lt_ + 8 * kc + 4); \
            if (tid < 128) btk = lt_[tid]; } } while (0)
    P1_LOAD(row0);
    for (int c = 0; c < nch; ++c) {
        {
            float fa[8], fb[8];
            if (IS_RET) {
                const float za = exp2f(lg2 * (float)(63 - 2 * tp)), zb = exp2f(lg2 * (float)(62 - 2 * tp));
#pragma unroll
                for (int i = 0; i < 8; ++i) { fa[i] = za; fb[i] = zb; }
                if (tid < 128) Edec[tid] = exp2f(lg2 * 64.0f);
            } else {
#pragma unroll
                for (int i = 0; i < 8; ++i) { const float bt = (i < 4) ? bt0[i & 3] : bt1[i & 3], ba = (i < 4) ? ba0[i & 3] : ba1[i & 3], bb = (i < 4) ? bb0[i & 3] : bb1[i & 3];
                    fa[i] = exp2f((bt - ba) * LOG2E); fb[i] = exp2f((bt - bb) * LOG2E);
                    if (tp == 0) Edec[8 * kc + i] = exp2f(bt * LOG2E); }
                if (tid < 128) sumb += btk;
            }
#pragma unroll
            for (int i = 0; i < 8; ++i) {
                const unsigned wa = ka[i >> 1], wb = kbv[i >> 1];
                const float xa = (i & 1) ? bfhi(wa) : bflo(wa), xb = (i & 1) ? bfhi(wb) : bflo(wb);
                *(LAS unsigned*)(L + MX_KHT + tr_off(8 * kc + i, tp)) = pk2(xa * fa[i], xb * fb[i]);
                const unsigned ua = va[i >> 1], ub = vbv[i >> 1];
                const unsigned lo = (i & 1) ? (ua >> 16) : (ua & 0xffffu), hi = (i & 1) ? (ub >> 16) : (ub & 0xffffu);
                *(LAS unsigned*)(L + MX_VT + tr_off(8 * kc + i, tp)) = lo | (hi << 16);
            }
        }
        __syncthreads();
        if (c + 1 < nch) P1_LOAD(row0 + 64 * (c + 1));
        {
            bf16x8 Y[2];
#pragma unroll
            for (int ss = 0; ss < 2; ++ss) Y[ss] = tr_frag(L + MX_VT, 16 * wave + l16, 4 * ss + g4);
#pragma unroll
            for (int kt = 0; kt < 8; ++kt) {
                const f32x4 d = *(const LAS f32x4*)(Edec + 16 * kt + 4 * g4);
                S[kt] = S[kt] * d;
#pragma unroll
                for (int ss = 0; ss < 2; ++ss) { const bf16x8 X = tr_frag(L + MX_KHT, 16 * kt + l16, 4 * ss + g4); S[kt] = __builtin_amdgcn_mfma_f32_16x16x32_bf16(X, Y[ss], S[kt], 0, 0, 0); }
            }
        }
        __syncthreads();
    }
#undef P1_LOAD
    if (IS_RET) {
        float* U = (float*)(F.ws + WS_UB) + ((size_t)(sg * HB + h) * 256 + 128 * vb + 16 * wave + l16) * 256 + 128 * kb + 4 * g4;
#pragma unroll
        for (int kt = 0; kt < 8; ++kt) *(f32x4*)(U + 16 * kt) = S[kt];
    } else {
        float* U = (float*)(F.ws + WS_UA) + ((size_t)(sg * HA + h) * 128 + 16 * wave + l16) * 128 + 4 * g4;
#pragma unroll
        for (int kt = 0; kt < 8; ++kt) *(f32x4*)(U + 16 * kt) = S[kt];
        if (tid < 128) ((float*)(F.ws + WS_DGA))[(size_t)(sg * HA + h) * 128 + tid] = exp2f(sumb * LOG2E);
    }
}
__device__ __forceinline__ void mix1_phase(Frame& F, int l) {
    for (int u = F.wg; u < 960; u += F.G) {
        bool is_ret; int sg, h, quad = 0;
        if (u < 256) { is_ret = false; sg = u >> 3; h = u & 7; }
        else if (u < 768) { const int r = u - 256; is_ret = true; sg = r >> 4; h = (r >> 2) & 3; quad = r & 3; }
        else if (u < 832) { const int r = u - 768; is_ret = false; sg = 32 + (r >> 3); h = r & 7; }
        else { const int r = u - 832; is_ret = true; sg = 32 + (r >> 4); h = (r >> 2) & 3; quad = r & 3; }
        if (is_ret) p1_unit<true>(F, l, sg, h, quad); else p1_unit<false>(F, l, sg, h, quad);
    }
}

__device__ __forceinline__ void mix2_phase(Frame& F, int l) {
    PHASE_IDS();
    const int gt = F.wg * (NWAVES * 64) + tid, NGT = F.G * NWAVES * 64;
    constexpr int IA = 128 * 32, IB = 256 * 64, PER_SEQ = HA * IA + HB * IB;
    for (int it = gt; it < NSEQ * PER_SEQ; it += NGT) {
        const int seq = it / PER_SEQ; int r = it % PER_SEQ;
        const int ng = seq == 0 ? 32 : 1, sg0 = seq == 0 ? 0 : 31 + seq;
        if (r < HA * IA) {
            const int h = r / IA, v = (r % IA) >> 5, k4 = r & 31;
            f32x4 s = (f32x4){0.f, 0.f, 0.f, 0.f};
            if (seq > 0) { const float* s0 = F.state_hgrn + ((size_t)((l * DECB + (seq - 1)) * HA + h) * 128) * 128;
#pragma unroll
                for (int e = 0; e < 4; ++e) s[e] = s0[(size_t)(4 * k4 + e) * 128 + v]; }
            for (int g0 = 0; g0 < ng; g0 += 8) {
                f32x4 u[8], d[8];
#pragma unroll
                for (int i = 0; i < 8; ++i) if (g0 + i < ng) { const size_t ub = (size_t)((sg0 + g0 + i) * HA + h);
                    u[i] = *(const f32x4*)((const float*)(F.ws + WS_UA) + (ub * 128 + v) * 128 + 4 * k4); d[i] = *(const f32x4*)((const float*)(F.ws + WS_DGA) + ub * 128 + 4 * k4); }
#pragma unroll
                for (int i = 0; i < 8; ++i) if (g0 + i < ng) { const size_t ub = (size_t)((sg0 + g0 + i) * HA + h);
                    *(f32x4*)((float*)(F.ws + WS_SSA) + (ub * 128 + v) * 128 + 4 * k4) = s; s = d[i] * s + u[i]; }
            }
            float* dst = F.out + (seq == 0 ? OFF_SA_P + ((size_t)(l * HA + h) * 128) * 128 : OFF_SA_S + ((size_t)((l * DECB + (seq - 1)) * HA + h) * 128) * 128);
#pragma unroll
            for (int e = 0; e < 4; ++e) dst[(size_t)(4 * k4 + e) * 128 + v] = s[e];
        } else {
            r -= HA * IA;
            const int h = r / IB, v = (r % IB) >> 6, k4 = r & 63;
            const float lg2 = gamma_log2(h); const float gd = exp2f(lg2 * (seq == 0 ? 256.0f : 64.0f));
            f32x4 s = (f32x4){0.f, 0.f, 0.f, 0.f};
            if (seq > 0) { const float* s0 = F.state_ret + ((size_t)((l * DECB + (seq - 1)) * HB + h) * 256) * 256;
#pragma unroll
                for (int e = 0; e < 4; ++e) s[e] = s0[(size_t)(4 * k4 + e) * 256 + v]; }
            for (int g0 = 0; g0 < ng; g0 += 8) {
                f32x4 u[8];
#pragma unroll
                for (int i = 0; i < 8; ++i) if (g0 + i < ng) { const size_t ub = (size_t)((sg0 + g0 + i) * HB + h); u[i] = *(const f32x4*)((const float*)(F.ws + WS_UB) + (ub * 256 + v) * 256 + 4 * k4); }
#pragma unroll
                for (int i = 0; i < 8; ++i) if (g0 + i < ng) { const size_t ub = (size_t)((sg0 + g0 + i) * HB + h);
                    v2u w; w.x = pk2(s[0], s[1]); w.y = pk2(s[2], s[3]);
                    *(v2u*)((bf16*)(F.ws + WS_SSB) + (ub * 256 + v) * 256 + 4 * k4) = w; s = s * gd + u[i]; }
            }
            float* dst = F.out + (seq == 0 ? OFF_SB_P + ((size_t)(l * HB + h) * 256) * 256 : OFF_SB_S + ((size_t)((l * DECB + (seq - 1)) * HB + h) * 256) * 256);
#pragma unroll
            for (int e = 0; e < 4; ++e) dst[(size_t)(4 * k4 + e) * 256 + v] = s[e];
        }
    }
}
typedef short bf16x4 __attribute__((ext_vector_type(4)));
__device__ __forceinline__ float clampf(float x, float lo, float hi) { return fminf(fmaxf(x, lo), hi); }
__device__ __forceinline__ void p3_hgrn_unit(Frame& F, int l, int sg, int h) {
    PHASE_IDS();
    const int g4 = lane >> 4, l16 = lane & 15;
    const int row0 = sg_row0(sg), nch = sg_nch(sg);
    LAS unsigned char* L = F.lds;
    LAS float* Edec = (LAS float*)(L + MX_EDEC); LAS float* Red = (LAS float*)(L + MX_RED);
    f32x4 S[8];
    { const float* ss = (const float*)(F.ws + WS_SSA) + ((size_t)(sg * HA + h) * 128 + 16 * wave + l16) * 128 + 4 * g4;
#pragma unroll
      for (int kt = 0; kt < 8; ++kt) S[kt] = *(const f32x4*)(ss + 16 * kt); }
    const f32x4 gn4 = *(const f32x4*)(F.hgrn_g + l * 1024 + h * 128 + 16 * wave + 4 * g4);
    const int tp = tid >> 4, kc = tid & 15;
    v4u qa, qb, ka, kb, va, vb; f32x4 ba0, ba1, bb0, bb1, br0, br1, bt0, bt1;
#define P3H_LOAD(rowc_) do { const int ra_ = (rowc_) + 2 * tp; const bf16* pa_ = F.P + (size_t)ra_ * 8192 + h * 128 + 8 * kc; const bf16* pb_ = pa_ + 8192; \
        qa = *(const v4u*)pa_; qb = *(const v4u*)pb_; ka = *(const v4u*)(pa_ + 1024); kb = *(const v4u*)(pb_ + 1024); va = *(const v4u*)(pa_ + 2048); vb = *(const v4u*)(pb_ + 2048); \
        const float* la_ = F.LF + (size_t)ra_ * 1024 + h * 128 + 8 * kc; const float* lr_ = F.LF + (size_t)((rowc_) + 31) * 1024 + h * 128 + 8 * kc; const float* lt_ = lr_ + 32 * 1024; \
        ba0 = *(const f32x4*)la_; ba1 = *(const f32x4*)(la_ + 4); bb0 = *(const f32x4*)(la_ + 1024); bb1 = *(const f32x4*)(la_ + 1028); \
        br0 = *(const f32x4*)lr_; br1 = *(const f32x4*)(lr_ + 4); bt0 = *(const f32x4*)lt_; bt1 = *(const f32x4*)(lt_ + 4); } while (0)
    P3H_LOAD(row0);
    for (int c = 0; c < nch; ++c) {
        const int rowc = row0 + 64 * c;
        {
            unsigned qta[4], qtb[4], kta[4], ktb[4], qha[4], qhb[4];
            float pqa = 0.f, pqb = 0.f, pka = 0.f, pkb = 0.f, pha = 0.f, phb = 0.f;
#pragma unroll
            for (int i = 0; i < 8; ++i) {
                const float bref = (i < 4) ? br0[i & 3] : br1[i & 3], btot = (i < 4) ? bt0[i & 3] : bt1[i & 3];
                const float ba = (i < 4) ? ba0[i & 3] : ba1[i & 3], bb = (i < 4) ? bb0[i & 3] : bb1[i & 3];
                const float e1a = exp2f(clampf((ba - bref) * LOG2E, -115.f, 115.f)), e1b = exp2f(clampf((bb - bref) * LOG2E, -115.f, 115.f));
                const float e2a = __builtin_amdgcn_rcpf(e1a), e2b = __builtin_amdgcn_rcpf(e1b);
                const float eref = exp2f(bref * LOG2E), etr = exp2f((btot - bref) * LOG2E);
                const unsigned wqa = qa[i >> 1], wqb = qb[i >> 1], wka = ka[i >> 1], wkb = kb[i >> 1];
                const float xqa = (i & 1) ? bfhi(wqa) : bflo(wqa), xqb = (i & 1) ? bfhi(wqb) : bflo(wqb), xka = (i & 1) ? bfhi(wka) : bflo(wka), xkb = (i & 1) ? bfhi(wkb) : bflo(wkb);
                const float tqa = xqa * e1a, tqb = xqb * e1b, tka = xka * e2a, tkb = xkb * e2b;
                const float hqa = tqa * eref, hqb = tqb * eref;
                *(LAS unsigned*)(L + MX_KHT + tr_off(8 * kc + i, tp)) = pk2(tka * etr, tkb * etr);
                const unsigned ua = va[i >> 1], ub = vb[i >> 1];
                const unsigned lo = (i & 1) ? (ua >> 16) : (ua & 0xffffu), hi = (i & 1) ? (ub >> 16) : (ub & 0xffffu);
                *(LAS unsigned*)(L + MX_VT + tr_off(8 * kc + i, tp)) = lo | (hi << 16);
                if (tp == 0) Edec[8 * kc + i] = exp2f(btot * LOG2E);
                if (i & 1) { qta[i >> 1] = pk2(pqa, tqa); qtb[i >> 1] = pk2(pqb, tqb); kta[i >> 1] = pk2(pka, tka); ktb[i >> 1] = pk2(pkb, tkb); qha[i >> 1] = pk2(pha, hqa); qhb[i >> 1] = pk2(phb, hqb); }
                else { pqa = tqa; pqb = tqb; pka = tka; pkb = tkb; pha = hqa; phb = hqb; }
            }
            const int oa = (2 * tp) * 272 + 16 * kc, ob = oa + 272;
            *(LAS v4u*)(L + MX_QT + oa) = (v4u){qta[0], qta[1], qta[2], qta[3]}; *(LAS v4u*)(L + MX_QT + ob) = (v4u){qtb[0], qtb[1], qtb[2], qtb[3]};
            *(LAS v4u*)(L + MX_KT + oa) = (v4u){kta[0], kta[1], kta[2], kta[3]}; *(LAS v4u*)(L + MX_KT + ob) = (v4u){ktb[0], ktb[1], ktb[2], ktb[3]};
            *(LAS v4u*)(L + MX_QH + oa) = (v4u){qha[0], qha[1], qha[2], qha[3]}; *(LAS v4u*)(L + MX_QH + ob) = (v4u){qhb[0], qhb[1], qhb[2], qhb[3]};
        }
        __syncthreads();
        if (c + 1 < nch) P3H_LOAD(rowc + 64);
        {
            const int jt = wave >> 1;
#pragma unroll
            for (int ii = 0; ii < 2; ++ii) {
                const int it = 2 * (wave & 1) + ii;
                f32x4 a = (f32x4){0.f, 0.f, 0.f, 0.f};
                if (it <= jt) {
#pragma unroll
                    for (int kk = 0; kk < 4; ++kk) a = __builtin_amdgcn_mfma_f32_16x16x32_bf16(ldfrag(L + MX_KT, 272, 16 * it + l16, 64 * kk + 16 * g4), ldfrag(L + MX_QT, 272, 16 * jt + l16, 64 * kk + 16 * g4), a, 0, 0, 0);
                }
                const int t = 16 * jt + l16, s0 = 16 * it + 4 * g4;
                v2u w; w.x = pk2(s0 <= t ? a[0] : 0.f, s0 + 1 <= t ? a[1] : 0.f); w.y = pk2(s0 + 2 <= t ? a[2] : 0.f, s0 + 3 <= t ? a[3] : 0.f);
                if (it > jt) { w.x = 0u; w.y = 0u; }
                *(LAS v2u*)(L + MX_A + t * 144 + s0 * 2) = w;
            }
        }
        f32x4 o[4];
#pragma unroll
        for (int j = 0; j < 4; ++j) o[j] = (f32x4){0.f, 0.f, 0.f, 0.f};
#pragma unroll
        for (int kk = 0; kk < 4; ++kk) {
            const f32x4 s0 = S[2 * kk], s1 = S[2 * kk + 1];
            const v4u xw = (v4u){pk2(s0[0], s0[1]), pk2(s0[2], s0[3]), pk2(s1[0], s1[1]), pk2(s1[2], s1[3])};
            const bf16x8 X = __builtin_bit_cast(bf16x8, xw);
#pragma unroll
            for (int j = 0; j < 4; ++j) {
                const LAS unsigned char* qp = L + MX_QH + (16 * j + l16) * 272 + 64 * kk + 8 * g4;
                const bf16x4 y0 = *(const LAS bf16x4*)qp, y1 = *(const LAS bf16x4*)(qp + 32);
                const bf16x8 Y = __builtin_shufflevector(y0, y1, 0, 1, 2, 3, 4, 5, 6, 7);
                o[j] = __builtin_amdgcn_mfma_f32_16x16x32_bf16(X, Y, o[j], 0, 0, 0);
            }
        }
        __syncthreads();
        {
            bf16x8 Yv[2];
#pragma unroll
            for (int ss = 0; ss < 2; ++ss) Yv[ss] = tr_frag(L + MX_VT, 16 * wave + l16, 4 * ss + g4);
#pragma unroll
            for (int ss = 0; ss < 2; ++ss)
#pragma unroll
                for (int j = 0; j < 4; ++j) { if (ss == 1 && j < 2) continue;
                    o[j] = __builtin_amdgcn_mfma_f32_16x16x32_bf16(Yv[ss], ldfrag(L + MX_A, 144, 16 * j + l16, 64 * ss + 16 * g4), o[j], 0, 0, 0); }
            if (c + 1 < nch) {
#pragma unroll
                for (int kt = 0; kt < 8; ++kt) {
                    S[kt] = S[kt] * *(const LAS f32x4*)(Edec + 16 * kt + 4 * g4);
#pragma unroll
                    for (int ss = 0; ss < 2; ++ss) S[kt] = __builtin_amdgcn_mfma_f32_16x16x32_bf16(tr_frag(L + MX_KHT, 16 * kt + l16, 4 * ss + g4), Yv[ss], S[kt], 0, 0, 0);
                }
            }
        }
#pragma unroll
        for (int j = 0; j < 4; ++j) { float q = (o[j][0] * o[j][0] + o[j][1] * o[j][1]) + (o[j][2] * o[j][2] + o[j][3] * o[j][3]); q += __shfl_xor(q, 16); q += __shfl_xor(q, 32); if (g4 == 0) Red[wave * 64 + 16 * j + l16] = q; }
        __syncthreads();
#pragma unroll
        for (int j = 0; j < 4; ++j) {
            float tot = 0.f;
#pragma unroll
            for (int w = 0; w < 8; ++w) tot += Red[w * 64 + 16 * j + l16];
            const float rstd = 1.0f / sqrtf(tot * (1.0f / 128.0f) + EPS);
            const size_t row = rowc + 16 * j + l16;
            const v2u gw = *(const v2u*)(F.P + row * 8192 + 3072 + h * 128 + 16 * wave + 4 * g4);
            const f32x4 r = o[j] * rstd * gn4;
            v2u w; w.x = pk2(r[0] * bflo(gw.x), r[1] * bfhi(gw.x)); w.y = pk2(r[2] * bflo(gw.y), r[3] * bfhi(gw.y));
            *(v2u*)(F.O + row * 2048 + h * 128 + 16 * wave + 4 * g4) = w;
        }
        __syncthreads();
    }
#undef P3H_LOAD
}
__device__ __forceinline__ void p3_ret_unit(Frame& F, int l, int sg, int jc, int h) {
    PHASE_IDS();
    const int g4 = lane >> 4, l16 = lane & 15;
    const int rowg = sg_row0(sg), rowq = rowg + 64 * jc;
    LAS unsigned char* L = F.lds;
    LAS float* Red = (LAS float*)(L + RX_RED);
    const float lg2 = gamma_log2(h);
    const int tp = tid >> 4, kc = tid & 15;
    const int oa = (2 * tp) * 528 + 16 * kc;
    v4u k0, k1, k2, k3, v0, v1, v2, v3;
#define P3R_LOADKV(jp_) do { const bf16* pa_ = F.P + (size_t)(rowg + 64 * (jp_) + 2 * tp) * 8192 + 5120 + h * 256 + 8 * kc; const bf16* pb_ = pa_ + 8192; \
        k0 = *(const v4u*)pa_; k1 = *(const v4u*)(pa_ + 128); k2 = *(const v4u*)pb_; k3 = *(const v4u*)(pb_ + 128); \
        v0 = *(const v4u*)(pa_ + 1024); v1 = *(const v4u*)(pa_ + 1024 + 128); v2 = *(const v4u*)(pb_ + 1024); v3 = *(const v4u*)(pb_ + 1024 + 128); } while (0)
#define P3R_STOREKV() do { *(LAS v4u*)(L + RX_K + oa) = k0; *(LAS v4u*)(L + RX_K + oa + 256) = k1; *(LAS v4u*)(L + RX_K + oa + 528) = k2; *(LAS v4u*)(L + RX_K + oa + 528 + 256) = k3; \
        _Pragma("unroll") for (int i = 0; i < 8; ++i) { \
            { const unsigned ua = v0[i >> 1], ub = v2[i >> 1]; const unsigned lo = (i & 1) ? (ua >> 16) : (ua & 0xffffu), hi = (i & 1) ? (ub >> 16) : (ub & 0xffffu); *(LAS unsigned*)(L + RX_VT + tr_off(8 * kc + i, tp)) = lo | (hi << 16); } \
            { const unsigned ua = v1[i >> 1], ub = v3[i >> 1]; const unsigned lo = (i & 1) ? (ua >> 16) : (ua & 0xffffu), hi = (i & 1) ? (ub >> 16) : (ub & 0xffffu); *(LAS unsigned*)(L + RX_VT + tr_off(128 + 8 * kc + i, tp)) = lo | (hi << 16); } } } while (0)
    bf16x8 X0[8], X1[8];
    {
        const bf16* pa = F.P + (size_t)(rowq + 2 * tp) * 8192 + 4096 + h * 256 + 8 * kc; const bf16* pb = pa + 8192;
        const v4u a0 = *(const v4u*)pa, a1 = *(const v4u*)(pa + 128), b0 = *(const v4u*)pb, b1 = *(const v4u*)(pb + 128);
        P3R_LOADKV(0);
        const bf16* sp = (const bf16*)(F.ws + WS_SSB) + ((size_t)(sg * HB + h) * 256 + 32 * wave + l16) * 256 + 8 * g4;
#pragma unroll
        for (int kk = 0; kk < 8; ++kk) { X0[kk] = *(const bf16x8*)(sp + 32 * kk); X1[kk] = *(const bf16x8*)(sp + (size_t)16 * 256 + 32 * kk); }
        *(LAS v4u*)(L + RX_Q + oa) = a0; *(LAS v4u*)(L + RX_Q + oa + 256) = a1; *(LAS v4u*)(L + RX_Q + oa + 528) = b0; *(LAS v4u*)(L + RX_Q + oa + 528 + 256) = b1;
        P3R_STOREKV();
    }
    f32x4 acc[2][4];
#pragma unroll
    for (int vt = 0; vt < 2; ++vt)
#pragma unroll
        for (int j = 0; j < 4; ++j) acc[vt][j] = (f32x4){0.f, 0.f, 0.f, 0.f};
    __syncthreads();
    if (jc > 0) P3R_LOADKV(1);
    {
#pragma unroll
        for (int kk = 0; kk < 8; ++kk)
#pragma unroll
            for (int j = 0; j < 4; ++j) { const bf16x8 Y = ldfrag(L + RX_Q, 528, 16 * j + l16, 64 * kk + 16 * g4);
                acc[0][j] = __builtin_amdgcn_mfma_f32_16x16x32_bf16(X0[kk], Y, acc[0][j], 0, 0, 0); acc[1][j] = __builtin_amdgcn_mfma_f32_16x16x32_bf16(X1[kk], Y, acc[1][j], 0, 0, 0); }
#pragma unroll
        for (int j = 0; j < 4; ++j) { const float xi = exp2f(lg2 * (float)(64 * jc + 16 * j + l16 + 1)); acc[0][j] = acc[0][j] * xi; acc[1][j] = acc[1][j] * xi; }
    }
    for (int jp = 0; jp <= jc; ++jp) {
        {
            const int jt = wave >> 1; const bool diag = (jp == jc);
#pragma unroll
            for (int ii = 0; ii < 2; ++ii) {
                const int it = 2 * (wave & 1) + ii;
                f32x4 a = (f32x4){0.f, 0.f, 0.f, 0.f};
                const bool live = !(diag && it > jt);
                if (live) {
#pragma unroll
                    for (int kk = 0; kk < 8; ++kk) a = __builtin_amdgcn_mfma_f32_16x16x32_bf16(ldfrag(L + RX_K, 528, 16 * it + l16, 64 * kk + 16 * g4), ldfrag(L + RX_Q, 528, 16 * jt + l16, 64 * kk + 16 * g4), a, 0, 0, 0);
                }
                const int t = 16 * jt + l16, s0 = 16 * it + 4 * g4; const int dd = 64 * (jc - jp) + t - s0;
                float e[4];
#pragma unroll
                for (int r = 0; r < 4; ++r) { const float dec = exp2f(lg2 * (float)(dd - r)); e[r] = (!diag || s0 + r <= t) ? a[r] * dec : 0.f; }
                v2u w; w.x = pk2(e[0], e[1]); w.y = pk2(e[2], e[3]);
                if (!live) { w.x = 0u; w.y = 0u; }
                *(LAS v2u*)(L + RX_A + t * 144 + s0 * 2) = w;
            }
        }
        __syncthreads();
#pragma unroll
        for (int ss = 0; ss < 2; ++ss)
#pragma unroll
            for (int vt = 0; vt < 2; ++vt) { const bf16x8 X = tr_frag(L + RX_VT, 32 * wave + 16 * vt + l16, 4 * ss + g4);
#pragma unroll
                for (int j = 0; j < 4; ++j) acc[vt][j] = __builtin_amdgcn_mfma_f32_16x16x32_bf16(X, ldfrag(L + RX_A, 144, 16 * j + l16, 64 * ss + 16 * g4), acc[vt][j], 0, 0, 0); }
        if (jp < jc) {
            __syncthreads();
            P3R_STOREKV();
            __syncthreads();
            if (jp + 2 <= jc) P3R_LOADKV(jp + 2);
        }
    }
#undef P3R_LOADKV
#undef P3R_STOREKV
#pragma unroll
    for (int j = 0; j < 4; ++j) { float q = 0.f;
#pragma unroll
        for (int vt = 0; vt < 2; ++vt) q += (acc[vt][j][0] * acc[vt][j][0] + acc[vt][j][1] * acc[vt][j][1]) + (acc[vt][j][2] * acc[vt][j][2] + acc[vt][j][3] * acc[vt][j][3]);
        q += __shfl_xor(q, 16); q += __shfl_xor(q, 32); if (g4 == 0) Red[wave * 64 + 16 * j + l16] = q; }
    __syncthreads();
#pragma unroll
    for (int j = 0; j < 4; ++j) {
        float tot = 0.f;
#pragma unroll
        for (int w = 0; w < 8; ++w) tot += Red[w * 64 + 16 * j + l16];
        const float rstd = 1.0f / sqrtf(tot * (1.0f / 256.0f) + EPS);
        const size_t row = rowq + 16 * j + l16;
#pragma unroll
        for (int vt = 0; vt < 2; ++vt) {
            const int vc = h * 256 + 32 * wave + 16 * vt + 4 * g4;
            const v2u gw = *(const v2u*)(F.P + row * 8192 + 7168 + vc);
            const f32x4 r = acc[vt][j] * rstd * *(const f32x4*)(F.ret_g + l * 1024 + vc);
            v2u w; w.x = pk2(r[0] * bflo(gw.x), r[1] * bfhi(gw.x)); w.y = pk2(r[2] * bflo(gw.y), r[3] * bfhi(gw.y));
            *(v2u*)(F.O + row * 2048 + 1024 + vc) = w;
        }
    }
    __syncthreads();
}
__device__ __forceinline__ void mix3_phase(Frame& F, int l) {
    for (int vw = F.wg; vw < 256; vw += F.G) {
        for (int q = 0; q < 2; ++q) {
            if (q == 1 && vw >= 64) break;
            const int sg = q == 0 ? (vw >> 3) : 32 + (vw >> 3);
            p3_hgrn_unit(F, l, sg, vw & 7);
        }
        for (int q = 0; q < 3; ++q) {
            int sg, jc, h;
            if (q < 2) { h = vw & 3; sg = (vw >> 2) & 31; const int half = vw >> 7; jc = q == 0 ? (half ? 2 : 3) : (half ? 1 : 0); }
            else { if (vw < 64 || vw >= 96) break; sg = 32 + ((vw - 64) >> 2); jc = 0; h = (vw - 64) & 3; }
            p3_ret_unit(F, l, sg, jc, h);
        }
    }
}
constexpr int PH_PRO = 0, PH_PER_LAYER = 9, PH_FINAL = 1 + DEPTH * PH_PER_LAYER, N_PHASES = PH_FINAL + 1;
struct Args { const float* in[18]; float* out; unsigned char* ws; int ph_lo, ph_hi; };
__global__ void __launch_bounds__(NWAVES * 64, 2) fwd(Args args) {
    extern __shared__ __attribute__((aligned(16))) unsigned char lds[];
    Frame F;
    F.lds = (LAS unsigned char*)lds;
    F.G = gridDim.x; F.wg = blockIdx.x;
    unsigned char* ws = args.ws;
    F.ctl = (unsigned*)(ws + WS_CTL); F.ws = ws;
    F.x_prompt = args.in[0]; F.x_sample = args.in[1]; F.state_hgrn = args.in[2]; F.state_ret = args.in[3]; F.c_prompt = args.in[4]; F.c_sample = args.in[5];
    F.lb_logits = args.in[6]; F.w_ada = args.in[7]; F.b_ada = args.in[8]; F.norm1_g = args.in[9]; F.norm2_g = args.in[10]; F.w_in = args.in[11];
    F.hgrn_g = args.in[12]; F.ret_g = args.in[13]; F.w_out = args.in[14]; F.w_up = args.in[15]; F.w_down = args.in[16]; F.final_g = args.in[17];
    F.out = args.out;
    F.Win_t = (bf16*)(ws + WS_WIN); F.Wout_t = (bf16*)(ws + WS_WOUT); F.Wup_t = (bf16*)(ws + WS_WUP); F.Wdn_t = (bf16*)(ws + WS_WDN);
    F.X = (float*)(ws + WS_X); F.H = (bf16*)(ws + WS_H); F.P = (bf16*)(ws + WS_P); F.LF = (float*)(ws + WS_LF); F.O = (bf16*)(ws + WS_O); F.U = (bf16*)(ws + WS_U);
    F.MOD = (float*)(ws + WS_MOD); F.LB = (float*)(ws + WS_LB); F.RC = (float*)(ws + WS_ROPE); F.RS = F.RC + SEQ * 128;
    volatile LAS unsigned* MISC = (volatile LAS unsigned*)(F.lds + MISC_OFF);
    if (threadIdx.x < 64) MISC[threadIdx.x] = 0u;
    __syncthreads();
    const int lo = args.ph_lo, hi = args.ph_hi;
    XcdBarrier bar; bar.bar = F.ctl + CW_BAR; bar.x = 0; bar.st = MISC + 8;
    if (hi - lo > 1) bar = xcd_barrier_post(F.ctl + CW_BAR, MISC + 8);
#define IN(k) (lo <= (k) && (k) < hi)
#define SEAM(k) do { if (IN(k) && IN((k) + 1)) xcd_barrier(bar); } while (0)

    if (IN(PH_PRO)) {
#ifndef SKIP_PRO
 p0_prologue(F, 0);
#endif
#ifdef PROBE_PRO
 __syncthreads(); p0_prologue(F, 1);
#endif
 } SEAM(PH_PRO);
    for (int l = 0; l < DEPTH; ++l) {
        const int pb = 1 + l * PH_PER_LAYER;
        if (IN(pb + 0)) {
#ifndef SKIP_NORM
 norm_rows<false>(F, F.norm1_g + l * DM, l, 0, l > 0 ? 16 : 0, l - 1, 5);
#endif
 } SEAM(pb + 0);
        if (IN(pb + 1)) {
            pg8::Gemm g{F.H, F.Win_t + (size_t)l * NPROJ * DM, M, NPROJ, DM};
            pg8::EpiInProj E{F.P, F.LF, F.LB + l * 1024, F.RC, F.RS};
            { pg8::StaticOrder S; S.init(M, NPROJ, DM, F.G, F.wg); pg8::gemm_phase<pg8::EpiInProj, pg8::StaticOrder, true, true, 0>(F.lds + RING_OFF, g, S, E); }
#ifdef PROBE_SAMETILE
            { xcd_barrier(bar); pg8::SameTileOrder S; S.init(M, NPROJ, DM, F.G, F.wg); pg8::EpiProbe E2{F.U, DFF}; pg8::gemm_phase<pg8::EpiProbe, pg8::SameTileOrder, true, true, 0>(F.lds + RING_OFF, g, S, E2); }
#endif
        } SEAM(pb + 1);
        if (IN(pb + 2)) { mix1_phase(F, l); } SEAM(pb + 2);
#ifdef PROBE_MIX1
        mix1_phase(F, l); xcd_barrier(bar);
#endif
        if (IN(pb + 3)) { mix2_phase(F, l); } SEAM(pb + 3);
#ifdef PROBE_MIX2
        mix2_phase(F, l); xcd_barrier(bar);
#endif
        if (IN(pb + 4)) { mix3_phase(F, l); } SEAM(pb + 4);
#ifdef PROBE_MIX3
        mix3_phase(F, l); xcd_barrier(bar);
#endif
        if (IN(pb + 5)) {
            pg8::Gemm g{F.O, F.Wout_t + (size_t)l * DM * DM, M, DM, DM}; pg8::ResidOrder S; S.init(DM, 8, F.G, F.wg);
            pg8::EpiResid E{F.X, F.MOD + (size_t)l * NMOD + 2 * DM, (float*)(F.ws + WS_SLAB)};
#ifndef SKIP_G2
            pg8::gemm_phase<pg8::EpiResid, pg8::ResidOrder, true, true>(F.lds + RING_OFF, g, S, E);
#endif
        } SEAM(pb + 5);
        if (IN(pb + 6)) {
#ifndef SKIP_NORM
 norm_rows<false>(F, F.norm2_g + l * DM, l, 3, 8, l, 2);
#endif
 } SEAM(pb + 6);
        if (IN(pb + 7)) {
            pg8::Gemm g{F.H, F.Wup_t + (size_t)l * DFF * DM, M, DFF, DM};
            pg8::EpiRelu2 E{F.U, DFF};
            { pg8::StaticOrder S; S.init(M, DFF, DM, F.G, F.wg); pg8::gemm_phase<pg8::EpiRelu2, pg8::StaticOrder, true, true, 0>(F.lds + RING_OFF, g, S, E); }
        } SEAM(pb + 7);
        if (IN(pb + 8)) {
            pg8::Gemm g{F.U, F.Wdn_t + (size_t)l * DM * DFF, M, DM, DFF}; pg8::ResidOrder S; S.init(DFF, 16, F.G, F.wg);
            pg8::EpiResid E{F.X, F.MOD + (size_t)l * NMOD + 5 * DM, (float*)(F.ws + WS_SLAB)};
#ifndef SKIP_G4
            pg8::gemm_phase<pg8::EpiResid, pg8::ResidOrder, true, true>(F.lds + RING_OFF, g, S, E);
#endif
#ifdef PROBE_DOWN
            { xcd_barrier(bar); pg8::EpiResid E2{(float*)(F.ws + WS_P), F.MOD + (size_t)l * NMOD + 5 * DM, (float*)(F.ws + WS_SLAB)}; pg8::gemm_phase<pg8::EpiResid, pg8::ResidOrder, true, true>(F.lds + RING_OFF, g, S, E2); }
#endif
        } SEAM(pb + 8);
    }
    if (IN(PH_FINAL)) {
#ifndef SKIP_NORM
 norm_rows<true>(F, F.final_g, DEPTH - 1, 0, 16, DEPTH - 1, 5);
#endif
 }
#undef IN
#undef SEAM
}

#ifndef MK_ONE_LAUNCH
#define MK_ONE_LAUNCH 1
#endif
extern "C" void kernel_launch(void* const* d_in, const int* in_sizes, int n_in, void* d_out, int out_size, void* d_ws, size_t ws_size, hipStream_t stream) {
    static int grid = 0;
    if (grid == 0) {
        if (n_in != 18 || (size_t)out_size != OUT_TOTAL || ws_size < WS_END2) { fprintf(stderr, "kernel_launch: unexpected shapes: n_in %d out %d ws %zu (need %zu)\n", n_in, out_size, ws_size, (size_t)WS_END2); grid = -1; return; }
        int dev = 0, cus = 0, per_cu = 0;
        if (hipGetDevice(&dev) != hipSuccess || hipDeviceGetAttribute(&cus, hipDeviceAttributeMultiprocessorCount, dev) != hipSuccess) { grid = -1; return; }
        if (hipFuncSetAttribute((const void*)fwd, hipFuncAttributeMaxDynamicSharedMemorySize, LDS_BYTES) != hipSuccess) { fprintf(stderr, "kernel_launch: hipFuncSetAttribute failed\n"); grid = -1; return; }
        if (hipOccupancyMaxActiveBlocksPerMultiprocessor(&per_cu, (const void*)fwd, NWAVES * 64, LDS_BYTES) != hipSuccess || per_cu < 1)
            fprintf(stderr, "kernel_launch: note: occupancy query reports %d workgroups per CU\n", per_cu);
        (void)hipGetLastError();
        grid = cus;
    }
    if (grid < 0) return;
    if (hipMemsetAsync((char*)d_ws + WS_CTL, 0, CTL_ZERO_BYTES, stream) != hipSuccess) { fprintf(stderr, "kernel_launch: memset failed\n"); return; }
    Args a{};
    for (int i = 0; i < 18; ++i) a.in[i] = (const float*)d_in[i];
    a.out = (float*)d_out; a.ws = (unsigned char*)d_ws;
#if MK_ONE_LAUNCH
    a.ph_lo = 0; a.ph_hi = N_PHASES;
    hipLaunchKernelGGL(fwd, dim3(grid), dim3(NWAVES * 64), LDS_BYTES, stream, a);
#else
    for (int ph = 0; ph < N_PHASES; ++ph) {
        a.ph_lo = ph; a.ph_hi = ph + 1;
        hipLaunchKernelGGL(fwd, dim3(grid), dim3(NWAVES * 64), LDS_BYTES, stream, a);
    }
#endif
    const hipError_t le = hipPeekAtLastError();
    if (le != hipSuccess) fprintf(stderr, "kernel_launch: launch failed: %s\n", hipGetErrorName(le));
}
```

```cpp
#define USE_ALIGNED_ORDER 1
#define FUSE_FROM 99
#include <hip/hip_runtime.h>
#include <cstdio>
#include <cstdint>
typedef _Float16 half_t;
typedef _Float16 half4 __attribute__((ext_vector_type(4)));
typedef float xf4 __attribute__((ext_vector_type(4)));
struct XSrc { const float* p32; const half_t* p16; };
__device__ __forceinline__ xf4 ldx4(const XSrc& s, size_t e) { return s.p32 ? *(const xf4*)(s.p32 + e) : __builtin_convertvector(*(const half4*)(s.p16 + e), xf4); }
__device__ __forceinline__ void stx4(half_t* p, xf4 v) { *(half4*)p = __builtin_convertvector(v, half4); }
__device__ __forceinline__ int row_pos(int row) { return row < 8192 ? row : 2048 + ((row - 8192) & 63); }
__device__ __forceinline__ int row_seq(int row) { return row < 8192 ? 0 : 1 + ((row - 8192) >> 6); }
namespace pg8 {
#define PG8_LAS __attribute__((address_space(3)))
typedef unsigned short bf16_t;
typedef short bf16x8 __attribute__((ext_vector_type(8)));
typedef float f32x4 __attribute__((ext_vector_type(4)));
typedef unsigned u32x4 __attribute__((ext_vector_type(4)));
typedef unsigned u32x2 __attribute__((ext_vector_type(2)));
constexpr int BM = 256, BK = 64, HALF = 128, HTB = HALF * BK * 2  , STAGE_BYTES = 8 * HTB, NXCD = 8, WGM = 4;

__host__ __device__ __forceinline__ int lds_byte(int r, int c) { const int st = (r >> 4) * 2 + (c >> 5), rr = r & 15, cc = c & 31, ob = rr * 64 + cc * 2; return st * 1024 + (ob ^ (((ob >> 9) & 1) << 5)); }
__host__ __device__ __forceinline__ void stage_rc(int b, int& R, int& C) { const int st = b / 1024, sb = b % 1024, swz = sb ^ (((sb >> 9) & 1) << 5); R = (st >> 1) * 16 + swz / 64; C = (st & 1) * 32 + (swz % 64) / 2; }
__host__ __device__ __forceinline__ int perm32(int rho) { const int n = rho >> 4, i = rho & 15; return 8 * (i >> 2) + 4 * n + (i & 3); }

struct Unit { int pm, pn, kt0, nt, slab, qa, qh; };
struct Gemm { const bf16_t* A; const bf16_t* Bt; int M, N, K; };

struct StaticOrder {
    int nM, nN, nwg, G, c, ntk;
    __host__ __device__ __forceinline__ void init(int M, int N, int K, int G_, int c_) { nM = M / BM; nN = N / BM; nwg = nM * nN; G = G_; c = c_; ntk = K / BK; }
    __host__ __device__ __forceinline__ bool next(int i, Unit& u) const {
        const long L = (long)i * G + c; if (L >= nwg) return false;
        int wgid = (int)L; { const int q = nwg / NXCD, r = nwg % NXCD, xcd = wgid % NXCD, off = wgid / NXCD; wgid = (xcd < r ? xcd * (q + 1) : r * (q + 1) + (xcd - r) * q) + off; }
        const int nig = WGM * nN, gid = wgid / nig, fm = gid * WGM, gsz = (nM - fm) < WGM ? (nM - fm) : WGM;
        u.pm = fm + ((wgid % nig) % gsz); u.pn = (wgid % nig) / gsz; u.kt0 = 0; u.nt = ntk; u.slab = -1; u.qa = -1; u.qh = 0; return true;
    }
    __device__ __forceinline__ void a_ready(const Unit&) const {}
    __device__ __forceinline__ void done(const Unit&) const {}
};

__device__ __forceinline__ void hook_wait(const unsigned* ready, unsigned need, unsigned* tmo) {
    if (threadIdx.x < 64) {
        const unsigned long long t0 = __builtin_amdgcn_s_memrealtime(); unsigned polls = 0;
        while ((unsigned)__builtin_amdgcn_readfirstlane(__hip_atomic_load(ready, __ATOMIC_RELAXED, __HIP_MEMORY_SCOPE_AGENT)) < need) {
            if ((++polls & 255u) == 0u && __builtin_amdgcn_readfirstlane(__hip_atomic_load(tmo, __ATOMIC_RELAXED, __HIP_MEMORY_SCOPE_AGENT)) != 0u) break;
            if (__builtin_amdgcn_s_memrealtime() - t0 > 2000000ull) { if (threadIdx.x == 0) __hip_atomic_store(tmo, 1u, __ATOMIC_RELAXED, __HIP_MEMORY_SCOPE_AGENT); break; }
            __builtin_amdgcn_s_sleep(2); }
        __builtin_amdgcn_fence(__ATOMIC_ACQUIRE, "agent");
        asm volatile("s_waitcnt vmcnt(0)" ::: "memory");
    }
    asm volatile("" ::: "memory"); __builtin_amdgcn_s_barrier(); asm volatile("" ::: "memory");
}
struct HookOrder : StaticOrder {
    const unsigned* ready; unsigned need; unsigned* tmo; int permute;
    __host__ __device__ __forceinline__ bool next(int i, Unit& u) const { const bool ok = StaticOrder::next(i, u); if (permute) u.pn = (u.pn * 5) & 31; return ok; }
    __device__ __forceinline__ void a_ready(const Unit& u) const { if (ready != nullptr && u.pm >= 32) hook_wait(ready, need, tmo); }
};
struct XcdAlignedOrder {
    int G, c, ntk, permute; const unsigned* ready; unsigned need; unsigned* tmo;
    __host__ __device__ __forceinline__ void init(int K, int G_, int c_) { G = G_; c = c_; ntk = K / BK; permute = 0; ready = nullptr; need = 0; tmo = nullptr; }
    __host__ __device__ __forceinline__ bool next(int i, Unit& u) const {
        const int x = c & 7, j = i * (G >> 3) + (c >> 3); if (j >= 136 || (c >> 3) >= (G >> 3)) return false;
        const int s0 = x >> 1, q = j / 17, r = j % 17;
        int pm, pn;
        if (r == 4 * (s0 + 1)) { pm = 32 + (x & 1); pn = 4 * q + s0; }
        else { const int rr = r > 4 * (s0 + 1) ? r - 1 : r; pm = 4 * x + (rr & 3); pn = 4 * q + (rr >> 2); }
        if (permute) {
            const unsigned long long lo = pn < 16 ? 0xc3e001e894f24db9ull : 0xa8376af2cd15765bull;
            pn = (int)((lo >> (4 * (pn & 15))) & 15ull) | (int)(((0x76a6129eu >> pn) & 1u) << 4); }
        u.pm = pm; u.pn = pn; u.kt0 = 0; u.nt = ntk; u.slab = -1; u.qa = -1; u.qh = 0; return true;
    }
    __device__ __forceinline__ void a_ready(const Unit& u) const { if (ready != nullptr && u.pm >= 32) hook_wait(ready, need, tmo); }
    __device__ __forceinline__ void done(const Unit&) const {}
};
struct ResidOrder {
    StaticOrder so; int G, c, nks, ntk, nsub, nmine, sub_last, nfull; const unsigned* ready; unsigned need; unsigned* tmo;
    __host__ __device__ __forceinline__ void init(int K, int nks_, int G_, int c_, int sub_last_ = 0, const unsigned* ready_ = nullptr, unsigned need_ = 0, unsigned* tmo_ = nullptr) {
        so.init(8192, 2048, K, G_, c_); G = G_; c = c_; nks = nks_; ntk = (K / BK) / nks; nsub = 16 * nks; nmine = c < nsub ? (nsub - c + G - 1) / G : 0;
        sub_last = sub_last_; ready = ready_; need = need_; tmo = tmo_; nfull = c < so.nwg ? (so.nwg - c + G - 1) / G : 0; }
    __host__ __device__ __forceinline__ bool sub(int i, Unit& u) const { if (i >= nmine) return false; const int s = c + i * G, su = s / nks, ks = s % nks; u.pm = 32 + (su >> 3); u.pn = su & 7; u.kt0 = ks * ntk; u.nt = ntk; u.slab = ks; u.qa = -1; u.qh = 0; return true; }
    __host__ __device__ __forceinline__ bool next(int i, Unit& u) const {
        if (sub_last) { if (i < nfull) return so.next(i, u); return sub(i - nfull, u); }
        if (i < nmine) return sub(i, u);
        return so.next(i - nmine, u);
    }
    __device__ __forceinline__ void a_ready(const Unit& u) const { if (ready != nullptr && u.slab >= 0) hook_wait(ready, need, tmo); }
    __device__ __forceinline__ void done(const Unit&) const {}
};
struct InUpOrder {
    StaticOrder so; int G, c, nmine;
#ifdef FIXMASK
    __host__ __device__ __forceinline__ void init(int K, int G_, int c_) { so.init(8704, 8192, K, G_, c_); G = G_; c = c_; nmine = c < 256 ? (256 - c + G - 1) / G : 0; }
#else
    __host__ __device__ __forceinline__ void init(int K, int G_, int c_) { so.init(8192, 8192, K, G_, c_); G = G_; c = c_; nmine = c < 256 ? (256 - c + G - 1) / G : 0; }
#endif
    __host__ __device__ __forceinline__ bool next(int i, Unit& u) const {
        if (i < nmine) { const int s = c + i * G, su = s >> 2, kq = s & 3; u.pm = 32 + (su >> 5); u.pn = su & 31; u.kt0 = kq * (so.ntk / 4); u.nt = so.ntk / 4; u.slab = kq; u.qa = -1; u.qh = 0; return true; }
        return so.next(i - nmine, u);
    }
    __device__ __forceinline__ void a_ready(const Unit&) const {}
    __device__ __forceinline__ void done(const Unit&) const {}
};
struct SameTileOrder : StaticOrder {
    __host__ __device__ __forceinline__ bool next(int i, Unit& u) const { const bool ok = StaticOrder::next(i, u); u.slab = u.pm * 64 + u.pn; u.pm = 0; u.pn = 0; return ok; }
};
struct QuarterOrder {
    int nN, G, c, ntk, nsub;
    __host__ __device__ __forceinline__ void init(int N, int K, int G_, int c_) { nN = N / BM; G = G_; c = c_; ntk = K / BK; nsub = 2 * nN * 4; }
    __host__ __device__ __forceinline__ bool next(int i, Unit& u) const {
        const int s = c + i * G; if (s >= nsub) return false;
        const int q = s / (2 * nN), t = s % (2 * nN);
        u.pm = 32 + t / nN; u.pn = t % nN; u.kt0 = 0; u.nt = ntk; u.slab = -1; u.qa = q >> 1; u.qh = q & 1; return true;
    }
    __device__ __forceinline__ void a_ready(const Unit&) const {}
    __device__ __forceinline__ void done(const Unit&) const {}
};

__device__ __forceinline__ unsigned cvt_pk_bf16(float lo, float hi) { unsigned r; asm volatile("v_cvt_pk_bf16_f32 %0, %1, %2" : "=v"(r) : "v"(lo), "v"(hi)); return r; }
__device__ __forceinline__ float fast_rcp(float x) { return __builtin_amdgcn_rcpf(x); }
__device__ __forceinline__ float silu_f(float x) { return x * fast_rcp(1.0f + __expf(-x)); }

__device__ __forceinline__ void store_slab_perm(float* slab2, const f32x4 (&acc)[2][2][4][2], const Unit& u, int wr, int wc, int fr, int fq) {
    float* sp = slab2 + ((size_t)u.slab * 512 + (u.pm * BM + wr * 64 + fr - 8192)) * 8192 + u.pn * BM + wc * 32 + 8 * fq;
#pragma unroll
    for (int ai = 0; ai < 2; ++ai)
#pragma unroll
        for (int m = 0; m < 4; ++m) { float* rowp = sp + (size_t)(ai * HALF + m * 16) * 8192;
#pragma unroll
            for (int bj = 0; bj < 2; ++bj) { *(f32x4*)(rowp + bj * HALF) = acc[ai][bj][m][0]; *(f32x4*)(rowp + bj * HALF + 4) = acc[ai][bj][m][1]; } }
}
struct EpiInProj {
    static constexpr bool PERM = true, AFTER_DRAIN = false;
    bf16_t* P; float* LF; const float* lb; const float* rc; const float* rs; float* slab2;
    const float* rss; const float* bias;
#ifdef PROBE_DUP_IN3
    int force_seg = -1;
#endif
    __device__ __forceinline__ void operator()(f32x4 (&acc)[2][2][4][2], const Unit& u, int wr, int wc, int fr, int fq) const {
        if (u.slab >= 0) { store_slab_perm(slab2, acc, u, wr, wc, fr, fq); return; }
        if ((rss != nullptr) && (u.pm < 32)) {
            const int cb = u.pn * BM + wc * 32 + 8 * fq;
#pragma unroll
            for (int ai = 0; ai < 2; ++ai)
#pragma unroll
                for (int m = 0; m < 4; ++m) {
                    const float r = __builtin_amdgcn_rsqf(rss[u.pm * BM + wr * 64 + fr + ai * HALF + m * 16] * (1.0f / 2048.0f) + 1e-6f);
#pragma unroll
                    for (int bj = 0; bj < 2; ++bj)
#pragma unroll
                        for (int n = 0; n < 2; ++n) acc[ai][bj][m][n] = acc[ai][bj][m][n] * r + *(const f32x4*)(bias + cb + bj * HALF + 4 * n);
                }
        }
#ifdef PROBE_DUP_IN3
        const int seg = force_seg >= 0 ? force_seg : (u.pn >> 2);
#else
        const int seg = u.pn >> 2;
#endif
        const int row0 = u.pm * BM + wr * 64 + fr;
        const int colg0 = u.pn * BM + wc * 32 + 8 * fq;
        if (seg == 4 || seg == 5) {
            const float ksc = (seg == 5) ? 0.0625f : 1.0f;
            const int j0 = wc * 32 + 8 * fq;
#pragma unroll
            for (int ai = 0; ai < 2; ++ai) {
                f32x4 tc0[4], tc1[4], ts0[4], ts1[4];
#pragma unroll
                for (int m = 0; m < 4; ++m) { const int pos = row_pos(row0 + ai * HALF + m * 16);
                    tc0[m] = *(const f32x4*)(rc + (size_t)pos * 128 + j0); tc1[m] = *(const f32x4*)(rc + (size_t)pos * 128 + j0 + 4);
                    ts0[m] = *(const f32x4*)(rs + (size_t)pos * 128 + j0); ts1[m] = *(const f32x4*)(rs + (size_t)pos * 128 + j0 + 4); }
#pragma unroll
                for (int m = 0; m < 4; ++m) {
                    const int row = row0 + ai * HALF + m * 16;
                    const f32x4 c0 = tc0[m], c1 = tc1[m], s0 = ts0[m], s1 = ts1[m];
                    const f32x4 x1a = acc[ai][0][m][0], x1b = acc[ai][0][m][1], x2a = acc[ai][1][m][0], x2b = acc[ai][1][m][1];
                    const f32x4 o1a = (x1a * c0 - x2a * s0) * ksc, o1b = (x1b * c1 - x2b * s1) * ksc;
                    const f32x4 o2a = (x2a * c0 + x1a * s0) * ksc, o2b = (x2b * c1 + x1b * s1) * ksc;
                    bf16_t* rowp = P + (size_t)row * 8192 + colg0;
                    u32x4 w; w.x = cvt_pk_bf16(o1a[0], o1a[1]); w.y = cvt_pk_bf16(o1a[2], o1a[3]); w.z = cvt_pk_bf16(o1b[0], o1b[1]); w.w = cvt_pk_bf16(o1b[2], o1b[3]);
                    *(u32x4*)(rowp) = w;
                    w.x = cvt_pk_bf16(o2a[0], o2a[1]); w.y = cvt_pk_bf16(o2a[2], o2a[3]); w.z = cvt_pk_bf16(o2b[0], o2b[1]); w.w = cvt_pk_bf16(o2b[2], o2b[3]);
                    *(u32x4*)(rowp + HALF) = w;
                }
            }
        } else if (seg == 1) {
#pragma unroll
            for (int bj = 0; bj < 2; ++bj)
#pragma unroll
                for (int n = 0; n < 2; ++n) {
                    const int cs = colg0 + bj * HALF - 1024 + 4 * n;
                    const f32x4 lbv = *(const f32x4*)(lb + cs);
#pragma unroll
                    for (int ai = 0; ai < 2; ++ai) {
                        f32x4 carry = (f32x4){0.f, 0.f, 0.f, 0.f};
#pragma unroll
                        for (int m = 0; m < 4; ++m) {
                            const int row = row0 + ai * HALF + m * 16;
                            f32x4 v, kk;
#pragma unroll
                            for (int e = 0; e < 4; ++e) {
                                const float l = lbv[e], oml = 1.0f - l;
                                const float ex = __builtin_amdgcn_exp2f(fminf(acc[ai][bj][m][n][e] * -1.44269504f, 115.0f)), sg = fast_rcp(1.0f + ex), sn = ex * sg;
                                v[e] = __builtin_amdgcn_logf(l + oml * sg) * 0.69314718f; kk[e] = oml * sn; }
                            u32x2 w; w.x = cvt_pk_bf16(kk[0], kk[1]); w.y = cvt_pk_bf16(kk[2], kk[3]);
                            *(u32x2*)(P + (size_t)row * 8192 + colg0 + bj * HALF + 4 * n) = w;
#pragma unroll
                            for (int e = 0; e < 4; ++e) {
                                float x = v[e];
                                x += __builtin_bit_cast(float, __builtin_amdgcn_update_dpp(0, __builtin_bit_cast(int, x), 0x111, 0xf, 0xf, true));
                                x += __builtin_bit_cast(float, __builtin_amdgcn_update_dpp(0, __builtin_bit_cast(int, x), 0x112, 0xf, 0xf, true));
                                x += __builtin_bit_cast(float, __builtin_amdgcn_update_dpp(0, __builtin_bit_cast(int, x), 0x114, 0xf, 0xf, true));
                                x += __builtin_bit_cast(float, __builtin_amdgcn_update_dpp(0, __builtin_bit_cast(int, x), 0x118, 0xf, 0xf, true));
                                x += carry[e];
                                v[e] = x;
                                carry[e] = __builtin_bit_cast(float, __builtin_amdgcn_update_dpp(0, __builtin_bit_cast(int, x), 0x15f, 0xf, 0xf, true));
                            }
                            *(f32x4*)(LF + (size_t)row * 1024 + cs) = v;
                        }
                    }
                }
        } else {
            const bool act = (seg == 0 || seg == 3 || seg == 7);
#pragma unroll
            for (int ai = 0; ai < 2; ++ai)
#pragma unroll
                for (int m = 0; m < 4; ++m) { if (u.qa >= 0 && (ai != u.qa || (m >> 1) != u.qh)) continue;
                    bf16_t* rowp = P + (size_t)(row0 + ai * HALF + m * 16) * 8192 + colg0;
#pragma unroll
                    for (int bj = 0; bj < 2; ++bj) { f32x4 v0 = acc[ai][bj][m][0], v1 = acc[ai][bj][m][1];
                        if (act) {
#pragma unroll
                            for (int e = 0; e < 4; ++e) { v0[e] = silu_f(v0[e]); v1[e] = silu_f(v1[e]); } }
                        u32x4 w; w.x = cvt_pk_bf16(v0[0], v0[1]); w.y = cvt_pk_bf16(v0[2], v0[3]); w.z = cvt_pk_bf16(v1[0], v1[1]); w.w = cvt_pk_bf16(v1[2], v1[3]);
                        *(u32x4*)(rowp + bj * HALF) = w; } }
        }
    }
};
struct EpiRelu2 {
    static constexpr bool PERM = true, AFTER_DRAIN = false;
    bf16_t* O; int ldc; float* slab2; const float* rss; const float* bias;
    __device__ __forceinline__ void operator()(const f32x4 (&acc)[2][2][4][2], const Unit& u, int wr, int wc, int fr, int fq) const {
        if (u.slab >= 0) { store_slab_perm(slab2, acc, u, wr, wc, fr, fq); return; }
        const int row0 = u.pm * BM + wr * 64 + fr, col0 = u.pn * BM + wc * 32 + 8 * fq;
        const bool fused = (rss != nullptr) && (u.pm < 32);
        f32x4 bv[2][2];
#pragma unroll
        for (int bj = 0; bj < 2; ++bj)
#pragma unroll
            for (int n = 0; n < 2; ++n) bv[bj][n] = fused ? *(const f32x4*)(bias + col0 + bj * HALF + 4 * n) : (f32x4){0.f, 0.f, 0.f, 0.f};
#pragma unroll
        for (int ai = 0; ai < 2; ++ai)
#pragma unroll
            for (int m = 0; m < 4; ++m) { if (u.qa >= 0 && (ai != u.qa || (m >> 1) != u.qh)) continue;
                bf16_t* rowp = O + (size_t)(row0 + ai * HALF + m * 16) * ldc + col0;
                float r = 1.0f; if (fused) r = __builtin_amdgcn_rsqf(rss[row0 + ai * HALF + m * 16] * (1.0f / 2048.0f) + 1e-6f);
#pragma unroll
                for (int bj = 0; bj < 2; ++bj) { f32x4 v0 = acc[ai][bj][m][0] * r + bv[bj][0], v1 = acc[ai][bj][m][1] * r + bv[bj][1];
#pragma unroll
                    for (int e = 0; e < 4; ++e) { const float a = fmaxf(v0[e], 0.f), b = fmaxf(v1[e], 0.f); v0[e] = a * a; v1[e] = b * b; }
                    u32x4 w; w.x = cvt_pk_bf16(v0[0], v0[1]); w.y = cvt_pk_bf16(v0[2], v0[3]); w.z = cvt_pk_bf16(v1[0], v1[1]); w.w = cvt_pk_bf16(v1[2], v1[3]);
#ifdef NT_U_STORE
                    __builtin_nontemporal_store(w, (u32x4*)(rowp + bj * HALF)); } }
#else
                    *(u32x4*)(rowp + bj * HALF) = w; } }
#endif
    }
};
struct EpiResid {
    static constexpr bool PERM = false, AFTER_DRAIN = false;
    half_t* X; const float* gate; float* slab;
    const float* Xin32;
    bf16_t* XS; const float* acol; float* rss;
    __device__ __forceinline__ void operator()(const f32x4 (&acc)[2][2][4][2], const Unit& u, int wr, int wc, int fr, int fq) const {
        const int row0 = u.pm * BM + wr * 64 + fr, col0 = u.pn * BM + wc * 32 + 4 * fq;
        if (u.slab >= 0) {
            half_t* sp = (half_t*)slab + ((size_t)u.slab * 512 + (row0 - 8192)) * 2048 + col0;
#pragma unroll
            for (int ai = 0; ai < 2; ++ai)
#pragma unroll
                for (int m = 0; m < 4; ++m) { half_t* rowp = sp + (size_t)(ai * HALF + m * 16) * 2048;
#pragma unroll
                    for (int bj = 0; bj < 2; ++bj)
#pragma unroll
                        for (int n = 0; n < 2; ++n) stx4(rowp + bj * HALF + n * 16, acc[ai][bj][m][n]); }
            return;
        }
        f32x4 gv[2][2];
#pragma unroll
        for (int bj = 0; bj < 2; ++bj)
#pragma unroll
            for (int n = 0; n < 2; ++n) gv[bj][n] = *(const f32x4*)(gate + col0 + bj * HALF + n * 16);
        if (Xin32 == nullptr && XS == nullptr) {
#pragma unroll
            for (int ai = 0; ai < 2; ++ai) {
                half4 xh[4][2][2];
#pragma unroll
                for (int m = 0; m < 4; ++m)
#pragma unroll
                    for (int bj = 0; bj < 2; ++bj)
#pragma unroll
                        for (int n = 0; n < 2; ++n) xh[m][bj][n] = *(const half4*)(X + (size_t)(row0 + ai * HALF + m * 16) * 2048 + col0 + bj * HALF + n * 16);
#pragma unroll
                for (int m = 0; m < 4; ++m)
#pragma unroll
                    for (int bj = 0; bj < 2; ++bj)
#pragma unroll
                        for (int n = 0; n < 2; ++n) { const f32x4 xn = __builtin_convertvector(xh[m][bj][n], f32x4) + gv[bj][n] * acc[ai][bj][m][n]; stx4(X + (size_t)(row0 + ai * HALF + m * 16) * 2048 + col0 + bj * HALF + n * 16, xn); }
                asm volatile("" ::: "memory");
            }
            return;
        }
#pragma unroll
        for (int ai = 0; ai < 2; ++ai)
#pragma unroll
            for (int m = 0; m < 4; ++m) { const int row = row0 + ai * HALF + m * 16; half_t* rowp = X + (size_t)row * 2048 + col0; const XSrc xs{Xin32, X}; const size_t eo = (size_t)row * 2048 + col0; float ssq = 0.f;
#pragma unroll
                for (int bj = 0; bj < 2; ++bj)
#pragma unroll
                    for (int n = 0; n < 2; ++n) { const f32x4 xv = ldx4(xs, eo + bj * HALF + n * 16); const f32x4 xn = xv + gv[bj][n] * acc[ai][bj][m][n]; stx4(rowp + bj * HALF + n * 16, xn);
                        if (XS != nullptr) { ssq += (xn[0] * xn[0] + xn[1] * xn[1]) + (xn[2] * xn[2] + xn[3] * xn[3]); const f32x4 av = *(const f32x4*)(acol + col0 + bj * HALF + n * 16); const f32x4 hs = xn * av;
                            u32x2 w; w.x = cvt_pk_bf16(hs[0], hs[1]); w.y = cvt_pk_bf16(hs[2], hs[3]); *(u32x2*)(XS + (size_t)row * 2048 + col0 + bj * HALF + n * 16) = w; } }
                if (XS != nullptr) { ssq += __shfl_xor(ssq, 16); ssq += __shfl_xor(ssq, 32); if (fq == 0) __hip_atomic_fetch_add(rss + row, ssq, __ATOMIC_RELAXED, __HIP_MEMORY_SCOPE_AGENT); }
                asm volatile("" ::: "memory"); }
    }
};
struct EpiProbe {
    static constexpr bool PERM = true, AFTER_DRAIN = false;
    bf16_t* O; int ldc;
    __device__ __forceinline__ void operator()(const f32x4 (&acc)[2][2][4][2], const Unit& u, int wr, int wc, int fr, int fq) const {
        Unit t = u; t.pm = u.slab >> 6; t.pn = u.slab & 63; t.qa = -1;
        t.slab = -1; EpiRelu2 e{O, ldc, nullptr, nullptr, nullptr}; e(acc, t, wr, wc, fr, fq);
    }
};
template <class Epi, class Sched, bool ALIGN_EPI = false, bool SP2 = false, int QM = 0>
__device__ __forceinline__ void gemm_phase(PG8_LAS unsigned char* lds, const Gemm g, const Sched& S, const Epi& E) {
    int tid_l = threadIdx.x; asm volatile("" : "+v"(tid_l));
    const int tid = tid_l, wid = __builtin_amdgcn_readfirstlane(tid >> 6), lane = tid & 63, wr = wid >> 2, wc = wid & 3, fr = lane & 15, fq = lane >> 4;
    const int K = g.K;
    unsigned voffA[2], voffB[2];
#pragma unroll
    for (int i = 0; i < 2; ++i) { int R, C; stage_rc(tid * 16 + i * 8192, R, C); const int Rb = Epi::PERM ? ((R & ~31) + perm32(R & 31)) : R;
        voffA[i] = (unsigned)(R * K + C) * 2u; voffB[i] = (unsigned)(Rb * K + C) * 2u; }
    const size_t kstep = (size_t)(BK * 2);
    const size_t hstep = (size_t)HALF * K * 2;
    const size_t tstep = 2 * hstep;
    const unsigned ldsw = (unsigned)wid * 1024u;
    const int aoff = lds_byte(wr * 64 + fr, fq * 8), boff = lds_byte(wc * 32 + fr, fq * 8);
#define PG8_SA(b, h) (((b) * 2 + (h)) * HTB)
#define PG8_SB(b, h) ((4 + (b) * 2 + (h)) * HTB)
#define PG8_STAGE(bufoff, gbase, voff) do { _Pragma("unroll") for (int _i = 0; _i < 2; ++_i) \
        __builtin_amdgcn_global_load_lds((const unsigned*)((const char*)(gbase) + (voff)[_i]), (PG8_LAS unsigned*)(lds + (bufoff) + ldsw + _i * 8192), 16, 0, 0); } while (0)
#define PG8_LDA(dst, b, h) do { if (!QM || (h) == q_a) { _Pragma("unroll") for (int m = 0; m < 4; ++m) _Pragma("unroll") for (int k = 0; k < 2; ++k) dst[m][k] = *(const PG8_LAS bf16x8*)(lds + PG8_SA(b, h) + aoff + m * 2048 + k * 1024); } } while (0)
#define PG8_LDB(dst, b, h) do { _Pragma("unroll") for (int n = 0; n < 2; ++n) _Pragma("unroll") for (int k = 0; k < 2; ++k) dst[n][k] = *(const PG8_LAS bf16x8*)(lds + PG8_SB(b, h) + boff + n * 2048 + k * 1024); } while (0)
#define PG8_MMA(ai, bj, At, Bt) do { if (!QM || (ai) == q_a) { __builtin_amdgcn_s_setprio(1); _Pragma("unroll") for (int m = 0; m < 4; ++m) { if (!QM || (m >> 1) == q_h) { _Pragma("unroll") for (int n = 0; n < 2; ++n) _Pragma("unroll") for (int k = 0; k < 2; ++k) \
        acc[ai][bj][m][n] = __builtin_amdgcn_mfma_f32_16x16x32_bf16(Bt[n][k], At[m][k], acc[ai][bj][m][n], 0, 0, 0); } } __builtin_amdgcn_s_setprio(0); } } while (0)
#define PG8_WAIT_V(n) asm volatile("s_waitcnt vmcnt(" #n ")" ::: "memory")
#define PG8_WAIT_L(n) asm volatile("s_waitcnt lgkmcnt(" #n ")" ::: "memory")
#define PG8_BAR __builtin_amdgcn_s_barrier()
#define PG8_SCHED __builtin_amdgcn_sched_barrier(0)
    Unit cur, nxt; int ui = 0;
    if (!S.next(0, cur)) return;
    int q_a = cur.qa, q_h = cur.qh; (void)q_a; (void)q_h;
    f32x4 acc[2][2][4][2];
#pragma unroll
    for (int a = 0; a < 2; ++a)
#pragma unroll
        for (int b = 0; b < 2; ++b)
#pragma unroll
            for (int m = 0; m < 4; ++m)
#pragma unroll
                for (int n = 0; n < 2; ++n) acc[a][b][m][n] = (f32x4){0.f, 0.f, 0.f, 0.f};
    bf16x8 At[4][2], B0[2][2], B1[2][2];
    const char* cA = (const char*)g.A + (size_t)cur.pm * tstep + (size_t)cur.kt0 * kstep; const char* cB = (const char*)g.Bt + (size_t)cur.pn * tstep + (size_t)cur.kt0 * kstep;
    S.a_ready(cur);
    if constexpr (SP2) {
        PG8_STAGE(PG8_SB(0, 0), cB, voffB); PG8_STAGE(PG8_SB(0, 1), cB + hstep, voffB); PG8_STAGE(PG8_SA(0, 0), cA, voffA); PG8_STAGE(PG8_SA(0, 1), cA + hstep, voffA);
        if (wr == 1) PG8_BAR;
        PG8_WAIT_V(2); PG8_BAR;
        PG8_STAGE(PG8_SB(1, 0), cB + kstep, voffB); PG8_STAGE(PG8_SA(1, 0), cA + kstep, voffA); PG8_STAGE(PG8_SB(1, 1), cB + hstep + kstep, voffB);
        PG8_WAIT_V(6); PG8_BAR;
    } else {
        PG8_STAGE(PG8_SB(0, 0), cB, voffB); PG8_STAGE(PG8_SA(0, 0), cA, voffA); PG8_STAGE(PG8_SB(0, 1), cB + hstep, voffB); PG8_STAGE(PG8_SA(0, 1), cA + hstep, voffA);
        if (wr == 1) PG8_BAR;
        PG8_WAIT_V(4); PG8_BAR;
        PG8_STAGE(PG8_SB(1, 0), cB + kstep, voffB); PG8_STAGE(PG8_SA(1, 0), cA + kstep, voffA); PG8_STAGE(PG8_SB(1, 1), cB + hstep + kstep, voffB);
        PG8_WAIT_V(6); PG8_BAR;
    }
    for (;;) {
        const bool has_next = S.next(ui + 1, nxt);
        const char* nA = has_next ? (const char*)g.A + (size_t)nxt.pm * tstep + (size_t)nxt.kt0 * kstep : cA; const char* nB = has_next ? (const char*)g.Bt + (size_t)nxt.pn * tstep + (size_t)nxt.kt0 * kstep : cB;
        const int nt = cur.nt;
        for (int t = 0; t < nt; t += 2) {
            const bool last = (t == nt - 2);
            const char* a1 = cA + (size_t)(t + 1) * kstep;
            const char* a2 = last ? nA : cA + (size_t)(t + 2) * kstep; const char* b2 = last ? nB : cB + (size_t)(t + 2) * kstep;
            const char* a3 = a2 + kstep; const char* b3 = b2 + kstep;
            if (last && has_next) S.a_ready(nxt);
            if constexpr (SP2) {
            PG8_LDB(B0, 0, 0); PG8_LDB(B1, 0, 1); PG8_SCHED; PG8_LDA(At, 0, 0); PG8_STAGE(PG8_SA(1, 1), a1 + hstep, voffA);
            PG8_WAIT_V(8); PG8_WAIT_L(0); PG8_BAR; PG8_MMA(0, 0, At, B0); PG8_MMA(0, 1, At, B1); PG8_BAR; PG8_SCHED;
            PG8_LDA(At, 0, 1); PG8_STAGE(PG8_SB(0, 0), b2, voffB); PG8_STAGE(PG8_SB(0, 1), b2 + hstep, voffB); PG8_STAGE(PG8_SA(0, 0), a2, voffA);
            PG8_WAIT_V(8); PG8_WAIT_L(0); PG8_BAR; PG8_MMA(1, 0, At, B0); PG8_MMA(1, 1, At, B1); PG8_BAR; PG8_SCHED;
            PG8_LDB(B0, 1, 0); PG8_LDB(B1, 1, 1); PG8_SCHED; PG8_LDA(At, 1, 0); PG8_STAGE(PG8_SA(0, 1), a2 + hstep, voffA);
            PG8_WAIT_V(8); PG8_WAIT_L(0); PG8_BAR; PG8_MMA(0, 0, At, B0); PG8_MMA(0, 1, At, B1); PG8_BAR; PG8_SCHED;
            PG8_LDA(At, 1, 1); PG8_STAGE(PG8_SB(1, 0), b3, voffB); PG8_STAGE(PG8_SB(1, 1), b3 + hstep, voffB); PG8_STAGE(PG8_SA(1, 0), a3, voffA);
            PG8_WAIT_V(8); PG8_WAIT_L(0); PG8_BAR; PG8_MMA(1, 0, At, B0); PG8_MMA(1, 1, At, B1); PG8_BAR; PG8_SCHED;
            } else {
            PG8_LDB(B0, 0, 0); PG8_SCHED; PG8_LDA(At, 0, 0); PG8_STAGE(PG8_SA(1, 1), a1 + hstep, voffA);
            PG8_WAIT_L(8); PG8_BAR; PG8_WAIT_L(0); PG8_MMA(0, 0, At, B0); PG8_BAR; PG8_SCHED;
            PG8_LDB(B1, 0, 1); PG8_STAGE(PG8_SB(0, 0), b2, voffB);
            PG8_BAR; PG8_WAIT_L(0); PG8_MMA(0, 1, At, B1); PG8_BAR;
            PG8_LDA(At, 0, 1); PG8_STAGE(PG8_SA(0, 0), a2, voffA);
            PG8_BAR; PG8_WAIT_L(0); PG8_MMA(1, 0, At, B0); PG8_BAR; PG8_SCHED;
            PG8_STAGE(PG8_SB(0, 1), b2 + hstep, voffB);
            PG8_WAIT_V(6); PG8_BAR; PG8_MMA(1, 1, At, B1); PG8_BAR;
            PG8_LDB(B0, 1, 0); PG8_SCHED; PG8_LDA(At, 1, 0); PG8_STAGE(PG8_SA(0, 1), a2 + hstep, voffA);
            PG8_WAIT_L(8); PG8_BAR; PG8_WAIT_L(0); PG8_MMA(0, 0, At, B0); PG8_BAR; PG8_SCHED;
            PG8_LDB(B1, 1, 1); PG8_STAGE(PG8_SB(1, 0), b3, voffB);
            PG8_BAR; PG8_WAIT_L(0); PG8_MMA(0, 1, At, B1); PG8_BAR;
            PG8_LDA(At, 1, 1); PG8_STAGE(PG8_SA(1, 0), a3, voffA);
            PG8_BAR; PG8_WAIT_L(0); PG8_MMA(1, 0, At, B0); PG8_BAR; PG8_SCHED;
            PG8_STAGE(PG8_SB(1, 1), b3 + hstep, voffB);
            PG8_WAIT_V(6); PG8_BAR; PG8_MMA(1, 1, At, B1); PG8_BAR;
            }
        }
        if constexpr (ALIGN_EPI) { if (wr == 0) PG8_BAR; }
        if constexpr (!Epi::AFTER_DRAIN) { E(acc, cur, wr, wc, fr, fq); S.done(cur); }
        if (!has_next) break;
#pragma unroll
        for (int a = 0; a < 2; ++a)
#pragma unroll
            for (int b = 0; b < 2; ++b)
#pragma unroll
                for (int m = 0; m < 4; ++m)
#pragma unroll
                    for (int n = 0; n < 2; ++n) acc[a][b][m][n] = (f32x4){0.f, 0.f, 0.f, 0.f};
        cur = nxt; cA = nA; cB = nB; ++ui; q_a = cur.qa; q_h = cur.qh;
        if constexpr (ALIGN_EPI) { if (wr == 1) PG8_BAR; }
    }
    PG8_WAIT_V(0);
    if constexpr (!ALIGN_EPI) { if (wr == 0) PG8_BAR; }
    PG8_BAR;
    if constexpr (Epi::AFTER_DRAIN) { E.fused(acc, cur, wr, wc, fr, fq, lds, wid, lane); S.done(cur); }
#undef PG8_SA
#undef PG8_SB
#undef PG8_STAGE
#undef PG8_LDA
#undef PG8_LDB
#undef PG8_MMA
#undef PG8_WAIT_V
#undef PG8_WAIT_L
#undef PG8_BAR
#undef PG8_SCHED
}
}
constexpr int NWAVES = 8;
constexpr int DM = 2048, SEQ = 8192, DEPTH = 4, DECB = 8, DECS = 64, M = SEQ + DECB * DECS, NPROJ = 8192, DFF = 8192, NSEQ = 9, NMOD = 6 * DM;
constexpr int HA = 8, HB = 4;
constexpr float EPS = 1e-6f;
constexpr size_t OFF_SA_P = (size_t)M * DM, OFF_SB_P = OFF_SA_P + (size_t)DEPTH * HA * 128 * 128, OFF_SA_S = OFF_SB_P + (size_t)DEPTH * HB * 256 * 256,
                 OFF_SB_S = OFF_SA_S + (size_t)DEPTH * DECB * HA * 128 * 128, OUT_TOTAL = OFF_SB_S + (size_t)DEPTH * DECB * HB * 256 * 256;

constexpr size_t MiB = 1u << 20;
constexpr size_t WS_CTL = 0, CTL_ZERO_BYTES = 1 * MiB;
constexpr size_t WS_WIN = 2 * MiB;
constexpr size_t WS_WOUT = WS_WIN + 128 * MiB;
constexpr size_t WS_WUP = WS_WOUT + 32 * MiB;
constexpr size_t WS_WDN = WS_WUP + 128 * MiB;
constexpr size_t WS_X = WS_WDN + 128 * MiB;
constexpr size_t WS_H = WS_X + 68 * MiB;
constexpr size_t WS_P = WS_H + 34 * MiB;
constexpr size_t WS_LF = WS_P + 136 * MiB;
constexpr size_t WS_O = WS_LF + 34 * MiB;
constexpr size_t WS_U = WS_O + 34 * MiB;
constexpr size_t WS_MOD = WS_U + 136 * MiB;
constexpr size_t WS_LB = WS_MOD + 2 * MiB;
constexpr size_t WS_ROPE = WS_LB + 1 * MiB;
constexpr size_t WS_SLAB = WS_ROPE + 8 * MiB;
constexpr size_t WS_SLAB2 = WS_SLAB + 64 * MiB;
constexpr size_t WS_ACOL = WS_SLAB2 + 64 * MiB;
constexpr size_t WS_END = WS_ACOL + 1 * MiB;
constexpr int CW_Q0 = 64;
constexpr int CW_TMO = 0;
constexpr int CW_FIX = 1024;
constexpr int CW_BAR = 4096;
constexpr int CW_XRANK = 3072;
constexpr int CW_SMP = 2048;
constexpr int CW_RSS = 65536;
constexpr int CW_BIAS = CW_RSS + 8 * 8192;

constexpr int RING_OFF = 0, RING_BYTES = 131072;
constexpr int LDS_BYTES = 151552;
constexpr int MISC_OFF = 147456;

#define GAS __attribute__((address_space(1)))
#define LAS __attribute__((address_space(3)))
typedef unsigned short bf16;
typedef unsigned v4u __attribute__((ext_vector_type(4)));
typedef unsigned v2u __attribute__((ext_vector_type(2)));
typedef float f32x4 __attribute__((ext_vector_type(4)));
typedef short bf16x8 __attribute__((ext_vector_type(8)));
#define LDS_WAIT() asm volatile("s_waitcnt lgkmcnt(0)" ::: "memory")
#define VM_WAIT() asm volatile("s_waitcnt vmcnt(0)" ::: "memory")
__device__ __forceinline__ unsigned f2bf(float f) { unsigned u = __builtin_bit_cast(unsigned, f); return (u + 0x7fffu + ((u >> 16) & 1u)) >> 16; }
__device__ __forceinline__ unsigned pk2(float lo, float hi) { return pg8::cvt_pk_bf16(lo, hi); }
__device__ __forceinline__ float bf2f(unsigned short b) { return __builtin_bit_cast(float, ((unsigned)b) << 16); }
__device__ __forceinline__ float bflo(unsigned w) { return __builtin_bit_cast(float, w << 16); }
__device__ __forceinline__ float bfhi(unsigned w) { return __builtin_bit_cast(float, w & 0xffff0000u); }

#define XB_TMO      128
#define XB_XCNT(j)  (256  + 64 * (j))
#define XB_XSUB(j)  (1280 + 64 * (j))
#define XB_XGEN(j)  (2304 + 64 * (j))
#define XB_TOP      3328
#define XB_TOPGEN   3392
#define XCD_BAR_WORDS 3456
#define XB_SPIN_CAP (1u << 20)
__device__ __forceinline__ unsigned xb_ld(unsigned* p)              { return __hip_atomic_load(p, __ATOMIC_RELAXED, __HIP_MEMORY_SCOPE_AGENT); }
__device__ __forceinline__ unsigned xb_add(unsigned* p, unsigned v) { return __hip_atomic_fetch_add(p, v, __ATOMIC_RELAXED, __HIP_MEMORY_SCOPE_AGENT); }
__device__ __forceinline__ unsigned xb_xcc_id() { return (unsigned)__builtin_amdgcn_s_getreg((3 << 11) | 20) & 0xFu; }
#define XB_SPIN(cond, bar) do { unsigned _sp = 0; while (cond) { __builtin_amdgcn_s_sleep(1); \
    if ((++_sp & 255u) == 0u) { if (xb_ld(&(bar)[XB_TMO])) break; if (_sp > XB_SPIN_CAP) { atomicAdd(&(bar)[XB_TMO], 1u); break; } } } } while (0)
struct XcdBarrier { unsigned* bar; unsigned x; volatile LAS unsigned* st; };
__device__ __forceinline__ XcdBarrier xcd_barrier_post(unsigned* bar, volatile LAS unsigned* st) {
    XcdBarrier b; b.bar = bar; b.x = xb_xcc_id(); b.st = st;
    if (threadIdx.x == 0) (void)xb_add(&bar[XB_XCNT(b.x)], 1u);
    return b;
}
__device__ __forceinline__ void xcd_barrier_complete(unsigned* bar, unsigned x, unsigned& nloc, unsigned& nx) {
    const unsigned G = gridDim.x * gridDim.y * gridDim.z;
    unsigned sum, cnt, mine, sp = 0u;
    for (;;) {
        sum = 0u; cnt = 0u; mine = 0u;
#pragma unroll
        for (unsigned j = 0; j < 16; ++j) { const unsigned c = xb_ld(&bar[XB_XCNT(j)]); sum += c; cnt += (c > 0u) ? 1u : 0u; mine = (j == x) ? c : mine; }
        if (sum == G) break;
        __builtin_amdgcn_s_sleep(1);
        if ((++sp & 255u) == 0u) { if (xb_ld(&bar[XB_TMO])) break; if (sp > XB_SPIN_CAP) { atomicAdd(&bar[XB_TMO], 1u); break; } }
    }
    nloc = mine > 0u ? mine : 1u; nx = cnt > 0u ? cnt : 1u;
}
__device__ __forceinline__ void xcd_barrier(const XcdBarrier& b) {
    asm volatile("s_waitcnt vmcnt(0)" ::: "memory");
    __syncthreads();
    if (threadIdx.x == 0) {
        unsigned* bar = b.bar;
        __builtin_amdgcn_s_waitcnt(0);
        unsigned nloc = b.st[0], nx = b.st[1];
        if (nloc == 0u) { xcd_barrier_complete(bar, b.x, nloc, nx); b.st[0] = nloc; b.st[1] = nx; }
        const unsigned old = xb_add(&bar[XB_XSUB(b.x)], 1u);
        const unsigned gen = old / nloc;
        if (old + 1u == (gen + 1u) * nloc) {
            __builtin_amdgcn_fence(__ATOMIC_RELEASE, "agent");
            asm volatile("s_waitcnt vmcnt(0)" ::: "memory");
            const unsigned og = xb_add(&bar[XB_TOP], 1u);
            const unsigned tg = og / nx;
            if (og + 1u == (tg + 1u) * nx) xb_add(&bar[XB_TOPGEN], 1u);
            else XB_SPIN(xb_ld(&bar[XB_TOPGEN]) == tg, bar);
            __builtin_amdgcn_fence(__ATOMIC_ACQUIRE, "agent");
            xb_add(&bar[XB_XGEN(b.x)], 1u);
            asm volatile("s_waitcnt vmcnt(0)" ::: "memory");
        } else {
            XB_SPIN(xb_ld(&bar[XB_XGEN(b.x)]) == gen, bar);
            __builtin_amdgcn_fence(__ATOMIC_ACQUIRE, "agent");
            asm volatile("s_waitcnt vmcnt(0)" ::: "memory");
        }
    }
    __syncthreads();
}

struct Frame {
    LAS unsigned char* lds;
    unsigned* ctl;
    unsigned char* ws;
    int G, wg;
    const float *x_prompt, *x_sample, *state_hgrn, *state_ret, *c_prompt, *c_sample, *lb_logits, *w_ada, *b_ada, *norm1_g, *norm2_g, *w_in, *hgrn_g, *ret_g, *w_out, *w_up, *w_down, *final_g;
    float* out;
    bf16 *Win_t, *Wout_t, *Wup_t, *Wdn_t, *H, *P, *O, *U;
    half_t* X;
    float *LF, *MOD, *LB, *RC, *RS;
};

__device__ __forceinline__ int ltid() { int t = threadIdx.x; asm volatile("" : "+v"(t)); return t; }
#define PHASE_IDS() const int tid = ltid(), lane = tid & 63, wave = __builtin_amdgcn_readfirstlane(tid >> 6); (void)lane; (void)wave
__device__ __forceinline__ float wave_sum(float v) {
#pragma unroll
    for (int o = 1; o < 64; o <<= 1) v += __shfl_xor(v, o);
    return v;
}
struct CvItem { const float* W; bf16* WT; const float* sh; float* bias; int K, N, k0, n0; };
#define CV_LOAD(v, I) do { _Pragma("unroll") for (int i_ = 0; i_ < 16; ++i_) v[i_] = __builtin_nontemporal_load((const f32x4*)((I).W + (size_t)((I).k0 + 4 * i_ + (lane >> 4)) * (I).N + (I).n0 + 4 * (lane & 15))); } while (0)
__device__ __forceinline__ void cv_process(const f32x4 (&v)[16], const CvItem& I, LAS float* scr, int lane) {
    const int r4 = lane >> 4, c16 = lane & 15;
    if (I.sh != nullptr) {
        f32x4 p = (f32x4){0.f, 0.f, 0.f, 0.f};
#pragma unroll
        for (int i = 0; i < 16; ++i) p += v[i] * I.sh[I.k0 + 4 * i + r4];
#pragma unroll
        for (int e = 0; e < 4; ++e) { float q = p[e]; q += __shfl_xor(q, 16); q += __shfl_xor(q, 32); if (r4 == 0) __hip_atomic_fetch_add(I.bias + I.n0 + 4 * c16 + e, q, __ATOMIC_RELAXED, __HIP_MEMORY_SCOPE_AGENT); }
    }
#pragma unroll
    for (int i = 0; i < 16; ++i) *(LAS f32x4*)(scr + (4 * i + r4) * 68 + 4 * c16) = v[i];
    LDS_WAIT(); asm volatile("" ::: "memory");
    const int c = lane & 7;
#pragma unroll
    for (int j = 0; j < 8; ++j) { const int n = (lane >> 3) + 8 * j; const LAS float* s = scr + (8 * c) * 68 + n;
        v4u o; o.x = pk2(s[0 * 68], s[1 * 68]); o.y = pk2(s[2 * 68], s[3 * 68]); o.z = pk2(s[4 * 68], s[5 * 68]); o.w = pk2(s[6 * 68], s[7 * 68]);
        __builtin_nontemporal_store(o, (v4u*)(I.WT + (size_t)(I.n0 + n) * I.K + I.k0 + 8 * c)); }
    LDS_WAIT(); asm volatile("" ::: "memory");
}
#ifndef CONV_PRO
#define CONV_PRO 1
#endif
#ifndef NGEMM
#define NGEMM 224
#endif
#ifndef FUSE_FROM
#define FUSE_FROM 1
#endif
#ifndef CV_SPLIT_PCT
#define CV_SPLIT_PCT 52
#endif
constexpr int CV_IN = (DM / 64) * (NPROJ / 64), CV_OUT = (DM / 64) * (DM / 64), CV_UP = (DM / 64) * (DFF / 64), CV_DN = (DFF / 64) * (DM / 64), CV_LAYER = CV_IN + CV_OUT + CV_UP + CV_DN, CV_SPLIT = ((CV_IN + CV_OUT + CV_UP + CV_DN) * CV_SPLIT_PCT / 100) & ~7;
__device__ __forceinline__ CvItem cv_item(Frame& F, int l, int it) {
    CvItem I; int r = it;
    const float* shp = (l >= FUSE_FROM && F.G > NGEMM) ? F.MOD + (size_t)l * NMOD : nullptr; float* bp = (float*)(F.ctl + CW_BIAS) + (size_t)l * 2 * 8192;
    I.sh = nullptr; I.bias = bp;
    if (r < CV_IN) { I.W = F.w_in + (size_t)l * DM * NPROJ; I.K = DM; I.N = NPROJ; I.WT = F.Win_t + (size_t)l * NPROJ * DM; I.sh = shp; }
    else if ((r -= CV_IN) < CV_OUT) { I.W = F.w_out + (size_t)l * DM * DM; I.K = DM; I.N = DM; I.WT = F.Wout_t + (size_t)l * DM * DM; }
    else if ((r -= CV_OUT) < CV_UP) { I.W = F.w_up + (size_t)l * DM * DFF; I.K = DM; I.N = DFF; I.WT = F.Wup_t + (size_t)l * DFF * DM; I.sh = shp ? shp + 3 * DM : nullptr; I.bias = bp + 8192; }
    else { r -= CV_UP; I.W = F.w_down + (size_t)l * DFF * DM; I.K = DFF; I.N = DM; I.WT = F.Wdn_t + (size_t)l * DM * DFF; }
    const int nblk = I.N / 64; I.k0 = 64 * (r / nblk); I.n0 = 64 * (r % nblk);
    return I;
}
__device__ __forceinline__ void convert_layer(Frame& F, int l, int wave, int lane, int it_lo = 0, int it_hi = CV_LAYER, int qword = 0) {
    LAS float* scr = (LAS float*)(F.lds + wave * 17408);
    int cur = 0, end = 0;
#define CV_NEXT(id) do { if (cur >= end) { int b_ = 0; if (lane == 0) b_ = (int)atomicAdd(F.ctl + CW_Q0 + 64 * (l + 1) + qword, 8u); cur = it_lo + __builtin_amdgcn_readfirstlane(b_); end = cur + 8; } id = cur < it_hi ? cur : -1; ++cur; } while (0)
    f32x4 va[16], vb[16]; CvItem Ia, Ib; int ia, ib;
    CV_NEXT(ia); if (ia < 0) return;
    Ia = cv_item(F, l, ia); CV_LOAD(va, Ia);
    for (;;) {
        CV_NEXT(ib); if (ib >= 0) { Ib = cv_item(F, l, ib); CV_LOAD(vb, Ib); }
        cv_process(va, Ia, scr, lane);
        if (ib < 0) break;
        CV_NEXT(ia); if (ia >= 0) { Ia = cv_item(F, l, ia); CV_LOAD(va, Ia); }
        cv_process(vb, Ib, scr, lane);
        if (ia < 0) break;
    }
#undef CV_NEXT
}
__device__ __forceinline__ void p0_mod_task(Frame& F, int task) {
    PHASE_IDS();
    const int l = task / 48, cb = task % 48;
    LAS float* cact = (LAS float*)(F.lds);
    LAS float* red = (LAS float*)(F.lds + 73728);
    for (int i = tid; i < NSEQ * DM; i += NWAVES * 64) { const int b = i / DM, k = i % DM; const float c = (b == 0) ? F.c_prompt[k] : F.c_sample[(b - 1) * DM + k]; cact[i] = c / (1.0f + __expf(-c)); }
    __syncthreads();
    const float* W = F.w_ada + (size_t)l * DM * NMOD + cb * 256 + 4 * lane;
    f32x4 acc[NSEQ];
#pragma unroll
    for (int b = 0; b < NSEQ; ++b) acc[b] = (f32x4){0.f, 0.f, 0.f, 0.f};
    const int kbeg = wave * 256;
#pragma unroll 4
    for (int k0 = kbeg; k0 < kbeg + 256; k0 += 4) {
        const f32x4 w0 = __builtin_nontemporal_load((const f32x4*)(W + (size_t)(k0 + 0) * NMOD)), w1 = __builtin_nontemporal_load((const f32x4*)(W + (size_t)(k0 + 1) * NMOD)), w2 = __builtin_nontemporal_load((const f32x4*)(W + (size_t)(k0 + 2) * NMOD)), w3 = __builtin_nontemporal_load((const f32x4*)(W + (size_t)(k0 + 3) * NMOD));
#pragma unroll
        for (int b = 0; b < NSEQ; ++b) { const f32x4 c = *(const LAS f32x4*)(cact + b * DM + k0); acc[b] += w0 * c.x + w1 * c.y + w2 * c.z + w3 * c.w; }
    }
#pragma unroll
    for (int b = 0; b < NSEQ; ++b) *(LAS f32x4*)(red + (wave * NSEQ + b) * 256 + 4 * lane) = acc[b];
    __syncthreads();
    for (int o = tid; o < NSEQ * 256; o += NWAVES * 64) { const int b = o / 256, c = o % 256; float s = 0.f;
#pragma unroll
        for (int w = 0; w < 8; ++w) s += red[(w * NSEQ + b) * 256 + c];
        F.MOD[(size_t)(b * DEPTH + l) * NMOD + cb * 256 + c] = s + F.b_ada[(size_t)l * NMOD + cb * 256 + c]; }
    __syncthreads();
}
__device__ __forceinline__ void sincos_acc(float angf, float& sn, float& cs) {
    const double a = (double)angf;
    const double q = __builtin_rint(a * 0.63661977236758134308);
    double r = __builtin_fma(-q, 1.57079632679489655800, a); r = __builtin_fma(-q, 6.12323399573676603587e-17, r);
    const double r2 = r * r;
    double sp = 1.0 / 6227020800.0; sp = sp * r2 - 1.0 / 39916800.0; sp = sp * r2 + 1.0 / 362880.0; sp = sp * r2 - 1.0 / 5040.0; sp = sp * r2 + 1.0 / 120.0; sp = sp * r2 - 1.0 / 6.0; sp = sp * r2 * r + r;
    double cp = 1.0 / 479001600.0; cp = cp * r2 - 1.0 / 3628800.0; cp = cp * r2 + 1.0 / 40320.0; cp = cp * r2 - 1.0 / 720.0; cp = cp * r2 + 1.0 / 24.0; cp = cp * r2 - 0.5; cp = cp * r2 + 1.0;
    const int qi = ((int)q) & 3;
    const double s = (qi == 0) ? sp : (qi == 1) ? cp : (qi == 2) ? -sp : -cp;
    const double c = (qi == 0) ? cp : (qi == 1) ? -sp : (qi == 2) ? -cp : sp;
    sn = (float)s; cs = (float)c;
}
__device__ __forceinline__ void p0_prologue(Frame& F, int qslot) {
    PHASE_IDS();
    const int gt = F.wg * (NWAVES * 64) + tid, NGT = F.G * NWAVES * 64;
    for (int c = gt; c < 1024; c += NGT) {
        const float a0 = F.lb_logits[c], a1 = F.lb_logits[1024 + c], a2 = F.lb_logits[2048 + c], a3 = F.lb_logits[3072 + c];
        const float mx = fmaxf(fmaxf(a0, a1), fmaxf(a2, a3));
        const float e0 = expf(a0 - mx), e1 = expf(a1 - mx), e2 = expf(a2 - mx), e3 = expf(a3 - mx), inv = 1.0f / (e0 + e1 + e2 + e3);
        F.LB[c] = 0.f; F.LB[1024 + c] = e1 * inv; F.LB[2048 + c] = (e1 + e2) * inv; F.LB[3072 + c] = (e1 + e2 + e3) * inv;
    }
    for (int i = gt; i < SEQ * 128; i += NGT) {
        const int pos = i >> 7, j = i & 127;
        const float t = (float)j * (1.0f / 127.0f);
        const float invf = (float)(1.0 / exp((double)t * 9.21034037197618271));
        const float ang = (float)pos * invf;
        float sn, cs; sincos_acc(ang, sn, cs);
        F.RC[i] = cs; F.RS[i] = sn;
    }
    for (int task = F.wg; task < DEPTH * 48; task += F.G) p0_mod_task(F, task);
    __syncthreads();
    const int nconv = (F.G > NGEMM) ? CONV_PRO : DEPTH;
    for (int l = 0; l < nconv; ++l) convert_layer(F, l, wave, lane);
}
template <bool FINAL>
__device__ __forceinline__ void norm_prompt_rows(Frame& F, const XSrc xin, const float* g, int l, int which_sh  ) {
    PHASE_IDS();
    const bool xl = (F.G == 256);
    const int gw = xl ? (F.wg >> 3) * NWAVES + wave : F.wg * NWAVES + wave, NGW = xl ? 256 : F.G * NWAVES, mbeg = xl ? 1024 * (F.wg & 7) : 0, mend = xl ? mbeg + 1024 : SEQ;
    f32x4 av[8], bv[8];
    { const f32x4* gp = (const f32x4*)g + lane;
      if (FINAL) {
#pragma unroll
          for (int j = 0; j < 8; ++j) { av[j] = gp[64 * j]; bv[j] = (f32x4){0.f, 0.f, 0.f, 0.f}; }
      } else {
          const float* mod = F.MOD + (size_t)l * NMOD;
          const f32x4* shp = (const f32x4*)(mod + which_sh * DM) + lane; const f32x4* scp = (const f32x4*)(mod + (which_sh + 1) * DM) + lane;
#pragma unroll
          for (int j = 0; j < 8; ++j) { av[j] = gp[64 * j] * (scp[64 * j] + 1.0f); bv[j] = shp[64 * j]; }
      } }
    for (int m0 = mbeg + gw; m0 < mend; m0 += 4 * NGW) {
        half4 hx[4][8]; f32x4 fx[8];
        const bool f32in = xin.p32 != nullptr;
        int mr[4]; bool ok[4];
#pragma unroll
        for (int q = 0; q < 4; ++q) { mr[q] = m0 + q * NGW; ok[q] = mr[q] < mend; if (!ok[q]) mr[q] = m0; }
        if (!f32in) {
#pragma unroll
            for (int q = 0; q < 4; ++q)
#pragma unroll
                for (int j = 0; j < 8; ++j) hx[q][j] = *(const half4*)(xin.p16 + (size_t)mr[q] * DM + 4 * (lane + 64 * j));
        }
#pragma unroll
        for (int q = 0; q < 4; ++q) {
            if (!ok[q]) continue;
            float ss = 0.f;
#pragma unroll
            for (int j = 0; j < 8; ++j) { fx[j] = f32in ? *(const f32x4*)(xin.p32 + (size_t)mr[q] * DM + 4 * (lane + 64 * j)) : __builtin_convertvector(hx[q][j], f32x4);
                ss += (fx[j].x * fx[j].x + fx[j].y * fx[j].y) + (fx[j].z * fx[j].z + fx[j].w * fx[j].w); }
            const float r = 1.0f / sqrtf(wave_sum(ss) * (1.0f / DM) + EPS);
            if (FINAL) { f32x4* o = (f32x4*)(F.out + (size_t)mr[q] * DM) + lane;
#pragma unroll
                for (int j = 0; j < 8; ++j) o[64 * j] = fx[j] * r * av[j];
            } else { v2u* p = (v2u*)(F.H + (size_t)mr[q] * DM) + lane;
#pragma unroll
                for (int j = 0; j < 8; ++j) { const f32x4 h = fx[j] * r * av[j] + bv[j]; v2u w; w.x = pk2(h.x, h.y); w.y = pk2(h.z, h.w); p[64 * j] = w; }
            }
        }
    }
}
template <bool FINAL, bool WT>
__device__ __forceinline__ void norm_sample_rows(Frame& F, const XSrc xin_s  , const float* g, int l, int which_sh, int nslab, int slab_l, int slab_which, unsigned* ctr) {
    PHASE_IDS();
    LAS float* red = (LAS float*)F.lds;
    int nrows = 0;
    const int idx = 64 * wave + lane;
    for (int rb = F.wg; rb < DECB * DECS; rb += 2 * F.G) {
        const int r0 = rb, r1 = rb + F.G; const bool two = r1 < DECB * DECS; const int r1c = two ? r1 : r0;
        nrows += two ? 2 : 1;
        f32x4 v[2]; v[0] = ldx4(xin_s, (size_t)r0 * DM + 4 * idx); v[1] = ldx4(xin_s, (size_t)r1c * DM + 4 * idx);
        if (nslab > 0) {
            f32x4 a[2]; a[0] = (f32x4){0.f, 0.f, 0.f, 0.f}; a[1] = a[0];
            const XSrc sp0{nullptr, (const half_t*)(F.ws + WS_SLAB) + (size_t)r0 * DM + 4 * idx}, sp1{nullptr, (const half_t*)(F.ws + WS_SLAB) + (size_t)r1c * DM + 4 * idx};
            if (nslab == 16) {
#pragma unroll
                for (int s = 0; s < 16; ++s) { a[0] += ldx4(sp0, (size_t)s * (512 * DM)); a[1] += ldx4(sp1, (size_t)s * (512 * DM)); }
            } else if (nslab == 8) {
#pragma unroll
                for (int s = 0; s < 8; ++s) { a[0] += ldx4(sp0, (size_t)s * (512 * DM)); a[1] += ldx4(sp1, (size_t)s * (512 * DM)); }
            } else {
#pragma unroll
                for (int s = 0; s < 4; ++s) { a[0] += ldx4(sp0, (size_t)s * (512 * DM)); a[1] += ldx4(sp1, (size_t)s * (512 * DM)); }
            }
#pragma unroll
            for (int q = 0; q < 2; ++q) { const int r = q ? r1c : r0; if (q && !two) break;
                const f32x4 gv = *((const f32x4*)(F.MOD + (size_t)((1 + (r >> 6)) * DEPTH + slab_l) * NMOD + slab_which * DM) + idx);
                v[q] += gv * a[q];
                stx4(F.X + (size_t)(SEQ + r) * DM + 4 * idx, v[q]); }
        }
        const float ss0 = wave_sum((v[0].x * v[0].x + v[0].y * v[0].y) + (v[0].z * v[0].z + v[0].w * v[0].w));
        const float ss1 = wave_sum((v[1].x * v[1].x + v[1].y * v[1].y) + (v[1].z * v[1].z + v[1].w * v[1].w));
        __syncthreads();
        if (lane == 0) { red[wave] = ss0; red[8 + wave] = ss1; }
        __syncthreads();
        const f32x4 gg = *((const f32x4*)g + idx);
#pragma unroll
        for (int q = 0; q < 2; ++q) { const int r = q ? r1c : r0; if (q && !two) break;
            const int m = SEQ + r, sq = 1 + (r >> 6);
            float tot = 0.f;
#pragma unroll
            for (int w = 0; w < 8; ++w) tot += red[8 * q + w];
            const float rstd = 1.0f / sqrtf(tot * (1.0f / DM) + EPS);
            if (FINAL) { *((f32x4*)(F.out + (size_t)m * DM) + idx) = v[q] * rstd * gg; }
            else {
                const float* mod = F.MOD + (size_t)(sq * DEPTH + l) * NMOD;
                const f32x4 sh = *((const f32x4*)(mod + which_sh * DM) + idx), sc = *((const f32x4*)(mod + (which_sh + 1) * DM) + idx);
                const f32x4 h = v[q] * rstd * gg * (sc + 1.0f) + sh;
                v2u w; w.x = pk2(h.x, h.y); w.y = pk2(h.z, h.w);
                if (WT) __hip_atomic_store((unsigned long long*)((v2u*)(F.H + (size_t)m * DM) + idx), ((unsigned long long)w.y << 32) | w.x, __ATOMIC_RELAXED, __HIP_MEMORY_SCOPE_AGENT);
                else *((v2u*)(F.H + (size_t)m * DM) + idx) = w;
            }
        }
    }
    if (WT) { asm volatile("s_waitcnt vmcnt(0)" ::: "memory"); __syncthreads(); if (threadIdx.x == 0 && nrows > 0) __hip_atomic_fetch_add(ctr, (unsigned)nrows, __ATOMIC_RELAXED, __HIP_MEMORY_SCOPE_AGENT); }
    __syncthreads();
}
__device__ __forceinline__ void acol_fill(Frame& F) {
    PHASE_IDS();
    const int gt = F.wg * (NWAVES * 64) + tid;
    if (gt < DEPTH * 2 * DM) { const int l = gt / (2 * DM), j = (gt / DM) & 1, c = gt % DM;
        const float g = (j ? F.norm2_g : F.norm1_g)[l * DM + c], sc = F.MOD[(size_t)l * NMOD + (j ? 4 : 1) * DM + c];
        ((float*)(F.ws + WS_ACOL))[gt] = g * (1.0f + sc); }
}
constexpr int NSG = 40;
constexpr size_t WS_UA = WS_END;
constexpr size_t WS_DGA = WS_UA + 20 * MiB;
constexpr size_t WS_SSA = WS_DGA + 1 * MiB;
constexpr size_t WS_UB = WS_SSA + 20 * MiB;
constexpr size_t WS_SSB = WS_UB + 40 * MiB;
constexpr size_t WS_END2 = WS_SSB + 20 * MiB;

constexpr int MX_KHT = 0, MX_VT = 18432, MX_QT = 36864, MX_KT = 54272, MX_QH = 71680, MX_A = 89088, MX_EDEC = 98304, MX_RED = 98816, MX_B = 100864, MX_QTOT = 133632  ;
constexpr int RX_Q = 0, RX_K = 33792, RX_VT = 67584, RX_A = 104448, RX_RED = 113664;
constexpr float LOG2E = 1.4426950408889634f;

__device__ __forceinline__ bf16x8 ldfrag(LAS unsigned char* base, int ld_bytes, int row, int kbyte) { return *(const LAS bf16x8*)(base + row * ld_bytes + kbyte); }
__device__ __forceinline__ int tr_off(int row, int tokpair) { return row * 144 + ((((tokpair >> 2) ^ (row >> 3)) & 7) << 4) + ((tokpair & 3) << 2); }
__device__ __forceinline__ bf16x8 tr_frag(LAS unsigned char* base, int row, int chunk) { return *(const LAS bf16x8*)(base + row * 144 + (((chunk ^ (row >> 3)) & 7) << 4)); }
__device__ __forceinline__ float fexp2(float x) { return __builtin_amdgcn_exp2f(x); }
__device__ __forceinline__ float frsq(float x) { return __builtin_amdgcn_rsqf(x); }
__device__ __forceinline__ float gamma_log2(int h) { return log2f(1.0f - exp2f(-5.0f - (float)h)); }
__device__ __forceinline__ int sg_row0(int sg) { return sg < 32 ? sg * 256 : SEQ + 64 * (sg - 32); }
__device__ __forceinline__ int sg_nch(int sg) { return sg < 32 ? 4 : 1; }

template <bool IS_RET>
__device__ __forceinline__ void p1_unit(Frame& F, int l, int sg, int h, int quad) {
    PHASE_IDS();
    const int g4 = lane >> 4, l16 = lane & 15;
    const int row0 = sg_row0(sg), nch = sg_nch(sg);
    const int kb = quad >> 1, vb = quad & 1;
    const int ck = IS_RET ? 5120 + h * 256 + 128 * kb : 1024 + h * 128;
    const int cv = IS_RET ? 6144 + h * 256 + 128 * vb : 2048 + h * 128;
    LAS unsigned char* L = F.lds;
    LAS float* Edec = (LAS float*)(L + MX_EDEC);
    const float lg2 = gamma_log2(h);
    f32x4 S[8];
#pragma unroll
    for (int kt = 0; kt < 8; ++kt) S[kt] = (f32x4){0.f, 0.f, 0.f, 0.f};
    float sumb = 0.f;
    const int tp = tid >> 4, kc = tid & 15;
    v4u ka, kbv, va, vbv; f32x4 ba0, ba1, bb0, bb1, bt0, bt1; float btk = 0.f;
#define P1_LOAD(rowc_) do { const int ra_ = (rowc_) + 2 * tp; \
        ka = *(const v4u*)(F.P + (size_t)ra_ * 8192 + ck + 8 * kc); kbv = *(const v4u*)(F.P + (size_t)(ra_ + 1) * 8192 + ck + 8 * kc); \
        va = *(const v4u*)(F.P + (size_t)ra_ * 8192 + cv + 8 * kc); vbv = *(const v4u*)(F.P + (size_t)(ra_ + 1) * 8192 + cv + 8 * kc); \
        if (!IS_RET) { const float* la_ = F.LF + (size_t)ra_ * 1024 + h * 128 + 8 * kc; const float* lt_ = F.LF + (size_t)((rowc_) + 63) * 1024 + h * 128; \
            ba0 = *(const f32x4*)la_; ba1 = *(const f32x4*)(la_ + 4); bb0 = *(const f32x4*)(la_ + 1024); bb1 = *(const f32x4*)(la_ + 1028); bt0 = *(const f32x4*)(lt_ + 8 * kc); bt1 = *(const f32x4*)(lt_ + 8 * kc + 4); \
            if (tid < 128) btk = lt_[tid]; } } while (0)
    P1_LOAD(row0);
    const bool smp = sg >= 32;
    f32x4 S0[8];
    const size_t s0base = IS_RET ? ((size_t)((l * DECB + (sg - 32)) * HB + h) * 256) * 256 : ((size_t)((l * DECB + (sg - 32)) * HA + h) * 128) * 128;
    if (smp) { const float* s0 = (IS_RET ? F.state_ret : F.state_hgrn) + s0base;
#pragma unroll
        for (int kt = 0; kt < 8; ++kt)
#pragma unroll
            for (int r = 0; r < 4; ++r) S0[kt][r] = IS_RET ? s0[(size_t)(128 * kb + 16 * kt + 4 * g4 + r) * 256 + 128 * vb + 16 * wave + l16] : s0[(size_t)(16 * kt + 4 * g4 + r) * 128 + 16 * wave + l16]; }
    for (int c = 0; c < nch; ++c) {
        {
            float fa[8], fb[8];
            if (IS_RET) {
                const float za = fexp2(lg2 * (float)(63 - 2 * tp)), zb = fexp2(lg2 * (float)(62 - 2 * tp));
#pragma unroll
                for (int i = 0; i < 8; ++i) { fa[i] = za; fb[i] = zb; }
                if (tid < 128) Edec[tid] = fexp2(lg2 * 64.0f);
            } else {
#pragma unroll
                for (int i = 0; i < 8; ++i) { const float bt = (i < 4) ? bt0[i & 3] : bt1[i & 3], ba = (i < 4) ? ba0[i & 3] : ba1[i & 3], bb = (i < 4) ? bb0[i & 3] : bb1[i & 3];
                    fa[i] = fexp2((bt - ba) * LOG2E); fb[i] = fexp2((bt - bb) * LOG2E);
                    if (tp == 0) Edec[8 * kc + i] = fexp2(bt * LOG2E); }
                if (tid < 128) sumb += btk;
            }
#pragma unroll
            for (int i = 0; i < 8; ++i) {
                const unsigned wa = ka[i >> 1], wb = kbv[i >> 1];
                const float xa = (i & 1) ? bfhi(wa) : bflo(wa), xb = (i & 1) ? bfhi(wb) : bflo(wb);
                *(LAS unsigned*)(L + MX_KHT + tr_off(8 * kc + i, tp)) = pk2(xa * fa[i], xb * fb[i]);
                const unsigned ua = va[i >> 1], ub = vbv[i >> 1];
                const unsigned lo = (i & 1) ? (ua >> 16) : (ua & 0xffffu), hi = (i & 1) ? (ub >> 16) : (ub & 0xffffu);
                *(LAS unsigned*)(L + MX_VT + tr_off(8 * kc + i, tp)) = lo | (hi << 16);
            }
        }
        __syncthreads();
        if (c + 1 < nch) P1_LOAD(row0 + 64 * (c + 1));
        {
            bf16x8 Y[2];
#pragma unroll
            for (int ss = 0; ss < 2; ++ss) Y[ss] = tr_frag(L + MX_VT, 16 * wave + l16, 4 * ss + g4);
#pragma unroll
            for (int hk = 0; hk < 2; ++hk) {
                bf16x8 fk[4][2]; f32x4 dv[4];
#pragma unroll
                for (int q = 0; q < 4; ++q) { const int kt = 4 * hk + q; dv[q] = *(const LAS f32x4*)(Edec + 16 * kt + 4 * g4);
#pragma unroll
                    for (int ss = 0; ss < 2; ++ss) fk[q][ss] = tr_frag(L + MX_KHT, 16 * kt + l16, 4 * ss + g4); }
                __builtin_amdgcn_sched_barrier(0);
#pragma unroll
                for (int q = 0; q < 4; ++q) { const int kt = 4 * hk + q; S[kt] = S[kt] * dv[q];
#pragma unroll
                    for (int ss = 0; ss < 2; ++ss) S[kt] = __builtin_amdgcn_mfma_f32_16x16x32_bf16(fk[q][ss], Y[ss], S[kt], 0, 0, 0); }
                __builtin_amdgcn_sched_barrier(0);
            }
        }
        __syncthreads();
    }
#undef P1_LOAD
    if (smp) {
        float* fin = F.out + (IS_RET ? OFF_SB_S : OFF_SA_S) + s0base;
#pragma unroll
        for (int kt = 0; kt < 8; ++kt) {
            const f32x4 d = *(const LAS f32x4*)(Edec + 16 * kt + 4 * g4);
            const f32x4 fs = d * S0[kt] + S[kt];
#pragma unroll
            for (int r = 0; r < 4; ++r) { if (IS_RET) fin[(size_t)(128 * kb + 16 * kt + 4 * g4 + r) * 256 + 128 * vb + 16 * wave + l16] = fs[r]; else fin[(size_t)(16 * kt + 4 * g4 + r) * 128 + 16 * wave + l16] = fs[r]; }
            if (IS_RET) { v2u w; w.x = pk2(S0[kt][0], S0[kt][1]); w.y = pk2(S0[kt][2], S0[kt][3]);
                *(v2u*)((bf16*)(F.ws + WS_SSB) + ((size_t)(sg * HB + h) * 256 + 128 * vb + 16 * wave + l16) * 256 + 128 * kb + 16 * kt + 4 * g4) = w; }
            else stx4((half_t*)(F.ws + WS_SSA) + ((size_t)(sg * HA + h) * 128 + 16 * wave + l16) * 128 + 16 * kt + 4 * g4, S0[kt]);
        }
        __syncthreads();
        return;
    }
    if (IS_RET) {
        half_t* U = (half_t*)(F.ws + WS_UB) + ((size_t)(sg * HB + h) * 256 + 128 * vb + 16 * wave + l16) * 256 + 128 * kb + 4 * g4;
#pragma unroll
        for (int kt = 0; kt < 8; ++kt) stx4(U + 16 * kt, S[kt]);
    } else {
        half_t* U = (half_t*)(F.ws + WS_UA) + ((size_t)(sg * HA + h) * 128 + 16 * wave + l16) * 128 + 4 * g4;
#pragma unroll
        for (int kt = 0; kt < 8; ++kt) stx4(U + 16 * kt, S[kt]);
        if (tid < 128) ((float*)(F.ws + WS_DGA))[(size_t)(sg * HA + h) * 128 + tid] = fexp2(sumb * LOG2E);
    }
}
__device__ __forceinline__ void mix1_phase(Frame& F, int l, const XcdBarrier& bar) {
    (void)bar;
    for (int u = F.wg; u < 960; u += F.G) {
        bool is_ret; int sg, h, quad = 0;
        if (F.G == 256 && u < 768) {
            const int x = F.wg & 7, k = F.wg >> 3;
            if (u < 256) { is_ret = false; sg = 4 * x + (k >> 3); h = k & 7; }
            else { const int e = k + 32 * ((u >> 8) - 1); is_ret = true; sg = 4 * x + (e >> 4); h = (e >> 2) & 3; quad = e & 3; }
        }
        else if (u < 256) { is_ret = false; sg = u >> 3; h = u & 7; }
        else if (u < 768) { const int r = u - 256, x = r & 7, k = (r >> 3) & 31, unit = (r >> 8) * 64 + (k >> 2) * 8 + x;
            is_ret = true; sg = unit >> 2; h = unit & 3; quad = k & 3; }
        else if (u < 832) { const int r = u - 768; is_ret = false; sg = 32 + (r >> 3); h = r & 7; }
        else { const int r = u - 832; is_ret = true; sg = 32 + (r >> 4); h = (r >> 2) & 3; quad = r & 3; }
        if (is_ret) p1_unit<true>(F, l, sg, h, quad); else p1_unit<false>(F, l, sg, h, quad);
    }
}

__device__ __forceinline__ void mix2_phase(Frame& F, int l) {
    PHASE_IDS();
    const int gt = F.wg * (NWAVES * 64) + tid, NGT = F.G * NWAVES * 64;
    constexpr int IA = 128 * 32, IB = 256 * 64, PER_SEQ = HA * IA + HB * IB;
    for (int it = gt; it < PER_SEQ; it += NGT) {
        const int seq = it / PER_SEQ; int r = it % PER_SEQ;
        const int ng = seq == 0 ? 32 : 1, sg0 = seq == 0 ? 0 : 31 + seq;
        if (r < HA * IA) {
            const int h = r / IA, v = seq == 0 ? ((r % IA) >> 5) : (r & 127), k4 = seq == 0 ? (r & 31) : ((r % IA) >> 7);
            f32x4 s = (f32x4){0.f, 0.f, 0.f, 0.f};
            if (seq > 0) { const float* s0 = F.state_hgrn + ((size_t)((l * DECB + (seq - 1)) * HA + h) * 128) * 128;
#pragma unroll
                for (int e = 0; e < 4; ++e) s[e] = s0[(size_t)(4 * k4 + e) * 128 + v]; }
            for (int g0 = 0; g0 < ng; g0 += 16) {
                half4 u[16]; f32x4 d[16];
#pragma unroll
                for (int i = 0; i < 16; ++i) if (g0 + i < ng) { const size_t ub = (size_t)((sg0 + g0 + i) * HA + h);
                    u[i] = *(const half4*)((const half_t*)(F.ws + WS_UA) + (ub * 128 + v) * 128 + 4 * k4); d[i] = *(const f32x4*)((const float*)(F.ws + WS_DGA) + ub * 128 + 4 * k4); }
#pragma unroll
                for (int i = 0; i < 16; ++i) if (g0 + i < ng) { const size_t ub = (size_t)((sg0 + g0 + i) * HA + h);
                    stx4((half_t*)(F.ws + WS_SSA) + (ub * 128 + v) * 128 + 4 * k4, s); s = d[i] * s + __builtin_convertvector(u[i], f32x4); }
            }
            float* dst = F.out + (seq == 0 ? OFF_SA_P + ((size_t)(l * HA + h) * 128) * 128 : OFF_SA_S + ((size_t)((l * DECB + (seq - 1)) * HA + h) * 128) * 128);
#pragma unroll
            for (int e = 0; e < 4; ++e) dst[(size_t)(4 * k4 + e) * 128 + v] = s[e];
        } else {
            r -= HA * IA;
            const int h = r / IB, v = seq == 0 ? ((r % IB) >> 6) : (r & 255), k4 = seq == 0 ? (r & 63) : ((r % IB) >> 8);
            const float lg2 = gamma_log2(h); const float gd = fexp2(lg2 * (seq == 0 ? 256.0f : 64.0f));
            f32x4 s = (f32x4){0.f, 0.f, 0.f, 0.f};
            if (seq > 0) { const float* s0 = F.state_ret + ((size_t)((l * DECB + (seq - 1)) * HB + h) * 256) * 256;
#pragma unroll
                for (int e = 0; e < 4; ++e) s[e] = s0[(size_t)(4 * k4 + e) * 256 + v]; }
            for (int g0 = 0; g0 < ng; g0 += 16) {
                half4 u[16];
#pragma unroll
                for (int i = 0; i < 16; ++i) if (g0 + i < ng) { const size_t ub = (size_t)((sg0 + g0 + i) * HB + h); u[i] = *(const half4*)((const half_t*)(F.ws + WS_UB) + (ub * 256 + v) * 256 + 4 * k4); }
#pragma unroll
                for (int i = 0; i < 16; ++i) if (g0 + i < ng) { const size_t ub = (size_t)((sg0 + g0 + i) * HB + h);
                    v2u w; w.x = pk2(s[0], s[1]); w.y = pk2(s[2], s[3]);
                    *(v2u*)((bf16*)(F.ws + WS_SSB) + (ub * 256 + v) * 256 + 4 * k4) = w; s = s * gd + __builtin_convertvector(u[i], f32x4); }
            }
            float* dst = F.out + (seq == 0 ? OFF_SB_P + ((size_t)(l * HB + h) * 256) * 256 : OFF_SB_S + ((size_t)((l * DECB + (seq - 1)) * HB + h) * 256) * 256);
#pragma unroll
            for (int e = 0; e < 4; ++e) dst[(size_t)(4 * k4 + e) * 256 + v] = s[e];
        }
    }
}
typedef short bf16x4 __attribute__((ext_vector_type(4)));
__device__ __forceinline__ float clampf(float x, float lo, float hi) { return fminf(fmaxf(x, lo), hi); }
__device__ __forceinline__ void p3_hgrn_unit(Frame& F, int l, int sg, int h) {
    PHASE_IDS();
    const int g4 = lane >> 4, l16 = lane & 15;
    const int row0 = sg_row0(sg), nch = sg_nch(sg);
    LAS unsigned char* L = F.lds;
    LAS float* Edec = (LAS float*)(L + MX_EDEC); LAS float* Red = (LAS float*)(L + MX_RED);
    f32x4 S[8];
    { const XSrc ss{nullptr, (const half_t*)(F.ws + WS_SSA) + ((size_t)(sg * HA + h) * 128 + 16 * wave + l16) * 128 + 4 * g4};
#pragma unroll
      for (int kt = 0; kt < 8; ++kt) S[kt] = ldx4(ss, 16 * kt); }
    const f32x4 gn4 = *(const f32x4*)(F.hgrn_g + l * 1024 + h * 128 + 16 * wave + 4 * g4);
    const int tp = tid >> 4, kc = tid & 15;
    v4u qa, qb, ka, kb, va, vb; f32x4 ba0, ba1, bb0, bb1, br0, br1, bt0, bt1;
#define P3H_LOAD(rowc_) do { const int ra_ = (rowc_) + 2 * tp; const bf16* pa_ = F.P + (size_t)ra_ * 8192 + h * 128 + 8 * kc; const bf16* pb_ = pa_ + 8192; \
        qa = *(const v4u*)pa_; qb = *(const v4u*)pb_; ka = *(const v4u*)(pa_ + 1024); kb = *(const v4u*)(pb_ + 1024); va = *(const v4u*)(pa_ + 2048); vb = *(const v4u*)(pb_ + 2048); \
        const float* la_ = F.LF + (size_t)ra_ * 1024 + h * 128 + 8 * kc; const float* lr_ = F.LF + (size_t)((rowc_) + 31) * 1024 + h * 128 + 8 * kc; const float* lt_ = lr_ + 32 * 1024; \
        ba0 = *(const f32x4*)la_; ba1 = *(const f32x4*)(la_ + 4); bb0 = *(const f32x4*)(la_ + 1024); bb1 = *(const f32x4*)(la_ + 1028); \
        br0 = *(const f32x4*)lr_; br1 = *(const f32x4*)(lr_ + 4); bt0 = *(const f32x4*)lt_; bt1 = *(const f32x4*)(lt_ + 4); } while (0)
    P3H_LOAD(row0);
    for (int c = 0; c < nch; ++c) {
        const int rowc = row0 + 64 * c;
        {
            unsigned qta[4], qtb[4], kta[4], ktb[4], qha[4], qhb[4];
            float pqa = 0.f, pqb = 0.f, pka = 0.f, pkb = 0.f, pha = 0.f, phb = 0.f;
#pragma unroll
            for (int i = 0; i < 8; ++i) {
                const float bref = (i < 4) ? br0[i & 3] : br1[i & 3], btot = (i < 4) ? bt0[i & 3] : bt1[i & 3];
                const float ba = (i < 4) ? ba0[i & 3] : ba1[i & 3], bb = (i < 4) ? bb0[i & 3] : bb1[i & 3];
                const float e1a = fexp2(clampf((ba - bref) * LOG2E, -115.f, 115.f)), e1b = fexp2(clampf((bb - bref) * LOG2E, -115.f, 115.f));
                const float e2a = __builtin_amdgcn_rcpf(e1a), e2b = __builtin_amdgcn_rcpf(e1b);
                const float eref = fexp2(bref * LOG2E), etr = fexp2((btot - bref) * LOG2E);
                const unsigned wqa = qa[i >> 1], wqb = qb[i >> 1], wka = ka[i >> 1], wkb = kb[i >> 1];
                const float xqa = (i & 1) ? bfhi(wqa) : bflo(wqa), xqb = (i & 1) ? bfhi(wqb) : bflo(wqb), xka = (i & 1) ? bfhi(wka) : bflo(wka), xkb = (i & 1) ? bfhi(wkb) : bflo(wkb);
                const float tqa = xqa * e1a, tqb = xqb * e1b, tka = xka * e2a, tkb = xkb * e2b;
                const float hqa = tqa * eref, hqb = tqb * eref;
                *(LAS unsigned*)(L + MX_KHT + tr_off(8 * kc + i, tp)) = pk2(tka * etr, tkb * etr);
                const unsigned ua = va[i >> 1], ub = vb[i >> 1];
                const unsigned lo = (i & 1) ? (ua >> 16) : (ua & 0xffffu), hi = (i & 1) ? (ub >> 16) : (ub & 0xffffu);
                *(LAS unsigned*)(L + MX_VT + tr_off(8 * kc + i, tp)) = lo | (hi << 16);
                if (tp == 0) Edec[8 * kc + i] = fexp2(btot * LOG2E);
                if (i & 1) { qta[i >> 1] = pk2(pqa, tqa); qtb[i >> 1] = pk2(pqb, tqb); kta[i >> 1] = pk2(pka, tka); ktb[i >> 1] = pk2(pkb, tkb); qha[i >> 1] = pk2(pha, hqa); qhb[i >> 1] = pk2(phb, hqb); }
                else { pqa = tqa; pqb = tqb; pka = tka; pkb = tkb; pha = hqa; phb = hqb; }
            }
            const int oa = (2 * tp) * 272 + 16 * kc, ob = oa + 272;
            *(LAS v4u*)(L + MX_QT + oa) = (v4u){qta[0], qta[1], qta[2], qta[3]}; *(LAS v4u*)(L + MX_QT + ob) = (v4u){qtb[0], qtb[1], qtb[2], qtb[3]};
            *(LAS v4u*)(L + MX_KT + oa) = (v4u){kta[0], kta[1], kta[2], kta[3]}; *(LAS v4u*)(L + MX_KT + ob) = (v4u){ktb[0], ktb[1], ktb[2], ktb[3]};
            *(LAS v4u*)(L + MX_QH + oa) = (v4u){qha[0], qha[1], qha[2], qha[3]}; *(LAS v4u*)(L + MX_QH + ob) = (v4u){qhb[0], qhb[1], qhb[2], qhb[3]};
        }
        __syncthreads();
        if (c + 1 < nch) P3H_LOAD(rowc + 64);
        v2u gpre[4];
#pragma unroll
        for (int j = 0; j < 4; ++j) gpre[j] = *(const v2u*)(F.P + (size_t)(rowc + 16 * j + l16) * 8192 + 3072 + h * 128 + 16 * wave + 4 * g4);
        {
            const int jt = wave >> 1;
#pragma unroll
            for (int ii = 0; ii < 2; ++ii) {
                const int it = 2 * (wave & 1) + ii;
                f32x4 a = (f32x4){0.f, 0.f, 0.f, 0.f};
                if (it <= jt) {
#pragma unroll
                    for (int kk = 0; kk < 4; ++kk) a = __builtin_amdgcn_mfma_f32_16x16x32_bf16(ldfrag(L + MX_KT, 272, 16 * it + l16, 64 * kk + 16 * g4), ldfrag(L + MX_QT, 272, 16 * jt + l16, 64 * kk + 16 * g4), a, 0, 0, 0);
                }
                const int t = 16 * jt + l16, s0 = 16 * it + 4 * g4;
                v2u w; w.x = pk2(s0 <= t ? a[0] : 0.f, s0 + 1 <= t ? a[1] : 0.f); w.y = pk2(s0 + 2 <= t ? a[2] : 0.f, s0 + 3 <= t ? a[3] : 0.f);
                if (it > jt) { w.x = 0u; w.y = 0u; }
                *(LAS v2u*)(L + MX_A + t * 144 + s0 * 2) = w;
            }
        }
        f32x4 o[4];
#pragma unroll
        for (int j = 0; j < 4; ++j) o[j] = (f32x4){0.f, 0.f, 0.f, 0.f};
#pragma unroll
        for (int kk = 0; kk < 4; ++kk) {
            const f32x4 s0 = S[2 * kk], s1 = S[2 * kk + 1];
            const v4u xw = (v4u){pk2(s0[0], s0[1]), pk2(s0[2], s0[3]), pk2(s1[0], s1[1]), pk2(s1[2], s1[3])};
            const bf16x8 X = __builtin_bit_cast(bf16x8, xw);
#pragma unroll
            for (int j = 0; j < 4; ++j) {
                const LAS unsigned char* qp = L + MX_QH + (16 * j + l16) * 272 + 64 * kk + 8 * g4;
                const bf16x4 y0 = *(const LAS bf16x4*)qp, y1 = *(const LAS bf16x4*)(qp + 32);
                const bf16x8 Y = __builtin_shufflevector(y0, y1, 0, 1, 2, 3, 4, 5, 6, 7);
                o[j] = __builtin_amdgcn_mfma_f32_16x16x32_bf16(X, Y, o[j], 0, 0, 0);
            }
        }
        __syncthreads();
        {
            bf16x8 Yv[2];
#pragma unroll
            for (int ss = 0; ss < 2; ++ss) Yv[ss] = tr_frag(L + MX_VT, 16 * wave + l16, 4 * ss + g4);
#pragma unroll
            for (int ss = 0; ss < 2; ++ss)
#pragma unroll
                for (int j = 0; j < 4; ++j) { if (ss == 1 && j < 2) continue;
                    o[j] = __builtin_amdgcn_mfma_f32_16x16x32_bf16(Yv[ss], ldfrag(L + MX_A, 144, 16 * j + l16, 64 * ss + 16 * g4), o[j], 0, 0, 0); }
            if (c + 1 < nch) {
#pragma unroll
                for (int kt = 0; kt < 8; ++kt) {
                    S[kt] = S[kt] * *(const LAS f32x4*)(Edec + 16 * kt + 4 * g4);
#pragma unroll
                    for (int ss = 0; ss < 2; ++ss) S[kt] = __builtin_amdgcn_mfma_f32_16x16x32_bf16(tr_frag(L + MX_KHT, 16 * kt + l16, 4 * ss + g4), Yv[ss], S[kt], 0, 0, 0);
                }
            }
        }
#pragma unroll
        for (int j = 0; j < 4; ++j) { float q = (o[j][0] * o[j][0] + o[j][1] * o[j][1]) + (o[j][2] * o[j][2] + o[j][3] * o[j][3]); q += __shfl_xor(q, 16); q += __shfl_xor(q, 32); if (g4 == 0) Red[wave * 64 + 16 * j + l16] = q; }
        __syncthreads();
#pragma unroll
        for (int j = 0; j < 4; ++j) {
            float tot = 0.f;
#pragma unroll
            for (int w = 0; w < 8; ++w) tot += Red[w * 64 + 16 * j + l16];
            const float rstd = frsq(tot * (1.0f / 128.0f) + EPS);
            const size_t row = rowc + 16 * j + l16;
            const v2u gw = gpre[j];
            const f32x4 r = o[j] * rstd * gn4;
            v2u w; w.x = pk2(r[0] * bflo(gw.x), r[1] * bfhi(gw.x)); w.y = pk2(r[2] * bflo(gw.y), r[3] * bfhi(gw.y));
            *(v2u*)(F.O + row * 2048 + h * 128 + 16 * wave + 4 * g4) = w;
        }
        __syncthreads();
    }
#undef P3H_LOAD
}
__device__ __forceinline__ void p3_ret_unit(Frame& F, int l, int sg, int jc, int h, bf16x8 (&X0)[8], bf16x8 (&X1)[8], bool load_S) {
    PHASE_IDS();
    const int g4 = lane >> 4, l16 = lane & 15;
    const int rowg = sg_row0(sg), rowq = rowg + 64 * jc;
    LAS unsigned char* L = F.lds;
    LAS float* Red = (LAS float*)(L + RX_RED);
    const float lg2 = gamma_log2(h);
    const int tp = tid >> 4, kc = tid & 15;
    const int oa = (2 * tp) * 528 + 16 * kc;
    v4u k0, k1, k2, k3, v0, v1, v2, v3;
#define P3R_LOADKV(jp_) do { const bf16* pa_ = F.P + (size_t)(rowg + 64 * (jp_) + 2 * tp) * 8192 + 5120 + h * 256 + 8 * kc; const bf16* pb_ = pa_ + 8192; \
        k0 = *(const v4u*)pa_; k1 = *(const v4u*)(pa_ + 128); k2 = *(const v4u*)pb_; k3 = *(const v4u*)(pb_ + 128); \
        v0 = *(const v4u*)(pa_ + 1024); v1 = *(const v4u*)(pa_ + 1024 + 128); v2 = *(const v4u*)(pb_ + 1024); v3 = *(const v4u*)(pb_ + 1024 + 128); } while (0)
#define P3R_STOREKV() do { *(LAS v4u*)(L + RX_K + oa) = k0; *(LAS v4u*)(L + RX_K + oa + 256) = k1; *(LAS v4u*)(L + RX_K + oa + 528) = k2; *(LAS v4u*)(L + RX_K + oa + 528 + 256) = k3; \
        _Pragma("unroll") for (int i = 0; i < 8; ++i) { \
            { const unsigned ua = v0[i >> 1], ub = v2[i >> 1]; const unsigned lo = (i & 1) ? (ua >> 16) : (ua & 0xffffu), hi = (i & 1) ? (ub >> 16) : (ub & 0xffffu); *(LAS unsigned*)(L + RX_VT + tr_off(8 * kc + i, tp)) = lo | (hi << 16); } \
            { const unsigned ua = v1[i >> 1], ub = v3[i >> 1]; const unsigned lo = (i & 1) ? (ua >> 16) : (ua & 0xffffu), hi = (i & 1) ? (ub >> 16) : (ub & 0xffffu); *(LAS unsigned*)(L + RX_VT + tr_off(128 + 8 * kc + i, tp)) = lo | (hi << 16); } } } while (0)
    {
        const bf16* pa = F.P + (size_t)(rowq + 2 * tp) * 8192 + 4096 + h * 256 + 8 * kc; const bf16* pb = pa + 8192;
        const v4u a0 = *(const v4u*)pa, a1 = *(const v4u*)(pa + 128), b0 = *(const v4u*)pb, b1 = *(const v4u*)(pb + 128);
        P3R_LOADKV(0);
        if (load_S) {
            const bf16* sp = (const bf16*)(F.ws + WS_SSB) + ((size_t)(sg * HB + h) * 256 + 32 * wave + l16) * 256 + 8 * g4;
#pragma unroll
            for (int kk = 0; kk < 8; ++kk) { X0[kk] = *(const bf16x8*)(sp + 32 * kk); X1[kk] = *(const bf16x8*)(sp + (size_t)16 * 256 + 32 * kk); } }
        *(LAS v4u*)(L + RX_Q + oa) = a0; *(LAS v4u*)(L + RX_Q + oa + 256) = a1; *(LAS v4u*)(L + RX_Q + oa + 528) = b0; *(LAS v4u*)(L + RX_Q + oa + 528 + 256) = b1;
        P3R_STOREKV();
    }
    f32x4 acc[2][4];
#pragma unroll
    for (int vt = 0; vt < 2; ++vt)
#pragma unroll
        for (int j = 0; j < 4; ++j) acc[vt][j] = (f32x4){0.f, 0.f, 0.f, 0.f};
    __syncthreads();
    if (jc > 0) P3R_LOADKV(1);
    v2u gpre[4][2];
    const f32x4 rg0 = *(const f32x4*)(F.ret_g + l * 1024 + h * 256 + 32 * wave + 4 * g4), rg1 = *(const f32x4*)(F.ret_g + l * 1024 + h * 256 + 32 * wave + 16 + 4 * g4);
#pragma unroll
    for (int j = 0; j < 4; ++j)
#pragma unroll
        for (int vt = 0; vt < 2; ++vt) gpre[j][vt] = *(const v2u*)(F.P + (size_t)(rowq + 16 * j + l16) * 8192 + 7168 + h * 256 + 32 * wave + 16 * vt + 4 * g4);
    {
#pragma unroll
        for (int kk = 0; kk < 8; ++kk)
            { bf16x8 Y[4];
#pragma unroll
              for (int j = 0; j < 4; ++j) Y[j] = ldfrag(L + RX_Q, 528, 16 * j + l16, 64 * kk + 16 * g4);
              __builtin_amdgcn_sched_barrier(0);
#pragma unroll
              for (int j = 0; j < 4; ++j) { acc[0][j] = __builtin_amdgcn_mfma_f32_16x16x32_bf16(X0[kk], Y[j], acc[0][j], 0, 0, 0); acc[1][j] = __builtin_amdgcn_mfma_f32_16x16x32_bf16(X1[kk], Y[j], acc[1][j], 0, 0, 0); }
              __builtin_amdgcn_sched_barrier(0); }
#pragma unroll
        for (int j = 0; j < 4; ++j) { const float xi = fexp2(lg2 * (float)(64 * jc + 16 * j + l16 + 1)); acc[0][j] = acc[0][j] * xi; acc[1][j] = acc[1][j] * xi; }
    }
    for (int jp = 0; jp <= jc; ++jp) {
        {
            const int jt = wave >> 1; const bool diag = (jp == jc);
#pragma unroll
            for (int ii = 0; ii < 2; ++ii) {
                const int it = 2 * (wave & 1) + ii;
                f32x4 a = (f32x4){0.f, 0.f, 0.f, 0.f};
                const bool live = !(diag && it > jt);
                if (live) {
#pragma unroll
                    for (int hk = 0; hk < 2; ++hk) {
                        bf16x8 fx[4], fy[4];
#pragma unroll
                        for (int q = 0; q < 4; ++q) { const int kk = 4 * hk + q; fx[q] = ldfrag(L + RX_K, 528, 16 * it + l16, 64 * kk + 16 * g4); fy[q] = ldfrag(L + RX_Q, 528, 16 * jt + l16, 64 * kk + 16 * g4); }
                        __builtin_amdgcn_sched_barrier(0);
#pragma unroll
                        for (int q = 0; q < 4; ++q) a = __builtin_amdgcn_mfma_f32_16x16x32_bf16(fx[q], fy[q], a, 0, 0, 0);
                        __builtin_amdgcn_sched_barrier(0);
                    }
                }
                const int t = 16 * jt + l16, s0 = 16 * it + 4 * g4; const int dd = 64 * (jc - jp) + t - s0;
                float e[4];
#pragma unroll
                for (int r = 0; r < 4; ++r) { const float dec = fexp2(lg2 * (float)(dd - r)); e[r] = (!diag || s0 + r <= t) ? a[r] * dec : 0.f; }
                v2u w; w.x = pk2(e[0], e[1]); w.y = pk2(e[2], e[3]);
                if (!live) { w.x = 0u; w.y = 0u; }
                *(LAS v2u*)(L + RX_A + t * 144 + s0 * 2) = w;
            }
        }
        __syncthreads();
        {
            bf16x8 fv[2][2], fp[2][4];
#pragma unroll
            for (int ss = 0; ss < 2; ++ss) {
#pragma unroll
                for (int vt = 0; vt < 2; ++vt) fv[ss][vt] = tr_frag(L + RX_VT, 32 * wave + 16 * vt + l16, 4 * ss + g4);
#pragma unroll
                for (int j = 0; j < 4; ++j) fp[ss][j] = ldfrag(L + RX_A, 144, 16 * j + l16, 64 * ss + 16 * g4); }
            __builtin_amdgcn_sched_barrier(0);
#pragma unroll
            for (int ss = 0; ss < 2; ++ss)
#pragma unroll
                for (int vt = 0; vt < 2; ++vt)
#pragma unroll
                    for (int j = 0; j < 4; ++j) acc[vt][j] = __builtin_amdgcn_mfma_f32_16x16x32_bf16(fv[ss][vt], fp[ss][j], acc[vt][j], 0, 0, 0);
            __builtin_amdgcn_sched_barrier(0);
        }
        if (jp < jc) {
            __syncthreads();
            P3R_STOREKV();
            __syncthreads();
            if (jp + 2 <= jc) P3R_LOADKV(jp + 2);
        }
    }
#undef P3R_LOADKV
#undef P3R_STOREKV
#pragma unroll
    for (int j = 0; j < 4; ++j) { float q = 0.f;
#pragma unroll
        for (int vt = 0; vt < 2; ++vt) q += (acc[vt][j][0] * acc[vt][j][0] + acc[vt][j][1] * acc[vt][j][1]) + (acc[vt][j][2] * acc[vt][j][2] + acc[vt][j][3] * acc[vt][j][3]);
        q += __shfl_xor(q, 16); q += __shfl_xor(q, 32); if (g4 == 0) Red[wave * 64 + 16 * j + l16] = q; }
    __syncthreads();
#pragma unroll
    for (int j = 0; j < 4; ++j) {
        float tot = 0.f;
#pragma unroll
        for (int w = 0; w < 8; ++w) tot += Red[w * 64 + 16 * j + l16];
        const float rstd = frsq(tot * (1.0f / 256.0f) + EPS);
        const size_t row = rowq + 16 * j + l16;
#pragma unroll
        for (int vt = 0; vt < 2; ++vt) {
            const int vc = h * 256 + 32 * wave + 16 * vt + 4 * g4;
            const v2u gw = gpre[j][vt];
            const f32x4 r = acc[vt][j] * rstd * (vt ? rg1 : rg0);
            v2u w; w.x = pk2(r[0] * bflo(gw.x), r[1] * bfhi(gw.x)); w.y = pk2(r[2] * bflo(gw.y), r[3] * bfhi(gw.y));
            *(v2u*)(F.O + row * 2048 + 1024 + vc) = w;
        }
    }
    __syncthreads();
}
__device__ __forceinline__ void mix3_phase(Frame& F, int l, int parts = 3) {
    for (int vw = F.wg; vw < 256; vw += F.G) {
        const bool xl = (F.G == 256); const int x = vw & 7, k = vw >> 3;
        if (parts & 1) for (int q = 0; q < 2; ++q) {
            if (q == 1 && vw >= 64) break;
            const int sg = q == 0 ? (xl ? 4 * x + (k >> 3) : (vw >> 3)) : 32 + (vw >> 3);
            const int h = q == 0 ? (xl ? (k & 7) : (vw & 7)) : (vw & 7);
            p3_hgrn_unit(F, l, sg, h);
        }
        bf16x8 SX0[8], SX1[8];
        if (parts & 2) for (int q = 0; q < 3; ++q) {
            int sg, jc, h;
            if (q < 2) { int half; if (xl) { sg = 4 * x + (k >> 3); h = (k >> 1) & 3; half = k & 1; } else { h = vw & 3; sg = (vw >> 2) & 31; half = vw >> 7; }
                jc = q == 0 ? (half ? 2 : 3) : (half ? 1 : 0); }
            else { if (vw < 64 || vw >= 96) break; sg = 32 + ((vw - 64) >> 2); jc = 0; h = (vw - 64) & 3; }
            p3_ret_unit(F, l, sg, jc, h, SX0, SX1, q != 1);
        }
    }
}
constexpr int PH_PRO = 0, PH_PER_LAYER = 9, PH_FINAL = 1 + DEPTH * PH_PER_LAYER, N_PHASES = PH_FINAL + 1;
struct Args { const float* in[18]; float* out; unsigned char* ws; int ph_lo, ph_hi; };
__global__ void __launch_bounds__(NWAVES * 64, 2) fwd(Args args) {
    extern __shared__ __attribute__((aligned(16))) unsigned char lds[];
    Frame F;
    F.lds = (LAS unsigned char*)lds;
    F.G = gridDim.x; F.wg = blockIdx.x;
    unsigned char* ws = args.ws;
    F.ctl = (unsigned*)(ws + WS_CTL); F.ws = ws;
    F.x_prompt = args.in[0]; F.x_sample = args.in[1]; F.state_hgrn = args.in[2]; F.state_ret = args.in[3]; F.c_prompt = args.in[4]; F.c_sample = args.in[5];
    F.lb_logits = args.in[6]; F.w_ada = args.in[7]; F.b_ada = args.in[8]; F.norm1_g = args.in[9]; F.norm2_g = args.in[10]; F.w_in = args.in[11];
    F.hgrn_g = args.in[12]; F.ret_g = args.in[13]; F.w_out = args.in[14]; F.w_up = args.in[15]; F.w_down = args.in[16]; F.final_g = args.in[17];
    F.out = args.out;
    F.Win_t = (bf16*)(ws + WS_WIN); F.Wout_t = (bf16*)(ws + WS_WOUT); F.Wup_t = (bf16*)(ws + WS_WUP); F.Wdn_t = (bf16*)(ws + WS_WDN);
    F.X = (half_t*)(ws + WS_X); F.H = (bf16*)(ws + WS_H); F.P = (bf16*)(ws + WS_P); F.LF = (float*)(ws + WS_LF); F.O = (bf16*)(ws + WS_O); F.U = (bf16*)(ws + WS_U);
    F.MOD = (float*)(ws + WS_MOD); F.LB = (float*)(ws + WS_LB); F.RC = (float*)(ws + WS_ROPE); F.RS = F.RC + SEQ * 128;
    volatile LAS unsigned* MISC = (volatile LAS unsigned*)(F.lds + MISC_OFF);
    if (threadIdx.x < 64) MISC[threadIdx.x] = 0u;
    __syncthreads();
#ifndef NO_XCC_REMAP
    if (threadIdx.x == 0) { const unsigned x = xb_xcc_id() & 7u; MISC[16] = x; MISC[17] = xb_add(F.ctl + CW_XRANK + 64 * x, 1u); }
#endif
    const int lo = args.ph_lo, hi = args.ph_hi;
    XcdBarrier bar; bar.bar = F.ctl + CW_BAR; bar.x = 0; bar.st = MISC + 8;
    if (hi - lo > 1) bar = xcd_barrier_post(F.ctl + CW_BAR, MISC + 8);
#define IN(k) (lo <= (k) && (k) < hi)
#ifdef PROBE_BAR2
#define SEAM(k) do { if (IN(k) && IN((k) + 1)) { xcd_barrier(bar); xcd_barrier(bar); } } while (0)
#else
#define SEAM(k) do { if (IN(k) && IN((k) + 1)) xcd_barrier(bar); } while (0)
#endif

    if (IN(PH_PRO)) {
#ifndef SKIP_PRO
 p0_prologue(F, 0);
#endif
#ifdef PROBE_PRO
 __syncthreads(); p0_prologue(F, 1);
#endif
 } SEAM(PH_PRO);
#ifndef NO_XCC_REMAP
    if (IN(PH_PRO) && IN(PH_PRO + 1) && (F.G & 7) == 0) {
        if (threadIdx.x == 0) { bool even = true; for (int j = 0; j < 8; ++j) even = even && (xb_ld(F.ctl + CW_XRANK + 64 * j) == (unsigned)(F.G >> 3)); MISC[18] = even ? (MISC[17] * 8u + MISC[16]) : (unsigned)blockIdx.x; }
        __syncthreads();
        F.wg = __builtin_amdgcn_readfirstlane((int)MISC[18]);
    }
#endif
    for (int l = 0; l < DEPTH; ++l) {
        const int pb = 1 + l * PH_PER_LAYER;
        const bool fz = (l >= FUSE_FROM) && (F.G > NGEMM);
        float* const RSS = (float*)(F.ctl + CW_RSS); float* const BIAS = (float*)(F.ctl + CW_BIAS); const float* const ACOL = (const float*)(F.ws + WS_ACOL);
        if (IN(pb + 0) && !fz) {
            if (l == 0) acol_fill(F);
            norm_prompt_rows<false>(F, l == 0 ? XSrc{F.x_prompt, nullptr} : XSrc{nullptr, F.X}, F.norm1_g + l * DM, l, 0);
            norm_sample_rows<false, false>(F, l == 0 ? XSrc{F.x_sample, nullptr} : XSrc{nullptr, F.X + (size_t)SEQ * DM}, F.norm1_g + l * DM, l, 0, l > 0 ? 4 : 0, l - 1, 5, nullptr);
        }
        if (!fz) SEAM(pb + 0);
        if (IN(pb + 1)) {
            unsigned* ctr = F.ctl + CW_SMP + 64 * (2 * l);
            if (fz) norm_sample_rows<false, true>(F, XSrc{nullptr, F.X + (size_t)SEQ * DM}, F.norm1_g + l * DM, l, 0, 4, l - 1, 5, ctr);
            const bool helpers = (CONV_PRO < DEPTH) && (l + 1 >= CONV_PRO) && (l + 1 < DEPTH) && (F.G > NGEMM);
            const int ng = helpers ? NGEMM : F.G;
#if defined(PROBE_DUP_IN) || defined(PROBE_DUP_IN3)
            for (int rep = 0; rep < 2; ++rep) { if (rep) xcd_barrier(bar);
#define REP0_IN (rep == 0)
#else
#define REP0_IN true
#endif
            if (F.wg < ng) {
                pg8::Gemm g{F.H, F.Win_t + (size_t)l * NPROJ * DM, M, NPROJ, DM};
                pg8::EpiInProj E{F.P, F.LF, F.LB + l * 1024, F.RC, F.RS, nullptr, fz ? RSS + (size_t)(2 * l) * 8192 : nullptr, BIAS + (size_t)(2 * l) * 8192};
#ifdef PROBE_DUP_IN3
                if (rep) { E.P = F.U; E.force_seg = PROBE_DUP_IN3; }
#endif
#ifdef USE_ALIGNED_ORDER
                if ((ng & 7) == 0) { pg8::XcdAlignedOrder S; S.init(DM, ng, F.wg); S.permute = 1; pg8::gemm_phase<pg8::EpiInProj, pg8::XcdAlignedOrder, true, true, 0>(F.lds + RING_OFF, g, S, E); } else
#endif
                { pg8::HookOrder S; S.init(M, NPROJ, DM, ng, F.wg); S.permute = 1; S.ready = fz ? ctr : nullptr; S.need = DECB * DECS; S.tmo = F.ctl + CW_TMO;
                pg8::gemm_phase<pg8::EpiInProj, pg8::HookOrder, true, true, 0>(F.lds + RING_OFF, g, S, E); }
            } else if (REP0_IN) { PHASE_IDS(); convert_layer(F, l + 1, wave, lane, 0, CV_SPLIT, 0); }
#if defined(PROBE_DUP_IN) || defined(PROBE_DUP_IN3)
            }
#endif
#ifdef PROBE_DUP_IN2
            xcd_barrier(bar);
            if (F.wg < ng) {
                pg8::Gemm g{F.H, F.Win_t + (size_t)l * NPROJ * DM, M, NPROJ, DM};
                pg8::EpiRelu2 E{F.U, DFF, nullptr, nullptr, BIAS};
                pg8::XcdAlignedOrder S; S.init(DM, ng, F.wg); S.permute = 1; pg8::gemm_phase<pg8::EpiRelu2, pg8::XcdAlignedOrder, true, true, 0>(F.lds + RING_OFF, g, S, E);
            }
#endif
#ifdef PROBE_HALFGRID
            xcd_barrier(bar);
            if (F.wg < PROBE_HALFGRID) {
                pg8::Gemm g{F.H, F.Win_t + (size_t)l * NPROJ * DM, M, NPROJ, DM};
                pg8::EpiInProj E{F.P, F.LF, F.LB + l * 1024, F.RC, F.RS, nullptr, fz ? RSS + (size_t)(2 * l) * 8192 : nullptr, BIAS + (size_t)(2 * l) * 8192};
                pg8::HookOrder S; S.init(M, NPROJ, DM, PROBE_HALFGRID, F.wg); S.permute = 1; S.ready = nullptr; S.need = 0; S.tmo = F.ctl + CW_TMO;
                pg8::gemm_phase<pg8::EpiInProj, pg8::HookOrder, true, true, 0>(F.lds + RING_OFF, g, S, E);
            }
#endif
        } SEAM(pb + 1);
#ifdef PROBE_REP_MIX
#define MIXREP(k_) for (int rep = 0; rep < ((PROBE_REP_MIX) == (k_) ? 2 : 1); ++rep)
#define MIXREPBAR() do { if (rep) xcd_barrier(bar); } while (0)
#else
#define MIXREP(k_)
#define MIXREPBAR() do { } while (0)
#endif
        if (IN(pb + 2)) { MIXREP(1) { MIXREPBAR(); mix1_phase(F, l, bar); } } SEAM(pb + 2);
        if (IN(pb + 3)) { MIXREP(2) { MIXREPBAR(); mix2_phase(F, l); } } SEAM(pb + 3);
        if (IN(pb + 4)) { MIXREP(3) { MIXREPBAR(); mix3_phase(F, l); } } SEAM(pb + 4);
        if (IN(pb + 5)) {
            pg8::Gemm g{F.O, F.Wout_t + (size_t)l * DM * DM, M, DM, DM}; pg8::ResidOrder S; S.init(DM, 8, F.G, F.wg);
            pg8::EpiResid E{F.X, F.MOD + (size_t)l * NMOD + 2 * DM, (float*)(F.ws + WS_SLAB), l == 0 ? F.x_prompt : nullptr, fz ? F.H : nullptr, ACOL + (size_t)(2 * l + 1) * DM, RSS + (size_t)(2 * l + 1) * 8192};
            pg8::gemm_phase<pg8::EpiResid, pg8::ResidOrder, true, true>(F.lds + RING_OFF, g, S, E);
        } SEAM(pb + 5);
        if (IN(pb + 6) && !fz) {
            norm_prompt_rows<false>(F, XSrc{nullptr, F.X}, F.norm2_g + l * DM, l, 3);
            norm_sample_rows<false, false>(F, l == 0 ? XSrc{F.x_sample, nullptr} : XSrc{nullptr, F.X + (size_t)SEQ * DM}, F.norm2_g + l * DM, l, 3, 8, l, 2, nullptr);
        }
        if (!fz) SEAM(pb + 6);
        if (IN(pb + 7)) {
            unsigned* ctr = F.ctl + CW_SMP + 64 * (2 * l + 1);
            if (fz) norm_sample_rows<false, true>(F, XSrc{nullptr, F.X + (size_t)SEQ * DM}, F.norm2_g + l * DM, l, 3, 8, l, 2, ctr);
            const bool helpers = (CONV_PRO < DEPTH) && (l + 1 >= CONV_PRO) && (l + 1 < DEPTH) && (F.G > NGEMM);
            const int ng = helpers ? NGEMM : F.G;
#ifdef PROBE_DUP_UP
            for (int rep = 0; rep < 2; ++rep) { if (rep) xcd_barrier(bar);
#define REP0_UP (rep == 0)
#else
#define REP0_UP true
#endif
            if (F.wg < ng) {
                pg8::Gemm g{F.H, F.Wup_t + (size_t)l * DFF * DM, M, DFF, DM};
                pg8::EpiRelu2 E{F.U, DFF, nullptr, fz ? RSS + (size_t)(2 * l + 1) * 8192 : nullptr, BIAS + (size_t)(2 * l + 1) * 8192};
#ifdef USE_ALIGNED_ORDER
                if ((ng & 7) == 0) { pg8::XcdAlignedOrder S; S.init(DM, ng, F.wg); pg8::gemm_phase<pg8::EpiRelu2, pg8::XcdAlignedOrder, true, true, 0>(F.lds + RING_OFF, g, S, E); } else
#endif
                { pg8::HookOrder S; S.init(M, DFF, DM, ng, F.wg); S.permute = 0; S.ready = fz ? ctr : nullptr; S.need = DECB * DECS; S.tmo = F.ctl + CW_TMO;
                pg8::gemm_phase<pg8::EpiRelu2, pg8::HookOrder, true, true, 0>(F.lds + RING_OFF, g, S, E); }
            } else if (REP0_UP) { PHASE_IDS(); convert_layer(F, l + 1, wave, lane, CV_SPLIT, CV_LAYER, 16); }
#ifdef PROBE_DUP_UP
            }
#endif
        } SEAM(pb + 7);
        if (IN(pb + 8)) {
            const bool fzn = (l + 1 < DEPTH) && (l + 1 >= FUSE_FROM) && (F.G > NGEMM);
            pg8::Gemm g{F.U, F.Wdn_t + (size_t)l * DM * DFF, M, DM, DFF}; pg8::ResidOrder S; S.init(DFF, 4, F.G, F.wg);
            pg8::EpiResid E{F.X, F.MOD + (size_t)l * NMOD + 5 * DM, (float*)(F.ws + WS_SLAB), nullptr, fzn ? F.H : nullptr, ACOL + (size_t)(2 * (l + 1)) * DM, RSS + (size_t)(2 * (l + 1)) * 8192};
#ifdef PROBE_DUP_DOWN
            for (int rep = 0; rep < 2; ++rep) { if (rep) { xcd_barrier(bar); E.X = (half_t*)(F.ws + WS_END2 + 64 * MiB); E.slab = (float*)(F.ws + WS_END2 + 128 * MiB); }
#endif
            pg8::gemm_phase<pg8::EpiResid, pg8::ResidOrder, true, true>(F.lds + RING_OFF, g, S, E);
#ifdef PROBE_DUP_DOWN
            }
#endif
        } SEAM(pb + 8);
    }
    if (IN(PH_FINAL)) {
        norm_prompt_rows<true>(F, XSrc{nullptr, F.X}, F.final_g, DEPTH - 1, 0);
        norm_sample_rows<true, false>(F, XSrc{nullptr, F.X + (size_t)SEQ * DM}, F.final_g, DEPTH - 1, 0, 4, DEPTH - 1, 5, nullptr);
    }
#undef IN
#undef SEAM
}

#ifndef MK_ONE_LAUNCH
#define MK_ONE_LAUNCH 1
#endif
extern "C" void kernel_launch(void* const* d_in, const int* in_sizes, int n_in, void* d_out, int out_size, void* d_ws, size_t ws_size, hipStream_t stream) {
    static int grid = 0;
    if (grid == 0) {
        if (n_in != 18 || (size_t)out_size != OUT_TOTAL || ws_size < WS_END2) { fprintf(stderr, "kernel_launch: unexpected shapes: n_in %d out %d ws %zu (need %zu)\n", n_in, out_size, ws_size, (size_t)WS_END2); grid = -1; return; }
        int dev = 0, cus = 0, per_cu = 0;
        if (hipGetDevice(&dev) != hipSuccess || hipDeviceGetAttribute(&cus, hipDeviceAttributeMultiprocessorCount, dev) != hipSuccess) { grid = -1; return; }
        if (hipFuncSetAttribute((const void*)fwd, hipFuncAttributeMaxDynamicSharedMemorySize, LDS_BYTES) != hipSuccess) { fprintf(stderr, "kernel_launch: hipFuncSetAttribute failed\n"); grid = -1; return; }
        if (hipOccupancyMaxActiveBlocksPerMultiprocessor(&per_cu, (const void*)fwd, NWAVES * 64, LDS_BYTES) != hipSuccess || per_cu < 1)
            fprintf(stderr, "kernel_launch: note: occupancy query reports %d workgroups per CU\n", per_cu);
        (void)hipGetLastError();
        grid = cus;
    }
    if (grid < 0) return;
    if (hipMemsetAsync((char*)d_ws + WS_CTL, 0, CTL_ZERO_BYTES, stream) != hipSuccess) { fprintf(stderr, "kernel_launch: memset failed\n"); return; }
    Args a{};
    for (int i = 0; i < 18; ++i) a.in[i] = (const float*)d_in[i];
    a.out = (float*)d_out; a.ws = (unsigned char*)d_ws;
#if MK_ONE_LAUNCH
    a.ph_lo = 0; a.ph_hi = N_PHASES;
    hipLaunchKernelGGL(fwd, dim3(grid), dim3(NWAVES * 64), LDS_BYTES, stream, a);
#else
    for (int ph = 0; ph < N_PHASES; ++ph) {
        a.ph_lo = ph; a.ph_hi = ph + 1;
        hipLaunchKernelGGL(fwd, dim3(grid), dim3(NWAVES * 64), LDS_BYTES, stream, a);
    }
#endif
    const hipError_t le = hipPeekAtLastError();
    if (le != hipSuccess) fprintf(stderr, "kernel_launch: launch failed: %s\n", hipGetErrorName(le));
}
```

```cpp
#define USE_ALIGNED_ORDER 1
#define FUSE_FROM 99
#include <hip/hip_runtime.h>
#include <cstdio>
#include <cstdint>
typedef _Float16 half_t;
typedef _Float16 half4 __attribute__((ext_vector_type(4)));
typedef float xf4 __attribute__((ext_vector_type(4)));
struct XSrc { const float* p32; const half_t* p16; };
__device__ __forceinline__ xf4 ldx4(const XSrc& s, size_t e) { return s.p32 ? *(const xf4*)(s.p32 + e) : __builtin_convertvector(*(const half4*)(s.p16 + e), xf4); }
__device__ __forceinline__ void stx4(half_t* p, xf4 v) { *(half4*)p = __builtin_convertvector(v, half4); }
__device__ __forceinline__ int row_pos(int row) { return row < 8192 ? row : 2048 + ((row - 8192) & 63); }
__device__ __forceinline__ int row_seq(int row) { return row < 8192 ? 0 : 1 + ((row - 8192) >> 6); }
namespace pg8 {
#define PG8_LAS __attribute__((address_space(3)))
typedef unsigned short bf16_t;
typedef short bf16x8 __attribute__((ext_vector_type(8)));
typedef float f32x4 __attribute__((ext_vector_type(4)));
typedef unsigned u32x4 __attribute__((ext_vector_type(4)));
typedef unsigned u32x2 __attribute__((ext_vector_type(2)));
constexpr int BM = 256, BK = 64, HALF = 128, HTB = HALF * BK * 2  , STAGE_BYTES = 8 * HTB, NXCD = 8, WGM = 4;

__host__ __device__ __forceinline__ int lds_byte(int r, int c) { const int st = (r >> 4) * 2 + (c >> 5), rr = r & 15, cc = c & 31, ob = rr * 64 + cc * 2; return st * 1024 + (ob ^ (((ob >> 9) & 1) << 5)); }
__host__ __device__ __forceinline__ void stage_rc(int b, int& R, int& C) { const int st = b / 1024, sb = b % 1024, swz = sb ^ (((sb >> 9) & 1) << 5); R = (st >> 1) * 16 + swz / 64; C = (st & 1) * 32 + (swz % 64) / 2; }
__host__ __device__ __forceinline__ int perm32(int rho) { const int n = rho >> 4, i = rho & 15; return 8 * (i >> 2) + 4 * n + (i & 3); }

struct Unit { int pm, pn, kt0, nt, slab, qa, qh; };
struct Gemm { const bf16_t* A; const bf16_t* Bt; int M, N, K; };

struct StaticOrder {
    int nM, nN, nwg, G, c, ntk;
    __host__ __device__ __forceinline__ void init(int M, int N, int K, int G_, int c_) { nM = M / BM; nN = N / BM; nwg = nM * nN; G = G_; c = c_; ntk = K / BK; }
    __host__ __device__ __forceinline__ bool next(int i, Unit& u) const {
        const long L = (long)i * G + c; if (L >= nwg) return false;
        int wgid = (int)L; { const int q = nwg / NXCD, r = nwg % NXCD, xcd = wgid % NXCD, off = wgid / NXCD; wgid = (xcd < r ? xcd * (q + 1) : r * (q + 1) + (xcd - r) * q) + off; }
        const int nig = WGM * nN, gid = wgid / nig, fm = gid * WGM, gsz = (nM - fm) < WGM ? (nM - fm) : WGM;
        u.pm = fm + ((wgid % nig) % gsz); u.pn = (wgid % nig) / gsz; u.kt0 = 0; u.nt = ntk; u.slab = -1; u.qa = -1; u.qh = 0; return true;
    }
    __device__ __forceinline__ void a_ready(const Unit&) const {}
    __device__ __forceinline__ void done(const Unit&) const {}
};

__device__ __forceinline__ void hook_wait(const unsigned* ready, unsigned need, unsigned* tmo) {
    if (threadIdx.x < 64) {
        const unsigned long long t0 = __builtin_amdgcn_s_memrealtime(); unsigned polls = 0;
        while ((unsigned)__builtin_amdgcn_readfirstlane(__hip_atomic_load(ready, __ATOMIC_RELAXED, __HIP_MEMORY_SCOPE_AGENT)) < need) {
            if ((++polls & 255u) == 0u && __builtin_amdgcn_readfirstlane(__hip_atomic_load(tmo, __ATOMIC_RELAXED, __HIP_MEMORY_SCOPE_AGENT)) != 0u) break;
            if (__builtin_amdgcn_s_memrealtime() - t0 > 2000000ull) { if (threadIdx.x == 0) __hip_atomic_store(tmo, 1u, __ATOMIC_RELAXED, __HIP_MEMORY_SCOPE_AGENT); break; }
            __builtin_amdgcn_s_sleep(2); }
        __builtin_amdgcn_fence(__ATOMIC_ACQUIRE, "agent");
        asm volatile("s_waitcnt vmcnt(0)" ::: "memory");
    }
    asm volatile("" ::: "memory"); __builtin_amdgcn_s_barrier(); asm volatile("" ::: "memory");
}
struct HookOrder : StaticOrder {
    const unsigned* ready; unsigned need; unsigned* tmo; int permute;
    __host__ __device__ __forceinline__ bool next(int i, Unit& u) const { const bool ok = StaticOrder::next(i, u); if (permute) u.pn = (u.pn * 5) & 31; return ok; }
    __device__ __forceinline__ void a_ready(const Unit& u) const { if (ready != nullptr && u.pm >= 32) hook_wait(ready, need, tmo); }
};
struct XcdAlignedOrder {
    int G, c, ntk, permute; const unsigned* ready; unsigned need; unsigned* tmo;
    __host__ __device__ __forceinline__ void init(int K, int G_, int c_) { G = G_; c = c_; ntk = K / BK; permute = 0; ready = nullptr; need = 0; tmo = nullptr; }
    __host__ __device__ __forceinline__ bool next(int i, Unit& u) const {
        const int x = c & 7, j = i * (G >> 3) + (c >> 3); if (j >= 136 || (c >> 3) >= (G >> 3)) return false;
        const int s0 = x >> 1, q = j / 17, r = j % 17;
        int pm, pn;
        if (r == 4 * (s0 + 1)) { pm = 32 + (x & 1); pn = 4 * q + s0; }
        else { const int rr = r > 4 * (s0 + 1) ? r - 1 : r; pm = 4 * x + (rr & 3); pn = 4 * q + (rr >> 2); }
        if (permute) {
            const unsigned long long lo = pn < 16 ? 0xc3e001e894f24db9ull : 0xa8376af2cd15765bull;
            pn = (int)((lo >> (4 * (pn & 15))) & 15ull) | (int)(((0x76a6129eu >> pn) & 1u) << 4); }
        u.pm = pm; u.pn = pn; u.kt0 = 0; u.nt = ntk; u.slab = -1; u.qa = -1; u.qh = 0; return true;
    }
    __device__ __forceinline__ void a_ready(const Unit& u) const { if (ready != nullptr && u.pm >= 32) hook_wait(ready, need, tmo); }
    __device__ __forceinline__ void done(const Unit&) const {}
};
struct ResidOrder {
    StaticOrder so; int G, c, nks, ntk, nsub, nmine, sub_last, nfull; const unsigned* ready; unsigned need; unsigned* tmo;
    __host__ __device__ __forceinline__ void init(int K, int nks_, int G_, int c_, int sub_last_ = 0, const unsigned* ready_ = nullptr, unsigned need_ = 0, unsigned* tmo_ = nullptr) {
        so.init(8192, 2048, K, G_, c_); G = G_; c = c_; nks = nks_; ntk = (K / BK) / nks; nsub = 16 * nks; nmine = c < nsub ? (nsub - c + G - 1) / G : 0;
        sub_last = sub_last_; ready = ready_; need = need_; tmo = tmo_; nfull = c < so.nwg ? (so.nwg - c + G - 1) / G : 0; }
    __host__ __device__ __forceinline__ bool sub(int i, Unit& u) const { if (i >= nmine) return false; const int s = c + i * G, su = s / nks, ks = s % nks; u.pm = 32 + (su >> 3); u.pn = su & 7; u.kt0 = ks * ntk; u.nt = ntk; u.slab = ks; u.qa = -1; u.qh = 0; return true; }
    __host__ __device__ __forceinline__ bool next(int i, Unit& u) const {
        if (sub_last) { if (i < nfull) return so.next(i, u); return sub(i - nfull, u); }
        if (i < nmine) return sub(i, u);
        return so.next(i - nmine, u);
    }
    __device__ __forceinline__ void a_ready(const Unit& u) const { if (ready != nullptr && u.slab >= 0) hook_wait(ready, need, tmo); }
    __device__ __forceinline__ void done(const Unit&) const {}
};
struct InUpOrder {
    StaticOrder so; int G, c, nmine;
#ifdef FIXMASK
    __host__ __device__ __forceinline__ void init(int K, int G_, int c_) { so.init(8704, 8192, K, G_, c_); G = G_; c = c_; nmine = c < 256 ? (256 - c + G - 1) / G : 0; }
#else
    __host__ __device__ __forceinline__ void init(int K, int G_, int c_) { so.init(8192, 8192, K, G_, c_); G = G_; c = c_; nmine = c < 256 ? (256 - c + G - 1) / G : 0; }
#endif
    __host__ __device__ __forceinline__ bool next(int i, Unit& u) const {
        if (i < nmine) { const int s = c + i * G, su = s >> 2, kq = s & 3; u.pm = 32 + (su >> 5); u.pn = su & 31; u.kt0 = kq * (so.ntk / 4); u.nt = so.ntk / 4; u.slab = kq; u.qa = -1; u.qh = 0; return true; }
        return so.next(i - nmine, u);
    }
    __device__ __forceinline__ void a_ready(const Unit&) const {}
    __device__ __forceinline__ void done(const Unit&) const {}
};
struct SameTileOrder : StaticOrder {
    __host__ __device__ __forceinline__ bool next(int i, Unit& u) const { const bool ok = StaticOrder::next(i, u); u.slab = u.pm * 64 + u.pn; u.pm = 0; u.pn = 0; return ok; }
};
struct QuarterOrder {
    int nN, G, c, ntk, nsub;
    __host__ __device__ __forceinline__ void init(int N, int K, int G_, int c_) { nN = N / BM; G = G_; c = c_; ntk = K / BK; nsub = 2 * nN * 4; }
    __host__ __device__ __forceinline__ bool next(int i, Unit& u) const {
        const int s = c + i * G; if (s >= nsub) return false;
        const int q = s / (2 * nN), t = s % (2 * nN);
        u.pm = 32 + t / nN; u.pn = t % nN; u.kt0 = 0; u.nt = ntk; u.slab = -1; u.qa = q >> 1; u.qh = q & 1; return true;
    }
    __device__ __forceinline__ void a_ready(const Unit&) const {}
    __device__ __forceinline__ void done(const Unit&) const {}
};

__device__ __forceinline__ unsigned cvt_pk_bf16(float lo, float hi) { unsigned r; asm volatile("v_cvt_pk_bf16_f32 %0, %1, %2" : "=v"(r) : "v"(lo), "v"(hi)); return r; }
__device__ __forceinline__ float fast_rcp(float x) { return __builtin_amdgcn_rcpf(x); }
__device__ __forceinline__ float silu_f(float x) { return x * fast_rcp(1.0f + __expf(-x)); }

__device__ __forceinline__ void store_slab_perm(float* slab2, const f32x4 (&acc)[2][2][4][2], const Unit& u, int wr, int wc, int fr, int fq) {
    float* sp = slab2 + ((size_t)u.slab * 512 + (u.pm * BM + wr * 64 + fr - 8192)) * 8192 + u.pn * BM + wc * 32 + 8 * fq;
#pragma unroll
    for (int ai = 0; ai < 2; ++ai)
#pragma unroll
        for (int m = 0; m < 4; ++m) { float* rowp = sp + (size_t)(ai * HALF + m * 16) * 8192;
#pragma unroll
            for (int bj = 0; bj < 2; ++bj) { *(f32x4*)(rowp + bj * HALF) = acc[ai][bj][m][0]; *(f32x4*)(rowp + bj * HALF + 4) = acc[ai][bj][m][1]; } }
}
struct EpiInProj {
    static constexpr bool PERM = true, AFTER_DRAIN = false;
    bf16_t* P; float* LF; const float* lb; const float* rc; const float* rs; float* slab2;
    const float* rss; const float* bias;
#ifdef PROBE_DUP_IN3
    int force_seg = -1;
#endif
    __device__ __forceinline__ void operator()(f32x4 (&acc)[2][2][4][2], const Unit& u, int wr, int wc, int fr, int fq) const {
        if (u.slab >= 0) { store_slab_perm(slab2, acc, u, wr, wc, fr, fq); return; }
        if ((rss != nullptr) && (u.pm < 32)) {
            const int cb = u.pn * BM + wc * 32 + 8 * fq;
#pragma unroll
            for (int ai = 0; ai < 2; ++ai)
#pragma unroll
                for (int m = 0; m < 4; ++m) {
                    const float r = __builtin_amdgcn_rsqf(rss[u.pm * BM + wr * 64 + fr + ai * HALF + m * 16] * (1.0f / 2048.0f) + 1e-6f);
#pragma unroll
                    for (int bj = 0; bj < 2; ++bj)
#pragma unroll
                        for (int n = 0; n < 2; ++n) acc[ai][bj][m][n] = acc[ai][bj][m][n] * r + *(const f32x4*)(bias + cb + bj * HALF + 4 * n);
                }
        }
#ifdef PROBE_DUP_IN3
        const int seg = force_seg >= 0 ? force_seg : (u.pn >> 2);
#else
        const int seg = u.pn >> 2;
#endif
        const int row0 = u.pm * BM + wr * 64 + fr;
        const int colg0 = u.pn * BM + wc * 32 + 8 * fq;
        if (seg == 4 || seg == 5) {
            const float ksc = (seg == 5) ? 0.0625f : 1.0f;
            const int j0 = wc * 32 + 8 * fq;
#pragma unroll
            for (int ai = 0; ai < 2; ++ai) {
                f32x4 tc0[4], tc1[4], ts0[4], ts1[4];
#pragma unroll
                for (int m = 0; m < 4; ++m) { const int pos = row_pos(row0 + ai * HALF + m * 16);
                    tc0[m] = *(const f32x4*)(rc + (size_t)pos * 128 + j0); tc1[m] = *(const f32x4*)(rc + (size_t)pos * 128 + j0 + 4);
                    ts0[m] = *(const f32x4*)(rs + (size_t)pos * 128 + j0); ts1[m] = *(const f32x4*)(rs + (size_t)pos * 128 + j0 + 4); }
#pragma unroll
                for (int m = 0; m < 4; ++m) {
                    const int row = row0 + ai * HALF + m * 16;
                    const f32x4 c0 = tc0[m], c1 = tc1[m], s0 = ts0[m], s1 = ts1[m];
                    const f32x4 x1a = acc[ai][0][m][0], x1b = acc[ai][0][m][1], x2a = acc[ai][1][m][0], x2b = acc[ai][1][m][1];
                    const f32x4 o1a = (x1a * c0 - x2a * s0) * ksc, o1b = (x1b * c1 - x2b * s1) * ksc;
                    const f32x4 o2a = (x2a * c0 + x1a * s0) * ksc, o2b = (x2b * c1 + x1b * s1) * ksc;
                    bf16_t* rowp = P + (size_t)row * 8192 + colg0;
                    u32x4 w; w.x = cvt_pk_bf16(o1a[0], o1a[1]); w.y = cvt_pk_bf16(o1a[2], o1a[3]); w.z = cvt_pk_bf16(o1b[0], o1b[1]); w.w = cvt_pk_bf16(o1b[2], o1b[3]);
                    *(u32x4*)(rowp) = w;
                    w.x = cvt_pk_bf16(o2a[0], o2a[1]); w.y = cvt_pk_bf16(o2a[2], o2a[3]); w.z = cvt_pk_bf16(o2b[0], o2b[1]); w.w = cvt_pk_bf16(o2b[2], o2b[3]);
                    *(u32x4*)(rowp + HALF) = w;
                }
            }
        } else if (seg == 1) {
#pragma unroll
            for (int bj = 0; bj < 2; ++bj)
#pragma unroll
                for (int n = 0; n < 2; ++n) {
                    const int cs = colg0 + bj * HALF - 1024 + 4 * n;
                    const f32x4 lbv = *(const f32x4*)(lb + cs);
#pragma unroll
                    for (int ai = 0; ai < 2; ++ai) {
                        f32x4 carry = (f32x4){0.f, 0.f, 0.f, 0.f};
#pragma unroll
                        for (int m = 0; m < 4; ++m) {
                            const int row = row0 + ai * HALF + m * 16;
                            f32x4 v, kk;
#pragma unroll
                            for (int e = 0; e < 4; ++e) {
                                const float l = lbv[e], oml = 1.0f - l;
                                const float ex = __builtin_amdgcn_exp2f(fminf(acc[ai][bj][m][n][e] * -1.44269504f, 115.0f)), sg = fast_rcp(1.0f + ex), sn = ex * sg;
                                v[e] = __builtin_amdgcn_logf(l + oml * sg) * 0.69314718f; kk[e] = oml * sn; }
                            u32x2 w; w.x = cvt_pk_bf16(kk[0], kk[1]); w.y = cvt_pk_bf16(kk[2], kk[3]);
                            *(u32x2*)(P + (size_t)row * 8192 + colg0 + bj * HALF + 4 * n) = w;
#pragma unroll
                            for (int e = 0; e < 4; ++e) {
                                float x = v[e];
                                x += __builtin_bit_cast(float, __builtin_amdgcn_update_dpp(0, __builtin_bit_cast(int, x), 0x111, 0xf, 0xf, true));
                                x += __builtin_bit_cast(float, __builtin_amdgcn_update_dpp(0, __builtin_bit_cast(int, x), 0x112, 0xf, 0xf, true));
                                x += __builtin_bit_cast(float, __builtin_amdgcn_update_dpp(0, __builtin_bit_cast(int, x), 0x114, 0xf, 0xf, true));
                                x += __builtin_bit_cast(float, __builtin_amdgcn_update_dpp(0, __builtin_bit_cast(int, x), 0x118, 0xf, 0xf, true));
                                x += carry[e];
                                v[e] = x;
                                carry[e] = __builtin_bit_cast(float, __builtin_amdgcn_update_dpp(0, __builtin_bit_cast(int, x), 0x15f, 0xf, 0xf, true));
                            }
                            *(f32x4*)(LF + (size_t)row * 1024 + cs) = v;
                        }
                    }
                }
        } else {
            const bool act = (seg == 0 || seg == 3 || seg == 7);
#pragma unroll
            for (int ai = 0; ai < 2; ++ai)
#pragma unroll
                for (int m = 0; m < 4; ++m) { if (u.qa >= 0 && (ai != u.qa || (m >> 1) != u.qh)) continue;
                    bf16_t* rowp = P + (size_t)(row0 + ai * HALF + m * 16) * 8192 + colg0;
#pragma unroll
                    for (int bj = 0; bj < 2; ++bj) { f32x4 v0 = acc[ai][bj][m][0], v1 = acc[ai][bj][m][1];
                        if (act) {
#pragma unroll
                            for (int e = 0; e < 4; ++e) { v0[e] = silu_f(v0[e]); v1[e] = silu_f(v1[e]); } }
                        u32x4 w; w.x = cvt_pk_bf16(v0[0], v0[1]); w.y = cvt_pk_bf16(v0[2], v0[3]); w.z = cvt_pk_bf16(v1[0], v1[1]); w.w = cvt_pk_bf16(v1[2], v1[3]);
                        *(u32x4*)(rowp + bj * HALF) = w; } }
        }
    }
};
struct EpiRelu2 {
    static constexpr bool PERM = true, AFTER_DRAIN = false;
    bf16_t* O; int ldc; float* slab2; const float* rss; const float* bias;
    __device__ __forceinline__ void operator()(const f32x4 (&acc)[2][2][4][2], const Unit& u, int wr, int wc, int fr, int fq) const {
        if (u.slab >= 0) { store_slab_perm(slab2, acc, u, wr, wc, fr, fq); return; }
        const int row0 = u.pm * BM + wr * 64 + fr, col0 = u.pn * BM + wc * 32 + 8 * fq;
        const bool fused = (rss != nullptr) && (u.pm < 32);
        f32x4 bv[2][2];
#pragma unroll
        for (int bj = 0; bj < 2; ++bj)
#pragma unroll
            for (int n = 0; n < 2; ++n) bv[bj][n] = fused ? *(const f32x4*)(bias + col0 + bj * HALF + 4 * n) : (f32x4){0.f, 0.f, 0.f, 0.f};
#pragma unroll
        for (int ai = 0; ai < 2; ++ai)
#pragma unroll
            for (int m = 0; m < 4; ++m) { if (u.qa >= 0 && (ai != u.qa || (m >> 1) != u.qh)) continue;
                bf16_t* rowp = O + (size_t)(row0 + ai * HALF + m * 16) * ldc + col0;
                float r = 1.0f; if (fused) r = __builtin_amdgcn_rsqf(rss[row0 + ai * HALF + m * 16] * (1.0f / 2048.0f) + 1e-6f);
#pragma unroll
                for (int bj = 0; bj < 2; ++bj) { f32x4 v0 = acc[ai][bj][m][0] * r + bv[bj][0], v1 = acc[ai][bj][m][1] * r + bv[bj][1];
#pragma unroll
                    for (int e = 0; e < 4; ++e) { const float a = fmaxf(v0[e], 0.f), b = fmaxf(v1[e], 0.f); v0[e] = a * a; v1[e] = b * b; }
                    u32x4 w; w.x = cvt_pk_bf16(v0[0], v0[1]); w.y = cvt_pk_bf16(v0[2], v0[3]); w.z = cvt_pk_bf16(v1[0], v1[1]); w.w = cvt_pk_bf16(v1[2], v1[3]);
#ifdef NT_U_STORE
                    __builtin_nontemporal_store(w, (u32x4*)(rowp + bj * HALF)); } }
#else
                    *(u32x4*)(rowp + bj * HALF) = w; } }
#endif
    }
};
struct EpiResid {
    static constexpr bool PERM = false, AFTER_DRAIN = false;
    half_t* X; const float* gate; float* slab;
    const float* Xin32;
    bf16_t* XS; const float* acol; float* rss;
    __device__ __forceinline__ void operator()(const f32x4 (&acc)[2][2][4][2], const Unit& u, int wr, int wc, int fr, int fq) const {
        const int row0 = u.pm * BM + wr * 64 + fr, col0 = u.pn * BM + wc * 32 + 4 * fq;
        if (u.slab >= 0) {
            half_t* sp = (half_t*)slab + ((size_t)u.slab * 512 + (row0 - 8192)) * 2048 + col0;
#pragma unroll
            for (int ai = 0; ai < 2; ++ai)
#pragma unroll
                for (int m = 0; m < 4; ++m) { half_t* rowp = sp + (size_t)(ai * HALF + m * 16) * 2048;
#pragma unroll
                    for (int bj = 0; bj < 2; ++bj)
#pragma unroll
                        for (int n = 0; n < 2; ++n) stx4(rowp + bj * HALF + n * 16, acc[ai][bj][m][n]); }
            return;
        }
        f32x4 gv[2][2];
#pragma unroll
        for (int bj = 0; bj < 2; ++bj)
#pragma unroll
            for (int n = 0; n < 2; ++n) gv[bj][n] = *(const f32x4*)(gate + col0 + bj * HALF + n * 16);
        if (Xin32 == nullptr && XS == nullptr) {
#pragma unroll
            for (int ai = 0; ai < 2; ++ai) {
                half4 xh[4][2][2];
#pragma unroll
                for (int m = 0; m < 4; ++m)
#pragma unroll
                    for (int bj = 0; bj < 2; ++bj)
#pragma unroll
                        for (int n = 0; n < 2; ++n) xh[m][bj][n] = *(const half4*)(X + (size_t)(row0 + ai * HALF + m * 16) * 2048 + col0 + bj * HALF + n * 16);
#pragma unroll
                for (int m = 0; m < 4; ++m)
#pragma unroll
                    for (int bj = 0; bj < 2; ++bj)
#pragma unroll
                        for (int n = 0; n < 2; ++n) { const f32x4 xn = __builtin_convertvector(xh[m][bj][n], f32x4) + gv[bj][n] * acc[ai][bj][m][n]; stx4(X + (size_t)(row0 + ai * HALF + m * 16) * 2048 + col0 + bj * HALF + n * 16, xn); }
                asm volatile("" ::: "memory");
            }
            return;
        }
#pragma unroll
        for (int ai = 0; ai < 2; ++ai)
#pragma unroll
            for (int m = 0; m < 4; ++m) { const int row = row0 + ai * HALF + m * 16; half_t* rowp = X + (size_t)row * 2048 + col0; const XSrc xs{Xin32, X}; const size_t eo = (size_t)row * 2048 + col0; float ssq = 0.f;
#pragma unroll
                for (int bj = 0; bj < 2; ++bj)
#pragma unroll
                    for (int n = 0; n < 2; ++n) { const f32x4 xv = ldx4(xs, eo + bj * HALF + n * 16); const f32x4 xn = xv + gv[bj][n] * acc[ai][bj][m][n]; stx4(rowp + bj * HALF + n * 16, xn);
                        if (XS != nullptr) { ssq += (xn[0] * xn[0] + xn[1] * xn[1]) + (xn[2] * xn[2] + xn[3] * xn[3]); const f32x4 av = *(const f32x4*)(acol + col0 + bj * HALF + n * 16); const f32x4 hs = xn * av;
                            u32x2 w; w.x = cvt_pk_bf16(hs[0], hs[1]); w.y = cvt_pk_bf16(hs[2], hs[3]); *(u32x2*)(XS + (size_t)row * 2048 + col0 + bj * HALF + n * 16) = w; } }
                if (XS != nullptr) { ssq += __shfl_xor(ssq, 16); ssq += __shfl_xor(ssq, 32); if (fq == 0) __hip_atomic_fetch_add(rss + row, ssq, __ATOMIC_RELAXED, __HIP_MEMORY_SCOPE_AGENT); }
                asm volatile("" ::: "memory"); }
    }
};
struct EpiProbe {
    static constexpr bool PERM = true, AFTER_DRAIN = false;
    bf16_t* O; int ldc;
    __device__ __forceinline__ void operator()(const f32x4 (&acc)[2][2][4][2], const Unit& u, int wr, int wc, int fr, int fq) const {
        Unit t = u; t.pm = u.slab >> 6; t.pn = u.slab & 63; t.qa = -1;
        t.slab = -1; EpiRelu2 e{O, ldc, nullptr, nullptr, nullptr}; e(acc, t, wr, wc, fr, fq);
    }
};
template <class Epi, class Sched, bool ALIGN_EPI = false, bool SP2 = false, int QM = 0>
__device__ __forceinline__ void gemm_phase(PG8_LAS unsigned char* lds, const Gemm g, const Sched& S, const Epi& E) {
    int tid_l = threadIdx.x; asm volatile("" : "+v"(tid_l));
    const int tid = tid_l, wid = __builtin_amdgcn_readfirstlane(tid >> 6), lane = tid & 63, wr = wid >> 2, wc = wid & 3, fr = lane & 15, fq = lane >> 4;
    const int K = g.K;
    unsigned voffA[2], voffB[2];
#pragma unroll
    for (int i = 0; i < 2; ++i) { int R, C; stage_rc(tid * 16 + i * 8192, R, C); const int Rb = Epi::PERM ? ((R & ~31) + perm32(R & 31)) : R;
        voffA[i] = (unsigned)(R * K + C) * 2u; voffB[i] = (unsigned)(Rb * K + C) * 2u; }
    const size_t kstep = (size_t)(BK * 2);
    const size_t hstep = (size_t)HALF * K * 2;
    const size_t tstep = 2 * hstep;
    const unsigned ldsw = (unsigned)wid * 1024u;
    const int aoff = lds_byte(wr * 64 + fr, fq * 8), boff = lds_byte(wc * 32 + fr, fq * 8);
#define PG8_SA(b, h) (((b) * 2 + (h)) * HTB)
#define PG8_SB(b, h) ((4 + (b) * 2 + (h)) * HTB)
#define PG8_STAGE(bufoff, gbase, voff) do { _Pragma("unroll") for (int _i = 0; _i < 2; ++_i) \
        __builtin_amdgcn_global_load_lds((const unsigned*)((const char*)(gbase) + (voff)[_i]), (PG8_LAS unsigned*)(lds + (bufoff) + ldsw + _i * 8192), 16, 0, 0); } while (0)
#define PG8_LDA(dst, b, h) do { if (!QM || (h) == q_a) { _Pragma("unroll") for (int m = 0; m < 4; ++m) _Pragma("unroll") for (int k = 0; k < 2; ++k) dst[m][k] = *(const PG8_LAS bf16x8*)(lds + PG8_SA(b, h) + aoff + m * 2048 + k * 1024); } } while (0)
#define PG8_LDB(dst, b, h) do { _Pragma("unroll") for (int n = 0; n < 2; ++n) _Pragma("unroll") for (int k = 0; k < 2; ++k) dst[n][k] = *(const PG8_LAS bf16x8*)(lds + PG8_SB(b, h) + boff + n * 2048 + k * 1024); } while (0)
#define PG8_MMA(ai, bj, At, Bt) do { if (!QM || (ai) == q_a) { __builtin_amdgcn_s_setprio(1); _Pragma("unroll") for (int m = 0; m < 4; ++m) { if (!QM || (m >> 1) == q_h) { _Pragma("unroll") for (int n = 0; n < 2; ++n) _Pragma("unroll") for (int k = 0; k < 2; ++k) \
        acc[ai][bj][m][n] = __builtin_amdgcn_mfma_f32_16x16x32_bf16(Bt[n][k], At[m][k], acc[ai][bj][m][n], 0, 0, 0); } } __builtin_amdgcn_s_setprio(0); } } while (0)
#define PG8_WAIT_V(n) asm volatile("s_waitcnt vmcnt(" #n ")" ::: "memory")
#define PG8_WAIT_L(n) asm volatile("s_waitcnt lgkmcnt(" #n ")" ::: "memory")
#define PG8_BAR __builtin_amdgcn_s_barrier()
#define PG8_SCHED __builtin_amdgcn_sched_barrier(0)
    Unit cur, nxt; int ui = 0;
    if (!S.next(0, cur)) return;
    int q_a = cur.qa, q_h = cur.qh; (void)q_a; (void)q_h;
    f32x4 acc[2][2][4][2];
#pragma unroll
    for (int a = 0; a < 2; ++a)
#pragma unroll
        for (int b = 0; b < 2; ++b)
#pragma unroll
            for (int m = 0; m < 4; ++m)
#pragma unroll
                for (int n = 0; n < 2; ++n) acc[a][b][m][n] = (f32x4){0.f, 0.f, 0.f, 0.f};
    bf16x8 At[4][2], B0[2][2], B1[2][2];
    const char* cA = (const char*)g.A + (size_t)cur.pm * tstep + (size_t)cur.kt0 * kstep; const char* cB = (const char*)g.Bt + (size_t)cur.pn * tstep + (size_t)cur.kt0 * kstep;
    S.a_ready(cur);
    if constexpr (SP2) {
        PG8_STAGE(PG8_SB(0, 0), cB, voffB); PG8_STAGE(PG8_SB(0, 1), cB + hstep, voffB); PG8_STAGE(PG8_SA(0, 0), cA, voffA); PG8_STAGE(PG8_SA(0, 1), cA + hstep, voffA);
        if (wr == 1) PG8_BAR;
        PG8_WAIT_V(2); PG8_BAR;
        PG8_STAGE(PG8_SB(1, 0), cB + kstep, voffB); PG8_STAGE(PG8_SA(1, 0), cA + kstep, voffA); PG8_STAGE(PG8_SB(1, 1), cB + hstep + kstep, voffB);
        PG8_WAIT_V(6); PG8_BAR;
    } else {
        PG8_STAGE(PG8_SB(0, 0), cB, voffB); PG8_STAGE(PG8_SA(0, 0), cA, voffA); PG8_STAGE(PG8_SB(0, 1), cB + hstep, voffB); PG8_STAGE(PG8_SA(0, 1), cA + hstep, voffA);
        if (wr == 1) PG8_BAR;
        PG8_WAIT_V(4); PG8_BAR;
        PG8_STAGE(PG8_SB(1, 0), cB + kstep, voffB); PG8_STAGE(PG8_SA(1, 0), cA + kstep, voffA); PG8_STAGE(PG8_SB(1, 1), cB + hstep + kstep, voffB);
        PG8_WAIT_V(6); PG8_BAR;
    }
    for (;;) {
        const bool has_next = S.next(ui + 1, nxt);
        const char* nA = has_next ? (const char*)g.A + (size_t)nxt.pm * tstep + (size_t)nxt.kt0 * kstep : cA; const char* nB = has_next ? (const char*)g.Bt + (size_t)nxt.pn * tstep + (size_t)nxt.kt0 * kstep : cB;
        const int nt = cur.nt;
        for (int t = 0; t < nt; t += 2) {
            const bool last = (t == nt - 2);
            const char* a1 = cA + (size_t)(t + 1) * kstep;
            const char* a2 = last ? nA : cA + (size_t)(t + 2) * kstep; const char* b2 = last ? nB : cB + (size_t)(t + 2) * kstep;
            const char* a3 = a2 + kstep; const char* b3 = b2 + kstep;
            if (last && has_next) S.a_ready(nxt);
            if constexpr (SP2) {
            PG8_LDB(B0, 0, 0); PG8_LDB(B1, 0, 1); PG8_SCHED; PG8_LDA(At, 0, 0); PG8_STAGE(PG8_SA(1, 1), a1 + hstep, voffA);
            PG8_WAIT_V(8); PG8_WAIT_L(0); PG8_BAR; PG8_MMA(0, 0, At, B0); PG8_MMA(0, 1, At, B1); PG8_BAR; PG8_SCHED;
            PG8_LDA(At, 0, 1); PG8_STAGE(PG8_SB(0, 0), b2, voffB); PG8_STAGE(PG8_SB(0, 1), b2 + hstep, voffB); PG8_STAGE(PG8_SA(0, 0), a2, voffA);
            PG8_WAIT_V(8); PG8_WAIT_L(0); PG8_BAR; PG8_MMA(1, 0, At, B0); PG8_MMA(1, 1, At, B1); PG8_BAR; PG8_SCHED;
            PG8_LDB(B0, 1, 0); PG8_LDB(B1, 1, 1); PG8_SCHED; PG8_LDA(At, 1, 0); PG8_STAGE(PG8_SA(0, 1), a2 + hstep, voffA);
            PG8_WAIT_V(8); PG8_WAIT_L(0); PG8_BAR; PG8_MMA(0, 0, At, B0); PG8_MMA(0, 1, At, B1); PG8_BAR; PG8_SCHED;
            PG8_LDA(At, 1, 1); PG8_STAGE(PG8_SB(1, 0), b3, voffB); PG8_STAGE(PG8_SB(1, 1), b3 + hstep, voffB); PG8_STAGE(PG8_SA(1, 0), a3, voffA);
            PG8_WAIT_V(8); PG8_WAIT_L(0); PG8_BAR; PG8_MMA(1, 0, At, B0); PG8_MMA(1, 1, At, B1); PG8_BAR; PG8_SCHED;
            } else {
            PG8_LDB(B0, 0, 0); PG8_SCHED; PG8_LDA(At, 0, 0); PG8_STAGE(PG8_SA(1, 1), a1 + hstep, voffA);
            PG8_WAIT_L(8); PG8_BAR; PG8_WAIT_L(0); PG8_MMA(0, 0, At, B0); PG8_BAR; PG8_SCHED;
            PG8_LDB(B1, 0, 1); PG8_STAGE(PG8_SB(0, 0), b2, voffB);
            PG8_BAR; PG8_WAIT_L(0); PG8_MMA(0, 1, At, B1); PG8_BAR;
            PG8_LDA(At, 0, 1); PG8_STAGE(PG8_SA(0, 0), a2, voffA);
            PG8_BAR; PG8_WAIT_L(0); PG8_MMA(1, 0, At, B0); PG8_BAR; PG8_SCHED;
            PG8_STAGE(PG8_SB(0, 1), b2 + hstep, voffB);
            PG8_WAIT_V(6); PG8_BAR; PG8_MMA(1, 1, At, B1); PG8_BAR;
            PG8_LDB(B0, 1, 0); PG8_SCHED; PG8_LDA(At, 1, 0); PG8_STAGE(PG8_SA(0, 1), a2 + hstep, voffA);
            PG8_WAIT_L(8); PG8_BAR; PG8_WAIT_L(0); PG8_MMA(0, 0, At, B0); PG8_BAR; PG8_SCHED;
            PG8_LDB(B1, 1, 1); PG8_STAGE(PG8_SB(1, 0), b3, voffB);
            PG8_BAR; PG8_WAIT_L(0); PG8_MMA(0, 1, At, B1); PG8_BAR;
            PG8_LDA(At, 1, 1); PG8_STAGE(PG8_SA(1, 0), a3, voffA);
            PG8_BAR; PG8_WAIT_L(0); PG8_MMA(1, 0, At, B0); PG8_BAR; PG8_SCHED;
            PG8_STAGE(PG8_SB(1, 1), b3 + hstep, voffB);
            PG8_WAIT_V(6); PG8_BAR; PG8_MMA(1, 1, At, B1); PG8_BAR;
            }
        }
        if constexpr (ALIGN_EPI) { if (wr == 0) PG8_BAR; }
        if constexpr (!Epi::AFTER_DRAIN) { E(acc, cur, wr, wc, fr, fq); S.done(cur); }
        if (!has_next) break;
#pragma unroll
        for (int a = 0; a < 2; ++a)
#pragma unroll
            for (int b = 0; b < 2; ++b)
#pragma unroll
                for (int m = 0; m < 4; ++m)
#pragma unroll
                    for (int n = 0; n < 2; ++n) acc[a][b][m][n] = (f32x4){0.f, 0.f, 0.f, 0.f};
        cur = nxt; cA = nA; cB = nB; ++ui; q_a = cur.qa; q_h = cur.qh;
        if constexpr (ALIGN_EPI) { if (wr == 1) PG8_BAR; }
    }
    PG8_WAIT_V(0);
    if constexpr (!ALIGN_EPI) { if (wr == 0) PG8_BAR; }
    PG8_BAR;
    if constexpr (Epi::AFTER_DRAIN) { E.fused(acc, cur, wr, wc, fr, fq, lds, wid, lane); S.done(cur); }
#undef PG8_SA
#undef PG8_SB
#undef PG8_STAGE
#undef PG8_LDA
#undef PG8_LDB
#undef PG8_MMA
#undef PG8_WAIT_V
#undef PG8_WAIT_L
#undef PG8_BAR
#undef PG8_SCHED
}
}
constexpr int NWAVES = 8;
constexpr int DM = 2048, SEQ = 8192, DEPTH = 4, DECB = 8, DECS = 64, M = SEQ + DECB * DECS, NPROJ = 8192, DFF = 8192, NSEQ = 9, NMOD = 6 * DM;
constexpr int HA = 8, HB = 4;
constexpr float EPS = 1e-6f;
constexpr size_t OFF_SA_P = (size_t)M * DM, OFF_SB_P = OFF_SA_P + (size_t)DEPTH * HA * 128 * 128, OFF_SA_S = OFF_SB_P + (size_t)DEPTH * HB * 256 * 256,
                 OFF_SB_S = OFF_SA_S + (size_t)DEPTH * DECB * HA * 128 * 128, OUT_TOTAL = OFF_SB_S + (size_t)DEPTH * DECB * HB * 256 * 256;

constexpr size_t MiB = 1u << 20;
constexpr size_t WS_CTL = 0, CTL_ZERO_BYTES = 1 * MiB;
constexpr size_t WS_WIN = 2 * MiB;
constexpr size_t WS_WOUT = WS_WIN + 128 * MiB;
constexpr size_t WS_WUP = WS_WOUT + 32 * MiB;
constexpr size_t WS_WDN = WS_WUP + 128 * MiB;
constexpr size_t WS_X = WS_WDN + 128 * MiB;
constexpr size_t WS_H = WS_X + 68 * MiB;
constexpr size_t WS_P = WS_H + 34 * MiB;
constexpr size_t WS_LF = WS_P + 136 * MiB;
constexpr size_t WS_O = WS_LF + 34 * MiB;
constexpr size_t WS_U = WS_O + 34 * MiB;
constexpr size_t WS_MOD = WS_U + 136 * MiB;
constexpr size_t WS_LB = WS_MOD + 2 * MiB;
constexpr size_t WS_ROPE = WS_LB + 1 * MiB;
constexpr size_t WS_SLAB = WS_ROPE + 8 * MiB;
constexpr size_t WS_SLAB2 = WS_SLAB + 64 * MiB;
constexpr size_t WS_ACOL = WS_SLAB2 + 64 * MiB;
constexpr size_t WS_END = WS_ACOL + 1 * MiB;
constexpr int CW_Q0 = 64;
constexpr int CW_TMO = 0;
constexpr int CW_FIX = 1024;
constexpr int CW_BAR = 4096;
constexpr int CW_XRANK = 3072;
constexpr int CW_SMP = 2048;
constexpr int CW_RSS = 65536;
constexpr int CW_BIAS = CW_RSS + 8 * 8192;

constexpr int RING_OFF = 0, RING_BYTES = 131072;
constexpr int LDS_BYTES = 151552;
constexpr int MISC_OFF = 147456;

#define GAS __attribute__((address_space(1)))
#define LAS __attribute__((address_space(3)))
typedef unsigned short bf16;
typedef unsigned v4u __attribute__((ext_vector_type(4)));
typedef unsigned v2u __attribute__((ext_vector_type(2)));
typedef float f32x4 __attribute__((ext_vector_type(4)));
typedef short bf16x8 __attribute__((ext_vector_type(8)));
#define LDS_WAIT() asm volatile("s_waitcnt lgkmcnt(0)" ::: "memory")
#define VM_WAIT() asm volatile("s_waitcnt vmcnt(0)" ::: "memory")
__device__ __forceinline__ unsigned f2bf(float f) { unsigned u = __builtin_bit_cast(unsigned, f); return (u + 0x7fffu + ((u >> 16) & 1u)) >> 16; }
__device__ __forceinline__ unsigned pk2(float lo, float hi) { return pg8::cvt_pk_bf16(lo, hi); }
__device__ __forceinline__ float bf2f(unsigned short b) { return __builtin_bit_cast(float, ((unsigned)b) << 16); }
__device__ __forceinline__ float bflo(unsigned w) { return __builtin_bit_cast(float, w << 16); }
__device__ __forceinline__ float bfhi(unsigned w) { return __builtin_bit_cast(float, w & 0xffff0000u); }

#define XB_TMO      128
#define XB_XCNT(j)  (256  + 64 * (j))
#define XB_XSUB(j)  (1280 + 64 * (j))
#define XB_XGEN(j)  (2304 + 64 * (j))
#define XB_TOP      3328
#define XB_TOPGEN   3392
#define XCD_BAR_WORDS 3456
#define XB_SPIN_CAP (1u << 20)
__device__ __forceinline__ unsigned xb_ld(unsigned* p)              { return __hip_atomic_load(p, __ATOMIC_RELAXED, __HIP_MEMORY_SCOPE_AGENT); }
__device__ __forceinline__ unsigned xb_add(unsigned* p, unsigned v) { return __hip_atomic_fetch_add(p, v, __ATOMIC_RELAXED, __HIP_MEMORY_SCOPE_AGENT); }
__device__ __forceinline__ unsigned xb_xcc_id() { return (unsigned)__builtin_amdgcn_s_getreg((3 << 11) | 20) & 0xFu; }
#define XB_SPIN(cond, bar) do { unsigned _sp = 0; while (cond) { __builtin_amdgcn_s_sleep(1); \
    if ((++_sp & 255u) == 0u) { if (xb_ld(&(bar)[XB_TMO])) break; if (_sp > XB_SPIN_CAP) { atomicAdd(&(bar)[XB_TMO], 1u); break; } } } } while (0)
struct XcdBarrier { unsigned* bar; unsigned x; volatile LAS unsigned* st; };
__device__ __forceinline__ XcdBarrier xcd_barrier_post(unsigned* bar, volatile LAS unsigned* st) {
    XcdBarrier b; b.bar = bar; b.x = xb_xcc_id(); b.st = st;
    if (threadIdx.x == 0) (void)xb_add(&bar[XB_XCNT(b.x)], 1u);
    return b;
}
__device__ __forceinline__ void xcd_barrier_complete(unsigned* bar, unsigned x, unsigned& nloc, unsigned& nx) {
    const unsigned G = gridDim.x * gridDim.y * gridDim.z;
    unsigned sum, cnt, mine, sp = 0u;
    for (;;) {
        sum = 0u; cnt = 0u; mine = 0u;
#pragma unroll
        for (unsigned j = 0; j < 16; ++j) { const unsigned c = xb_ld(&bar[XB_XCNT(j)]); sum += c; cnt += (c > 0u) ? 1u : 0u; mine = (j == x) ? c : mine; }
        if (sum == G) break;
        __builtin_amdgcn_s_sleep(1);
        if ((++sp & 255u) == 0u) { if (xb_ld(&bar[XB_TMO])) break; if (sp > XB_SPIN_CAP) { atomicAdd(&bar[XB_TMO], 1u); break; } }
    }
    nloc = mine > 0u ? mine : 1u; nx = cnt > 0u ? cnt : 1u;
}
__device__ __forceinline__ void xcd_barrier(const XcdBarrier& b) {
    asm volatile("s_waitcnt vmcnt(0)" ::: "memory");
    __syncthreads();
    if (threadIdx.x == 0) {
        unsigned* bar = b.bar;
        __builtin_amdgcn_s_waitcnt(0);
        unsigned nloc = b.st[0], nx = b.st[1];
        if (nloc == 0u) { xcd_barrier_complete(bar, b.x, nloc, nx); b.st[0] = nloc; b.st[1] = nx; }
        const unsigned old = xb_add(&bar[XB_XSUB(b.x)], 1u);
        const unsigned gen = old / nloc;
        if (old + 1u == (gen + 1u) * nloc) {
            __builtin_amdgcn_fence(__ATOMIC_RELEASE, "agent");
            asm volatile("s_waitcnt vmcnt(0)" ::: "memory");
            const unsigned og = xb_add(&bar[XB_TOP], 1u);
            const unsigned tg = og / nx;
            if (og + 1u == (tg + 1u) * nx) xb_add(&bar[XB_TOPGEN], 1u);
            else XB_SPIN(xb_ld(&bar[XB_TOPGEN]) == tg, bar);
            __builtin_amdgcn_fence(__ATOMIC_ACQUIRE, "agent");
            xb_add(&bar[XB_XGEN(b.x)], 1u);
            asm volatile("s_waitcnt vmcnt(0)" ::: "memory");
        } else {
            XB_SPIN(xb_ld(&bar[XB_XGEN(b.x)]) == gen, bar);
            __builtin_amdgcn_fence(__ATOMIC_ACQUIRE, "agent");
            asm volatile("s_waitcnt vmcnt(0)" ::: "memory");
        }
    }
    __syncthreads();
}

struct Frame {
    LAS unsigned char* lds;
    unsigned* ctl;
    unsigned char* ws;
    int G, wg;
    const float *x_prompt, *x_sample, *state_hgrn, *state_ret, *c_prompt, *c_sample, *lb_logits, *w_ada, *b_ada, *norm1_g, *norm2_g, *w_in, *hgrn_g, *ret_g, *w_out, *w_up, *w_down, *final_g;
    float* out;
    bf16 *Win_t, *Wout_t, *Wup_t, *Wdn_t, *H, *P, *O, *U;
    half_t* X;
    float *LF, *MOD, *LB, *RC, *RS;
};

__device__ __forceinline__ int ltid() { int t = threadIdx.x; asm volatile("" : "+v"(t)); return t; }
#define PHASE_IDS() const int tid = ltid(), lane = tid & 63, wave = __builtin_amdgcn_readfirstlane(tid >> 6); (void)lane; (void)wave
__device__ __forceinline__ float wave_sum(float v) {
#pragma unroll
    for (int o = 1; o < 64; o <<= 1) v += __shfl_xor(v, o);
    return v;
}
struct CvItem { const float* W; bf16* WT; const float* sh; float* bias; int K, N, k0, n0; };
#define CV_LOAD(v, I) do { _Pragma("unroll") for (int i_ = 0; i_ < 16; ++i_) v[i_] = __builtin_nontemporal_load((const f32x4*)((I).W + (size_t)((I).k0 + 4 * i_ + (lane >> 4)) * (I).N + (I).n0 + 4 * (lane & 15))); } while (0)
__device__ __forceinline__ void cv_process(const f32x4 (&v)[16], const CvItem& I, LAS float* scr, int lane) {
    const int r4 = lane >> 4, c16 = lane & 15;
    if (I.sh != nullptr) {
        f32x4 p = (f32x4){0.f, 0.f, 0.f, 0.f};
#pragma unroll
        for (int i = 0; i < 16; ++i) p += v[i] * I.sh[I.k0 + 4 * i + r4];
#pragma unroll
        for (int e = 0; e < 4; ++e) { float q = p[e]; q += __shfl_xor(q, 16); q += __shfl_xor(q, 32); if (r4 == 0) __hip_atomic_fetch_add(I.bias + I.n0 + 4 * c16 + e, q, __ATOMIC_RELAXED, __HIP_MEMORY_SCOPE_AGENT); }
    }
#pragma unroll
    for (int i = 0; i < 16; ++i) *(LAS f32x4*)(scr + (4 * i + r4) * 68 + 4 * c16) = v[i];
    LDS_WAIT(); asm volatile("" ::: "memory");
    const int c = lane & 7;
#pragma unroll
    for (int j = 0; j < 8; ++j) { const int n = (lane >> 3) + 8 * j; const LAS float* s = scr + (8 * c) * 68 + n;
        v4u o; o.x = pk2(s[0 * 68], s[1 * 68]); o.y = pk2(s[2 * 68], s[3 * 68]); o.z = pk2(s[4 * 68], s[5 * 68]); o.w = pk2(s[6 * 68], s[7 * 68]);
        __builtin_nontemporal_store(o, (v4u*)(I.WT + (size_t)(I.n0 + n) * I.K + I.k0 + 8 * c)); }
    LDS_WAIT(); asm volatile("" ::: "memory");
}
#ifndef CONV_PRO
#define CONV_PRO 1
#endif
#ifndef NGEMM
#define NGEMM 224
#endif
#ifndef FUSE_FROM
#define FUSE_FROM 1
#endif
#ifndef CV_SPLIT_PCT
#define CV_SPLIT_PCT 52
#endif
constexpr int CV_IN = (DM / 64) * (NPROJ / 64), CV_OUT = (DM / 64) * (DM / 64), CV_UP = (DM / 64) * (DFF / 64), CV_DN = (DFF / 64) * (DM / 64), CV_LAYER = CV_IN + CV_OUT + CV_UP + CV_DN, CV_SPLIT = ((CV_IN + CV_OUT + CV_UP + CV_DN) * CV_SPLIT_PCT / 100) & ~7;
__device__ __forceinline__ CvItem cv_item(Frame& F, int l, int it) {
    CvItem I; int r = it;
    const float* shp = (l >= FUSE_FROM && F.G > NGEMM) ? F.MOD + (size_t)l * NMOD : nullptr; float* bp = (float*)(F.ctl + CW_BIAS) + (size_t)l * 2 * 8192;
    I.sh = nullptr; I.bias = bp;
    if (r < CV_IN) { I.W = F.w_in + (size_t)l * DM * NPROJ; I.K = DM; I.N = NPROJ; I.WT = F.Win_t + (size_t)l * NPROJ * DM; I.sh = shp; }
    else if ((r -= CV_IN) < CV_OUT) { I.W = F.w_out + (size_t)l * DM * DM; I.K = DM; I.N = DM; I.WT = F.Wout_t + (size_t)l * DM * DM; }
    else if ((r -= CV_OUT) < CV_UP) { I.W = F.w_up + (size_t)l * DM * DFF; I.K = DM; I.N = DFF; I.WT = F.Wup_t + (size_t)l * DFF * DM; I.sh = shp ? shp + 3 * DM : nullptr; I.bias = bp + 8192; }
    else { r -= CV_UP; I.W = F.w_down + (size_t)l * DFF * DM; I.K = DFF; I.N = DM; I.WT = F.Wdn_t + (size_t)l * DM * DFF; }
    const int nblk = I.N / 64; I.k0 = 64 * (r / nblk); I.n0 = 64 * (r % nblk);
    return I;
}
__device__ __forceinline__ void convert_layer(Frame& F, int l, int wave, int lane, int it_lo = 0, int it_hi = CV_LAYER, int qword = 0) {
    LAS float* scr = (LAS float*)(F.lds + wave * 17408);
    int cur = 0, end = 0;
#define CV_NEXT(id) do { if (cur >= end) { int b_ = 0; if (lane == 0) b_ = (int)atomicAdd(F.ctl + CW_Q0 + 64 * (l + 1) + qword, 8u); cur = it_lo + __builtin_amdgcn_readfirstlane(b_); end = cur + 8; } id = cur < it_hi ? cur : -1; ++cur; } while (0)
    f32x4 va[16], vb[16]; CvItem Ia, Ib; int ia, ib;
    CV_NEXT(ia); if (ia < 0) return;
    Ia = cv_item(F, l, ia); CV_LOAD(va, Ia);
    for (;;) {
        CV_NEXT(ib); if (ib >= 0) { Ib = cv_item(F, l, ib); CV_LOAD(vb, Ib); }
        cv_process(va, Ia, scr, lane);
        if (ib < 0) break;
        CV_NEXT(ia); if (ia >= 0) { Ia = cv_item(F, l, ia); CV_LOAD(va, Ia); }
        cv_process(vb, Ib, scr, lane);
        if (ia < 0) break;
    }
#undef CV_NEXT
}
__device__ __forceinline__ void p0_mod_task(Frame& F, int task) {
    PHASE_IDS();
    const int l = task / 48, cb = task % 48;
    LAS float* cact = (LAS float*)(F.lds);
    LAS float* red = (LAS float*)(F.lds + 73728);
    for (int i = tid; i < NSEQ * DM; i += NWAVES * 64) { const int b = i / DM, k = i % DM; const float c = (b == 0) ? F.c_prompt[k] : F.c_sample[(b - 1) * DM + k]; cact[i] = c / (1.0f + __expf(-c)); }
    __syncthreads();
    const float* W = F.w_ada + (size_t)l * DM * NMOD + cb * 256 + 4 * lane;
    f32x4 acc[NSEQ];
#pragma unroll
    for (int b = 0; b < NSEQ; ++b) acc[b] = (f32x4){0.f, 0.f, 0.f, 0.f};
    const int kbeg = wave * 256;
#pragma unroll 4
    for (int k0 = kbeg; k0 < kbeg + 256; k0 += 4) {
        const f32x4 w0 = __builtin_nontemporal_load((const f32x4*)(W + (size_t)(k0 + 0) * NMOD)), w1 = __builtin_nontemporal_load((const f32x4*)(W + (size_t)(k0 + 1) * NMOD)), w2 = __builtin_nontemporal_load((const f32x4*)(W + (size_t)(k0 + 2) * NMOD)), w3 = __builtin_nontemporal_load((const f32x4*)(W + (size_t)(k0 + 3) * NMOD));
#pragma unroll
        for (int b = 0; b < NSEQ; ++b) { const f32x4 c = *(const LAS f32x4*)(cact + b * DM + k0); acc[b] += w0 * c.x + w1 * c.y + w2 * c.z + w3 * c.w; }
    }
#pragma unroll
    for (int b = 0; b < NSEQ; ++b) *(LAS f32x4*)(red + (wave * NSEQ + b) * 256 + 4 * lane) = acc[b];
    __syncthreads();
    for (int o = tid; o < NSEQ * 256; o += NWAVES * 64) { const int b = o / 256, c = o % 256; float s = 0.f;
#pragma unroll
        for (int w = 0; w < 8; ++w) s += red[(w * NSEQ + b) * 256 + c];
        F.MOD[(size_t)(b * DEPTH + l) * NMOD + cb * 256 + c] = s + F.b_ada[(size_t)l * NMOD + cb * 256 + c]; }
    __syncthreads();
}
__device__ __forceinline__ void sincos_acc(float angf, float& sn, float& cs) {
    const double a = (double)angf;
    const double q = __builtin_rint(a * 0.63661977236758134308);
    double r = __builtin_fma(-q, 1.57079632679489655800, a); r = __builtin_fma(-q, 6.12323399573676603587e-17, r);
    const double r2 = r * r;
    double sp = 1.0 / 6227020800.0; sp = sp * r2 - 1.0 / 39916800.0; sp = sp * r2 + 1.0 / 362880.0; sp = sp * r2 - 1.0 / 5040.0; sp = sp * r2 + 1.0 / 120.0; sp = sp * r2 - 1.0 / 6.0; sp = sp * r2 * r + r;
    double cp = 1.0 / 479001600.0; cp = cp * r2 - 1.0 / 3628800.0; cp = cp * r2 + 1.0 / 40320.0; cp = cp * r2 - 1.0 / 720.0; cp = cp * r2 + 1.0 / 24.0; cp = cp * r2 - 0.5; cp = cp * r2 + 1.0;
    const int qi = ((int)q) & 3;
    const double s = (qi == 0) ? sp : (qi == 1) ? cp : (qi == 2) ? -sp : -cp;
    const double c = (qi == 0) ? cp : (qi == 1) ? -sp : (qi == 2) ? -cp : sp;
    sn = (float)s; cs = (float)c;
}
__device__ __forceinline__ void p0_prologue(Frame& F, int qslot) {
    PHASE_IDS();
    const int gt = F.wg * (NWAVES * 64) + tid, NGT = F.G * NWAVES * 64;
    for (int c = gt; c < 1024; c += NGT) {
        const float a0 = F.lb_logits[c], a1 = F.lb_logits[1024 + c], a2 = F.lb_logits[2048 + c], a3 = F.lb_logits[3072 + c];
        const float mx = fmaxf(fmaxf(a0, a1), fmaxf(a2, a3));
        const float e0 = expf(a0 - mx), e1 = expf(a1 - mx), e2 = expf(a2 - mx), e3 = expf(a3 - mx), inv = 1.0f / (e0 + e1 + e2 + e3);
        F.LB[c] = 0.f; F.LB[1024 + c] = e1 * inv; F.LB[2048 + c] = (e1 + e2) * inv; F.LB[3072 + c] = (e1 + e2 + e3) * inv;
    }
    for (int i = gt; i < SEQ * 128; i += NGT) {
        const int pos = i >> 7, j = i & 127;
        const float t = (float)j * (1.0f / 127.0f);
        const float invf = (float)(1.0 / exp((double)t * 9.21034037197618271));
        const float ang = (float)pos * invf;
        float sn, cs; sincos_acc(ang, sn, cs);
        F.RC[i] = cs; F.RS[i] = sn;
    }
    for (int task = F.wg; task < DEPTH * 48; task += F.G) p0_mod_task(F, task);
    __syncthreads();
    const int nconv = (F.G > NGEMM) ? CONV_PRO : DEPTH;
    for (int l = 0; l < nconv; ++l) convert_layer(F, l, wave, lane);
}
template <bool FINAL>
__device__ __forceinline__ void norm_prompt_rows(Frame& F, const XSrc xin, const float* g, int l, int which_sh  ) {
    PHASE_IDS();
    const bool xl = (F.G == 256);
    const int gw = xl ? (F.wg >> 3) * NWAVES + wave : F.wg * NWAVES + wave, NGW = xl ? 256 : F.G * NWAVES, mbeg = xl ? 1024 * (F.wg & 7) : 0, mend = xl ? mbeg + 1024 : SEQ;
    f32x4 av[8], bv[8];
    { const f32x4* gp = (const f32x4*)g + lane;
      if (FINAL) {
#pragma unroll
          for (int j = 0; j < 8; ++j) { av[j] = gp[64 * j]; bv[j] = (f32x4){0.f, 0.f, 0.f, 0.f}; }
      } else {
          const float* mod = F.MOD + (size_t)l * NMOD;
          const f32x4* shp = (const f32x4*)(mod + which_sh * DM) + lane; const f32x4* scp = (const f32x4*)(mod + (which_sh + 1) * DM) + lane;
#pragma unroll
          for (int j = 0; j < 8; ++j) { av[j] = gp[64 * j] * (scp[64 * j] + 1.0f); bv[j] = shp[64 * j]; }
      } }
    for (int m0 = mbeg + gw; m0 < mend; m0 += 4 * NGW) {
        half4 hx[4][8]; f32x4 fx[8];
        const bool f32in = xin.p32 != nullptr;
        int mr[4]; bool ok[4];
#pragma unroll
        for (int q = 0; q < 4; ++q) { mr[q] = m0 + q * NGW; ok[q] = mr[q] < mend; if (!ok[q]) mr[q] = m0; }
        if (!f32in) {
#pragma unroll
            for (int q = 0; q < 4; ++q)
#pragma unroll
                for (int j = 0; j < 8; ++j) hx[q][j] = *(const half4*)(xin.p16 + (size_t)mr[q] * DM + 4 * (lane + 64 * j));
        }
#pragma unroll
        for (int q = 0; q < 4; ++q) {
            if (!ok[q]) continue;
            float ss = 0.f;
#pragma unroll
            for (int j = 0; j < 8; ++j) { fx[j] = f32in ? *(const f32x4*)(xin.p32 + (size_t)mr[q] * DM + 4 * (lane + 64 * j)) : __builtin_convertvector(hx[q][j], f32x4);
                ss += (fx[j].x * fx[j].x + fx[j].y * fx[j].y) + (fx[j].z * fx[j].z + fx[j].w * fx[j].w); }
            const float r = 1.0f / sqrtf(wave_sum(ss) * (1.0f / DM) + EPS);
            if (FINAL) { f32x4* o = (f32x4*)(F.out + (size_t)mr[q] * DM) + lane;
#pragma unroll
                for (int j = 0; j < 8; ++j) o[64 * j] = fx[j] * r * av[j];
            } else { v2u* p = (v2u*)(F.H + (size_t)mr[q] * DM) + lane;
#pragma unroll
                for (int j = 0; j < 8; ++j) { const f32x4 h = fx[j] * r * av[j] + bv[j]; v2u w; w.x = pk2(h.x, h.y); w.y = pk2(h.z, h.w); p[64 * j] = w; }
            }
        }
    }
}
template <bool FINAL, bool WT>
__device__ __forceinline__ void norm_sample_rows(Frame& F, const XSrc xin_s  , const float* g, int l, int which_sh, int nslab, int slab_l, int slab_which, unsigned* ctr) {
    PHASE_IDS();
    LAS float* red = (LAS float*)F.lds;
    int nrows = 0;
    const int idx = 64 * wave + lane;
    for (int rb = F.wg; rb < DECB * DECS; rb += 2 * F.G) {
        const int r0 = rb, r1 = rb + F.G; const bool two = r1 < DECB * DECS; const int r1c = two ? r1 : r0;
        nrows += two ? 2 : 1;
        f32x4 v[2]; v[0] = ldx4(xin_s, (size_t)r0 * DM + 4 * idx); v[1] = ldx4(xin_s, (size_t)r1c * DM + 4 * idx);
        if (nslab > 0) {
            f32x4 a[2]; a[0] = (f32x4){0.f, 0.f, 0.f, 0.f}; a[1] = a[0];
            const XSrc sp0{nullptr, (const half_t*)(F.ws + WS_SLAB) + (size_t)r0 * DM + 4 * idx}, sp1{nullptr, (const half_t*)(F.ws + WS_SLAB) + (size_t)r1c * DM + 4 * idx};
            if (nslab == 16) {
#pragma unroll
                for (int s = 0; s < 16; ++s) { a[0] += ldx4(sp0, (size_t)s * (512 * DM)); a[1] += ldx4(sp1, (size_t)s * (512 * DM)); }
            } else if (nslab == 8) {
#pragma unroll
                for (int s = 0; s < 8; ++s) { a[0] += ldx4(sp0, (size_t)s * (512 * DM)); a[1] += ldx4(sp1, (size_t)s * (512 * DM)); }
            } else {
#pragma unroll
                for (int s = 0; s < 4; ++s) { a[0] += ldx4(sp0, (size_t)s * (512 * DM)); a[1] += ldx4(sp1, (size_t)s * (512 * DM)); }
            }
#pragma unroll
            for (int q = 0; q < 2; ++q) { const int r = q ? r1c : r0; if (q && !two) break;
                const f32x4 gv = *((const f32x4*)(F.MOD + (size_t)((1 + (r >> 6)) * DEPTH + slab_l) * NMOD + slab_which * DM) + idx);
                v[q] += gv * a[q];
                stx4(F.X + (size_t)(SEQ + r) * DM + 4 * idx, v[q]); }
        }
        const float ss0 = wave_sum((v[0].x * v[0].x + v[0].y * v[0].y) + (v[0].z * v[0].z + v[0].w * v[0].w));
        const float ss1 = wave_sum((v[1].x * v[1].x + v[1].y * v[1].y) + (v[1].z * v[1].z + v[1].w * v[1].w));
        __syncthreads();
        if (lane == 0) { red[wave] = ss0; red[8 + wave] = ss1; }
        __syncthreads();
        const f32x4 gg = *((const f32x4*)g + idx);
#pragma unroll
        for (int q = 0; q < 2; ++q) { const int r = q ? r1c : r0; if (q && !two) break;
            const int m = SEQ + r, sq = 1 + (r >> 6);
            float tot = 0.f;
#pragma unroll
            for (int w = 0; w < 8; ++w) tot += red[8 * q + w];
            const float rstd = 1.0f / sqrtf(tot * (1.0f / DM) + EPS);
            if (FINAL) { *((f32x4*)(F.out + (size_t)m * DM) + idx) = v[q] * rstd * gg; }
            else {
                const float* mod = F.MOD + (size_t)(sq * DEPTH + l) * NMOD;
                const f32x4 sh = *((const f32x4*)(mod + which_sh * DM) + idx), sc = *((const f32x4*)(mod + (which_sh + 1) * DM) + idx);
                const f32x4 h = v[q] * rstd * gg * (sc + 1.0f) + sh;
                v2u w; w.x = pk2(h.x, h.y); w.y = pk2(h.z, h.w);
                if (WT) __hip_atomic_store((unsigned long long*)((v2u*)(F.H + (size_t)m * DM) + idx), ((unsigned long long)w.y << 32) | w.x, __ATOMIC_RELAXED, __HIP_MEMORY_SCOPE_AGENT);
                else *((v2u*)(F.H + (size_t)m * DM) + idx) = w;
            }
        }
    }
    if (WT) { asm volatile("s_waitcnt vmcnt(0)" ::: "memory"); __syncthreads(); if (threadIdx.x == 0 && nrows > 0) __hip_atomic_fetch_add(ctr, (unsigned)nrows, __ATOMIC_RELAXED, __HIP_MEMORY_SCOPE_AGENT); }
    __syncthreads();
}
__device__ __forceinline__ void acol_fill(Frame& F) {
    PHASE_IDS();
    const int gt = F.wg * (NWAVES * 64) + tid;
    if (gt < DEPTH * 2 * DM) { const int l = gt / (2 * DM), j = (gt / DM) & 1, c = gt % DM;
        const float g = (j ? F.norm2_g : F.norm1_g)[l * DM + c], sc = F.MOD[(size_t)l * NMOD + (j ? 4 : 1) * DM + c];
        ((float*)(F.ws + WS_ACOL))[gt] = g * (1.0f + sc); }
}
constexpr int NSG = 40;
constexpr size_t WS_UA = WS_END;
constexpr size_t WS_DGA = WS_UA + 20 * MiB;
constexpr size_t WS_SSA = WS_DGA + 1 * MiB;
constexpr size_t WS_UB = WS_SSA + 20 * MiB;
constexpr size_t WS_SSB = WS_UB + 40 * MiB;
constexpr size_t WS_END2 = WS_SSB + 20 * MiB;

constexpr int MX_KHT = 0, MX_VT = 18432, MX_QT = 36864, MX_KT = 54272, MX_QH = 71680, MX_A = 89088, MX_EDEC = 98304, MX_RED = 98816, MX_B = 100864, MX_QTOT = 133632  ;
constexpr int RX_Q = 0, RX_K = 33792, RX_VT = 67584, RX_A = 104448, RX_RED = 113664;
constexpr float LOG2E = 1.4426950408889634f;

__device__ __forceinline__ bf16x8 ldfrag(LAS unsigned char* base, int ld_bytes, int row, int kbyte) { return *(const LAS bf16x8*)(base + row * ld_bytes + kbyte); }
__device__ __forceinline__ int tr_off(int row, int tokpair) { return row * 144 + ((((tokpair >> 2) ^ (row >> 3)) & 7) << 4) + ((tokpair & 3) << 2); }
__device__ __forceinline__ bf16x8 tr_frag(LAS unsigned char* base, int row, int chunk) { return *(const LAS bf16x8*)(base + row * 144 + (((chunk ^ (row >> 3)) & 7) << 4)); }
__device__ __forceinline__ float fexp2(float x) { return __builtin_amdgcn_exp2f(x); }
__device__ __forceinline__ float frsq(float x) { return __builtin_amdgcn_rsqf(x); }
__device__ __forceinline__ float gamma_log2(int h) { return log2f(1.0f - exp2f(-5.0f - (float)h)); }
__device__ __forceinline__ int sg_row0(int sg) { return sg < 32 ? sg * 256 : SEQ + 64 * (sg - 32); }
__device__ __forceinline__ int sg_nch(int sg) { return sg < 32 ? 4 : 1; }

template <bool IS_RET>
__device__ __forceinline__ void p1_unit(Frame& F, int l, int sg, int h, int quad) {
    PHASE_IDS();
    const int g4 = lane >> 4, l16 = lane & 15;
    const int row0 = sg_row0(sg), nch = sg_nch(sg);
    const int kb = quad >> 1, vb = quad & 1;
    const int ck = IS_RET ? 5120 + h * 256 + 128 * kb : 1024 + h * 128;
    const int cv = IS_RET ? 6144 + h * 256 + 128 * vb : 2048 + h * 128;
    LAS unsigned char* L = F.lds;
    LAS float* Edec = (LAS float*)(L + MX_EDEC);
    const float lg2 = gamma_log2(h);
    f32x4 S[8];
#pragma unroll
    for (int kt = 0; kt < 8; ++kt) S[kt] = (f32x4){0.f, 0.f, 0.f, 0.f};
    float sumb = 0.f;
    const int tp = tid >> 4, kc = tid & 15;
    v4u ka, kbv, va, vbv; f32x4 ba0, ba1, bb0, bb1, bt0, bt1; float btk = 0.f;
#define P1_LOAD(rowc_) do { const int ra_ = (rowc_) + 2 * tp; \
        ka = *(const v4u*)(F.P + (size_t)ra_ * 8192 + ck + 8 * kc); kbv = *(const v4u*)(F.P + (size_t)(ra_ + 1) * 8192 + ck + 8 * kc); \
        va = *(const v4u*)(F.P + (size_t)ra_ * 8192 + cv + 8 * kc); vbv = *(const v4u*)(F.P + (size_t)(ra_ + 1) * 8192 + cv + 8 * kc); \
        if (!IS_RET) { const float* la_ = F.LF + (size_t)ra_ * 1024 + h * 128 + 8 * kc; const float* lt_ = F.LF + (size_t)((rowc_) + 63) * 1024 + h * 128; \
            ba0 = *(const f32x4*)la_; ba1 = *(const f32x4*)(la_ + 4); bb0 = *(const f32x4*)(la_ + 1024); bb1 = *(const f32x4*)(la_ + 1028); bt0 = *(const f32x4*)(lt_ + 8 * kc); bt1 = *(const f32x4*)(lt_ + 8 * kc + 4); \
            if (tid < 128) btk = lt_[tid]; } } while (0)
    P1_LOAD(row0);
    const bool smp = sg >= 32;
    f32x4 S0[8];
    const size_t s0base = IS_RET ? ((size_t)((l * DECB + (sg - 32)) * HB + h) * 256) * 256 : ((size_t)((l * DECB + (sg - 32)) * HA + h) * 128) * 128;
    if (smp) { const float* s0 = (IS_RET ? F.state_ret : F.state_hgrn) + s0base;
#pragma unroll
        for (int kt = 0; kt < 8; ++kt)
#pragma unroll
            for (int r = 0; r < 4; ++r) S0[kt][r] = IS_RET ? s0[(size_t)(128 * kb + 16 * kt + 4 * g4 + r) * 256 + 128 * vb + 16 * wave + l16] : s0[(size_t)(16 * kt + 4 * g4 + r) * 128 + 16 * wave + l16]; }
    for (int c = 0; c < nch; ++c) {
        {
            float fa[8], fb[8];
            if (IS_RET) {
                const float za = fexp2(lg2 * (float)(63 - 2 * tp)), zb = fexp2(lg2 * (float)(62 - 2 * tp));
#pragma unroll
                for (int i = 0; i < 8; ++i) { fa[i] = za; fb[i] = zb; }
                if (tid < 128) Edec[tid] = fexp2(lg2 * 64.0f);
            } else {
#pragma unroll
                for (int i = 0; i < 8; ++i) { const float bt = (i < 4) ? bt0[i & 3] : bt1[i & 3], ba = (i < 4) ? ba0[i & 3] : ba1[i & 3], bb = (i < 4) ? bb0[i & 3] : bb1[i & 3];
                    fa[i] = fexp2((bt - ba) * LOG2E); fb[i] = fexp2((bt - bb) * LOG2E);
                    if (tp == 0) Edec[8 * kc + i] = fexp2(bt * LOG2E); }
                if (tid < 128) sumb += btk;
            }
#pragma unroll
            for (int i = 0; i < 8; ++i) {
                const unsigned wa = ka[i >> 1], wb = kbv[i >> 1];
                const float xa = (i & 1) ? bfhi(wa) : bflo(wa), xb = (i & 1) ? bfhi(wb) : bflo(wb);
                *(LAS unsigned*)(L + MX_KHT + tr_off(8 * kc + i, tp)) = pk2(xa * fa[i], xb * fb[i]);
                const unsigned ua = va[i >> 1], ub = vbv[i >> 1];
                const unsigned lo = (i & 1) ? (ua >> 16) : (ua & 0xffffu), hi = (i & 1) ? (ub >> 16) : (ub & 0xffffu);
                *(LAS unsigned*)(L + MX_VT + tr_off(8 * kc + i, tp)) = lo | (hi << 16);
            }
        }
        __syncthreads();
        if (c + 1 < nch) P1_LOAD(row0 + 64 * (c + 1));
        {
            bf16x8 Y[2];
#pragma unroll
            for (int ss = 0; ss < 2; ++ss) Y[ss] = tr_frag(L + MX_VT, 16 * wave + l16, 4 * ss + g4);
#pragma unroll
            for (int hk = 0; hk < 2; ++hk) {
                bf16x8 fk[4][2]; f32x4 dv[4];
#pragma unroll
                for (int q = 0; q < 4; ++q) { const int kt = 4 * hk + q; dv[q] = *(const LAS f32x4*)(Edec + 16 * kt + 4 * g4);
#pragma unroll
                    for (int ss = 0; ss < 2; ++ss) fk[q][ss] = tr_frag(L + MX_KHT, 16 * kt + l16, 4 * ss + g4); }
                __builtin_amdgcn_sched_barrier(0);
#pragma unroll
                for (int q = 0; q < 4; ++q) { const int kt = 4 * hk + q; S[kt] = S[kt] * dv[q];
#pragma unroll
                    for (int ss = 0; ss < 2; ++ss) S[kt] = __builtin_amdgcn_mfma_f32_16x16x32_bf16(fk[q][ss], Y[ss], S[kt], 0, 0, 0); }
                __builtin_amdgcn_sched_barrier(0);
            }
        }
        __syncthreads();
    }
#undef P1_LOAD
    if (smp) {
        float* fin = F.out + (IS_RET ? OFF_SB_S : OFF_SA_S) + s0base;
#pragma unroll
        for (int kt = 0; kt < 8; ++kt) {
            const f32x4 d = *(const LAS f32x4*)(Edec + 16 * kt + 4 * g4);
            const f32x4 fs = d * S0[kt] + S[kt];
#pragma unroll
            for (int r = 0; r < 4; ++r) { if (IS_RET) fin[(size_t)(128 * kb + 16 * kt + 4 * g4 + r) * 256 + 128 * vb + 16 * wave + l16] = fs[r]; else fin[(size_t)(16 * kt + 4 * g4 + r) * 128 + 16 * wave + l16] = fs[r]; }
            if (IS_RET) { v2u w; w.x = pk2(S0[kt][0], S0[kt][1]); w.y = pk2(S0[kt][2], S0[kt][3]);
                *(v2u*)((bf16*)(F.ws + WS_SSB) + ((size_t)(sg * HB + h) * 256 + 128 * vb + 16 * wave + l16) * 256 + 128 * kb + 16 * kt + 4 * g4) = w; }
            else stx4((half_t*)(F.ws + WS_SSA) + ((size_t)(sg * HA + h) * 128 + 16 * wave + l16) * 128 + 16 * kt + 4 * g4, S0[kt]);
        }
        __syncthreads();
        return;
    }
    if (IS_RET) {
        half_t* U = (half_t*)(F.ws + WS_UB) + ((size_t)(sg * HB + h) * 256 + 128 * vb + 16 * wave + l16) * 256 + 128 * kb + 4 * g4;
#pragma unroll
        for (int kt = 0; kt < 8; ++kt) stx4(U + 16 * kt, S[kt]);
    } else {
        half_t* U = (half_t*)(F.ws + WS_UA) + ((size_t)(sg * HA + h) * 128 + 16 * wave + l16) * 128 + 4 * g4;
#pragma unroll
        for (int kt = 0; kt < 8; ++kt) stx4(U + 16 * kt, S[kt]);
        if (tid < 128) ((float*)(F.ws + WS_DGA))[(size_t)(sg * HA + h) * 128 + tid] = fexp2(sumb * LOG2E);
    }
}
__device__ __forceinline__ void mix1_phase(Frame& F, int l, const XcdBarrier& bar) {
    (void)bar;
    for (int u = F.wg; u < 960; u += F.G) {
        bool is_ret; int sg, h, quad = 0;
        if (F.G == 256 && u < 768) {
            const int x = F.wg & 7, k = F.wg >> 3;
            if (u < 256) { is_ret = false; sg = 4 * x + (k >> 3); h = k & 7; }
            else { const int e = k + 32 * ((u >> 8) - 1); is_ret = true; sg = 4 * x + (e >> 4); h = (e >> 2) & 3; quad = e & 3; }
        }
        else if (u < 256) { is_ret = false; sg = u >> 3; h = u & 7; }
        else if (u < 768) { const int r = u - 256, x = r & 7, k = (r >> 3) & 31, unit = (r >> 8) * 64 + (k >> 2) * 8 + x;
            is_ret = true; sg = unit >> 2; h = unit & 3; quad = k & 3; }
        else if (u < 832) { const int r = u - 768; is_ret = false; sg = 32 + (r >> 3); h = r & 7; }
        else { const int r = u - 832; is_ret = true; sg = 32 + (r >> 4); h = (r >> 2) & 3; quad = r & 3; }
        if (is_ret) p1_unit<true>(F, l, sg, h, quad); else p1_unit<false>(F, l, sg, h, quad);
    }
}

__device__ __forceinline__ void mix2_phase(Frame& F, int l) {
    PHASE_IDS();
    const int gt = F.wg * (NWAVES * 64) + tid, NGT = F.G * NWAVES * 64;
    constexpr int IA = 128 * 32, IB = 256 * 64, PER_SEQ = HA * IA + HB * IB;
    for (int it = gt; it < PER_SEQ; it += NGT) {
        const int seq = it / PER_SEQ; int r = it % PER_SEQ;
        const int ng = seq == 0 ? 32 : 1, sg0 = seq == 0 ? 0 : 31 + seq;
        if (r < HA * IA) {
            const int h = r / IA, v = seq == 0 ? ((r % IA) >> 5) : (r & 127), k4 = seq == 0 ? (r & 31) : ((r % IA) >> 7);
            f32x4 s = (f32x4){0.f, 0.f, 0.f, 0.f};
            if (seq > 0) { const float* s0 = F.state_hgrn + ((size_t)((l * DECB + (seq - 1)) * HA + h) * 128) * 128;
#pragma unroll
                for (int e = 0; e < 4; ++e) s[e] = s0[(size_t)(4 * k4 + e) * 128 + v]; }
            for (int g0 = 0; g0 < ng; g0 += 16) {
                half4 u[16]; f32x4 d[16];
#pragma unroll
                for (int i = 0; i < 16; ++i) if (g0 + i < ng) { const size_t ub = (size_t)((sg0 + g0 + i) * HA + h);
                    u[i] = *(const half4*)((const half_t*)(F.ws + WS_UA) + (ub * 128 + v) * 128 + 4 * k4); d[i] = *(const f32x4*)((const float*)(F.ws + WS_DGA) + ub * 128 + 4 * k4); }
#pragma unroll
                for (int i = 0; i < 16; ++i) if (g0 + i < ng) { const size_t ub = (size_t)((sg0 + g0 + i) * HA + h);
                    stx4((half_t*)(F.ws + WS_SSA) + (ub * 128 + v) * 128 + 4 * k4, s); s = d[i] * s + __builtin_convertvector(u[i], f32x4); }
            }
            float* dst = F.out + (seq == 0 ? OFF_SA_P + ((size_t)(l * HA + h) * 128) * 128 : OFF_SA_S + ((size_t)((l * DECB + (seq - 1)) * HA + h) * 128) * 128);
#pragma unroll
            for (int e = 0; e < 4; ++e) dst[(size_t)(4 * k4 + e) * 128 + v] = s[e];
        } else {
            r -= HA * IA;
            const int h = r / IB, v = seq == 0 ? ((r % IB) >> 6) : (r & 255), k4 = seq == 0 ? (r & 63) : ((r % IB) >> 8);
            const float lg2 = gamma_log2(h); const float gd = fexp2(lg2 * (seq == 0 ? 256.0f : 64.0f));
            f32x4 s = (f32x4){0.f, 0.f, 0.f, 0.f};
            if (seq > 0) { const float* s0 = F.state_ret + ((size_t)((l * DECB + (seq - 1)) * HB + h) * 256) * 256;
#pragma unroll
                for (int e = 0; e < 4; ++e) s[e] = s0[(size_t)(4 * k4 + e) * 256 + v]; }
            for (int g0 = 0; g0 < ng; g0 += 16) {
                half4 u[16];
#pragma unroll
                for (int i = 0; i < 16; ++i) if (g0 + i < ng) { const size_t ub = (size_t)((sg0 + g0 + i) * HB + h); u[i] = *(const half4*)((const half_t*)(F.ws + WS_UB) + (ub * 256 + v) * 256 + 4 * k4); }
#pragma unroll
                for (int i = 0; i < 16; ++i) if (g0 + i < ng) { const size_t ub = (size_t)((sg0 + g0 + i) * HB + h);
                    v2u w; w.x = pk2(s[0], s[1]); w.y = pk2(s[2], s[3]);
                    *(v2u*)((bf16*)(F.ws + WS_SSB) + (ub * 256 + v) * 256 + 4 * k4) = w; s = s * gd + __builtin_convertvector(u[i], f32x4); }
            }
            float* dst = F.out + (seq == 0 ? OFF_SB_P + ((size_t)(l * HB + h) * 256) * 256 : OFF_SB_S + ((size_t)((l * DECB + (seq - 1)) * HB + h) * 256) * 256);
#pragma unroll
            for (int e = 0; e < 4; ++e) dst[(size_t)(4 * k4 + e) * 256 + v] = s[e];
        }
    }
}
typedef short bf16x4 __attribute__((ext_vector_type(4)));
__device__ __forceinline__ float clampf(float x, float lo, float hi) { return fminf(fmaxf(x, lo), hi); }
__device__ __forceinline__ void p3_hgrn_unit(Frame& F, int l, int sg, int h) {
    PHASE_IDS();
    const int g4 = lane >> 4, l16 = lane & 15;
    const int row0 = sg_row0(sg), nch = sg_nch(sg);
    LAS unsigned char* L = F.lds;
    LAS float* Edec = (LAS float*)(L + MX_EDEC); LAS float* Red = (LAS float*)(L + MX_RED);
    f32x4 S[8];
    { const XSrc ss{nullptr, (const half_t*)(F.ws + WS_SSA) + ((size_t)(sg * HA + h) * 128 + 16 * wave + l16) * 128 + 4 * g4};
#pragma unroll
      for (int kt = 0; kt < 8; ++kt) S[kt] = ldx4(ss, 16 * kt); }
    const f32x4 gn4 = *(const f32x4*)(F.hgrn_g + l * 1024 + h * 128 + 16 * wave + 4 * g4);
    const int tp = tid >> 4, kc = tid & 15;
    v4u qa, qb, ka, kb, va, vb; f32x4 ba0, ba1, bb0, bb1, br0, br1, bt0, bt1;
#define P3H_LOAD(rowc_) do { const int ra_ = (rowc_) + 2 * tp; const bf16* pa_ = F.P + (size_t)ra_ * 8192 + h * 128 + 8 * kc; const bf16* pb_ = pa_ + 8192; \
        qa = *(const v4u*)pa_; qb = *(const v4u*)pb_; ka = *(const v4u*)(pa_ + 1024); kb = *(const v4u*)(pb_ + 1024); va = *(const v4u*)(pa_ + 2048); vb = *(const v4u*)(pb_ + 2048); \
        const float* la_ = F.LF + (size_t)ra_ * 1024 + h * 128 + 8 * kc; const float* lr_ = F.LF + (size_t)((rowc_) + 31) * 1024 + h * 128 + 8 * kc; const float* lt_ = lr_ + 32 * 1024; \
        ba0 = *(const f32x4*)la_; ba1 = *(const f32x4*)(la_ + 4); bb0 = *(const f32x4*)(la_ + 1024); bb1 = *(const f32x4*)(la_ + 1028); \
        br0 = *(const f32x4*)lr_; br1 = *(const f32x4*)(lr_ + 4); bt0 = *(const f32x4*)lt_; bt1 = *(const f32x4*)(lt_ + 4); } while (0)
    P3H_LOAD(row0);
    for (int c = 0; c < nch; ++c) {
        const int rowc = row0 + 64 * c;
        {
            unsigned qta[4], qtb[4], kta[4], ktb[4], qha[4], qhb[4];
            float pqa = 0.f, pqb = 0.f, pka = 0.f, pkb = 0.f, pha = 0.f, phb = 0.f;
#pragma unroll
            for (int i = 0; i < 8; ++i) {
                const float bref = (i < 4) ? br0[i & 3] : br1[i & 3], btot = (i < 4) ? bt0[i & 3] : bt1[i & 3];
                const float ba = (i < 4) ? ba0[i & 3] : ba1[i & 3], bb = (i < 4) ? bb0[i & 3] : bb1[i & 3];
                const float e1a = fexp2(clampf((ba - bref) * LOG2E, -115.f, 115.f)), e1b = fexp2(clampf((bb - bref) * LOG2E, -115.f, 115.f));
                const float e2a = __builtin_amdgcn_rcpf(e1a), e2b = __builtin_amdgcn_rcpf(e1b);
                const float eref = fexp2(bref * LOG2E), etr = fexp2((btot - bref) * LOG2E);
                const unsigned wqa = qa[i >> 1], wqb = qb[i >> 1], wka = ka[i >> 1], wkb = kb[i >> 1];
                const float xqa = (i & 1) ? bfhi(wqa) : bflo(wqa), xqb = (i & 1) ? bfhi(wqb) : bflo(wqb), xka = (i & 1) ? bfhi(wka) : bflo(wka), xkb = (i & 1) ? bfhi(wkb) : bflo(wkb);
                const float tqa = xqa * e1a, tqb = xqb * e1b, tka = xka * e2a, tkb = xkb * e2b;
                const float hqa = tqa * eref, hqb = tqb * eref;
                *(LAS unsigned*)(L + MX_KHT + tr_off(8 * kc + i, tp)) = pk2(tka * etr, tkb * etr);
                const unsigned ua = va[i >> 1], ub = vb[i >> 1];
                const unsigned lo = (i & 1) ? (ua >> 16) : (ua & 0xffffu), hi = (i & 1) ? (ub >> 16) : (ub & 0xffffu);
                *(LAS unsigned*)(L + MX_VT + tr_off(8 * kc + i, tp)) = lo | (hi << 16);
                if (tp == 0) Edec[8 * kc + i] = fexp2(btot * LOG2E);
                if (i & 1) { qta[i >> 1] = pk2(pqa, tqa); qtb[i >> 1] = pk2(pqb, tqb); kta[i >> 1] = pk2(pka, tka); ktb[i >> 1] = pk2(pkb, tkb); qha[i >> 1] = pk2(pha, hqa); qhb[i >> 1] = pk2(phb, hqb); }
                else { pqa = tqa; pqb = tqb; pka = tka; pkb = tkb; pha = hqa; phb = hqb; }
            }
            const int oa = (2 * tp) * 272 + 16 * kc, ob = oa + 272;
            *(LAS v4u*)(L + MX_QT + oa) = (v4u){qta[0], qta[1], qta[2], qta[3]}; *(LAS v4u*)(L + MX_QT + ob) = (v4u){qtb[0], qtb[1], qtb[2], qtb[3]};
            *(LAS v4u*)(L + MX_KT + oa) = (v4u){kta[0], kta[1], kta[2], kta[3]}; *(LAS v4u*)(L + MX_KT + ob) = (v4u){ktb[0], ktb[1], ktb[2], ktb[3]};
            *(LAS v4u*)(L + MX_QH + oa) = (v4u){qha[0], qha[1], qha[2], qha[3]}; *(LAS v4u*)(L + MX_QH + ob) = (v4u){qhb[0], qhb[1], qhb[2], qhb[3]};
        }
        __syncthreads();
        if (c + 1 < nch) P3H_LOAD(rowc + 64);
        v2u gpre[4];
#pragma unroll
        for (int j = 0; j < 4; ++j) gpre[j] = *(const v2u*)(F.P + (size_t)(rowc + 16 * j + l16) * 8192 + 3072 + h * 128 + 16 * wave + 4 * g4);
        {
            const int jt = wave >> 1;
#pragma unroll
            for (int ii = 0; ii < 2; ++ii) {
                const int it = 2 * (wave & 1) + ii;
                f32x4 a = (f32x4){0.f, 0.f, 0.f, 0.f};
                if (it <= jt) {
#pragma unroll
                    for (int kk = 0; kk < 4; ++kk) a = __builtin_amdgcn_mfma_f32_16x16x32_bf16(ldfrag(L + MX_KT, 272, 16 * it + l16, 64 * kk + 16 * g4), ldfrag(L + MX_QT, 272, 16 * jt + l16, 64 * kk + 16 * g4), a, 0, 0, 0);
                }
                const int t = 16 * jt + l16, s0 = 16 * it + 4 * g4;
                v2u w; w.x = pk2(s0 <= t ? a[0] : 0.f, s0 + 1 <= t ? a[1] : 0.f); w.y = pk2(s0 + 2 <= t ? a[2] : 0.f, s0 + 3 <= t ? a[3] : 0.f);
                if (it > jt) { w.x = 0u; w.y = 0u; }
                *(LAS v2u*)(L + MX_A + t * 144 + s0 * 2) = w;
            }
        }
        f32x4 o[4];
#pragma unroll
        for (int j = 0; j < 4; ++j) o[j] = (f32x4){0.f, 0.f, 0.f, 0.f};
#pragma unroll
        for (int kk = 0; kk < 4; ++kk) {
            const f32x4 s0 = S[2 * kk], s1 = S[2 * kk + 1];
            const v4u xw = (v4u){pk2(s0[0], s0[1]), pk2(s0[2], s0[3]), pk2(s1[0], s1[1]), pk2(s1[2], s1[3])};
            const bf16x8 X = __builtin_bit_cast(bf16x8, xw);
#pragma unroll
            for (int j = 0; j < 4; ++j) {
                const LAS unsigned char* qp = L + MX_QH + (16 * j + l16) * 272 + 64 * kk + 8 * g4;
                const bf16x4 y0 = *(const LAS bf16x4*)qp, y1 = *(const LAS bf16x4*)(qp + 32);
                const bf16x8 Y = __builtin_shufflevector(y0, y1, 0, 1, 2, 3, 4, 5, 6, 7);
                o[j] = __builtin_amdgcn_mfma_f32_16x16x32_bf16(X, Y, o[j], 0, 0, 0);
            }
        }
        __syncthreads();
        {
            bf16x8 Yv[2];
#pragma unroll
            for (int ss = 0; ss < 2; ++ss) Yv[ss] = tr_frag(L + MX_VT, 16 * wave + l16, 4 * ss + g4);
#pragma unroll
            for (int ss = 0; ss < 2; ++ss)
#pragma unroll
                for (int j = 0; j < 4; ++j) { if (ss == 1 && j < 2) continue;
                    o[j] = __builtin_amdgcn_mfma_f32_16x16x32_bf16(Yv[ss], ldfrag(L + MX_A, 144, 16 * j + l16, 64 * ss + 16 * g4), o[j], 0, 0, 0); }
            if (c + 1 < nch) {
#pragma unroll
                for (int kt = 0; kt < 8; ++kt) {
                    S[kt] = S[kt] * *(const LAS f32x4*)(Edec + 16 * kt + 4 * g4);
#pragma unroll
                    for (int ss = 0; ss < 2; ++ss) S[kt] = __builtin_amdgcn_mfma_f32_16x16x32_bf16(tr_frag(L + MX_KHT, 16 * kt + l16, 4 * ss + g4), Yv[ss], S[kt], 0, 0, 0);
                }
            }
        }
#pragma unroll
        for (int j = 0; j < 4; ++j) { float q = (o[j][0] * o[j][0] + o[j][1] * o[j][1]) + (o[j][2] * o[j][2] + o[j][3] * o[j][3]); q += __shfl_xor(q, 16); q += __shfl_xor(q, 32); if (g4 == 0) Red[wave * 64 + 16 * j + l16] = q; }
        __syncthreads();
#pragma unroll
        for (int j = 0; j < 4; ++j) {
            float tot = 0.f;
#pragma unroll
            for (int w = 0; w < 8; ++w) tot += Red[w * 64 + 16 * j + l16];
            const float rstd = frsq(tot * (1.0f / 128.0f) + EPS);
            const size_t row = rowc + 16 * j + l16;
            const v2u gw = gpre[j];
            const f32x4 r = o[j] * rstd * gn4;
            v2u w; w.x = pk2(r[0] * bflo(gw.x), r[1] * bfhi(gw.x)); w.y = pk2(r[2] * bflo(gw.y), r[3] * bfhi(gw.y));
            *(v2u*)(F.O + row * 2048 + h * 128 + 16 * wave + 4 * g4) = w;
        }
        __syncthreads();
    }
#undef P3H_LOAD
}
__device__ __forceinline__ void p3_ret_unit(Frame& F, int l, int sg, int jc, int h, bf16x8 (&X0)[8], bf16x8 (&X1)[8], bool load_S) {
    PHASE_IDS();
    const int g4 = lane >> 4, l16 = lane & 15;
    const int rowg = sg_row0(sg), rowq = rowg + 64 * jc;
    LAS unsigned char* L = F.lds;
    LAS float* Red = (LAS float*)(L + RX_RED);
    const float lg2 = gamma_log2(h);
    const int tp = tid >> 4, kc = tid & 15;
    const int oa = (2 * tp) * 528 + 16 * kc;
    v4u k0, k1, k2, k3, v0, v1, v2, v3;
#define P3R_LOADKV(jp_) do { const bf16* pa_ = F.P + (size_t)(rowg + 64 * (jp_) + 2 * tp) * 8192 + 5120 + h * 256 + 8 * kc; const bf16* pb_ = pa_ + 8192; \
        k0 = *(const v4u*)pa_; k1 = *(const v4u*)(pa_ + 128); k2 = *(const v4u*)pb_; k3 = *(const v4u*)(pb_ + 128); \
        v0 = *(const v4u*)(pa_ + 1024); v1 = *(const v4u*)(pa_ + 1024 + 128); v2 = *(const v4u*)(pb_ + 1024); v3 = *(const v4u*)(pb_ + 1024 + 128); } while (0)
#define P3R_STOREKV() do { *(LAS v4u*)(L + RX_K + oa) = k0; *(LAS v4u*)(L + RX_K + oa + 256) = k1; *(LAS v4u*)(L + RX_K + oa + 528) = k2; *(LAS v4u*)(L + RX_K + oa + 528 + 256) = k3; \
        _Pragma("unroll") for (int i = 0; i < 8; ++i) { \
            { const unsigned ua = v0[i >> 1], ub = v2[i >> 1]; const unsigned lo = (i & 1) ? (ua >> 16) : (ua & 0xffffu), hi = (i & 1) ? (ub >> 16) : (ub & 0xffffu); *(LAS unsigned*)(L + RX_VT + tr_off(8 * kc + i, tp)) = lo | (hi << 16); } \
            { const unsigned ua = v1[i >> 1], ub = v3[i >> 1]; const unsigned lo = (i & 1) ? (ua >> 16) : (ua & 0xffffu), hi = (i & 1) ? (ub >> 16) : (ub & 0xffffu); *(LAS unsigned*)(L + RX_VT + tr_off(128 + 8 * kc + i, tp)) = lo | (hi << 16); } } } while (0)
    {
        const bf16* pa = F.P + (size_t)(rowq + 2 * tp) * 8192 + 4096 + h * 256 + 8 * kc; const bf16* pb = pa + 8192;
        const v4u a0 = *(const v4u*)pa, a1 = *(const v4u*)(pa + 128), b0 = *(const v4u*)pb, b1 = *(const v4u*)(pb + 128);
        P3R_LOADKV(0);
        if (load_S) {
            const bf16* sp = (const bf16*)(F.ws + WS_SSB) + ((size_t)(sg * HB + h) * 256 + 32 * wave + l16) * 256 + 8 * g4;
#pragma unroll
            for (int kk = 0; kk < 8; ++kk) { X0[kk] = *(const bf16x8*)(sp + 32 * kk); X1[kk] = *(const bf16x8*)(sp + (size_t)16 * 256 + 32 * kk); } }
        *(LAS v4u*)(L + RX_Q + oa) = a0; *(LAS v4u*)(L + RX_Q + oa + 256) = a1; *(LAS v4u*)(L + RX_Q + oa + 528) = b0; *(LAS v4u*)(L + RX_Q + oa + 528 + 256) = b1;
        P3R_STOREKV();
    }
    f32x4 acc[2][4];
#pragma unroll
    for (int vt = 0; vt < 2; ++vt)
#pragma unroll
        for (int j = 0; j < 4; ++j) acc[vt][j] = (f32x4){0.f, 0.f, 0.f, 0.f};
    __syncthreads();
    if (jc > 0) P3R_LOADKV(1);
    v2u gpre[4][2];
    const f32x4 rg0 = *(const f32x4*)(F.ret_g + l * 1024 + h * 256 + 32 * wave + 4 * g4), rg1 = *(const f32x4*)(F.ret_g + l * 1024 + h * 256 + 32 * wave + 16 + 4 * g4);
#pragma unroll
    for (int j = 0; j < 4; ++j)
#pragma unroll
        for (int vt = 0; vt < 2; ++vt) gpre[j][vt] = *(const v2u*)(F.P + (size_t)(rowq + 16 * j + l16) * 8192 + 7168 + h * 256 + 32 * wave + 16 * vt + 4 * g4);
    {
#pragma unroll
        for (int kk = 0; kk < 8; ++kk)
            { bf16x8 Y[4];
#pragma unroll
              for (int j = 0; j < 4; ++j) Y[j] = ldfrag(L + RX_Q, 528, 16 * j + l16, 64 * kk + 16 * g4);
              __builtin_amdgcn_sched_barrier(0);
#pragma unroll
              for (int j = 0; j < 4; ++j) { acc[0][j] = __builtin_amdgcn_mfma_f32_16x16x32_bf16(X0[kk], Y[j], acc[0][j], 0, 0, 0); acc[1][j] = __builtin_amdgcn_mfma_f32_16x16x32_bf16(X1[kk], Y[j], acc[1][j], 0, 0, 0); }
              __builtin_amdgcn_sched_barrier(0); }
#pragma unroll
        for (int j = 0; j < 4; ++j) { const float xi = fexp2(lg2 * (float)(64 * jc + 16 * j + l16 + 1)); acc[0][j] = acc[0][j] * xi; acc[1][j] = acc[1][j] * xi; }
    }
    for (int jp = 0; jp <= jc; ++jp) {
        {
            const int jt = wave >> 1; const bool diag = (jp == jc);
#pragma unroll
            for (int ii = 0; ii < 2; ++ii) {
                const int it = 2 * (wave & 1) + ii;
                f32x4 a = (f32x4){0.f, 0.f, 0.f, 0.f};
                const bool live = !(diag && it > jt);
                if (live) {
#pragma unroll
                    for (int hk = 0; hk < 2; ++hk) {
                        bf16x8 fx[4], fy[4];
#pragma unroll
                        for (int q = 0; q < 4; ++q) { const int kk = 4 * hk + q; fx[q] = ldfrag(L + RX_K, 528, 16 * it + l16, 64 * kk + 16 * g4); fy[q] = ldfrag(L + RX_Q, 528, 16 * jt + l16, 64 * kk + 16 * g4); }
                        __builtin_amdgcn_sched_barrier(0);
#pragma unroll
                        for (int q = 0; q < 4; ++q) a = __builtin_amdgcn_mfma_f32_16x16x32_bf16(fx[q], fy[q], a, 0, 0, 0);
                        __builtin_amdgcn_sched_barrier(0);
                    }
                }
                const int t = 16 * jt + l16, s0 = 16 * it + 4 * g4; const int dd = 64 * (jc - jp) + t - s0;
                float e[4];
#pragma unroll
                for (int r = 0; r < 4; ++r) { const float dec = fexp2(lg2 * (float)(dd - r)); e[r] = (!diag || s0 + r <= t) ? a[r] * dec : 0.f; }
                v2u w; w.x = pk2(e[0], e[1]); w.y = pk2(e[2], e[3]);
                if (!live) { w.x = 0u; w.y = 0u; }
                *(LAS v2u*)(L + RX_A + t * 144 + s0 * 2) = w;
            }
        }
        __syncthreads();
        {
            bf16x8 fv[2][2], fp[2][4];
#pragma unroll
            for (int ss = 0; ss < 2; ++ss) {
#pragma unroll
                for (int vt = 0; vt < 2; ++vt) fv[ss][vt] = tr_frag(L + RX_VT, 32 * wave + 16 * vt + l16, 4 * ss + g4);
#pragma unroll
                for (int j = 0; j < 4; ++j) fp[ss][j] = ldfrag(L + RX_A, 144, 16 * j + l16, 64 * ss + 16 * g4); }
            __builtin_amdgcn_sched_barrier(0);
#pragma unroll
            for (int ss = 0; ss < 2; ++ss)
#pragma unroll
                for (int vt = 0; vt < 2; ++vt)
#pragma unroll
                    for (int j = 0; j < 4; ++j) acc[vt][j] = __builtin_amdgcn_mfma_f32_16x16x32_bf16(fv[ss][vt], fp[ss][j], acc[vt][j], 0, 0, 0);
            __builtin_amdgcn_sched_barrier(0);
        }
        if (jp < jc) {
            __syncthreads();
            P3R_STOREKV();
            __syncthreads();
            if (jp + 2 <= jc) P3R_LOADKV(jp + 2);
        }
    }
#undef P3R_LOADKV
#undef P3R_STOREKV
#pragma unroll
    for (int j = 0; j < 4; ++j) { float q = 0.f;
#pragma unroll
        for (int vt = 0; vt < 2; ++vt) q += (acc[vt][j][0] * acc[vt][j][0] + acc[vt][j][1] * acc[vt][j][1]) + (acc[vt][j][2] * acc[vt][j][2] + acc[vt][j][3] * acc[vt][j][3]);
        q += __shfl_xor(q, 16); q += __shfl_xor(q, 32); if (g4 == 0) Red[wave * 64 + 16 * j + l16] = q; }
    __syncthreads();
#pragma unroll
    for (int j = 0; j < 4; ++j) {
        float tot = 0.f;
#pragma unroll
        for (int w = 0; w < 8; ++w) tot += Red[w * 64 + 16 * j + l16];
        const float rstd = frsq(tot * (1.0f / 256.0f) + EPS);
        const size_t row = rowq + 16 * j + l16;
#pragma unroll
        for (int vt = 0; vt < 2; ++vt) {
            const int vc = h * 256 + 32 * wave + 16 * vt + 4 * g4;
            const v2u gw = gpre[j][vt];
            const f32x4 r = acc[vt][j] * rstd * (vt ? rg1 : rg0);
            v2u w; w.x = pk2(r[0] * bflo(gw.x), r[1] * bfhi(gw.x)); w.y = pk2(r[2] * bflo(gw.y), r[3] * bfhi(gw.y));
            *(v2u*)(F.O + row * 2048 + 1024 + vc) = w;
        }
    }
    __syncthreads();
}
__device__ __forceinline__ void mix3_phase(Frame& F, int l, int parts = 3) {
    for (int vw = F.wg; vw < 256; vw += F.G) {
        const bool xl = (F.G == 256); const int x = vw & 7, k = vw >> 3;
        if (parts & 1) for (int q = 0; q < 2; ++q) {
            if (q == 1 && vw >= 64) break;
            const int sg = q == 0 ? (xl ? 4 * x + (k >> 3) : (vw >> 3)) : 32 + (vw >> 3);
            const int h = q == 0 ? (xl ? (k & 7) : (vw & 7)) : (vw & 7);
            p3_hgrn_unit(F, l, sg, h);
        }
        bf16x8 SX0[8], SX1[8];
        if (parts & 2) for (int q = 0; q < 3; ++q) {
            int sg, jc, h;
            if (q < 2) { int half; if (xl) { sg = 4 * x + (k >> 3); h = (k >> 1) & 3; half = k & 1; } else { h = vw & 3; sg = (vw >> 2) & 31; half = vw >> 7; }
                jc = q == 0 ? (half ? 2 : 3) : (half ? 1 : 0); }
            else { if (vw < 64 || vw >= 96) break; sg = 32 + ((vw - 64) >> 2); jc = 0; h = (vw - 64) & 3; }
            p3_ret_unit(F, l, sg, jc, h, SX0, SX1, q != 1);
        }
    }
}
constexpr int PH_PRO = 0, PH_PER_LAYER = 9, PH_FINAL = 1 + DEPTH * PH_PER_LAYER, N_PHASES = PH_FINAL + 1;
struct Args { const float* in[18]; float* out; unsigned char* ws; int ph_lo, ph_hi; };
__global__ void __launch_bounds__(NWAVES * 64, 2) fwd(Args args) {
    extern __shared__ __attribute__((aligned(16))) unsigned char lds[];
    Frame F;
    F.lds = (LAS unsigned char*)lds;
    F.G = gridDim.x; F.wg = blockIdx.x;
    unsigned char* ws = args.ws;
    F.ctl = (unsigned*)(ws + WS_CTL); F.ws = ws;
    F.x_prompt = args.in[0]; F.x_sample = args.in[1]; F.state_hgrn = args.in[2]; F.state_ret = args.in[3]; F.c_prompt = args.in[4]; F.c_sample = args.in[5];
    F.lb_logits = args.in[6]; F.w_ada = args.in[7]; F.b_ada = args.in[8]; F.norm1_g = args.in[9]; F.norm2_g = args.in[10]; F.w_in = args.in[11];
    F.hgrn_g = args.in[12]; F.ret_g = args.in[13]; F.w_out = args.in[14]; F.w_up = args.in[15]; F.w_down = args.in[16]; F.final_g = args.in[17];
    F.out = args.out;
    F.Win_t = (bf16*)(ws + WS_WIN); F.Wout_t = (bf16*)(ws + WS_WOUT); F.Wup_t = (bf16*)(ws + WS_WUP); F.Wdn_t = (bf16*)(ws + WS_WDN);
    F.X = (half_t*)(ws + WS_X); F.H = (bf16*)(ws + WS_H); F.P = (bf16*)(ws + WS_P); F.LF = (float*)(ws + WS_LF); F.O = (bf16*)(ws + WS_O); F.U = (bf16*)(ws + WS_U);
    F.MOD = (float*)(ws + WS_MOD); F.LB = (float*)(ws + WS_LB); F.RC = (float*)(ws + WS_ROPE); F.RS = F.RC + SEQ * 128;
    volatile LAS unsigned* MISC = (volatile LAS unsigned*)(F.lds + MISC_OFF);
    if (threadIdx.x < 64) MISC[threadIdx.x] = 0u;
    __syncthreads();
#ifndef NO_XCC_REMAP
    if (threadIdx.x == 0) { const unsigned x = xb_xcc_id() & 7u; MISC[16] = x; MISC[17] = xb_add(F.ctl + CW_XRANK + 64 * x, 1u); }
#endif
    const int lo = args.ph_lo, hi = args.ph_hi;
    XcdBarrier bar; bar.bar = F.ctl + CW_BAR; bar.x = 0; bar.st = MISC + 8;
    if (hi - lo > 1) bar = xcd_barrier_post(F.ctl + CW_BAR, MISC + 8);
#define IN(k) (lo <= (k) && (k) < hi)
#ifdef PROBE_BAR2
#define SEAM(k) do { if (IN(k) && IN((k) + 1)) { xcd_barrier(bar); xcd_barrier(bar); } } while (0)
#else
#define SEAM(k) do { if (IN(k) && IN((k) + 1)) xcd_barrier(bar); } while (0)
#endif

    if (IN(PH_PRO)) {
#ifndef SKIP_PRO
 p0_prologue(F, 0);
#endif
#ifdef PROBE_PRO
 __syncthreads(); p0_prologue(F, 1);
#endif
 } SEAM(PH_PRO);
#ifndef NO_XCC_REMAP
    if (IN(PH_PRO) && IN(PH_PRO + 1) && (F.G & 7) == 0) {
        if (threadIdx.x == 0) { bool even = true; for (int j = 0; j < 8; ++j) even = even && (xb_ld(F.ctl + CW_XRANK + 64 * j) == (unsigned)(F.G >> 3)); MISC[18] = even ? (MISC[17] * 8u + MISC[16]) : (unsigned)blockIdx.x; }
        __syncthreads();
        F.wg = __builtin_amdgcn_readfirstlane((int)MISC[18]);
    }
#endif
    for (int l = 0; l < DEPTH; ++l) {
        const int pb = 1 + l * PH_PER_LAYER;
        const bool fz = (l >= FUSE_FROM) && (F.G > NGEMM);
        float* const RSS = (float*)(F.ctl + CW_RSS); float* const BIAS = (float*)(F.ctl + CW_BIAS); const float* const ACOL = (const float*)(F.ws + WS_ACOL);
        if (IN(pb + 0) && !fz) {
            if (l == 0) acol_fill(F);
            norm_prompt_rows<false>(F, l == 0 ? XSrc{F.x_prompt, nullptr} : XSrc{nullptr, F.X}, F.norm1_g + l * DM, l, 0);
            norm_sample_rows<false, false>(F, l == 0 ? XSrc{F.x_sample, nullptr} : XSrc{nullptr, F.X + (size_t)SEQ * DM}, F.norm1_g + l * DM, l, 0, l > 0 ? 8 : 0, l - 1, 5, nullptr);
        }
        if (!fz) SEAM(pb + 0);
        if (IN(pb + 1)) {
            unsigned* ctr = F.ctl + CW_SMP + 64 * (2 * l);
            if (fz) norm_sample_rows<false, true>(F, XSrc{nullptr, F.X + (size_t)SEQ * DM}, F.norm1_g + l * DM, l, 0, 8, l - 1, 5, ctr);
            const bool helpers = (CONV_PRO < DEPTH) && (l + 1 >= CONV_PRO) && (l + 1 < DEPTH) && (F.G > NGEMM);
            const int ng = helpers ? NGEMM : F.G;
#if defined(PROBE_DUP_IN) || defined(PROBE_DUP_IN3)
            for (int rep = 0; rep < 2; ++rep) { if (rep) xcd_barrier(bar);
#define REP0_IN (rep == 0)
#else
#define REP0_IN true
#endif
            if (F.wg < ng) {
                pg8::Gemm g{F.H, F.Win_t + (size_t)l * NPROJ * DM, M, NPROJ, DM};
                pg8::EpiInProj E{F.P, F.LF, F.LB + l * 1024, F.RC, F.RS, nullptr, fz ? RSS + (size_t)(2 * l) * 8192 : nullptr, BIAS + (size_t)(2 * l) * 8192};
#ifdef PROBE_DUP_IN3
                if (rep) { E.P = F.U; E.force_seg = PROBE_DUP_IN3; }
#endif
#ifdef USE_ALIGNED_ORDER
                if ((ng & 7) == 0) { pg8::XcdAlignedOrder S; S.init(DM, ng, F.wg); S.permute = 1; pg8::gemm_phase<pg8::EpiInProj, pg8::XcdAlignedOrder, true, true, 0>(F.lds + RING_OFF, g, S, E); } else
#endif
                { pg8::HookOrder S; S.init(M, NPROJ, DM, ng, F.wg); S.permute = 1; S.ready = fz ? ctr : nullptr; S.need = DECB * DECS; S.tmo = F.ctl + CW_TMO;
                pg8::gemm_phase<pg8::EpiInProj, pg8::HookOrder, true, true, 0>(F.lds + RING_OFF, g, S, E); }
            } else if (REP0_IN) { PHASE_IDS(); convert_layer(F, l + 1, wave, lane, 0, CV_SPLIT, 0); }
#if defined(PROBE_DUP_IN) || defined(PROBE_DUP_IN3)
            }
#endif
#ifdef PROBE_DUP_IN2
            xcd_barrier(bar);
            if (F.wg < ng) {
                pg8::Gemm g{F.H, F.Win_t + (size_t)l * NPROJ * DM, M, NPROJ, DM};
                pg8::EpiRelu2 E{F.U, DFF, nullptr, nullptr, BIAS};
                pg8::XcdAlignedOrder S; S.init(DM, ng, F.wg); S.permute = 1; pg8::gemm_phase<pg8::EpiRelu2, pg8::XcdAlignedOrder, true, true, 0>(F.lds + RING_OFF, g, S, E);
            }
#endif
#ifdef PROBE_HALFGRID
            xcd_barrier(bar);
            if (F.wg < PROBE_HALFGRID) {
                pg8::Gemm g{F.H, F.Win_t + (size_t)l * NPROJ * DM, M, NPROJ, DM};
                pg8::EpiInProj E{F.P, F.LF, F.LB + l * 1024, F.RC, F.RS, nullptr, fz ? RSS + (size_t)(2 * l) * 8192 : nullptr, BIAS + (size_t)(2 * l) * 8192};
                pg8::HookOrder S; S.init(M, NPROJ, DM, PROBE_HALFGRID, F.wg); S.permute = 1; S.ready = nullptr; S.need = 0; S.tmo = F.ctl + CW_TMO;
                pg8::gemm_phase<pg8::EpiInProj, pg8::HookOrder, true, true, 0>(F.lds + RING_OFF, g, S, E);
            }
#endif
        } SEAM(pb + 1);
#ifdef PROBE_REP_MIX
#define MIXREP(k_) for (int rep = 0; rep < ((PROBE_REP_MIX) == (k_) ? 2 : 1); ++rep)
#define MIXREPBAR() do { if (rep) xcd_barrier(bar); } while (0)
#else
#define MIXREP(k_)
#define MIXREPBAR() do { } while (0)
#endif
        if (IN(pb + 2)) { MIXREP(1) { MIXREPBAR(); mix1_phase(F, l, bar); } } SEAM(pb + 2);
        if (IN(pb + 3)) { MIXREP(2) { MIXREPBAR(); mix2_phase(F, l); } } SEAM(pb + 3);
        if (IN(pb + 4)) { MIXREP(3) { MIXREPBAR(); mix3_phase(F, l); } } SEAM(pb + 4);
        if (IN(pb + 5)) {
            pg8::Gemm g{F.O, F.Wout_t + (size_t)l * DM * DM, M, DM, DM}; pg8::ResidOrder S; S.init(DM, 4, F.G, F.wg);
            pg8::EpiResid E{F.X, F.MOD + (size_t)l * NMOD + 2 * DM, (float*)(F.ws + WS_SLAB), l == 0 ? F.x_prompt : nullptr, fz ? F.H : nullptr, ACOL + (size_t)(2 * l + 1) * DM, RSS + (size_t)(2 * l + 1) * 8192};
            pg8::gemm_phase<pg8::EpiResid, pg8::ResidOrder, true, true>(F.lds + RING_OFF, g, S, E);
        } SEAM(pb + 5);
        if (IN(pb + 6) && !fz) {
            norm_prompt_rows<false>(F, XSrc{nullptr, F.X}, F.norm2_g + l * DM, l, 3);
            norm_sample_rows<false, false>(F, l == 0 ? XSrc{F.x_sample, nullptr} : XSrc{nullptr, F.X + (size_t)SEQ * DM}, F.norm2_g + l * DM, l, 3, 4, l, 2, nullptr);
        }
        if (!fz) SEAM(pb + 6);
        if (IN(pb + 7)) {
            unsigned* ctr = F.ctl + CW_SMP + 64 * (2 * l + 1);
            if (fz) norm_sample_rows<false, true>(F, XSrc{nullptr, F.X + (size_t)SEQ * DM}, F.norm2_g + l * DM, l, 3, 4, l, 2, ctr);
            const bool helpers = (CONV_PRO < DEPTH) && (l + 1 >= CONV_PRO) && (l + 1 < DEPTH) && (F.G > NGEMM);
            const int ng = helpers ? NGEMM : F.G;
#ifdef PROBE_DUP_UP
            for (int rep = 0; rep < 2; ++rep) { if (rep) xcd_barrier(bar);
#define REP0_UP (rep == 0)
#else
#define REP0_UP true
#endif
            if (F.wg < ng) {
                pg8::Gemm g{F.H, F.Wup_t + (size_t)l * DFF * DM, M, DFF, DM};
                pg8::EpiRelu2 E{F.U, DFF, nullptr, fz ? RSS + (size_t)(2 * l + 1) * 8192 : nullptr, BIAS + (size_t)(2 * l + 1) * 8192};
#ifdef USE_ALIGNED_ORDER
                if ((ng & 7) == 0) { pg8::XcdAlignedOrder S; S.init(DM, ng, F.wg); pg8::gemm_phase<pg8::EpiRelu2, pg8::XcdAlignedOrder, true, true, 0>(F.lds + RING_OFF, g, S, E); } else
#endif
                { pg8::HookOrder S; S.init(M, DFF, DM, ng, F.wg); S.permute = 0; S.ready = fz ? ctr : nullptr; S.need = DECB * DECS; S.tmo = F.ctl + CW_TMO;
                pg8::gemm_phase<pg8::EpiRelu2, pg8::HookOrder, true, true, 0>(F.lds + RING_OFF, g, S, E); }
            } else if (REP0_UP) { PHASE_IDS(); convert_layer(F, l + 1, wave, lane, CV_SPLIT, CV_LAYER, 16); }
#ifdef PROBE_DUP_UP
            }
#endif
        } SEAM(pb + 7);
        if (IN(pb + 8)) {
            const bool fzn = (l + 1 < DEPTH) && (l + 1 >= FUSE_FROM) && (F.G > NGEMM);
            pg8::Gemm g{F.U, F.Wdn_t + (size_t)l * DM * DFF, M, DM, DFF}; pg8::ResidOrder S; S.init(DFF, 8, F.G, F.wg);
            pg8::EpiResid E{F.X, F.MOD + (size_t)l * NMOD + 5 * DM, (float*)(F.ws + WS_SLAB), nullptr, fzn ? F.H : nullptr, ACOL + (size_t)(2 * (l + 1)) * DM, RSS + (size_t)(2 * (l + 1)) * 8192};
#ifdef PROBE_DUP_DOWN
            for (int rep = 0; rep < 2; ++rep) { if (rep) { xcd_barrier(bar); E.X = (half_t*)(F.ws + WS_END2 + 64 * MiB); E.slab = (float*)(F.ws + WS_END2 + 128 * MiB); }
#endif
            pg8::gemm_phase<pg8::EpiResid, pg8::ResidOrder, true, true>(F.lds + RING_OFF, g, S, E);
#ifdef PROBE_DUP_DOWN
            }
#endif
        } SEAM(pb + 8);
    }
    if (IN(PH_FINAL)) {
        norm_prompt_rows<true>(F, XSrc{nullptr, F.X}, F.final_g, DEPTH - 1, 0);
        norm_sample_rows<true, false>(F, XSrc{nullptr, F.X + (size_t)SEQ * DM}, F.final_g, DEPTH - 1, 0, 8, DEPTH - 1, 5, nullptr);
    }
#undef IN
#undef SEAM
}

#ifndef MK_ONE_LAUNCH
#define MK_ONE_LAUNCH 1
#endif
extern "C" void kernel_launch(void* const* d_in, const int* in_sizes, int n_in, void* d_out, int out_size, void* d_ws, size_t ws_size, hipStream_t stream) {
    static int grid = 0;
    if (grid == 0) {
        if (n_in != 18 || (size_t)out_size != OUT_TOTAL || ws_size < WS_END2) { fprintf(stderr, "kernel_launch: unexpected shapes: n_in %d out %d ws %zu (need %zu)\n", n_in, out_size, ws_size, (size_t)WS_END2); grid = -1; return; }
        int dev = 0, cus = 0, per_cu = 0;
        if (hipGetDevice(&dev) != hipSuccess || hipDeviceGetAttribute(&cus, hipDeviceAttributeMultiprocessorCount, dev) != hipSuccess) { grid = -1; return; }
        if (hipFuncSetAttribute((const void*)fwd, hipFuncAttributeMaxDynamicSharedMemorySize, LDS_BYTES) != hipSuccess) { fprintf(stderr, "kernel_launch: hipFuncSetAttribute failed\n"); grid = -1; return; }
        if (hipOccupancyMaxActiveBlocksPerMultiprocessor(&per_cu, (const void*)fwd, NWAVES * 64, LDS_BYTES) != hipSuccess || per_cu < 1)
            fprintf(stderr, "kernel_launch: note: occupancy query reports %d workgroups per CU\n", per_cu);
        (void)hipGetLastError();
        grid = cus;
    }
    if (grid < 0) return;
    if (hipMemsetAsync((char*)d_ws + WS_CTL, 0, CTL_ZERO_BYTES, stream) != hipSuccess) { fprintf(stderr, "kernel_launch: memset failed\n"); return; }
    Args a{};
    for (int i = 0; i < 18; ++i) a.in[i] = (const float*)d_in[i];
    a.out = (float*)d_out; a.ws = (unsigned char*)d_ws;
#if MK_ONE_LAUNCH
    a.ph_lo = 0; a.ph_hi = N_PHASES;
    hipLaunchKernelGGL(fwd, dim3(grid), dim3(NWAVES * 64), LDS_BYTES, stream, a);
#else
    for (int ph = 0; ph < N_PHASES; ++ph) {
        a.ph_lo = ph; a.ph_hi = ph + 1;
        hipLaunchKernelGGL(fwd, dim3(grid), dim3(NWAVES * 64), LDS_BYTES, stream, a);
    }
#endif
    const hipError_t le = hipPeekAtLastError();
    if (le != hipSuccess) fprintf(stderr, "kernel_launch: launch failed: %s\n", hipGetErrorName(le));
}
```

```cpp
#define USE_ALIGNED_ORDER 1
#define FUSE_FROM 99
#include <hip/hip_runtime.h>
#include <cstdio>
#include <cstdint>
typedef _Float16 half_t;
typedef _Float16 half4 __attribute__((ext_vector_type(4)));
typedef float xf4 __attribute__((ext_vector_type(4)));
struct XSrc { const float* p32; const half_t* p16; };
__device__ __forceinline__ xf4 ldx4(const XSrc& s, size_t e) { return s.p32 ? *(const xf4*)(s.p32 + e) : __builtin_convertvector(*(const half4*)(s.p16 + e), xf4); }
__device__ __forceinline__ void stx4(half_t* p, xf4 v) { *(half4*)p = __builtin_convertvector(v, half4); }
__device__ __forceinline__ int row_pos(int row) { return row < 8192 ? row : 2048 + ((row - 8192) & 63); }
__device__ __forceinline__ int row_seq(int row) { return row < 8192 ? 0 : 1 + ((row - 8192) >> 6); }
namespace pg8 {
#define PG8_LAS __attribute__((address_space(3)))
typedef unsigned short bf16_t;
typedef short bf16x8 __attribute__((ext_vector_type(8)));
typedef float f32x4 __attribute__((ext_vector_type(4)));
typedef unsigned u32x4 __attribute__((ext_vector_type(4)));
typedef unsigned u32x2 __attribute__((ext_vector_type(2)));
constexpr int BM = 256, BK = 64, HALF = 128, HTB = HALF * BK * 2  , STAGE_BYTES = 8 * HTB, NXCD = 8, WGM = 4;

__host__ __device__ __forceinline__ int lds_byte(int r, int c) { const int st = (r >> 4) * 2 + (c >> 5), rr = r & 15, cc = c & 31, ob = rr * 64 + cc * 2; return st * 1024 + (ob ^ (((ob >> 9) & 1) << 5)); }
__host__ __device__ __forceinline__ void stage_rc(int b, int& R, int& C) { const int st = b / 1024, sb = b % 1024, swz = sb ^ (((sb >> 9) & 1) << 5); R = (st >> 1) * 16 + swz / 64; C = (st & 1) * 32 + (swz % 64) / 2; }
__host__ __device__ __forceinline__ int perm32(int rho) { const int n = rho >> 4, i = rho & 15; return 8 * (i >> 2) + 4 * n + (i & 3); }

struct Unit { int pm, pn, kt0, nt, slab, qa, qh; };
struct Gemm { const bf16_t* A; const bf16_t* Bt; int M, N, K; };

struct StaticOrder {
    int nM, nN, nwg, G, c, ntk;
    __host__ __device__ __forceinline__ void init(int M, int N, int K, int G_, int c_) { nM = M / BM; nN = N / BM; nwg = nM * nN; G = G_; c = c_; ntk = K / BK; }
    __host__ __device__ __forceinline__ bool next(int i, Unit& u) const {
        const long L = (long)i * G + c; if (L >= nwg) return false;
        int wgid = (int)L; { const int q = nwg / NXCD, r = nwg % NXCD, xcd = wgid % NXCD, off = wgid / NXCD; wgid = (xcd < r ? xcd * (q + 1) : r * (q + 1) + (xcd - r) * q) + off; }
        const int nig = WGM * nN, gid = wgid / nig, fm = gid * WGM, gsz = (nM - fm) < WGM ? (nM - fm) : WGM;
        u.pm = fm + ((wgid % nig) % gsz); u.pn = (wgid % nig) / gsz; u.kt0 = 0; u.nt = ntk; u.slab = -1; u.qa = -1; u.qh = 0; return true;
    }
    __device__ __forceinline__ void a_ready(const Unit&) const {}
    __device__ __forceinline__ void done(const Unit&) const {}
};

__device__ __forceinline__ void hook_wait(const unsigned* ready, unsigned need, unsigned* tmo) {
    if (threadIdx.x < 64) {
        const unsigned long long t0 = __builtin_amdgcn_s_memrealtime(); unsigned polls = 0;
        while ((unsigned)__builtin_amdgcn_readfirstlane(__hip_atomic_load(ready, __ATOMIC_RELAXED, __HIP_MEMORY_SCOPE_AGENT)) < need) {
            if ((++polls & 255u) == 0u && __builtin_amdgcn_readfirstlane(__hip_atomic_load(tmo, __ATOMIC_RELAXED, __HIP_MEMORY_SCOPE_AGENT)) != 0u) break;
            if (__builtin_amdgcn_s_memrealtime() - t0 > 2000000ull) { if (threadIdx.x == 0) __hip_atomic_store(tmo, 1u, __ATOMIC_RELAXED, __HIP_MEMORY_SCOPE_AGENT); break; }
            __builtin_amdgcn_s_sleep(2); }
        __builtin_amdgcn_fence(__ATOMIC_ACQUIRE, "agent");
        asm volatile("s_waitcnt vmcnt(0)" ::: "memory");
    }
    asm volatile("" ::: "memory"); __builtin_amdgcn_s_barrier(); asm volatile("" ::: "memory");
}
struct HookOrder : StaticOrder {
    const unsigned* ready; unsigned need; unsigned* tmo; int permute;
    __host__ __device__ __forceinline__ bool next(int i, Unit& u) const { const bool ok = StaticOrder::next(i, u); if (permute) u.pn = (u.pn * 5) & 31; return ok; }
    __device__ __forceinline__ void a_ready(const Unit& u) const { if (ready != nullptr && u.pm >= 32) hook_wait(ready, need, tmo); }
};
struct XcdAlignedOrder {
    int G, c, ntk, permute; const unsigned* ready; unsigned need; unsigned* tmo;
    __host__ __device__ __forceinline__ void init(int K, int G_, int c_) { G = G_; c = c_; ntk = K / BK; permute = 0; ready = nullptr; need = 0; tmo = nullptr; }
    __host__ __device__ __forceinline__ bool next(int i, Unit& u) const {
        const int x = c & 7, j = i * (G >> 3) + (c >> 3); if (j >= 136 || (c >> 3) >= (G >> 3)) return false;
        const int s0 = x >> 1, q = j / 17, r = j % 17;
        int pm, pn;
        if (r == 4 * (s0 + 1)) { pm = 32 + (x & 1); pn = 4 * q + s0; }
        else { const int rr = r > 4 * (s0 + 1) ? r - 1 : r; pm = 4 * x + (rr & 3); pn = 4 * q + (rr >> 2); }
        if (permute) {
            const unsigned long long lo = pn < 16 ? 0xc3e001e894f24db9ull : 0xa8376af2cd15765bull;
            pn = (int)((lo >> (4 * (pn & 15))) & 15ull) | (int)(((0x76a6129eu >> pn) & 1u) << 4); }
        u.pm = pm; u.pn = pn; u.kt0 = 0; u.nt = ntk; u.slab = -1; u.qa = -1; u.qh = 0; return true;
    }
    __device__ __forceinline__ void a_ready(const Unit& u) const { if (ready != nullptr && u.pm >= 32) hook_wait(ready, need, tmo); }
    __device__ __forceinline__ void done(const Unit&) const {}
};
struct ResidOrder {
    StaticOrder so; int G, c, nks, ntk, nsub, nmine, sub_last, nfull; const unsigned* ready; unsigned need; unsigned* tmo;
    __host__ __device__ __forceinline__ void init(int K, int nks_, int G_, int c_, int sub_last_ = 0, const unsigned* ready_ = nullptr, unsigned need_ = 0, unsigned* tmo_ = nullptr) {
        so.init(8192, 2048, K, G_, c_); G = G_; c = c_; nks = nks_; ntk = (K / BK) / nks; nsub = 16 * nks; nmine = c < nsub ? (nsub - c + G - 1) / G : 0;
        sub_last = sub_last_; ready = ready_; need = need_; tmo = tmo_; nfull = c < so.nwg ? (so.nwg - c + G - 1) / G : 0; }
    __host__ __device__ __forceinline__ bool sub(int i, Unit& u) const { if (i >= nmine) return false; const int s = c + i * G, su = s / nks, ks = s % nks; u.pm = 32 + (su >> 3); u.pn = su & 7; u.kt0 = ks * ntk; u.nt = ntk; u.slab = ks; u.qa = -1; u.qh = 0; return true; }
    __host__ __device__ __forceinline__ bool next(int i, Unit& u) const {
        if (sub_last) { if (i < nfull) return so.next(i, u); return sub(i - nfull, u); }
        if (i < nmine) return sub(i, u);
        return so.next(i - nmine, u);
    }
    __device__ __forceinline__ void a_ready(const Unit& u) const { if (ready != nullptr && u.slab >= 0) hook_wait(ready, need, tmo); }
    __device__ __forceinline__ void done(const Unit&) const {}
};
struct InUpOrder {
    StaticOrder so; int G, c, nmine;
#ifdef FIXMASK
    __host__ __device__ __forceinline__ void init(int K, int G_, int c_) { so.init(8704, 8192, K, G_, c_); G = G_; c = c_; nmine = c < 256 ? (256 - c + G - 1) / G : 0; }
#else
    __host__ __device__ __forceinline__ void init(int K, int G_, int c_) { so.init(8192, 8192, K, G_, c_); G = G_; c = c_; nmine = c < 256 ? (256 - c + G - 1) / G : 0; }
#endif
    __host__ __device__ __forceinline__ bool next(int i, Unit& u) const {
        if (i < nmine) { const int s = c + i * G, su = s >> 2, kq = s & 3; u.pm = 32 + (su >> 5); u.pn = su & 31; u.kt0 = kq * (so.ntk / 4); u.nt = so.ntk / 4; u.slab = kq; u.qa = -1; u.qh = 0; return true; }
        return so.next(i - nmine, u);
    }
    __device__ __forceinline__ void a_ready(const Unit&) const {}
    __device__ __forceinline__ void done(const Unit&) const {}
};
struct SameTileOrder : StaticOrder {
    __host__ __device__ __forceinline__ bool next(int i, Unit& u) const { const bool ok = StaticOrder::next(i, u); u.slab = u.pm * 64 + u.pn; u.pm = 0; u.pn = 0; return ok; }
};
struct QuarterOrder {
    int nN, G, c, ntk, nsub;
    __host__ __device__ __forceinline__ void init(int N, int K, int G_, int c_) { nN = N / BM; G = G_; c = c_; ntk = K / BK; nsub = 2 * nN * 4; }
    __host__ __device__ __forceinline__ bool next(int i, Unit& u) const {
        const int s = c + i * G; if (s >= nsub) return false;
        const int q = s / (2 * nN), t = s % (2 * nN);
        u.pm = 32 + t / nN; u.pn = t % nN; u.kt0 = 0; u.nt = ntk; u.slab = -1; u.qa = q >> 1; u.qh = q & 1; return true;
    }
    __device__ __forceinline__ void a_ready(const Unit&) const {}
    __device__ __forceinline__ void done(const Unit&) const {}
};

__device__ __forceinline__ unsigned cvt_pk_bf16(float lo, float hi) { unsigned r; asm volatile("v_cvt_pk_bf16_f32 %0, %1, %2" : "=v"(r) : "v"(lo), "v"(hi)); return r; }
__device__ __forceinline__ float fast_rcp(float x) { return __builtin_amdgcn_rcpf(x); }
__device__ __forceinline__ float silu_f(float x) { return x * fast_rcp(1.0f + __expf(-x)); }

__device__ __forceinline__ void store_slab_perm(float* slab2, const f32x4 (&acc)[2][2][4][2], const Unit& u, int wr, int wc, int fr, int fq) {
    float* sp = slab2 + ((size_t)u.slab * 512 + (u.pm * BM + wr * 64 + fr - 8192)) * 8192 + u.pn * BM + wc * 32 + 8 * fq;
#pragma unroll
    for (int ai = 0; ai < 2; ++ai)
#pragma unroll
        for (int m = 0; m < 4; ++m) { float* rowp = sp + (size_t)(ai * HALF + m * 16) * 8192;
#pragma unroll
            for (int bj = 0; bj < 2; ++bj) { *(f32x4*)(rowp + bj * HALF) = acc[ai][bj][m][0]; *(f32x4*)(rowp + bj * HALF + 4) = acc[ai][bj][m][1]; } }
}
struct EpiInProj {
    static constexpr bool PERM = true, AFTER_DRAIN = false;
    bf16_t* P; float* LF; const float* lb; const float* rc; const float* rs; float* slab2;
    const float* rss; const float* bias;
#ifdef PROBE_DUP_IN3
    int force_seg = -1;
#endif
    __device__ __forceinline__ void operator()(f32x4 (&acc)[2][2][4][2], const Unit& u, int wr, int wc, int fr, int fq) const {
        if (u.slab >= 0) { store_slab_perm(slab2, acc, u, wr, wc, fr, fq); return; }
        if ((rss != nullptr) && (u.pm < 32)) {
            const int cb = u.pn * BM + wc * 32 + 8 * fq;
#pragma unroll
            for (int ai = 0; ai < 2; ++ai)
#pragma unroll
                for (int m = 0; m < 4; ++m) {
                    const float r = __builtin_amdgcn_rsqf(rss[u.pm * BM + wr * 64 + fr + ai * HALF + m * 16] * (1.0f / 2048.0f) + 1e-6f);
#pragma unroll
                    for (int bj = 0; bj < 2; ++bj)
#pragma unroll
                        for (int n = 0; n < 2; ++n) acc[ai][bj][m][n] = acc[ai][bj][m][n] * r + *(const f32x4*)(bias + cb + bj * HALF + 4 * n);
                }
        }
#ifdef PROBE_DUP_IN3
        const int seg = force_seg >= 0 ? force_seg : (u.pn >> 2);
#else
        const int seg = u.pn >> 2;
#endif
        const int row0 = u.pm * BM + wr * 64 + fr;
        const int colg0 = u.pn * BM + wc * 32 + 8 * fq;
        if (seg == 4 || seg == 5) {
            const float ksc = (seg == 5) ? 0.0625f : 1.0f;
            const int j0 = wc * 32 + 8 * fq;
#pragma unroll
            for (int ai = 0; ai < 2; ++ai) {
                f32x4 tc0[4], tc1[4], ts0[4], ts1[4];
#pragma unroll
                for (int m = 0; m < 4; ++m) { const int pos = row_pos(row0 + ai * HALF + m * 16);
                    tc0[m] = *(const f32x4*)(rc + (size_t)pos * 128 + j0); tc1[m] = *(const f32x4*)(rc + (size_t)pos * 128 + j0 + 4);
                    ts0[m] = *(const f32x4*)(rs + (size_t)pos * 128 + j0); ts1[m] = *(const f32x4*)(rs + (size_t)pos * 128 + j0 + 4); }
#pragma unroll
                for (int m = 0; m < 4; ++m) {
                    const int row = row0 + ai * HALF + m * 16;
                    const f32x4 c0 = tc0[m], c1 = tc1[m], s0 = ts0[m], s1 = ts1[m];
                    const f32x4 x1a = acc[ai][0][m][0], x1b = acc[ai][0][m][1], x2a = acc[ai][1][m][0], x2b = acc[ai][1][m][1];
                    const f32x4 o1a = (x1a * c0 - x2a * s0) * ksc, o1b = (x1b * c1 - x2b * s1) * ksc;
                    const f32x4 o2a = (x2a * c0 + x1a * s0) * ksc, o2b = (x2b * c1 + x1b * s1) * ksc;
                    bf16_t* rowp = P + (size_t)row * 8192 + colg0;
                    u32x4 w; w.x = cvt_pk_bf16(o1a[0], o1a[1]); w.y = cvt_pk_bf16(o1a[2], o1a[3]); w.z = cvt_pk_bf16(o1b[0], o1b[1]); w.w = cvt_pk_bf16(o1b[2], o1b[3]);
                    *(u32x4*)(rowp) = w;
                    w.x = cvt_pk_bf16(o2a[0], o2a[1]); w.y = cvt_pk_bf16(o2a[2], o2a[3]); w.z = cvt_pk_bf16(o2b[0], o2b[1]); w.w = cvt_pk_bf16(o2b[2], o2b[3]);
                    *(u32x4*)(rowp + HALF) = w;
                }
            }
        } else if (seg == 1) {
#pragma unroll
            for (int bj = 0; bj < 2; ++bj)
#pragma unroll
                for (int n = 0; n < 2; ++n) {
                    const int cs = colg0 + bj * HALF - 1024 + 4 * n;
                    const f32x4 lbv = *(const f32x4*)(lb + cs);
#pragma unroll
                    for (int ai = 0; ai < 2; ++ai) {
                        f32x4 carry = (f32x4){0.f, 0.f, 0.f, 0.f};
#pragma unroll
                        for (int m = 0; m < 4; ++m) {
                            const int row = row0 + ai * HALF + m * 16;
                            f32x4 v, kk;
#pragma unroll
                            for (int e = 0; e < 4; ++e) {
                                const float l = lbv[e], oml = 1.0f - l;
                                const float ex = __builtin_amdgcn_exp2f(fminf(acc[ai][bj][m][n][e] * -1.44269504f, 115.0f)), sg = fast_rcp(1.0f + ex), sn = ex * sg;
                                v[e] = __builtin_amdgcn_logf(l + oml * sg) * 0.69314718f; kk[e] = oml * sn; }
                            u32x2 w; w.x = cvt_pk_bf16(kk[0], kk[1]); w.y = cvt_pk_bf16(kk[2], kk[3]);
                            *(u32x2*)(P + (size_t)row * 8192 + colg0 + bj * HALF + 4 * n) = w;
#pragma unroll
                            for (int e = 0; e < 4; ++e) {
                                float x = v[e];
                                x += __builtin_bit_cast(float, __builtin_amdgcn_update_dpp(0, __builtin_bit_cast(int, x), 0x111, 0xf, 0xf, true));
                                x += __builtin_bit_cast(float, __builtin_amdgcn_update_dpp(0, __builtin_bit_cast(int, x), 0x112, 0xf, 0xf, true));
                                x += __builtin_bit_cast(float, __builtin_amdgcn_update_dpp(0, __builtin_bit_cast(int, x), 0x114, 0xf, 0xf, true));
                                x += __builtin_bit_cast(float, __builtin_amdgcn_update_dpp(0, __builtin_bit_cast(int, x), 0x118, 0xf, 0xf, true));
                                x += carry[e];
                                v[e] = x;
                                carry[e] = __builtin_bit_cast(float, __builtin_amdgcn_update_dpp(0, __builtin_bit_cast(int, x), 0x15f, 0xf, 0xf, true));
                            }
                            *(f32x4*)(LF + (size_t)row * 1024 + cs) = v;
                        }
                    }
                }
        } else {
            const bool act = (seg == 0 || seg == 3 || seg == 7);
#pragma unroll
            for (int ai = 0; ai < 2; ++ai)
#pragma unroll
                for (int m = 0; m < 4; ++m) { if (u.qa >= 0 && (ai != u.qa || (m >> 1) != u.qh)) continue;
                    bf16_t* rowp = P + (size_t)(row0 + ai * HALF + m * 16) * 8192 + colg0;
#pragma unroll
                    for (int bj = 0; bj < 2; ++bj) { f32x4 v0 = acc[ai][bj][m][0], v1 = acc[ai][bj][m][1];
                        if (act) {
#pragma unroll
                            for (int e = 0; e < 4; ++e) { v0[e] = silu_f(v0[e]); v1[e] = silu_f(v1[e]); } }
                        u32x4 w; w.x = cvt_pk_bf16(v0[0], v0[1]); w.y = cvt_pk_bf16(v0[2], v0[3]); w.z = cvt_pk_bf16(v1[0], v1[1]); w.w = cvt_pk_bf16(v1[2], v1[3]);
                        *(u32x4*)(rowp + bj * HALF) = w; } }
        }
    }
};
struct EpiRelu2 {
    static constexpr bool PERM = true, AFTER_DRAIN = false;
    bf16_t* O; int ldc; float* slab2; const float* rss; const float* bias;
    __device__ __forceinline__ void operator()(const f32x4 (&acc)[2][2][4][2], const Unit& u, int wr, int wc, int fr, int fq) const {
        if (u.slab >= 0) { store_slab_perm(slab2, acc, u, wr, wc, fr, fq); return; }
        const int row0 = u.pm * BM + wr * 64 + fr, col0 = u.pn * BM + wc * 32 + 8 * fq;
        const bool fused = (rss != nullptr) && (u.pm < 32);
        f32x4 bv[2][2];
#pragma unroll
        for (int bj = 0; bj < 2; ++bj)
#pragma unroll
            for (int n = 0; n < 2; ++n) bv[bj][n] = fused ? *(const f32x4*)(bias + col0 + bj * HALF + 4 * n) : (f32x4){0.f, 0.f, 0.f, 0.f};
#pragma unroll
        for (int ai = 0; ai < 2; ++ai)
#pragma unroll
            for (int m = 0; m < 4; ++m) { if (u.qa >= 0 && (ai != u.qa || (m >> 1) != u.qh)) continue;
                bf16_t* rowp = O + (size_t)(row0 + ai * HALF + m * 16) * ldc + col0;
                float r = 1.0f; if (fused) r = __builtin_amdgcn_rsqf(rss[row0 + ai * HALF + m * 16] * (1.0f / 2048.0f) + 1e-6f);
#pragma unroll
                for (int bj = 0; bj < 2; ++bj) { f32x4 v0 = acc[ai][bj][m][0] * r + bv[bj][0], v1 = acc[ai][bj][m][1] * r + bv[bj][1];
#pragma unroll
                    for (int e = 0; e < 4; ++e) { const float a = fmaxf(v0[e], 0.f), b = fmaxf(v1[e], 0.f); v0[e] = a * a; v1[e] = b * b; }
                    u32x4 w; w.x = cvt_pk_bf16(v0[0], v0[1]); w.y = cvt_pk_bf16(v0[2], v0[3]); w.z = cvt_pk_bf16(v1[0], v1[1]); w.w = cvt_pk_bf16(v1[2], v1[3]);
#ifdef NT_U_STORE
                    __builtin_nontemporal_store(w, (u32x4*)(rowp + bj * HALF)); } }
#else
                    *(u32x4*)(rowp + bj * HALF) = w; } }
#endif
    }
};
struct EpiResid {
    static constexpr bool PERM = false, AFTER_DRAIN = false;
    half_t* X; const float* gate; float* slab;
    const float* Xin32;
    bf16_t* XS; const float* acol; float* rss;
    __device__ __forceinline__ void operator()(const f32x4 (&acc)[2][2][4][2], const Unit& u, int wr, int wc, int fr, int fq) const {
        const int row0 = u.pm * BM + wr * 64 + fr, col0 = u.pn * BM + wc * 32 + 4 * fq;
        if (u.slab >= 0) {
            half_t* sp = (half_t*)slab + ((size_t)u.slab * 512 + (row0 - 8192)) * 2048 + col0;
#pragma unroll
            for (int ai = 0; ai < 2; ++ai)
#pragma unroll
                for (int m = 0; m < 4; ++m) { half_t* rowp = sp + (size_t)(ai * HALF + m * 16) * 2048;
#pragma unroll
                    for (int bj = 0; bj < 2; ++bj)
#pragma unroll
                        for (int n = 0; n < 2; ++n) stx4(rowp + bj * HALF + n * 16, acc[ai][bj][m][n]); }
            return;
        }
        f32x4 gv[2][2];
#pragma unroll
        for (int bj = 0; bj < 2; ++bj)
#pragma unroll
            for (int n = 0; n < 2; ++n) gv[bj][n] = *(const f32x4*)(gate + col0 + bj * HALF + n * 16);
        if (Xin32 == nullptr && XS == nullptr) {
#pragma unroll
            for (int ai = 0; ai < 2; ++ai) {
                half4 xh[4][2][2];
#pragma unroll
                for (int m = 0; m < 4; ++m)
#pragma unroll
                    for (int bj = 0; bj < 2; ++bj)
#pragma unroll
                        for (int n = 0; n < 2; ++n) xh[m][bj][n] = *(const half4*)(X + (size_t)(row0 + ai * HALF + m * 16) * 2048 + col0 + bj * HALF + n * 16);
#pragma unroll
                for (int m = 0; m < 4; ++m)
#pragma unroll
                    for (int bj = 0; bj < 2; ++bj)
#pragma unroll
                        for (int n = 0; n < 2; ++n) { const f32x4 xn = __builtin_convertvector(xh[m][bj][n], f32x4) + gv[bj][n] * acc[ai][bj][m][n]; stx4(X + (size_t)(row0 + ai * HALF + m * 16) * 2048 + col0 + bj * HALF + n * 16, xn); }
                asm volatile("" ::: "memory");
            }
            return;
        }
#pragma unroll
        for (int ai = 0; ai < 2; ++ai)
#pragma unroll
            for (int m = 0; m < 4; ++m) { const int row = row0 + ai * HALF + m * 16; half_t* rowp = X + (size_t)row * 2048 + col0; const XSrc xs{Xin32, X}; const size_t eo = (size_t)row * 2048 + col0; float ssq = 0.f;
#pragma unroll
                for (int bj = 0; bj < 2; ++bj)
#pragma unroll
                    for (int n = 0; n < 2; ++n) { const f32x4 xv = ldx4(xs, eo + bj * HALF + n * 16); const f32x4 xn = xv + gv[bj][n] * acc[ai][bj][m][n]; stx4(rowp + bj * HALF + n * 16, xn);
                        if (XS != nullptr) { ssq += (xn[0] * xn[0] + xn[1] * xn[1]) + (xn[2] * xn[2] + xn[3] * xn[3]); const f32x4 av = *(const f32x4*)(acol + col0 + bj * HALF + n * 16); const f32x4 hs = xn * av;
                            u32x2 w; w.x = cvt_pk_bf16(hs[0], hs[1]); w.y = cvt_pk_bf16(hs[2], hs[3]); *(u32x2*)(XS + (size_t)row * 2048 + col0 + bj * HALF + n * 16) = w; } }
                if (XS != nullptr) { ssq += __shfl_xor(ssq, 16); ssq += __shfl_xor(ssq, 32); if (fq == 0) __hip_atomic_fetch_add(rss + row, ssq, __ATOMIC_RELAXED, __HIP_MEMORY_SCOPE_AGENT); }
                asm volatile("" ::: "memory"); }
    }
};
struct EpiProbe {
    static constexpr bool PERM = true, AFTER_DRAIN = false;
    bf16_t* O; int ldc;
    __device__ __forceinline__ void operator()(const f32x4 (&acc)[2][2][4][2], const Unit& u, int wr, int wc, int fr, int fq) const {
        Unit t = u; t.pm = u.slab >> 6; t.pn = u.slab & 63; t.qa = -1;
        t.slab = -1; EpiRelu2 e{O, ldc, nullptr, nullptr, nullptr}; e(acc, t, wr, wc, fr, fq);
    }
};
template <class Epi, class Sched, bool ALIGN_EPI = false, bool SP2 = false, int QM = 0>
__device__ __forceinline__ void gemm_phase(PG8_LAS unsigned char* lds, const Gemm g, const Sched& S, const Epi& E) {
    int tid_l = threadIdx.x; asm volatile("" : "+v"(tid_l));
    const int tid = tid_l, wid = __builtin_amdgcn_readfirstlane(tid >> 6), lane = tid & 63, wr = wid >> 2, wc = wid & 3, fr = lane & 15, fq = lane >> 4;
    const int K = g.K;
    unsigned voffA[2], voffB[2];
#pragma unroll
    for (int i = 0; i < 2; ++i) { int R, C; stage_rc(tid * 16 + i * 8192, R, C); const int Rb = Epi::PERM ? ((R & ~31) + perm32(R & 31)) : R;
        voffA[i] = (unsigned)(R * K + C) * 2u; voffB[i] = (unsigned)(Rb * K + C) * 2u; }
    const size_t kstep = (size_t)(BK * 2);
    const size_t hstep = (size_t)HALF * K * 2;
    const size_t tstep = 2 * hstep;
    const unsigned ldsw = (unsigned)wid * 1024u;
    const int aoff = lds_byte(wr * 64 + fr, fq * 8), boff = lds_byte(wc * 32 + fr, fq * 8);
#define PG8_SA(b, h) (((b) * 2 + (h)) * HTB)
#define PG8_SB(b, h) ((4 + (b) * 2 + (h)) * HTB)
#define PG8_STAGE(bufoff, gbase, voff) do { _Pragma("unroll") for (int _i = 0; _i < 2; ++_i) \
        __builtin_amdgcn_global_load_lds((const unsigned*)((const char*)(gbase) + (voff)[_i]), (PG8_LAS unsigned*)(lds + (bufoff) + ldsw + _i * 8192), 16, 0, 0); } while (0)
#define PG8_LDA(dst, b, h) do { if (!QM || (h) == q_a) { _Pragma("unroll") for (int m = 0; m < 4; ++m) _Pragma("unroll") for (int k = 0; k < 2; ++k) dst[m][k] = *(const PG8_LAS bf16x8*)(lds + PG8_SA(b, h) + aoff + m * 2048 + k * 1024); } } while (0)
#define PG8_LDB(dst, b, h) do { _Pragma("unroll") for (int n = 0; n < 2; ++n) _Pragma("unroll") for (int k = 0; k < 2; ++k) dst[n][k] = *(const PG8_LAS bf16x8*)(lds + PG8_SB(b, h) + boff + n * 2048 + k * 1024); } while (0)
#define PG8_MMA(ai, bj, At, Bt) do { if (!QM || (ai) == q_a) { __builtin_amdgcn_s_setprio(1); _Pragma("unroll") for (int m = 0; m < 4; ++m) { if (!QM || (m >> 1) == q_h) { _Pragma("unroll") for (int n = 0; n < 2; ++n) _Pragma("unroll") for (int k = 0; k < 2; ++k) \
        acc[ai][bj][m][n] = __builtin_amdgcn_mfma_f32_16x16x32_bf16(Bt[n][k], At[m][k], acc[ai][bj][m][n], 0, 0, 0); } } __builtin_amdgcn_s_setprio(0); } } while (0)
#define PG8_WAIT_V(n) asm volatile("s_waitcnt vmcnt(" #n ")" ::: "memory")
#define PG8_WAIT_L(n) asm volatile("s_waitcnt lgkmcnt(" #n ")" ::: "memory")
#define PG8_BAR __builtin_amdgcn_s_barrier()
#define PG8_SCHED __builtin_amdgcn_sched_barrier(0)
    Unit cur, nxt; int ui = 0;
    if (!S.next(0, cur)) return;
    int q_a = cur.qa, q_h = cur.qh; (void)q_a; (void)q_h;
    f32x4 acc[2][2][4][2];
#pragma unroll
    for (int a = 0; a < 2; ++a)
#pragma unroll
        for (int b = 0; b < 2; ++b)
#pragma unroll
            for (int m = 0; m < 4; ++m)
#pragma unroll
                for (int n = 0; n < 2; ++n) acc[a][b][m][n] = (f32x4){0.f, 0.f, 0.f, 0.f};
    bf16x8 At[4][2], B0[2][2], B1[2][2];
    const char* cA = (const char*)g.A + (size_t)cur.pm * tstep + (size_t)cur.kt0 * kstep; const char* cB = (const char*)g.Bt + (size_t)cur.pn * tstep + (size_t)cur.kt0 * kstep;
    S.a_ready(cur);
    if constexpr (SP2) {
        PG8_STAGE(PG8_SB(0, 0), cB, voffB); PG8_STAGE(PG8_SB(0, 1), cB + hstep, voffB); PG8_STAGE(PG8_SA(0, 0), cA, voffA); PG8_STAGE(PG8_SA(0, 1), cA + hstep, voffA);
        if (wr == 1) PG8_BAR;
        PG8_WAIT_V(2); PG8_BAR;
        PG8_STAGE(PG8_SB(1, 0), cB + kstep, voffB); PG8_STAGE(PG8_SA(1, 0), cA + kstep, voffA); PG8_STAGE(PG8_SB(1, 1), cB + hstep + kstep, voffB);
        PG8_WAIT_V(6); PG8_BAR;
    } else {
        PG8_STAGE(PG8_SB(0, 0), cB, voffB); PG8_STAGE(PG8_SA(0, 0), cA, voffA); PG8_STAGE(PG8_SB(0, 1), cB + hstep, voffB); PG8_STAGE(PG8_SA(0, 1), cA + hstep, voffA);
        if (wr == 1) PG8_BAR;
        PG8_WAIT_V(4); PG8_BAR;
        PG8_STAGE(PG8_SB(1, 0), cB + kstep, voffB); PG8_STAGE(PG8_SA(1, 0), cA + kstep, voffA); PG8_STAGE(PG8_SB(1, 1), cB + hstep + kstep, voffB);
        PG8_WAIT_V(6); PG8_BAR;
    }
    for (;;) {
        const bool has_next = S.next(ui + 1, nxt);
        const char* nA = has_next ? (const char*)g.A + (size_t)nxt.pm * tstep + (size_t)nxt.kt0 * kstep : cA; const char* nB = has_next ? (const char*)g.Bt + (size_t)nxt.pn * tstep + (size_t)nxt.kt0 * kstep : cB;
        const int nt = cur.nt;
        for (int t = 0; t < nt; t += 2) {
            const bool last = (t == nt - 2);
            const char* a1 = cA + (size_t)(t + 1) * kstep;
            const char* a2 = last ? nA : cA + (size_t)(t + 2) * kstep; const char* b2 = last ? nB : cB + (size_t)(t + 2) * kstep;
            const char* a3 = a2 + kstep; const char* b3 = b2 + kstep;
            if (last && has_next) S.a_ready(nxt);
            if constexpr (SP2) {
            PG8_LDB(B0, 0, 0); PG8_LDB(B1, 0, 1); PG8_SCHED; PG8_LDA(At, 0, 0); PG8_STAGE(PG8_SA(1, 1), a1 + hstep, voffA);
            PG8_WAIT_V(8); PG8_WAIT_L(0); PG8_BAR; PG8_MMA(0, 0, At, B0); PG8_MMA(0, 1, At, B1); PG8_BAR; PG8_SCHED;
            PG8_LDA(At, 0, 1); PG8_STAGE(PG8_SB(0, 0), b2, voffB); PG8_STAGE(PG8_SB(0, 1), b2 + hstep, voffB); PG8_STAGE(PG8_SA(0, 0), a2, voffA);
            PG8_WAIT_V(8); PG8_WAIT_L(0); PG8_BAR; PG8_MMA(1, 0, At, B0); PG8_MMA(1, 1, At, B1); PG8_BAR; PG8_SCHED;
            PG8_LDB(B0, 1, 0); PG8_LDB(B1, 1, 1); PG8_SCHED; PG8_LDA(At, 1, 0); PG8_STAGE(PG8_SA(0, 1), a2 + hstep, voffA);
            PG8_WAIT_V(8); PG8_WAIT_L(0); PG8_BAR; PG8_MMA(0, 0, At, B0); PG8_MMA(0, 1, At, B1); PG8_BAR; PG8_SCHED;
            PG8_LDA(At, 1, 1); PG8_STAGE(PG8_SB(1, 0), b3, voffB); PG8_STAGE(PG8_SB(1, 1), b3 + hstep, voffB); PG8_STAGE(PG8_SA(1, 0), a3, voffA);
            PG8_WAIT_V(8); PG8_WAIT_L(0); PG8_BAR; PG8_MMA(1, 0, At, B0); PG8_MMA(1, 1, At, B1); PG8_BAR; PG8_SCHED;
            } else {
            PG8_LDB(B0, 0, 0); PG8_SCHED; PG8_LDA(At, 0, 0); PG8_STAGE(PG8_SA(1, 1), a1 + hstep, voffA);
            PG8_WAIT_L(8); PG8_BAR; PG8_WAIT_L(0); PG8_MMA(0, 0, At, B0); PG8_BAR; PG8_SCHED;
            PG8_LDB(B1, 0, 1); PG8_STAGE(PG8_SB(0, 0), b2, voffB);
            PG8_BAR; PG8_WAIT_L(0); PG8_MMA(0, 1, At, B1); PG8_BAR;
            PG8_LDA(At, 0, 1); PG8_STAGE(PG8_SA(0, 0), a2, voffA);
            PG8_BAR; PG8_WAIT_L(0); PG8_MMA(1, 0, At, B0); PG8_BAR; PG8_SCHED;
            PG8_STAGE(PG8_SB(0, 1), b2 + hstep, voffB);
            PG8_WAIT_V(6); PG8_BAR; PG8_MMA(1, 1, At, B1); PG8_BAR;
            PG8_LDB(B0, 1, 0); PG8_SCHED; PG8_LDA(At, 1, 0); PG8_STAGE(PG8_SA(0, 1), a2 + hstep, voffA);
            PG8_WAIT_L(8); PG8_BAR; PG8_WAIT_L(0); PG8_MMA(0, 0, At, B0); PG8_BAR; PG8_SCHED;
            PG8_LDB(B1, 1, 1); PG8_STAGE(PG8_SB(1, 0), b3, voffB);
            PG8_BAR; PG8_WAIT_L(0); PG8_MMA(0, 1, At, B1); PG8_BAR;
            PG8_LDA(At, 1, 1); PG8_STAGE(PG8_SA(1, 0), a3, voffA);
            PG8_BAR; PG8_WAIT_L(0); PG8_MMA(1, 0, At, B0); PG8_BAR; PG8_SCHED;
            PG8_STAGE(PG8_SB(1, 1), b3 + hstep, voffB);
            PG8_WAIT_V(6); PG8_BAR; PG8_MMA(1, 1, At, B1); PG8_BAR;
            }
        }
        if constexpr (ALIGN_EPI) { if (wr == 0) PG8_BAR; }
        if constexpr (!Epi::AFTER_DRAIN) { E(acc, cur, wr, wc, fr, fq); S.done(cur); }
        if (!has_next) break;
#pragma unroll
        for (int a = 0; a < 2; ++a)
#pragma unroll
            for (int b = 0; b < 2; ++b)
#pragma unroll
                for (int m = 0; m < 4; ++m)
#pragma unroll
                    for (int n = 0; n < 2; ++n) acc[a][b][m][n] = (f32x4){0.f, 0.f, 0.f, 0.f};
        cur = nxt; cA = nA; cB = nB; ++ui; q_a = cur.qa; q_h = cur.qh;
        if constexpr (ALIGN_EPI) { if (wr == 1) PG8_BAR; }
    }
    PG8_WAIT_V(0);
    if constexpr (!ALIGN_EPI) { if (wr == 0) PG8_BAR; }
    PG8_BAR;
    if constexpr (Epi::AFTER_DRAIN) { E.fused(acc, cur, wr, wc, fr, fq, lds, wid, lane); S.done(cur); }
#undef PG8_SA
#undef PG8_SB
#undef PG8_STAGE
#undef PG8_LDA
#undef PG8_LDB
#undef PG8_MMA
#undef PG8_WAIT_V
#undef PG8_WAIT_L
#undef PG8_BAR
#undef PG8_SCHED
}
}
constexpr int NWAVES = 8;
constexpr int DM = 2048, SEQ = 8192, DEPTH = 4, DECB = 8, DECS = 64, M = SEQ + DECB * DECS, NPROJ = 8192, DFF = 8192, NSEQ = 9, NMOD = 6 * DM;
constexpr int HA = 8, HB = 4;
constexpr float EPS = 1e-6f;
constexpr size_t OFF_SA_P = (size_t)M * DM, OFF_SB_P = OFF_SA_P + (size_t)DEPTH * HA * 128 * 128, OFF_SA_S = OFF_SB_P + (size_t)DEPTH * HB * 256 * 256,
                 OFF_SB_S = OFF_SA_S + (size_t)DEPTH * DECB * HA * 128 * 128, OUT_TOTAL = OFF_SB_S + (size_t)DEPTH * DECB * HB * 256 * 256;

constexpr size_t MiB = 1u << 20;
constexpr size_t WS_CTL = 0, CTL_ZERO_BYTES = 1 * MiB;
constexpr size_t WS_WIN = 2 * MiB;
constexpr size_t WS_WOUT = WS_WIN + 128 * MiB;
constexpr size_t WS_WUP = WS_WOUT + 32 * MiB;
constexpr size_t WS_WDN = WS_WUP + 128 * MiB;
constexpr size_t WS_X = WS_WDN + 128 * MiB;
constexpr size_t WS_H = WS_X + 68 * MiB;
constexpr size_t WS_P = WS_H + 34 * MiB;
constexpr size_t WS_LF = WS_P + 136 * MiB;
constexpr size_t WS_O = WS_LF + 34 * MiB;
constexpr size_t WS_U = WS_O + 34 * MiB;
constexpr size_t WS_MOD = WS_U + 136 * MiB;
constexpr size_t WS_LB = WS_MOD + 2 * MiB;
constexpr size_t WS_ROPE = WS_LB + 1 * MiB;
constexpr size_t WS_SLAB = WS_ROPE + 8 * MiB;
constexpr size_t WS_SLAB2 = WS_SLAB + 64 * MiB;
constexpr size_t WS_ACOL = WS_SLAB2 + 64 * MiB;
constexpr size_t WS_END = WS_ACOL + 1 * MiB;
constexpr int CW_Q0 = 64;
constexpr int CW_TMO = 0;
constexpr int CW_FIX = 1024;
constexpr int CW_BAR = 4096;
constexpr int CW_XRANK = 3072;
constexpr int CW_SMP = 2048;
constexpr int CW_RSS = 65536;
constexpr int CW_BIAS = CW_RSS + 8 * 8192;

constexpr int RING_OFF = 0, RING_BYTES = 131072;
constexpr int LDS_BYTES = 151552;
constexpr int MISC_OFF = 147456;

#define GAS __attribute__((address_space(1)))
#define LAS __attribute__((address_space(3)))
typedef unsigned short bf16;
typedef unsigned v4u __attribute__((ext_vector_type(4)));
typedef unsigned v2u __attribute__((ext_vector_type(2)));
typedef float f32x4 __attribute__((ext_vector_type(4)));
typedef short bf16x8 __attribute__((ext_vector_type(8)));
#define LDS_WAIT() asm volatile("s_waitcnt lgkmcnt(0)" ::: "memory")
#define VM_WAIT() asm volatile("s_waitcnt vmcnt(0)" ::: "memory")
__device__ __forceinline__ unsigned f2bf(float f) { unsigned u = __builtin_bit_cast(unsigned, f); return (u + 0x7fffu + ((u >> 16) & 1u)) >> 16; }
__device__ __forceinline__ unsigned pk2(float lo, float hi) { return pg8::cvt_pk_bf16(lo, hi); }
__device__ __forceinline__ float bf2f(unsigned short b) { return __builtin_bit_cast(float, ((unsigned)b) << 16); }
__device__ __forceinline__ float bflo(unsigned w) { return __builtin_bit_cast(float, w << 16); }
__device__ __forceinline__ float bfhi(unsigned w) { return __builtin_bit_cast(float, w & 0xffff0000u); }

#define XB_TMO      128
#define XB_XCNT(j)  (256  + 64 * (j))
#define XB_XSUB(j)  (1280 + 64 * (j))
#define XB_XGEN(j)  (2304 + 64 * (j))
#define XB_TOP      3328
#define XB_TOPGEN   3392
#define XCD_BAR_WORDS 3456
#define XB_SPIN_CAP (1u << 20)
__device__ __forceinline__ unsigned xb_ld(unsigned* p)              { return __hip_atomic_load(p, __ATOMIC_RELAXED, __HIP_MEMORY_SCOPE_AGENT); }
__device__ __forceinline__ unsigned xb_add(unsigned* p, unsigned v) { return __hip_atomic_fetch_add(p, v, __ATOMIC_RELAXED, __HIP_MEMORY_SCOPE_AGENT); }
__device__ __forceinline__ unsigned xb_xcc_id() { return (unsigned)__builtin_amdgcn_s_getreg((3 << 11) | 20) & 0xFu; }
#define XB_SPIN(cond, bar) do { unsigned _sp = 0; while (cond) { __builtin_amdgcn_s_sleep(1); \
    if ((++_sp & 255u) == 0u) { if (xb_ld(&(bar)[XB_TMO])) break; if (_sp > XB_SPIN_CAP) { atomicAdd(&(bar)[XB_TMO], 1u); break; } } } } while (0)
struct XcdBarrier { unsigned* bar; unsigned x; volatile LAS unsigned* st; };
__device__ __forceinline__ XcdBarrier xcd_barrier_post(unsigned* bar, volatile LAS unsigned* st) {
    XcdBarrier b; b.bar = bar; b.x = xb_xcc_id(); b.st = st;
    if (threadIdx.x == 0) (void)xb_add(&bar[XB_XCNT(b.x)], 1u);
    return b;
}
__device__ __forceinline__ void xcd_barrier_complete(unsigned* bar, unsigned x, unsigned& nloc, unsigned& nx) {
    const unsigned G = gridDim.x * gridDim.y * gridDim.z;
    unsigned sum, cnt, mine, sp = 0u;
    for (;;) {
        sum = 0u; cnt = 0u; mine = 0u;
#pragma unroll
        for (unsigned j = 0; j < 16; ++j) { const unsigned c = xb_ld(&bar[XB_XCNT(j)]); sum += c; cnt += (c > 0u) ? 1u : 0u; mine = (j == x) ? c : mine; }
        if (sum == G) break;
        __builtin_amdgcn_s_sleep(1);
        if ((++sp & 255u) == 0u) { if (xb_ld(&bar[XB_TMO])) break; if (sp > XB_SPIN_CAP) { atomicAdd(&bar[XB_TMO], 1u); break; } }
    }
    nloc = mine > 0u ? mine : 1u; nx = cnt > 0u ? cnt : 1u;
}
__device__ __forceinline__ void xcd_barrier(const XcdBarrier& b) {
    asm volatile("s_waitcnt vmcnt(0)" ::: "memory");
    __syncthreads();
    if (threadIdx.x == 0) {
        unsigned* bar = b.bar;
        __builtin_amdgcn_s_waitcnt(0);
        unsigned nloc = b.st[0], nx = b.st[1];
        if (nloc == 0u) { xcd_barrier_complete(bar, b.x, nloc, nx); b.st[0] = nloc; b.st[1] = nx; }
        const unsigned old = xb_add(&bar[XB_XSUB(b.x)], 1u);
        const unsigned gen = old / nloc;
        if (old + 1u == (gen + 1u) * nloc) {
            __builtin_amdgcn_fence(__ATOMIC_RELEASE, "agent");
            asm volatile("s_waitcnt vmcnt(0)" ::: "memory");
            const unsigned og = xb_add(&bar[XB_TOP], 1u);
            const unsigned tg = og / nx;
            if (og + 1u == (tg + 1u) * nx) xb_add(&bar[XB_TOPGEN], 1u);
            else XB_SPIN(xb_ld(&bar[XB_TOPGEN]) == tg, bar);
            __builtin_amdgcn_fence(__ATOMIC_ACQUIRE, "agent");
            xb_add(&bar[XB_XGEN(b.x)], 1u);
            asm volatile("s_waitcnt vmcnt(0)" ::: "memory");
        } else {
            XB_SPIN(xb_ld(&bar[XB_XGEN(b.x)]) == gen, bar);
            __builtin_amdgcn_fence(__ATOMIC_ACQUIRE, "agent");
            asm volatile("s_waitcnt vmcnt(0)" ::: "memory");
        }
    }
    __syncthreads();
}

struct Frame {
    LAS unsigned char* lds;
    unsigned* ctl;
    unsigned char* ws;
    int G, wg;
    const float *x_prompt, *x_sample, *state_hgrn, *state_ret, *c_prompt, *c_sample, *lb_logits, *w_ada, *b_ada, *norm1_g, *norm2_g, *w_in, *hgrn_g, *ret_g, *w_out, *w_up, *w_down, *final_g;
    float* out;
    bf16 *Win_t, *Wout_t, *Wup_t, *Wdn_t, *H, *P, *O, *U;
    half_t* X;
    float *LF, *MOD, *LB, *RC, *RS;
};

__device__ __forceinline__ int ltid() { int t = threadIdx.x; asm volatile("" : "+v"(t)); return t; }
#define PHASE_IDS() const int tid = ltid(), lane = tid & 63, wave = __builtin_amdgcn_readfirstlane(tid >> 6); (void)lane; (void)wave
__device__ __forceinline__ float wave_sum(float v) {
#pragma unroll
    for (int o = 1; o < 64; o <<= 1) v += __shfl_xor(v, o);
    return v;
}
struct CvItem { const float* W; bf16* WT; const float* sh; float* bias; int K, N, k0, n0; };
#define CV_LOAD(v, I) do { _Pragma("unroll") for (int i_ = 0; i_ < 16; ++i_) v[i_] = __builtin_nontemporal_load((const f32x4*)((I).W + (size_t)((I).k0 + 4 * i_ + (lane >> 4)) * (I).N + (I).n0 + 4 * (lane & 15))); } while (0)
__device__ __forceinline__ void cv_process(const f32x4 (&v)[16], const CvItem& I, LAS float* scr, int lane) {
    const int r4 = lane >> 4, c16 = lane & 15;
    if (I.sh != nullptr) {
        f32x4 p = (f32x4){0.f, 0.f, 0.f, 0.f};
#pragma unroll
        for (int i = 0; i < 16; ++i) p += v[i] * I.sh[I.k0 + 4 * i + r4];
#pragma unroll
        for (int e = 0; e < 4; ++e) { float q = p[e]; q += __shfl_xor(q, 16); q += __shfl_xor(q, 32); if (r4 == 0) __hip_atomic_fetch_add(I.bias + I.n0 + 4 * c16 + e, q, __ATOMIC_RELAXED, __HIP_MEMORY_SCOPE_AGENT); }
    }
#pragma unroll
    for (int i = 0; i < 16; ++i) *(LAS f32x4*)(scr + (4 * i + r4) * 68 + 4 * c16) = v[i];
    LDS_WAIT(); asm volatile("" ::: "memory");
    const int c = lane & 7;
#pragma unroll
    for (int j = 0; j < 8; ++j) { const int n = (lane >> 3) + 8 * j; const LAS float* s = scr + (8 * c) * 68 + n;
        v4u o; o.x = pk2(s[0 * 68], s[1 * 68]); o.y = pk2(s[2 * 68], s[3 * 68]); o.z = pk2(s[4 * 68], s[5 * 68]); o.w = pk2(s[6 * 68], s[7 * 68]);
        __builtin_nontemporal_store(o, (v4u*)(I.WT + (size_t)(I.n0 + n) * I.K + I.k0 + 8 * c)); }
    LDS_WAIT(); asm volatile("" ::: "memory");
}
#ifndef CONV_PRO
#define CONV_PRO 1
#endif
#ifndef NGEMM
#define NGEMM 224
#endif
#ifndef FUSE_FROM
#define FUSE_FROM 1
#endif
#ifndef CV_SPLIT_PCT
#define CV_SPLIT_PCT 52
#endif
constexpr int CV_IN = (DM / 64) * (NPROJ / 64), CV_OUT = (DM / 64) * (DM / 64), CV_UP = (DM / 64) * (DFF / 64), CV_DN = (DFF / 64) * (DM / 64), CV_LAYER = CV_IN + CV_OUT + CV_UP + CV_DN, CV_SPLIT = ((CV_IN + CV_OUT + CV_UP + CV_DN) * CV_SPLIT_PCT / 100) & ~7;
__device__ __forceinline__ CvItem cv_item(Frame& F, int l, int it) {
    CvItem I; int r = it;
    const float* shp = (l >= FUSE_FROM && F.G > NGEMM) ? F.MOD + (size_t)l * NMOD : nullptr; float* bp = (float*)(F.ctl + CW_BIAS) + (size_t)l * 2 * 8192;
    I.sh = nullptr; I.bias = bp;
    if (r < CV_IN) { I.W = F.w_in + (size_t)l * DM * NPROJ; I.K = DM; I.N = NPROJ; I.WT = F.Win_t + (size_t)l * NPROJ * DM; I.sh = shp; }
    else if ((r -= CV_IN) < CV_OUT) { I.W = F.w_out + (size_t)l * DM * DM; I.K = DM; I.N = DM; I.WT = F.Wout_t + (size_t)l * DM * DM; }
    else if ((r -= CV_OUT) < CV_UP) { I.W = F.w_up + (size_t)l * DM * DFF; I.K = DM; I.N = DFF; I.WT = F.Wup_t + (size_t)l * DFF * DM; I.sh = shp ? shp + 3 * DM : nullptr; I.bias = bp + 8192; }
    else { r -= CV_UP; I.W = F.w_down + (size_t)l * DFF * DM; I.K = DFF; I.N = DM; I.WT = F.Wdn_t + (size_t)l * DM * DFF; }
    const int nblk = I.N / 64; I.k0 = 64 * (r / nblk); I.n0 = 64 * (r % nblk);
    return I;
}
__device__ __forceinline__ void convert_layer(Frame& F, int l, int wave, int lane, int it_lo = 0, int it_hi = CV_LAYER, int qword = 0) {
    LAS float* scr = (LAS float*)(F.lds + wave * 17408);
    int cur = 0, end = 0;
#define CV_NEXT(id) do { if (cur >= end) { int b_ = 0; if (lane == 0) b_ = (int)atomicAdd(F.ctl + CW_Q0 + 64 * (l + 1) + qword, 8u); cur = it_lo + __builtin_amdgcn_readfirstlane(b_); end = cur + 8; } id = cur < it_hi ? cur : -1; ++cur; } while (0)
    f32x4 va[16], vb[16]; CvItem Ia, Ib; int ia, ib;
    CV_NEXT(ia); if (ia < 0) return;
    Ia = cv_item(F, l, ia); CV_LOAD(va, Ia);
    for (;;) {
        CV_NEXT(ib); if (ib >= 0) { Ib = cv_item(F, l, ib); CV_LOAD(vb, Ib); }
        cv_process(va, Ia, scr, lane);
        if (ib < 0) break;
        CV_NEXT(ia); if (ia >= 0) { Ia = cv_item(F, l, ia); CV_LOAD(va, Ia); }
        cv_process(vb, Ib, scr, lane);
        if (ia < 0) break;
    }
#undef CV_NEXT
}
__device__ __forceinline__ void p0_mod_task(Frame& F, int task) {
    PHASE_IDS();
    const int l = task / 48, cb = task % 48;
    LAS float* cact = (LAS float*)(F.lds);
    LAS float* red = (LAS float*)(F.lds + 73728);
    for (int i = tid; i < NSEQ * DM; i += NWAVES * 64) { const int b = i / DM, k = i % DM; const float c = (b == 0) ? F.c_prompt[k] : F.c_sample[(b - 1) * DM + k]; cact[i] = c / (1.0f + __expf(-c)); }
    __syncthreads();
    const float* W = F.w_ada + (size_t)l * DM * NMOD + cb * 256 + 4 * lane;
    f32x4 acc[NSEQ];
#pragma unroll
    for (int b = 0; b < NSEQ; ++b) acc[b] = (f32x4){0.f, 0.f, 0.f, 0.f};
    const int kbeg = wave * 256;
#pragma unroll 4
    for (int k0 = kbeg; k0 < kbeg + 256; k0 += 4) {
        const f32x4 w0 = __builtin_nontemporal_load((const f32x4*)(W + (size_t)(k0 + 0) * NMOD)), w1 = __builtin_nontemporal_load((const f32x4*)(W + (size_t)(k0 + 1) * NMOD)), w2 = __builtin_nontemporal_load((const f32x4*)(W + (size_t)(k0 + 2) * NMOD)), w3 = __builtin_nontemporal_load((const f32x4*)(W + (size_t)(k0 + 3) * NMOD));
#pragma unroll
        for (int b = 0; b < NSEQ; ++b) { const f32x4 c = *(const LAS f32x4*)(cact + b * DM + k0); acc[b] += w0 * c.x + w1 * c.y + w2 * c.z + w3 * c.w; }
    }
#pragma unroll
    for (int b = 0; b < NSEQ; ++b) *(LAS f32x4*)(red + (wave * NSEQ + b) * 256 + 4 * lane) = acc[b];
    __syncthreads();
    for (int o = tid; o < NSEQ * 256; o += NWAVES * 64) { const int b = o / 256, c = o % 256; float s = 0.f;
#pragma unroll
        for (int w = 0; w < 8; ++w) s += red[(w * NSEQ + b) * 256 + c];
        F.MOD[(size_t)(b * DEPTH + l) * NMOD + cb * 256 + c] = s + F.b_ada[(size_t)l * NMOD + cb * 256 + c]; }
    __syncthreads();
}
__device__ __forceinline__ void sincos_acc(float angf, float& sn, float& cs) {
    const double a = (double)angf;
    const double q = __builtin_rint(a * 0.63661977236758134308);
    double r = __builtin_fma(-q, 1.57079632679489655800, a); r = __builtin_fma(-q, 6.12323399573676603587e-17, r);
    const double r2 = r * r;
    double sp = 1.0 / 6227020800.0; sp = sp * r2 - 1.0 / 39916800.0; sp = sp * r2 + 1.0 / 362880.0; sp = sp * r2 - 1.0 / 5040.0; sp = sp * r2 + 1.0 / 120.0; sp = sp * r2 - 1.0 / 6.0; sp = sp * r2 * r + r;
    double cp = 1.0 / 479001600.0; cp = cp * r2 - 1.0 / 3628800.0; cp = cp * r2 + 1.0 / 40320.0; cp = cp * r2 - 1.0 / 720.0; cp = cp * r2 + 1.0 / 24.0; cp = cp * r2 - 0.5; cp = cp * r2 + 1.0;
    const int qi = ((int)q) & 3;
    const double s = (qi == 0) ? sp : (qi == 1) ? cp : (qi == 2) ? -sp : -cp;
    const double c = (qi == 0) ? cp : (qi == 1) ? -sp : (qi == 2) ? -cp : sp;
    sn = (float)s; cs = (float)c;
}
__device__ __forceinline__ void p0_prologue(Frame& F, int qslot) {
    PHASE_IDS();
    const int gt = F.wg * (NWAVES * 64) + tid, NGT = F.G * NWAVES * 64;
    for (int c = gt; c < 1024; c += NGT) {
        const float a0 = F.lb_logits[c], a1 = F.lb_logits[1024 + c], a2 = F.lb_logits[2048 + c], a3 = F.lb_logits[3072 + c];
        const float mx = fmaxf(fmaxf(a0, a1), fmaxf(a2, a3));
        const float e0 = expf(a0 - mx), e1 = expf(a1 - mx), e2 = expf(a2 - mx), e3 = expf(a3 - mx), inv = 1.0f / (e0 + e1 + e2 + e3);
        F.LB[c] = 0.f; F.LB[1024 + c] = e1 * inv; F.LB[2048 + c] = (e1 + e2) * inv; F.LB[3072 + c] = (e1 + e2 + e3) * inv;
    }
    for (int i = gt; i < SEQ * 128; i += NGT) {
        const int pos = i >> 7, j = i & 127;
        const float t = (float)j * (1.0f / 127.0f);
        const float invf = (float)(1.0 / exp((double)t * 9.21034037197618271));
        const float ang = (float)pos * invf;
        float sn, cs; sincos_acc(ang, sn, cs);
        F.RC[i] = cs; F.RS[i] = sn;
    }
    for (int task = F.wg; task < DEPTH * 48; task += F.G) p0_mod_task(F, task);
    __syncthreads();
    const int nconv = (F.G > NGEMM) ? CONV_PRO : DEPTH;
    for (int l = 0; l < nconv; ++l) convert_layer(F, l, wave, lane);
}
template <bool FINAL>
__device__ __forceinline__ void norm_prompt_rows(Frame& F, const XSrc xin, const float* g, int l, int which_sh  ) {
    PHASE_IDS();
    const bool xl = (F.G == 256);
    const int gw = xl ? (F.wg >> 3) * NWAVES + wave : F.wg * NWAVES + wave, NGW = xl ? 256 : F.G * NWAVES, mbeg = xl ? 1024 * (F.wg & 7) : 0, mend = xl ? mbeg + 1024 : SEQ;
    f32x4 av[8], bv[8];
    { const f32x4* gp = (const f32x4*)g + lane;
      if (FINAL) {
#pragma unroll
          for (int j = 0; j < 8; ++j) { av[j] = gp[64 * j]; bv[j] = (f32x4){0.f, 0.f, 0.f, 0.f}; }
      } else {
          const float* mod = F.MOD + (size_t)l * NMOD;
          const f32x4* shp = (const f32x4*)(mod + which_sh * DM) + lane; const f32x4* scp = (const f32x4*)(mod + (which_sh + 1) * DM) + lane;
#pragma unroll
          for (int j = 0; j < 8; ++j) { av[j] = gp[64 * j] * (scp[64 * j] + 1.0f); bv[j] = shp[64 * j]; }
      } }
    for (int m0 = mbeg + gw; m0 < mend; m0 += 4 * NGW) {
        half4 hx[4][8]; f32x4 fx[8];
        const bool f32in = xin.p32 != nullptr;
        int mr[4]; bool ok[4];
#pragma unroll
        for (int q = 0; q < 4; ++q) { mr[q] = m0 + q * NGW; ok[q] = mr[q] < mend; if (!ok[q]) mr[q] = m0; }
        if (!f32in) {
#pragma unroll
            for (int q = 0; q < 4; ++q)
#pragma unroll
                for (int j = 0; j < 8; ++j) hx[q][j] = *(const half4*)(xin.p16 + (size_t)mr[q] * DM + 4 * (lane + 64 * j));
        }
#pragma unroll
        for (int q = 0; q < 4; ++q) {
            if (!ok[q]) continue;
            float ss = 0.f;
#pragma unroll
            for (int j = 0; j < 8; ++j) { fx[j] = f32in ? *(const f32x4*)(xin.p32 + (size_t)mr[q] * DM + 4 * (lane + 64 * j)) : __builtin_convertvector(hx[q][j], f32x4);
                ss += (fx[j].x * fx[j].x + fx[j].y * fx[j].y) + (fx[j].z * fx[j].z + fx[j].w * fx[j].w); }
            const float r = 1.0f / sqrtf(wave_sum(ss) * (1.0f / DM) + EPS);
            if (FINAL) { f32x4* o = (f32x4*)(F.out + (size_t)mr[q] * DM) + lane;
#pragma unroll
                for (int j = 0; j < 8; ++j) o[64 * j] = fx[j] * r * av[j];
            } else { v2u* p = (v2u*)(F.H + (size_t)mr[q] * DM) + lane;
#pragma unroll
                for (int j = 0; j < 8; ++j) { const f32x4 h = fx[j] * r * av[j] + bv[j]; v2u w; w.x = pk2(h.x, h.y); w.y = pk2(h.z, h.w); p[64 * j] = w; }
            }
        }
    }
}
template <bool FINAL, bool WT>
__device__ __forceinline__ void norm_sample_rows(Frame& F, const XSrc xin_s  , const float* g, int l, int which_sh, int nslab, int slab_l, int slab_which, unsigned* ctr) {
    PHASE_IDS();
    LAS float* red = (LAS float*)F.lds;
    int nrows = 0;
    const int idx = 64 * wave + lane;
    for (int rb = F.wg; rb < DECB * DECS; rb += 2 * F.G) {
        const int r0 = rb, r1 = rb + F.G; const bool two = r1 < DECB * DECS; const int r1c = two ? r1 : r0;
        nrows += two ? 2 : 1;
        f32x4 v[2]; v[0] = ldx4(xin_s, (size_t)r0 * DM + 4 * idx); v[1] = ldx4(xin_s, (size_t)r1c * DM + 4 * idx);
        if (nslab > 0) {
            f32x4 a[2]; a[0] = (f32x4){0.f, 0.f, 0.f, 0.f}; a[1] = a[0];
            const XSrc sp0{nullptr, (const half_t*)(F.ws + WS_SLAB) + (size_t)r0 * DM + 4 * idx}, sp1{nullptr, (const half_t*)(F.ws + WS_SLAB) + (size_t)r1c * DM + 4 * idx};
            if (nslab == 16) {
#pragma unroll
                for (int s = 0; s < 16; ++s) { a[0] += ldx4(sp0, (size_t)s * (512 * DM)); a[1] += ldx4(sp1, (size_t)s * (512 * DM)); }
            } else if (nslab == 8) {
#pragma unroll
                for (int s = 0; s < 8; ++s) { a[0] += ldx4(sp0, (size_t)s * (512 * DM)); a[1] += ldx4(sp1, (size_t)s * (512 * DM)); }
            } else {
#pragma unroll
                for (int s = 0; s < 4; ++s) { a[0] += ldx4(sp0, (size_t)s * (512 * DM)); a[1] += ldx4(sp1, (size_t)s * (512 * DM)); }
            }
#pragma unroll
            for (int q = 0; q < 2; ++q) { const int r = q ? r1c : r0; if (q && !two) break;
                const f32x4 gv = *((const f32x4*)(F.MOD + (size_t)((1 + (r >> 6)) * DEPTH + slab_l) * NMOD + slab_which * DM) + idx);
                v[q] += gv * a[q];
                stx4(F.X + (size_t)(SEQ + r) * DM + 4 * idx, v[q]); }
        }
        const float ss0 = wave_sum((v[0].x * v[0].x + v[0].y * v[0].y) + (v[0].z * v[0].z + v[0].w * v[0].w));
        const float ss1 = wave_sum((v[1].x * v[1].x + v[1].y * v[1].y) + (v[1].z * v[1].z + v[1].w * v[1].w));
        __syncthreads();
        if (lane == 0) { red[wave] = ss0; red[8 + wave] = ss1; }
        __syncthreads();
        const f32x4 gg = *((const f32x4*)g + idx);
#pragma unroll
        for (int q = 0; q < 2; ++q) { const int r = q ? r1c : r0; if (q && !two) break;
            const int m = SEQ + r, sq = 1 + (r >> 6);
            float tot = 0.f;
#pragma unroll
            for (int w = 0; w < 8; ++w) tot += red[8 * q + w];
            const float rstd = 1.0f / sqrtf(tot * (1.0f / DM) + EPS);
            if (FINAL) { *((f32x4*)(F.out + (size_t)m * DM) + idx) = v[q] * rstd * gg; }
            else {
                const float* mod = F.MOD + (size_t)(sq * DEPTH + l) * NMOD;
                const f32x4 sh = *((const f32x4*)(mod + which_sh * DM) + idx), sc = *((const f32x4*)(mod + (which_sh + 1) * DM) + idx);
                const f32x4 h = v[q] * rstd * gg * (sc + 1.0f) + sh;
                v2u w; w.x = pk2(h.x, h.y); w.y = pk2(h.z, h.w);
                if (WT) __hip_atomic_store((unsigned long long*)((v2u*)(F.H + (size_t)m * DM) + idx), ((unsigned long long)w.y << 32) | w.x, __ATOMIC_RELAXED, __HIP_MEMORY_SCOPE_AGENT);
                else *((v2u*)(F.H + (size_t)m * DM) + idx) = w;
            }
        }
    }
    if (WT) { asm volatile("s_waitcnt vmcnt(0)" ::: "memory"); __syncthreads(); if (threadIdx.x == 0 && nrows > 0) __hip_atomic_fetch_add(ctr, (unsigned)nrows, __ATOMIC_RELAXED, __HIP_MEMORY_SCOPE_AGENT); }
    __syncthreads();
}
__device__ __forceinline__ void acol_fill(Frame& F) {
    PHASE_IDS();
    const int gt = F.wg * (NWAVES * 64) + tid;
    if (gt < DEPTH * 2 * DM) { const int l = gt / (2 * DM), j = (gt / DM) & 1, c = gt % DM;
        const float g = (j ? F.norm2_g : F.norm1_g)[l * DM + c], sc = F.MOD[(size_t)l * NMOD + (j ? 4 : 1) * DM + c];
        ((float*)(F.ws + WS_ACOL))[gt] = g * (1.0f + sc); }
}
constexpr int NSG = 40;
constexpr size_t WS_UA = WS_END;
constexpr size_t WS_DGA = WS_UA + 20 * MiB;
constexpr size_t WS_SSA = WS_DGA + 1 * MiB;
constexpr size_t WS_UB = WS_SSA + 20 * MiB;
constexpr size_t WS_SSB = WS_UB + 40 * MiB;
constexpr size_t WS_END2 = WS_SSB + 20 * MiB;

constexpr int MX_KHT = 0, MX_VT = 18432, MX_QT = 36864, MX_KT = 54272, MX_QH = 71680, MX_A = 89088, MX_EDEC = 98304, MX_RED = 98816, MX_B = 100864, MX_QTOT = 133632  ;
constexpr int RX_Q = 0, RX_K = 33792, RX_VT = 67584, RX_A = 104448, RX_RED = 113664;
constexpr float LOG2E = 1.4426950408889634f;

__device__ __forceinline__ bf16x8 ldfrag(LAS unsigned char* base, int ld_bytes, int row, int kbyte) { return *(const LAS bf16x8*)(base + row * ld_bytes + kbyte); }
__device__ __forceinline__ int tr_off(int row, int tokpair) { return row * 144 + ((((tokpair >> 2) ^ (row >> 3)) & 7) << 4) + ((tokpair & 3) << 2); }
__device__ __forceinline__ bf16x8 tr_frag(LAS unsigned char* base, int row, int chunk) { return *(const LAS bf16x8*)(base + row * 144 + (((chunk ^ (row >> 3)) & 7) << 4)); }
__device__ __forceinline__ float fexp2(float x) { return __builtin_amdgcn_exp2f(x); }
__device__ __forceinline__ float frsq(float x) { return __builtin_amdgcn_rsqf(x); }
__device__ __forceinline__ float gamma_log2(int h) { return log2f(1.0f - exp2f(-5.0f - (float)h)); }
__device__ __forceinline__ int sg_row0(int sg) { return sg < 32 ? sg * 256 : SEQ + 64 * (sg - 32); }
__device__ __forceinline__ int sg_nch(int sg) { return sg < 32 ? 4 : 1; }

template <bool IS_RET>
__device__ __forceinline__ void p1_unit(Frame& F, int l, int sg, int h, int quad) {
    PHASE_IDS();
    const int g4 = lane >> 4, l16 = lane & 15;
    const int row0 = sg_row0(sg), nch = sg_nch(sg);
    const int kb = quad >> 1, vb = quad & 1;
    const int ck = IS_RET ? 5120 + h * 256 + 128 * kb : 1024 + h * 128;
    const int cv = IS_RET ? 6144 + h * 256 + 128 * vb : 2048 + h * 128;
    LAS unsigned char* L = F.lds;
    LAS float* Edec = (LAS float*)(L + MX_EDEC);
    const float lg2 = gamma_log2(h);
    f32x4 S[8];
#pragma unroll
    for (int kt = 0; kt < 8; ++kt) S[kt] = (f32x4){0.f, 0.f, 0.f, 0.f};
    float sumb = 0.f;
    const int tp = tid >> 4, kc = tid & 15;
    v4u ka, kbv, va, vbv; f32x4 ba0, ba1, bb0, bb1, bt0, bt1; float btk = 0.f;
#define P1_LOAD(rowc_) do { const int ra_ = (rowc_) + 2 * tp; \
        ka = *(const v4u*)(F.P + (size_t)ra_ * 8192 + ck + 8 * kc); kbv = *(const v4u*)(F.P + (size_t)(ra_ + 1) * 8192 + ck + 8 * kc); \
        va = *(const v4u*)(F.P + (size_t)ra_ * 8192 + cv + 8 * kc); vbv = *(const v4u*)(F.P + (size_t)(ra_ + 1) * 8192 + cv + 8 * kc); \
        if (!IS_RET) { const float* la_ = F.LF + (size_t)ra_ * 1024 + h * 128 + 8 * kc; const float* lt_ = F.LF + (size_t)((rowc_) + 63) * 1024 + h * 128; \
            ba0 = *(const f32x4*)la_; ba1 = *(const f32x4*)(la_ + 4); bb0 = *(const f32x4*)(la_ + 1024); bb1 = *(const f32x4*)(la_ + 1028); bt0 = *(const f32x4*)(lt_ + 8 * kc); bt1 = *(const f32x4*)(lt_ + 8 * kc + 4); \
            if (tid < 128) btk = lt_[tid]; } } while (0)
    P1_LOAD(row0);
    const bool smp = sg >= 32;
    f32x4 S0[8];
    const size_t s0base = IS_RET ? ((size_t)((l * DECB + (sg - 32)) * HB + h) * 256) * 256 : ((size_t)((l * DECB + (sg - 32)) * HA + h) * 128) * 128;
    if (smp) { const float* s0 = (IS_RET ? F.state_ret : F.state_hgrn) + s0base;
#pragma unroll
        for (int kt = 0; kt < 8; ++kt)
#pragma unroll
            for (int r = 0; r < 4; ++r) S0[kt][r] = IS_RET ? s0[(size_t)(128 * kb + 16 * kt + 4 * g4 + r) * 256 + 128 * vb + 16 * wave + l16] : s0[(size_t)(16 * kt + 4 * g4 + r) * 128 + 16 * wave + l16]; }
    for (int c = 0; c < nch; ++c) {
        {
            float fa[8], fb[8];
            if (IS_RET) {
                const float za = fexp2(lg2 * (float)(63 - 2 * tp)), zb = fexp2(lg2 * (float)(62 - 2 * tp));
#pragma unroll
                for (int i = 0; i < 8; ++i) { fa[i] = za; fb[i] = zb; }
                if (tid < 128) Edec[tid] = fexp2(lg2 * 64.0f);
            } else {
#pragma unroll
                for (int i = 0; i < 8; ++i) { const float bt = (i < 4) ? bt0[i & 3] : bt1[i & 3], ba = (i < 4) ? ba0[i & 3] : ba1[i & 3], bb = (i < 4) ? bb0[i & 3] : bb1[i & 3];
                    fa[i] = fexp2((bt - ba) * LOG2E); fb[i] = fexp2((bt - bb) * LOG2E);
                    if (tp == 0) Edec[8 * kc + i] = fexp2(bt * LOG2E); }
                if (tid < 128) sumb += btk;
            }
#pragma unroll
            for (int i = 0; i < 8; ++i) {
                const unsigned wa = ka[i >> 1], wb = kbv[i >> 1];
                const float xa = (i & 1) ? bfhi(wa) : bflo(wa), xb = (i & 1) ? bfhi(wb) : bflo(wb);
                *(LAS unsigned*)(L + MX_KHT + tr_off(8 * kc + i, tp)) = pk2(xa * fa[i], xb * fb[i]);
                const unsigned ua = va[i >> 1], ub = vbv[i >> 1];
                const unsigned lo = (i & 1) ? (ua >> 16) : (ua & 0xffffu), hi = (i & 1) ? (ub >> 16) : (ub & 0xffffu);
                *(LAS unsigned*)(L + MX_VT + tr_off(8 * kc + i, tp)) = lo | (hi << 16);
            }
        }
        __syncthreads();
        if (c + 1 < nch) P1_LOAD(row0 + 64 * (c + 1));
        {
            bf16x8 Y[2];
#pragma unroll
            for (int ss = 0; ss < 2; ++ss) Y[ss] = tr_frag(L + MX_VT, 16 * wave + l16, 4 * ss + g4);
#pragma unroll
            for (int hk = 0; hk < 2; ++hk) {
                bf16x8 fk[4][2]; f32x4 dv[4];
#pragma unroll
                for (int q = 0; q < 4; ++q) { const int kt = 4 * hk + q; dv[q] = *(const LAS f32x4*)(Edec + 16 * kt + 4 * g4);
#pragma unroll
                    for (int ss = 0; ss < 2; ++ss) fk[q][ss] = tr_frag(L + MX_KHT, 16 * kt + l16, 4 * ss + g4); }
                __builtin_amdgcn_sched_barrier(0);
#pragma unroll
                for (int q = 0; q < 4; ++q) { const int kt = 4 * hk + q; S[kt] = S[kt] * dv[q];
#pragma unroll
                    for (int ss = 0; ss < 2; ++ss) S[kt] = __builtin_amdgcn_mfma_f32_16x16x32_bf16(fk[q][ss], Y[ss], S[kt], 0, 0, 0); }
                __builtin_amdgcn_sched_barrier(0);
            }
        }
        __syncthreads();
    }
#undef P1_LOAD
    if (smp) {
        float* fin = F.out + (IS_RET ? OFF_SB_S : OFF_SA_S) + s0base;
#pragma unroll
        for (int kt = 0; kt < 8; ++kt) {
            const f32x4 d = *(const LAS f32x4*)(Edec + 16 * kt + 4 * g4);
            const f32x4 fs = d * S0[kt] + S[kt];
#pragma unroll
            for (int r = 0; r < 4; ++r) { if (IS_RET) fin[(size_t)(128 * kb + 16 * kt + 4 * g4 + r) * 256 + 128 * vb + 16 * wave + l16] = fs[r]; else fin[(size_t)(16 * kt + 4 * g4 + r) * 128 + 16 * wave + l16] = fs[r]; }
            if (IS_RET) { v2u w; w.x = pk2(S0[kt][0], S0[kt][1]); w.y = pk2(S0[kt][2], S0[kt][3]);
                *(v2u*)((bf16*)(F.ws + WS_SSB) + ((size_t)(sg * HB + h) * 256 + 128 * vb + 16 * wave + l16) * 256 + 128 * kb + 16 * kt + 4 * g4) = w; }
            else stx4((half_t*)(F.ws + WS_SSA) + ((size_t)(sg * HA + h) * 128 + 16 * wave + l16) * 128 + 16 * kt + 4 * g4, S0[kt]);
        }
        __syncthreads();
        return;
    }
    if (IS_RET) {
        half_t* U = (half_t*)(F.ws + WS_UB) + ((size_t)(sg * HB + h) * 256 + 128 * vb + 16 * wave + l16) * 256 + 128 * kb + 4 * g4;
#pragma unroll
        for (int kt = 0; kt < 8; ++kt) stx4(U + 16 * kt, S[kt]);
    } else {
        half_t* U = (half_t*)(F.ws + WS_UA) + ((size_t)(sg * HA + h) * 128 + 16 * wave + l16) * 128 + 4 * g4;
#pragma unroll
        for (int kt = 0; kt < 8; ++kt) stx4(U + 16 * kt, S[kt]);
        if (tid < 128) ((float*)(F.ws + WS_DGA))[(size_t)(sg * HA + h) * 128 + tid] = fexp2(sumb * LOG2E);
    }
}
__device__ __forceinline__ void mix1_phase(Frame& F, int l, const XcdBarrier& bar) {
    (void)bar;
    for (int u = F.wg; u < 960; u += F.G) {
        bool is_ret; int sg, h, quad = 0;
        if (F.G == 256 && u < 768) {
            const int x = F.wg & 7, k = F.wg >> 3;
            if (u < 256) { is_ret = false; sg = 4 * x + (k >> 3); h = k & 7; }
            else { const int e = k + 32 * ((u >> 8) - 1); is_ret = true; sg = 4 * x + (e >> 4); h = (e >> 2) & 3; quad = e & 3; }
        }
        else if (u < 256) { is_ret = false; sg = u >> 3; h = u & 7; }
        else if (u < 768) { const int r = u - 256, x = r & 7, k = (r >> 3) & 31, unit = (r >> 8) * 64 + (k >> 2) * 8 + x;
            is_ret = true; sg = unit >> 2; h = unit & 3; quad = k & 3; }
        else if (u < 832) { const int r = u - 768; is_ret = false; sg = 32 + (r >> 3); h = r & 7; }
        else { const int r = u - 832; is_ret = true; sg = 32 + (r >> 4); h = (r >> 2) & 3; quad = r & 3; }
        if (is_ret) p1_unit<true>(F, l, sg, h, quad); else p1_unit<false>(F, l, sg, h, quad);
    }
}

__device__ __forceinline__ void mix2_phase(Frame& F, int l) {
    PHASE_IDS();
    const int gt = F.wg * (NWAVES * 64) + tid, NGT = F.G * NWAVES * 64;
    constexpr int IA = 128 * 32, IB = 256 * 64, PER_SEQ = HA * IA + HB * IB;
    for (int it = gt; it < PER_SEQ; it += NGT) {
        const int seq = it / PER_SEQ; int r = it % PER_SEQ;
        const int ng = seq == 0 ? 32 : 1, sg0 = seq == 0 ? 0 : 31 + seq;
        if (r < HA * IA) {
            const int h = r / IA, v = seq == 0 ? ((r % IA) >> 5) : (r & 127), k4 = seq == 0 ? (r & 31) : ((r % IA) >> 7);
            f32x4 s = (f32x4){0.f, 0.f, 0.f, 0.f};
            if (seq > 0) { const float* s0 = F.state_hgrn + ((size_t)((l * DECB + (seq - 1)) * HA + h) * 128) * 128;
#pragma unroll
                for (int e = 0; e < 4; ++e) s[e] = s0[(size_t)(4 * k4 + e) * 128 + v]; }
            for (int g0 = 0; g0 < ng; g0 += 16) {
                half4 u[16]; f32x4 d[16];
#pragma unroll
                for (int i = 0; i < 16; ++i) if (g0 + i < ng) { const size_t ub = (size_t)((sg0 + g0 + i) * HA + h);
                    u[i] = *(const half4*)((const half_t*)(F.ws + WS_UA) + (ub * 128 + v) * 128 + 4 * k4); d[i] = *(const f32x4*)((const float*)(F.ws + WS_DGA) + ub * 128 + 4 * k4); }
#pragma unroll
                for (int i = 0; i < 16; ++i) if (g0 + i < ng) { const size_t ub = (size_t)((sg0 + g0 + i) * HA + h);
                    stx4((half_t*)(F.ws + WS_SSA) + (ub * 128 + v) * 128 + 4 * k4, s); s = d[i] * s + __builtin_convertvector(u[i], f32x4); }
            }
            float* dst = F.out + (seq == 0 ? OFF_SA_P + ((size_t)(l * HA + h) * 128) * 128 : OFF_SA_S + ((size_t)((l * DECB + (seq - 1)) * HA + h) * 128) * 128);
#pragma unroll
            for (int e = 0; e < 4; ++e) dst[(size_t)(4 * k4 + e) * 128 + v] = s[e];
        } else {
            r -= HA * IA;
            const int h = r / IB, v = seq == 0 ? ((r % IB) >> 6) : (r & 255), k4 = seq == 0 ? (r & 63) : ((r % IB) >> 8);
            const float lg2 = gamma_log2(h); const float gd = fexp2(lg2 * (seq == 0 ? 256.0f : 64.0f));
            f32x4 s = (f32x4){0.f, 0.f, 0.f, 0.f};
            if (seq > 0) { const float* s0 = F.state_ret + ((size_t)((l * DECB + (seq - 1)) * HB + h) * 256) * 256;
#pragma unroll
                for (int e = 0; e < 4; ++e) s[e] = s0[(size_t)(4 * k4 + e) * 256 + v]; }
            for (int g0 = 0; g0 < ng; g0 += 16) {
                half4 u[16];
#pragma unroll
                for (int i = 0; i < 16; ++i) if (g0 + i < ng) { const size_t ub = (size_t)((sg0 + g0 + i) * HB + h); u[i] = *(const half4*)((const half_t*)(F.ws + WS_UB) + (ub * 256 + v) * 256 + 4 * k4); }
#pragma unroll
                for (int i = 0; i < 16; ++i) if (g0 + i < ng) { const size_t ub = (size_t)((sg0 + g0 + i) * HB + h);
                    v2u w; w.x = pk2(s[0], s[1]); w.y = pk2(s[2], s[3]);
                    *(v2u*)((bf16*)(F.ws + WS_SSB) + (ub * 256 + v) * 256 + 4 * k4) = w; s = s * gd + __builtin_convertvector(u[i], f32x4); }
            }
            float* dst = F.out + (seq == 0 ? OFF_SB_P + ((size_t)(l * HB + h) * 256) * 256 : OFF_SB_S + ((size_t)((l * DECB + (seq - 1)) * HB + h) * 256) * 256);
#pragma unroll
            for (int e = 0; e < 4; ++e) dst[(size_t)(4 * k4 + e) * 256 + v] = s[e];
        }
    }
}
typedef short bf16x4 __attribute__((ext_vector_type(4)));
__device__ __forceinline__ float clampf(float x, float lo, float hi) { return fminf(fmaxf(x, lo), hi); }
__device__ __forceinline__ void p3_hgrn_unit(Frame& F, int l, int sg, int h) {
    PHASE_IDS();
    const int g4 = lane >> 4, l16 = lane & 15;
    const int row0 = sg_row0(sg), nch = sg_nch(sg);
    LAS unsigned char* L = F.lds;
    LAS float* Edec = (LAS float*)(L + MX_EDEC); LAS float* Red = (LAS float*)(L + MX_RED);
    f32x4 S[8];
    { const XSrc ss{nullptr, (const half_t*)(F.ws + WS_SSA) + ((size_t)(sg * HA + h) * 128 + 16 * wave + l16) * 128 + 4 * g4};
#pragma unroll
      for (int kt = 0; kt < 8; ++kt) S[kt] = ldx4(ss, 16 * kt); }
    const f32x4 gn4 = *(const f32x4*)(F.hgrn_g + l * 1024 + h * 128 + 16 * wave + 4 * g4);
    const int tp = tid >> 4, kc = tid & 15;
    v4u qa, qb, ka, kb, va, vb; f32x4 ba0, ba1, bb0, bb1, br0, br1, bt0, bt1;
#define P3H_LOAD(rowc_) do { const int ra_ = (rowc_) + 2 * tp; const bf16* pa_ = F.P + (size_t)ra_ * 8192 + h * 128 + 8 * kc; const bf16* pb_ = pa_ + 8192; \
        qa = *(const v4u*)pa_; qb = *(const v4u*)pb_; ka = *(const v4u*)(pa_ + 1024); kb = *(const v4u*)(pb_ + 1024); va = *(const v4u*)(pa_ + 2048); vb = *(const v4u*)(pb_ + 2048); \
        const float* la_ = F.LF + (size_t)ra_ * 1024 + h * 128 + 8 * kc; const float* lr_ = F.LF + (size_t)((rowc_) + 31) * 1024 + h * 128 + 8 * kc; const float* lt_ = lr_ + 32 * 1024; \
        ba0 = *(const f32x4*)la_; ba1 = *(const f32x4*)(la_ + 4); bb0 = *(const f32x4*)(la_ + 1024); bb1 = *(const f32x4*)(la_ + 1028); \
        br0 = *(const f32x4*)lr_; br1 = *(const f32x4*)(lr_ + 4); bt0 = *(const f32x4*)lt_; bt1 = *(const f32x4*)(lt_ + 4); } while (0)
    P3H_LOAD(row0);
    for (int c = 0; c < nch; ++c) {
        const int rowc = row0 + 64 * c;
        {
            unsigned qta[4], qtb[4], kta[4], ktb[4], qha[4], qhb[4];
            float pqa = 0.f, pqb = 0.f, pka = 0.f, pkb = 0.f, pha = 0.f, phb = 0.f;
#pragma unroll
            for (int i = 0; i < 8; ++i) {
                const float bref = (i < 4) ? br0[i & 3] : br1[i & 3], btot = (i < 4) ? bt0[i & 3] : bt1[i & 3];
                const float ba = (i < 4) ? ba0[i & 3] : ba1[i & 3], bb = (i < 4) ? bb0[i & 3] : bb1[i & 3];
                const float e1a = fexp2(clampf((ba - bref) * LOG2E, -115.f, 115.f)), e1b = fexp2(clampf((bb - bref) * LOG2E, -115.f, 115.f));
                const float e2a = __builtin_amdgcn_rcpf(e1a), e2b = __builtin_amdgcn_rcpf(e1b);
                const float eref = fexp2(bref * LOG2E), etr = fexp2((btot - bref) * LOG2E);
                const unsigned wqa = qa[i >> 1], wqb = qb[i >> 1], wka = ka[i >> 1], wkb = kb[i >> 1];
                const float xqa = (i & 1) ? bfhi(wqa) : bflo(wqa), xqb = (i & 1) ? bfhi(wqb) : bflo(wqb), xka = (i & 1) ? bfhi(wka) : bflo(wka), xkb = (i & 1) ? bfhi(wkb) : bflo(wkb);
                const float tqa = xqa * e1a, tqb = xqb * e1b, tka = xka * e2a, tkb = xkb * e2b;
                const float hqa = tqa * eref, hqb = tqb * eref;
                *(LAS unsigned*)(L + MX_KHT + tr_off(8 * kc + i, tp)) = pk2(tka * etr, tkb * etr);
                const unsigned ua = va[i >> 1], ub = vb[i >> 1];
                const unsigned lo = (i & 1) ? (ua >> 16) : (ua & 0xffffu), hi = (i & 1) ? (ub >> 16) : (ub & 0xffffu);
                *(LAS unsigned*)(L + MX_VT + tr_off(8 * kc + i, tp)) = lo | (hi << 16);
                if (tp == 0) Edec[8 * kc + i] = fexp2(btot * LOG2E);
                if (i & 1) { qta[i >> 1] = pk2(pqa, tqa); qtb[i >> 1] = pk2(pqb, tqb); kta[i >> 1] = pk2(pka, tka); ktb[i >> 1] = pk2(pkb, tkb); qha[i >> 1] = pk2(pha, hqa); qhb[i >> 1] = pk2(phb, hqb); }
                else { pqa = tqa; pqb = tqb; pka = tka; pkb = tkb; pha = hqa; phb = hqb; }
            }
            const int oa = (2 * tp) * 272 + 16 * kc, ob = oa + 272;
            *(LAS v4u*)(L + MX_QT + oa) = (v4u){qta[0], qta[1], qta[2], qta[3]}; *(LAS v4u*)(L + MX_QT + ob) = (v4u){qtb[0], qtb[1], qtb[2], qtb[3]};
            *(LAS v4u*)(L + MX_KT + oa) = (v4u){kta[0], kta[1], kta[2], kta[3]}; *(LAS v4u*)(L + MX_KT + ob) = (v4u){ktb[0], ktb[1], ktb[2], ktb[3]};
            *(LAS v4u*)(L + MX_QH + oa) = (v4u){qha[0], qha[1], qha[2], qha[3]}; *(LAS v4u*)(L + MX_QH + ob) = (v4u){qhb[0], qhb[1], qhb[2], qhb[3]};
        }
        __syncthreads();
        if (c + 1 < nch) P3H_LOAD(rowc + 64);
        v2u gpre[4];
#pragma unroll
        for (int j = 0; j < 4; ++j) gpre[j] = *(const v2u*)(F.P + (size_t)(rowc + 16 * j + l16) * 8192 + 3072 + h * 128 + 16 * wave + 4 * g4);
        {
            const int jt = wave >> 1;
#pragma unroll
            for (int ii = 0; ii < 2; ++ii) {
                const int it = 2 * (wave & 1) + ii;
                f32x4 a = (f32x4){0.f, 0.f, 0.f, 0.f};
                if (it <= jt) {
#pragma unroll
                    for (int kk = 0; kk < 4; ++kk) a = __builtin_amdgcn_mfma_f32_16x16x32_bf16(ldfrag(L + MX_KT, 272, 16 * it + l16, 64 * kk + 16 * g4), ldfrag(L + MX_QT, 272, 16 * jt + l16, 64 * kk + 16 * g4), a, 0, 0, 0);
                }
                const int t = 16 * jt + l16, s0 = 16 * it + 4 * g4;
                v2u w; w.x = pk2(s0 <= t ? a[0] : 0.f, s0 + 1 <= t ? a[1] : 0.f); w.y = pk2(s0 + 2 <= t ? a[2] : 0.f, s0 + 3 <= t ? a[3] : 0.f);
                if (it > jt) { w.x = 0u; w.y = 0u; }
                *(LAS v2u*)(L + MX_A + t * 144 + s0 * 2) = w;
            }
        }
        f32x4 o[4];
#pragma unroll
        for (int j = 0; j < 4; ++j) o[j] = (f32x4){0.f, 0.f, 0.f, 0.f};
#pragma unroll
        for (int kk = 0; kk < 4; ++kk) {
            const f32x4 s0 = S[2 * kk], s1 = S[2 * kk + 1];
            const v4u xw = (v4u){pk2(s0[0], s0[1]), pk2(s0[2], s0[3]), pk2(s1[0], s1[1]), pk2(s1[2], s1[3])};
            const bf16x8 X = __builtin_bit_cast(bf16x8, xw);
#pragma unroll
            for (int j = 0; j < 4; ++j) {
                const LAS unsigned char* qp = L + MX_QH + (16 * j + l16) * 272 + 64 * kk + 8 * g4;
                const bf16x4 y0 = *(const LAS bf16x4*)qp, y1 = *(const LAS bf16x4*)(qp + 32);
                const bf16x8 Y = __builtin_shufflevector(y0, y1, 0, 1, 2, 3, 4, 5, 6, 7);
                o[j] = __builtin_amdgcn_mfma_f32_16x16x32_bf16(X, Y, o[j], 0, 0, 0);
            }
        }
        __syncthreads();
        {
            bf16x8 Yv[2];
#pragma unroll
            for (int ss = 0; ss < 2; ++ss) Yv[ss] = tr_frag(L + MX_VT, 16 * wave + l16, 4 * ss + g4);
#pragma unroll
            for (int ss = 0; ss < 2; ++ss)
#pragma unroll
                for (int j = 0; j < 4; ++j) { if (ss == 1 && j < 2) continue;
                    o[j] = __builtin_amdgcn_mfma_f32_16x16x32_bf16(Yv[ss], ldfrag(L + MX_A, 144, 16 * j + l16, 64 * ss + 16 * g4), o[j], 0, 0, 0); }
            if (c + 1 < nch) {
#pragma unroll
                for (int kt = 0; kt < 8; ++kt) {
                    S[kt] = S[kt] * *(const LAS f32x4*)(Edec + 16 * kt + 4 * g4);
#pragma unroll
                    for (int ss = 0; ss < 2; ++ss) S[kt] = __builtin_amdgcn_mfma_f32_16x16x32_bf16(tr_frag(L + MX_KHT, 16 * kt + l16, 4 * ss + g4), Yv[ss], S[kt], 0, 0, 0);
                }
            }
        }
#pragma unroll
        for (int j = 0; j < 4; ++j) { float q = (o[j][0] * o[j][0] + o[j][1] * o[j][1]) + (o[j][2] * o[j][2] + o[j][3] * o[j][3]); q += __shfl_xor(q, 16); q += __shfl_xor(q, 32); if (g4 == 0) Red[wave * 64 + 16 * j + l16] = q; }
        __syncthreads();
#pragma unroll
        for (int j = 0; j < 4; ++j) {
            float tot = 0.f;
#pragma unroll
            for (int w = 0; w < 8; ++w) tot += Red[w * 64 + 16 * j + l16];
            const float rstd = frsq(tot * (1.0f / 128.0f) + EPS);
            const size_t row = rowc + 16 * j + l16;
            const v2u gw = gpre[j];
            const f32x4 r = o[j] * rstd * gn4;
            v2u w; w.x = pk2(r[0] * bflo(gw.x), r[1] * bfhi(gw.x)); w.y = pk2(r[2] * bflo(gw.y), r[3] * bfhi(gw.y));
            *(v2u*)(F.O + row * 2048 + h * 128 + 16 * wave + 4 * g4) = w;
        }
        __syncthreads();
    }
#undef P3H_LOAD
}
__device__ __forceinline__ void p3_ret_unit(Frame& F, int l, int sg, int jc, int h, bf16x8 (&X0)[8], bf16x8 (&X1)[8], bool load_S) {
    PHASE_IDS();
    const int g4 = lane >> 4, l16 = lane & 15;
    const int rowg = sg_row0(sg), rowq = rowg + 64 * jc;
    LAS unsigned char* L = F.lds;
    LAS float* Red = (LAS float*)(L + RX_RED);
    const float lg2 = gamma_log2(h);
    const int tp = tid >> 4, kc = tid & 15;
    const int oa = (2 * tp) * 528 + 16 * kc;
    v4u k0, k1, k2, k3, v0, v1, v2, v3;
#define P3R_LOADKV(jp_) do { const bf16* pa_ = F.P + (size_t)(rowg + 64 * (jp_) + 2 * tp) * 8192 + 5120 + h * 256 + 8 * kc; const bf16* pb_ = pa_ + 8192; \
        k0 = *(const v4u*)pa_; k1 = *(const v4u*)(pa_ + 128); k2 = *(const v4u*)pb_; k3 = *(const v4u*)(pb_ + 128); \
        v0 = *(const v4u*)(pa_ + 1024); v1 = *(const v4u*)(pa_ + 1024 + 128); v2 = *(const v4u*)(pb_ + 1024); v3 = *(const v4u*)(pb_ + 1024 + 128); } while (0)
#define P3R_STOREKV() do { *(LAS v4u*)(L + RX_K + oa) = k0; *(LAS v4u*)(L + RX_K + oa + 256) = k1; *(LAS v4u*)(L + RX_K + oa + 528) = k2; *(LAS v4u*)(L + RX_K + oa + 528 + 256) = k3; \
        _Pragma("unroll") for (int i = 0; i < 8; ++i) { \
            { const unsigned ua = v0[i >> 1], ub = v2[i >> 1]; const unsigned lo = (i & 1) ? (ua >> 16) : (ua & 0xffffu), hi = (i & 1) ? (ub >> 16) : (ub & 0xffffu); *(LAS unsigned*)(L + RX_VT + tr_off(8 * kc + i, tp)) = lo | (hi << 16); } \
            { const unsigned ua = v1[i >> 1], ub = v3[i >> 1]; const unsigned lo = (i & 1) ? (ua >> 16) : (ua & 0xffffu), hi = (i & 1) ? (ub >> 16) : (ub & 0xffffu); *(LAS unsigned*)(L + RX_VT + tr_off(128 + 8 * kc + i, tp)) = lo | (hi << 16); } } } while (0)
    {
        const bf16* pa = F.P + (size_t)(rowq + 2 * tp) * 8192 + 4096 + h * 256 + 8 * kc; const bf16* pb = pa + 8192;
        const v4u a0 = *(const v4u*)pa, a1 = *(const v4u*)(pa + 128), b0 = *(const v4u*)pb, b1 = *(const v4u*)(pb + 128);
        P3R_LOADKV(0);
        if (load_S) {
            const bf16* sp = (const bf16*)(F.ws + WS_SSB) + ((size_t)(sg * HB + h) * 256 + 32 * wave + l16) * 256 + 8 * g4;
#pragma unroll
            for (int kk = 0; kk < 8; ++kk) { X0[kk] = *(const bf16x8*)(sp + 32 * kk); X1[kk] = *(const bf16x8*)(sp + (size_t)16 * 256 + 32 * kk); } }
        *(LAS v4u*)(L + RX_Q + oa) = a0; *(LAS v4u*)(L + RX_Q + oa + 256) = a1; *(LAS v4u*)(L + RX_Q + oa + 528) = b0; *(LAS v4u*)(L + RX_Q + oa + 528 + 256) = b1;
        P3R_STOREKV();
    }
    f32x4 acc[2][4];
#pragma unroll
    for (int vt = 0; vt < 2; ++vt)
#pragma unroll
        for (int j = 0; j < 4; ++j) acc[vt][j] = (f32x4){0.f, 0.f, 0.f, 0.f};
    __syncthreads();
    if (jc > 0) P3R_LOADKV(1);
    v2u gpre[4][2];
    const f32x4 rg0 = *(const f32x4*)(F.ret_g + l * 1024 + h * 256 + 32 * wave + 4 * g4), rg1 = *(const f32x4*)(F.ret_g + l * 1024 + h * 256 + 32 * wave + 16 + 4 * g4);
#pragma unroll
    for (int j = 0; j < 4; ++j)
#pragma unroll
        for (int vt = 0; vt < 2; ++vt) gpre[j][vt] = *(const v2u*)(F.P + (size_t)(rowq + 16 * j + l16) * 8192 + 7168 + h * 256 + 32 * wave + 16 * vt + 4 * g4);
    {
#pragma unroll
        for (int kk = 0; kk < 8; ++kk)
            { bf16x8 Y[4];
#pragma unroll
              for (int j = 0; j < 4; ++j) Y[j] = ldfrag(L + RX_Q, 528, 16 * j + l16, 64 * kk + 16 * g4);
              __builtin_amdgcn_sched_barrier(0);
#pragma unroll
              for (int j = 0; j < 4; ++j) { acc[0][j] = __builtin_amdgcn_mfma_f32_16x16x32_bf16(X0[kk], Y[j], acc[0][j], 0, 0, 0); acc[1][j] = __builtin_amdgcn_mfma_f32_16x16x32_bf16(X1[kk], Y[j], acc[1][j], 0, 0, 0); }
              __builtin_amdgcn_sched_barrier(0); }
#pragma unroll
        for (int j = 0; j < 4; ++j) { const float xi = fexp2(lg2 * (float)(64 * jc + 16 * j + l16 + 1)); acc[0][j] = acc[0][j] * xi; acc[1][j] = acc[1][j] * xi; }
    }
    for (int jp = 0; jp <= jc; ++jp) {
        {
            const int jt = wave >> 1; const bool diag = (jp == jc);
#pragma unroll
            for (int ii = 0; ii < 2; ++ii) {
                const int it = 2 * (wave & 1) + ii;
                f32x4 a = (f32x4){0.f, 0.f, 0.f, 0.f};
                const bool live = !(diag && it > jt);
                if (live) {
#pragma unroll
                    for (int hk = 0; hk < 2; ++hk) {
                        bf16x8 fx[4], fy[4];
#pragma unroll
                        for (int q = 0; q < 4; ++q) { const int kk = 4 * hk + q; fx[q] = ldfrag(L + RX_K, 528, 16 * it + l16, 64 * kk + 16 * g4); fy[q] = ldfrag(L + RX_Q, 528, 16 * jt + l16, 64 * kk + 16 * g4); }
                        __builtin_amdgcn_sched_barrier(0);
#pragma unroll
                        for (int q = 0; q < 4; ++q) a = __builtin_amdgcn_mfma_f32_16x16x32_bf16(fx[q], fy[q], a, 0, 0, 0);
                        __builtin_amdgcn_sched_barrier(0);
                    }
                }
                const int t = 16 * jt + l16, s0 = 16 * it + 4 * g4; const int dd = 64 * (jc - jp) + t - s0;
                float e[4];
#pragma unroll
                for (int r = 0; r < 4; ++r) { const float dec = fexp2(lg2 * (float)(dd - r)); e[r] = (!diag || s0 + r <= t) ? a[r] * dec : 0.f; }
                v2u w; w.x = pk2(e[0], e[1]); w.y = pk2(e[2], e[3]);
                if (!live) { w.x = 0u; w.y = 0u; }
                *(LAS v2u*)(L + RX_A + t * 144 + s0 * 2) = w;
            }
        }
        __syncthreads();
        {
            bf16x8 fv[2][2], fp[2][4];
#pragma unroll
            for (int ss = 0; ss < 2; ++ss) {
#pragma unroll
                for (int vt = 0; vt < 2; ++vt) fv[ss][vt] = tr_frag(L + RX_VT, 32 * wave + 16 * vt + l16, 4 * ss + g4);
#pragma unroll
                for (int j = 0; j < 4; ++j) fp[ss][j] = ldfrag(L + RX_A, 144, 16 * j + l16, 64 * ss + 16 * g4); }
            __builtin_amdgcn_sched_barrier(0);
#pragma unroll
            for (int ss = 0; ss < 2; ++ss)
#pragma unroll
                for (int vt = 0; vt < 2; ++vt)
#pragma unroll
                    for (int j = 0; j < 4; ++j) acc[vt][j] = __builtin_amdgcn_mfma_f32_16x16x32_bf16(fv[ss][vt], fp[ss][j], acc[vt][j], 0, 0, 0);
            __builtin_amdgcn_sched_barrier(0);
        }
        if (jp < jc) {
            __syncthreads();
            P3R_STOREKV();
            __syncthreads();
            if (jp + 2 <= jc) P3R_LOADKV(jp + 2);
        }
    }
#undef P3R_LOADKV
#undef P3R_STOREKV
#pragma unroll
    for (int j = 0; j < 4; ++j) { float q = 0.f;
#pragma unroll
        for (int vt = 0; vt < 2; ++vt) q += (acc[vt][j][0] * acc[vt][j][0] + acc[vt][j][1] * acc[vt][j][1]) + (acc[vt][j][2] * acc[vt][j][2] + acc[vt][j][3] * acc[vt][j][3]);
        q += __shfl_xor(q, 16); q += __shfl_xor(q, 32); if (g4 == 0) Red[wave * 64 + 16 * j + l16] = q; }
    __syncthreads();
#pragma unroll
    for (int j = 0; j < 4; ++j) {
        float tot = 0.f;
#pragma unroll
        for (int w = 0; w < 8; ++w) tot += Red[w * 64 + 16 * j + l16];
        const float rstd = frsq(tot * (1.0f / 256.0f) + EPS);
        const size_t row = rowq + 16 * j + l16;
#pragma unroll
        for (int vt = 0; vt < 2; ++vt) {
            const int vc = h * 256 + 32 * wave + 16 * vt + 4 * g4;
            const v2u gw = gpre[j][vt];
            const f32x4 r = acc[vt][j] * rstd * (vt ? rg1 : rg0);
            v2u w; w.x = pk2(r[0] * bflo(gw.x), r[1] * bfhi(gw.x)); w.y = pk2(r[2] * bflo(gw.y), r[3] * bfhi(gw.y));
            *(v2u*)(F.O + row * 2048 + 1024 + vc) = w;
        }
    }
    __syncthreads();
}
__device__ __forceinline__ void mix3_phase(Frame& F, int l, int parts = 3) {
    for (int vw = F.wg; vw < 256; vw += F.G) {
        const bool xl = (F.G == 256); const int x = vw & 7, k = vw >> 3;
        if (parts & 1) for (int q = 0; q < 2; ++q) {
            if (q == 1 && vw >= 64) break;
            const int sg = q == 0 ? (xl ? 4 * x + (k >> 3) : (vw >> 3)) : 32 + (vw >> 3);
            const int h = q == 0 ? (xl ? (k & 7) : (vw & 7)) : (vw & 7);
            p3_hgrn_unit(F, l, sg, h);
        }
        bf16x8 SX0[8], SX1[8];
        if (parts & 2) for (int q = 0; q < 3; ++q) {
            int sg, jc, h;
            if (q < 2) { int half; if (xl) { sg = 4 * x + (k >> 3); h = (k >> 1) & 3; half = k & 1; } else { h = vw & 3; sg = (vw >> 2) & 31; half = vw >> 7; }
                jc = q == 0 ? (half ? 2 : 3) : (half ? 1 : 0); }
            else { if (vw < 64 || vw >= 96) break; sg = 32 + ((vw - 64) >> 2); jc = 0; h = (vw - 64) & 3; }
            p3_ret_unit(F, l, sg, jc, h, SX0, SX1, q != 1);
        }
    }
}
constexpr int PH_PRO = 0, PH_PER_LAYER = 9, PH_FINAL = 1 + DEPTH * PH_PER_LAYER, N_PHASES = PH_FINAL + 1;
struct Args { const float* in[18]; float* out; unsigned char* ws; int ph_lo, ph_hi; };
__global__ void __launch_bounds__(NWAVES * 64, 2) fwd(Args args) {
    extern __shared__ __attribute__((aligned(16))) unsigned char lds[];
    Frame F;
    F.lds = (LAS unsigned char*)lds;
    F.G = gridDim.x; F.wg = blockIdx.x;
    unsigned char* ws = args.ws;
    F.ctl = (unsigned*)(ws + WS_CTL); F.ws = ws;
    F.x_prompt = args.in[0]; F.x_sample = args.in[1]; F.state_hgrn = args.in[2]; F.state_ret = args.in[3]; F.c_prompt = args.in[4]; F.c_sample = args.in[5];
    F.lb_logits = args.in[6]; F.w_ada = args.in[7]; F.b_ada = args.in[8]; F.norm1_g = args.in[9]; F.norm2_g = args.in[10]; F.w_in = args.in[11];
    F.hgrn_g = args.in[12]; F.ret_g = args.in[13]; F.w_out = args.in[14]; F.w_up = args.in[15]; F.w_down = args.in[16]; F.final_g = args.in[17];
    F.out = args.out;
    F.Win_t = (bf16*)(ws + WS_WIN); F.Wout_t = (bf16*)(ws + WS_WOUT); F.Wup_t = (bf16*)(ws + WS_WUP); F.Wdn_t = (bf16*)(ws + WS_WDN);
    F.X = (half_t*)(ws + WS_X); F.H = (bf16*)(ws + WS_H); F.P = (bf16*)(ws + WS_P); F.LF = (float*)(ws + WS_LF); F.O = (bf16*)(ws + WS_O); F.U = (bf16*)(ws + WS_U);
    F.MOD = (float*)(ws + WS_MOD); F.LB = (float*)(ws + WS_LB); F.RC = (float*)(ws + WS_ROPE); F.RS = F.RC + SEQ * 128;
    volatile LAS unsigned* MISC = (volatile LAS unsigned*)(F.lds + MISC_OFF);
    if (threadIdx.x < 64) MISC[threadIdx.x] = 0u;
    __syncthreads();
#ifndef NO_XCC_REMAP
    if (threadIdx.x == 0) { const unsigned x = xb_xcc_id() & 7u; MISC[16] = x; MISC[17] = xb_add(F.ctl + CW_XRANK + 64 * x, 1u); }
#endif
    const int lo = args.ph_lo, hi = args.ph_hi;
    XcdBarrier bar; bar.bar = F.ctl + CW_BAR; bar.x = 0; bar.st = MISC + 8;
    if (hi - lo > 1) bar = xcd_barrier_post(F.ctl + CW_BAR, MISC + 8);
#define IN(k) (lo <= (k) && (k) < hi)
#ifdef PROBE_BAR2
#define SEAM(k) do { if (IN(k) && IN((k) + 1)) { xcd_barrier(bar); xcd_barrier(bar); } } while (0)
#else
#define SEAM(k) do { if (IN(k) && IN((k) + 1)) xcd_barrier(bar); } while (0)
#endif

    if (IN(PH_PRO)) {
#ifndef SKIP_PRO
 p0_prologue(F, 0);
#endif
#ifdef PROBE_PRO
 __syncthreads(); p0_prologue(F, 1);
#endif
 } SEAM(PH_PRO);
#ifndef NO_XCC_REMAP
    if (IN(PH_PRO) && IN(PH_PRO + 1) && (F.G & 7) == 0) {
        if (threadIdx.x == 0) { bool even = true; for (int j = 0; j < 8; ++j) even = even && (xb_ld(F.ctl + CW_XRANK + 64 * j) == (unsigned)(F.G >> 3)); MISC[18] = even ? (MISC[17] * 8u + MISC[16]) : (unsigned)blockIdx.x; }
        __syncthreads();
        F.wg = __builtin_amdgcn_readfirstlane((int)MISC[18]);
    }
#endif
    for (int l = 0; l < DEPTH; ++l) {
        const int pb = 1 + l * PH_PER_LAYER;
        const bool fz = (l >= FUSE_FROM) && (F.G > NGEMM);
        float* const RSS = (float*)(F.ctl + CW_RSS); float* const BIAS = (float*)(F.ctl + CW_BIAS); const float* const ACOL = (const float*)(F.ws + WS_ACOL);
        if (IN(pb + 0) && !fz) {
            if (l == 0) acol_fill(F);
            norm_prompt_rows<false>(F, l == 0 ? XSrc{F.x_prompt, nullptr} : XSrc{nullptr, F.X}, F.norm1_g + l * DM, l, 0);
            norm_sample_rows<false, false>(F, l == 0 ? XSrc{F.x_sample, nullptr} : XSrc{nullptr, F.X + (size_t)SEQ * DM}, F.norm1_g + l * DM, l, 0, l > 0 ? 8 : 0, l - 1, 5, nullptr);
        }
        if (!fz) SEAM(pb + 0);
        if (IN(pb + 1)) {
            unsigned* ctr = F.ctl + CW_SMP + 64 * (2 * l);
            if (fz) norm_sample_rows<false, true>(F, XSrc{nullptr, F.X + (size_t)SEQ * DM}, F.norm1_g + l * DM, l, 0, 8, l - 1, 5, ctr);
            const bool helpers = (CONV_PRO < DEPTH) && (l + 1 >= CONV_PRO) && (l + 1 < DEPTH) && (F.G > NGEMM);
            const int ng = helpers ? NGEMM : F.G;
#if defined(PROBE_DUP_IN) || defined(PROBE_DUP_IN3)
            for (int rep = 0; rep < 2; ++rep) { if (rep) xcd_barrier(bar);
#define REP0_IN (rep == 0)
#else
#define REP0_IN true
#endif
            if (F.wg < ng) {
                pg8::Gemm g{F.H, F.Win_t + (size_t)l * NPROJ * DM, M, NPROJ, DM};
                pg8::EpiInProj E{F.P, F.LF, F.LB + l * 1024, F.RC, F.RS, nullptr, fz ? RSS + (size_t)(2 * l) * 8192 : nullptr, BIAS + (size_t)(2 * l) * 8192};
#ifdef PROBE_DUP_IN3
                if (rep) { E.P = F.U; E.force_seg = PROBE_DUP_IN3; }
#endif
#ifdef USE_ALIGNED_ORDER
                if ((ng & 7) == 0) { pg8::XcdAlignedOrder S; S.init(DM, ng, F.wg); S.permute = 1; pg8::gemm_phase<pg8::EpiInProj, pg8::XcdAlignedOrder, true, true, 0>(F.lds + RING_OFF, g, S, E); } else
#endif
                { pg8::HookOrder S; S.init(M, NPROJ, DM, ng, F.wg); S.permute = 1; S.ready = fz ? ctr : nullptr; S.need = DECB * DECS; S.tmo = F.ctl + CW_TMO;
                pg8::gemm_phase<pg8::EpiInProj, pg8::HookOrder, true, true, 0>(F.lds + RING_OFF, g, S, E); }
            } else if (REP0_IN) { PHASE_IDS(); convert_layer(F, l + 1, wave, lane, 0, CV_SPLIT, 0); }
#if defined(PROBE_DUP_IN) || defined(PROBE_DUP_IN3)
            }
#endif
#ifdef PROBE_DUP_IN2
            xcd_barrier(bar);
            if (F.wg < ng) {
                pg8::Gemm g{F.H, F.Win_t + (size_t)l * NPROJ * DM, M, NPROJ, DM};
                pg8::EpiRelu2 E{F.U, DFF, nullptr, nullptr, BIAS};
                pg8::XcdAlignedOrder S; S.init(DM, ng, F.wg); S.permute = 1; pg8::gemm_phase<pg8::EpiRelu2, pg8::XcdAlignedOrder, true, true, 0>(F.lds + RING_OFF, g, S, E);
            }
#endif
#ifdef PROBE_HALFGRID
            xcd_barrier(bar);
            if (F.wg < PROBE_HALFGRID) {
                pg8::Gemm g{F.H, F.Win_t + (size_t)l * NPROJ * DM, M, NPROJ, DM};
                pg8::EpiInProj E{F.P, F.LF, F.LB + l * 1024, F.RC, F.RS, nullptr, fz ? RSS + (size_t)(2 * l) * 8192 : nullptr, BIAS + (size_t)(2 * l) * 8192};
                pg8::HookOrder S; S.init(M, NPROJ, DM, PROBE_HALFGRID, F.wg); S.permute = 1; S.ready = nullptr; S.need = 0; S.tmo = F.ctl + CW_TMO;
                pg8::gemm_phase<pg8::EpiInProj, pg8::HookOrder, true, true, 0>(F.lds + RING_OFF, g, S, E);
            }
#endif
        } SEAM(pb + 1);
#ifdef PROBE_REP_MIX
#define MIXREP(k_) for (int rep = 0; rep < ((PROBE_REP_MIX) == (k_) ? 2 : 1); ++rep)
#define MIXREPBAR() do { if (rep) xcd_barrier(bar); } while (0)
#else
#define MIXREP(k_)
#define MIXREPBAR() do { } while (0)
#endif
        if (IN(pb + 2)) { MIXREP(1) { MIXREPBAR(); mix1_phase(F, l, bar); } } SEAM(pb + 2);
        if (IN(pb + 3)) { MIXREP(2) { MIXREPBAR(); mix2_phase(F, l); } } SEAM(pb + 3);
        if (IN(pb + 4)) { MIXREP(3) { MIXREPBAR(); mix3_phase(F, l); } } SEAM(pb + 4);
        if (IN(pb + 5)) {
            pg8::Gemm g{F.O, F.Wout_t + (size_t)l * DM * DM, M, DM, DM}; pg8::ResidOrder S; S.init(DM, 8, F.G, F.wg);
            pg8::EpiResid E{F.X, F.MOD + (size_t)l * NMOD + 2 * DM, (float*)(F.ws + WS_SLAB), l == 0 ? F.x_prompt : nullptr, fz ? F.H : nullptr, ACOL + (size_t)(2 * l + 1) * DM, RSS + (size_t)(2 * l + 1) * 8192};
            pg8::gemm_phase<pg8::EpiResid, pg8::ResidOrder, true, true>(F.lds + RING_OFF, g, S, E);
        } SEAM(pb + 5);
        if (IN(pb + 6) && !fz) {
            norm_prompt_rows<false>(F, XSrc{nullptr, F.X}, F.norm2_g + l * DM, l, 3);
            norm_sample_rows<false, false>(F, l == 0 ? XSrc{F.x_sample, nullptr} : XSrc{nullptr, F.X + (size_t)SEQ * DM}, F.norm2_g + l * DM, l, 3, 8, l, 2, nullptr);
        }
        if (!fz) SEAM(pb + 6);
        if (IN(pb + 7)) {
            unsigned* ctr = F.ctl + CW_SMP + 64 * (2 * l + 1);
            if (fz) norm_sample_rows<false, true>(F, XSrc{nullptr, F.X + (size_t)SEQ * DM}, F.norm2_g + l * DM, l, 3, 8, l, 2, ctr);
            const bool helpers = (CONV_PRO < DEPTH) && (l + 1 >= CONV_PRO) && (l + 1 < DEPTH) && (F.G > NGEMM);
            const int ng = helpers ? NGEMM : F.G;
#ifdef PROBE_DUP_UP
            for (int rep = 0; rep < 2; ++rep) { if (rep) xcd_barrier(bar);
#define REP0_UP (rep == 0)
#else
#define REP0_UP true
#endif
            if (F.wg < ng) {
                pg8::Gemm g{F.H, F.Wup_t + (size_t)l * DFF * DM, M, DFF, DM};
                pg8::EpiRelu2 E{F.U, DFF, nullptr, fz ? RSS + (size_t)(2 * l + 1) * 8192 : nullptr, BIAS + (size_t)(2 * l + 1) * 8192};
#ifdef USE_ALIGNED_ORDER
                if ((ng & 7) == 0) { pg8::XcdAlignedOrder S; S.init(DM, ng, F.wg); pg8::gemm_phase<pg8::EpiRelu2, pg8::XcdAlignedOrder, true, true, 0>(F.lds + RING_OFF, g, S, E); } else
#endif
                { pg8::HookOrder S; S.init(M, DFF, DM, ng, F.wg); S.permute = 0; S.ready = fz ? ctr : nullptr; S.need = DECB * DECS; S.tmo = F.ctl + CW_TMO;
                pg8::gemm_phase<pg8::EpiRelu2, pg8::HookOrder, true, true, 0>(F.lds + RING_OFF, g, S, E); }
            } else if (REP0_UP) { PHASE_IDS(); convert_layer(F, l + 1, wave, lane, CV_SPLIT, CV_LAYER, 16); }
#ifdef PROBE_DUP_UP
            }
#endif
        } SEAM(pb + 7);
        if (IN(pb + 8)) {
            const bool fzn = (l + 1 < DEPTH) && (l + 1 >= FUSE_FROM) && (F.G > NGEMM);
            pg8::Gemm g{F.U, F.Wdn_t + (size_t)l * DM * DFF, M, DM, DFF}; pg8::ResidOrder S; S.init(DFF, 8, F.G, F.wg, 1);
            pg8::EpiResid E{F.X, F.MOD + (size_t)l * NMOD + 5 * DM, (float*)(F.ws + WS_SLAB), nullptr, fzn ? F.H : nullptr, ACOL + (size_t)(2 * (l + 1)) * DM, RSS + (size_t)(2 * (l + 1)) * 8192};
#ifdef PROBE_DUP_DOWN
            for (int rep = 0; rep < 2; ++rep) { if (rep) { xcd_barrier(bar); E.X = (half_t*)(F.ws + WS_END2 + 64 * MiB); E.slab = (float*)(F.ws + WS_END2 + 128 * MiB); }
#endif
            pg8::gemm_phase<pg8::EpiResid, pg8::ResidOrder, true, true>(F.lds + RING_OFF, g, S, E);
#ifdef PROBE_DUP_DOWN
            }
#endif
        } SEAM(pb + 8);
    }
    if (IN(PH_FINAL)) {
        norm_prompt_rows<true>(F, XSrc{nullptr, F.X}, F.final_g, DEPTH - 1, 0);
        norm_sample_rows<true, false>(F, XSrc{nullptr, F.X + (size_t)SEQ * DM}, F.final_g, DEPTH - 1, 0, 8, DEPTH - 1, 5, nullptr);
    }
#undef IN
#undef SEAM
}

#ifndef MK_ONE_LAUNCH
#define MK_ONE_LAUNCH 1
#endif
extern "C" void kernel_launch(void* const* d_in, const int* in_sizes, int n_in, void* d_out, int out_size, void* d_ws, size_t ws_size, hipStream_t stream) {
    static int grid = 0;
    if (grid == 0) {
        if (n_in != 18 || (size_t)out_size != OUT_TOTAL || ws_size < WS_END2) { fprintf(stderr, "kernel_launch: unexpected shapes: n_in %d out %d ws %zu (need %zu)\n", n_in, out_size, ws_size, (size_t)WS_END2); grid = -1; return; }
        int dev = 0, cus = 0, per_cu = 0;
        if (hipGetDevice(&dev) != hipSuccess || hipDeviceGetAttribute(&cus, hipDeviceAttributeMultiprocessorCount, dev) != hipSuccess) { grid = -1; return; }
        if (hipFuncSetAttribute((const void*)fwd, hipFuncAttributeMaxDynamicSharedMemorySize, LDS_BYTES) != hipSuccess) { fprintf(stderr, "kernel_launch: hipFuncSetAttribute failed\n"); grid = -1; return; }
        if (hipOccupancyMaxActiveBlocksPerMultiprocessor(&per_cu, (const void*)fwd, NWAVES * 64, LDS_BYTES) != hipSuccess || per_cu < 1)
            fprintf(stderr, "kernel_launch: note: occupancy query reports %d workgroups per CU\n", per_cu);
        (void)hipGetLastError();
        grid = cus;
    }
    if (grid < 0) return;
    if (hipMemsetAsync((char*)d_ws + WS_CTL, 0, CTL_ZERO_BYTES, stream) != hipSuccess) { fprintf(stderr, "kernel_launch: memset failed\n"); return; }
    Args a{};
    for (int i = 0; i < 18; ++i) a.in[i] = (const float*)d_in[i];
    a.out = (float*)d_out; a.ws = (unsigned char*)d_ws;
#if MK_ONE_LAUNCH
    a.ph_lo = 0; a.ph_hi = N_PHASES;
    hipLaunchKernelGGL(fwd, dim3(grid), dim3(NWAVES * 64), LDS_BYTES, stream, a);
#else
    for (int ph = 0; ph < N_PHASES; ++ph) {
        a.ph_lo = ph; a.ph_hi = ph + 1;
        hipLaunchKernelGGL(fwd, dim3(grid), dim3(NWAVES * 64), LDS_BYTES, stream, a);
    }
#endif
    const hipError_t le = hipPeekAtLastError();
    if (le != hipSuccess) fprintf(stderr, "kernel_launch: launch failed: %s\n", hipGetErrorName(le));
}
```
